# Optimizing an MI355X kernel written in HIP

```python
import math
import jax, jax.numpy as jnp
from jax import lax
import numpy as np

D_MODEL = 1024
BATCH = 32
SEQ = 2048
DEPTH = 2

N_A_LAYERS = DEPTH // 2
N_B_LAYERS = DEPTH - N_A_LAYERS
NORM_EPS = 1e-6

RWKV_HEAD = 64
RWKV_HEADS = D_MODEL // RWKV_HEAD
RWKV_DECAY_LORA = 64
RWKV_AAA_LORA = 64
RWKV_GATE_LORA = 160
RWKV_GN_EPS = 64e-5

NSA_HEADS = 16
NSA_KV_GROUPS = 4
NSA_HPG = NSA_HEADS // NSA_KV_GROUPS
NSA_HEAD_DIM = D_MODEL // NSA_HEADS
NSA_KV_PARTS = 6
CMP_BLOCK = 32
CMP_STRIDE = 16
CMP_HIDDEN = 256
SEL_BLOCK = 64
SEL_TOPK = 8
WINDOW = 512
Q_CHUNK = 32
N_BRANCH = 3
IMP_FORCE = 1e4

REL_BUCKETS = 32
REL_MAX_DIST = 128

MOE_GROUPS = 4
MOE_EXPERTS_PER_GROUP = 8
MOE_EXPERTS = MOE_GROUPS * MOE_EXPERTS_PER_GROUP
MOE_TOPK = 2
MOE_HIDDEN = 512
MOE_BLOCK = 128

kernel_name = 'hybrid_rwkv7_nsa_hmoe_yoco'


def rms_norm(x, g):
    xf = x.astype(jnp.float32)
    y = xf * lax.rsqrt(jnp.mean(xf * xf, axis=-1, keepdims=True) + NORM_EPS)
    return (y * g.astype(jnp.float32)).astype(x.dtype)


def rel_bucket(dist):
    n = jnp.maximum(dist, 0)
    max_exact = REL_BUCKETS // 2
    nf = jnp.maximum(n, 1).astype(jnp.float32)
    large = max_exact + (jnp.log(nf / max_exact) / math.log(REL_MAX_DIST / max_exact)
                         * (REL_BUCKETS - max_exact)).astype(jnp.int32)
    large = jnp.minimum(large, REL_BUCKETS - 1)
    return jnp.where(n < max_exact, n, large)


def masked_softmax(logits, mask):
    logits = jnp.where(mask, logits, -1e30)
    m = jnp.max(logits, axis=-1, keepdims=True)
    p = jnp.exp(logits - m) * mask
    return p / jnp.maximum(jnp.sum(p, axis=-1, keepdims=True), 1e-30)


def rwkv7_time_mix(x, mu, w_r, w_k, w_v, w_o, w0, w1, w2, a0, a1, a2, g1, g2,
                   k_k, k_a, r_k, lnx_w, lnx_b):
    b, t, c = x.shape
    f32 = jnp.float32
    hshape = (b, t, RWKV_HEADS, RWKV_HEAD)
    xx = jnp.pad(x, ((0, 0), (1, 0), (0, 0)))[:, :-1] - x
    xr, xw, xk, xv, xa, xg = (x + xx * mu[i] for i in range(6))
    r = xr @ w_r
    k = xk @ w_k
    v = xv @ w_v
    w = -jax.nn.softplus(-(w0 + jnp.tanh(xw @ w1) @ w2)) - 0.5
    a = jax.nn.sigmoid(a0 + (xa @ a1) @ a2)
    g = jax.nn.sigmoid(xg @ g1) @ g2
    kk = (k * k_k).reshape(hshape).astype(f32)
    kk = kk * lax.rsqrt(jnp.maximum(jnp.sum(kk * kk, -1, keepdims=True), 1e-24))
    k = k * (1.0 + (a - 1.0) * k_a)
    decay = jnp.exp(-jnp.exp(w.astype(f32)))
    r_h = r.reshape(hshape).astype(f32)
    k_h = k.reshape(hshape).astype(f32)
    v_h = v.reshape(hshape).astype(f32)
    a_h = a.reshape(hshape).astype(f32)

    def to_time(z):
        return jnp.moveaxis(z.reshape(hshape).astype(f32), 1, 0)

    xs = (to_time(r_h), to_time(decay), to_time(k_h), to_time(v_h),
          to_time(-kk), to_time(kk * a_h))

    def step(state, inp):
        r_t, w_t, k_t, v_t, a_t, b_t = inp
        sa = jnp.einsum('bhij,bhj->bhi', state, a_t)
        state = (state * w_t[:, :, None, :] + sa[..., None] * b_t[:, :, None, :]
                 + v_t[..., None] * k_t[:, :, None, :])
        return state, jnp.einsum('bhij,bhj->bhi', state, r_t)

    s0 = jnp.zeros((b, RWKV_HEADS, RWKV_HEAD, RWKV_HEAD), f32)
    _, y = lax.scan(step, s0, xs)
    y = jnp.moveaxis(y, 0, 1)
    mean = jnp.mean(y, -1, keepdims=True)
    var = jnp.mean(jnp.square(y - mean), -1, keepdims=True)
    y = ((y - mean) * lax.rsqrt(var + RWKV_GN_EPS)).reshape(b, t, c)
    y = y * lnx_w.astype(f32) + lnx_b.astype(f32)
    bonus = jnp.sum(r_h * k_h * r_k.astype(f32), -1, keepdims=True) * v_h
    y = y + bonus.reshape(b, t, c)
    return (y * g.astype(f32)).astype(x.dtype) @ w_o


def nsa_shared_kv(h, kv_ln, kv_w, cmp_pe_k, cmp_pe_v, cmp_k_w1, cmp_k_w2, cmp_v_w1, cmp_v_w2):
    b, t, _ = h.shape
    G, dh = NSA_KV_GROUPS, NSA_HEAD_DIM
    hn = rms_norm(h, kv_ln)
    kv = (hn @ kv_w).reshape(b, t, NSA_KV_PARTS, G, dh)
    kv = jnp.moveaxis(kv, 1, 3)
    k_cr, v_cr, k_sel, v_sel, k_win, v_win = (kv[:, i] for i in range(NSA_KV_PARTS))
    n_cmp = (t - CMP_BLOCK) // CMP_STRIDE + 1
    blk_idx = jnp.arange(n_cmp)[:, None] * CMP_STRIDE + jnp.arange(CMP_BLOCK)[None, :]

    def compress(z, pe, w1, w2):
        zb = z[:, :, blk_idx] + pe[:, None]
        zb = zb.reshape(b, G, n_cmp, CMP_BLOCK * dh)
        return jax.nn.gelu(zb @ w1) @ w2

    k_cmp = compress(k_cr, cmp_pe_k, cmp_k_w1, cmp_k_w2)
    v_cmp = compress(v_cr, cmp_pe_v, cmp_v_w1, cmp_v_w2)
    n_sel = t // SEL_BLOCK
    k_sel = k_sel.reshape(b, G, n_sel, SEL_BLOCK, dh)
    v_sel = v_sel.reshape(b, G, n_sel, SEL_BLOCK, dh)
    return k_cmp, v_cmp, k_sel, v_sel, k_win, v_win


def nsa_attention(hn, w_qg, w_o, rel_bias, k_cmp, v_cmp, k_sel, v_sel, k_win, v_win):
    b, t, _ = hn.shape
    f32 = jnp.float32
    G, HPG, dh = NSA_KV_GROUPS, NSA_HPG, NSA_HEAD_DIM
    qg = hn @ w_qg
    q = qg[..., :NSA_HEADS * dh].reshape(b, t, G, HPG, dh).transpose(0, 2, 3, 1, 4)
    gates = jax.nn.sigmoid(qg[..., NSA_HEADS * dh:].astype(f32))
    gates = gates.reshape(b, t, G, HPG, N_BRANCH).transpose(0, 2, 3, 1, 4)
    table = rel_bias.astype(f32).reshape(REL_BUCKETS, G, HPG).transpose(1, 2, 0)
    n_cmp = k_cmp.shape[2]
    n_sel = k_sel.shape[2]
    topk = min(SEL_TOPK, n_sel)
    cmp_start = jnp.arange(n_cmp) * CMP_STRIDE
    cmp_end = cmp_start + CMP_BLOCK - 1
    sel_start = jnp.arange(n_sel) * SEL_BLOCK
    overlap = ((cmp_start[:, None] < sel_start[None, :] + SEL_BLOCK)
               & (cmp_start[:, None] + CMP_BLOCK > sel_start[None, :])).astype(f32)
    k_win_p = jnp.pad(k_win, ((0, 0), (0, 0), (WINDOW, 0), (0, 0)))
    v_win_p = jnp.pad(v_win, ((0, 0), (0, 0), (WINDOW, 0), (0, 0)))
    scale = NSA_HEAD_DIM ** -0.5
    g_idx = jnp.arange(G)[None, :, None, None, None]
    h_idx = jnp.arange(HPG)[None, None, :, None, None]
    gather_blocks = jax.vmap(jax.vmap(lambda blocks, ix: blocks[ix]))

    def chunk(c):
        t0 = c * Q_CHUNK
        tq = t0 + jnp.arange(Q_CHUNK)
        qc = lax.dynamic_slice_in_dim(q, t0, Q_CHUNK, axis=3)
        gc = lax.dynamic_slice_in_dim(gates, t0, Q_CHUNK, axis=3)
        lc = (jnp.einsum('bghqd,bgkd->bghqk', qc, k_cmp).astype(f32) * scale
              + table[:, :, rel_bucket(tq[:, None] - cmp_end[None, :])])
        pc = masked_softmax(lc, cmp_end[None, :] <= tq[:, None])
        oc = jnp.einsum('bghqk,bgkd->bghqd', pc.astype(v_cmp.dtype), v_cmp)
        imp = jnp.einsum('bghqk,kj->bgqj', pc, overlap)
        blk_q = (tq // SEL_BLOCK)[:, None]
        jj = jnp.arange(n_sel)[None, :]
        forced = (jj == 0) | (jj == blk_q) | (jj == blk_q - 1)
        score = jnp.where(forced, IMP_FORCE, jnp.where(jj <= blk_q, imp, -1.0))
        _, idx = lax.top_k(score, topk)
        ks = gather_blocks(k_sel, idx).reshape(b, G, Q_CHUNK, topk * SEL_BLOCK, dh)
        vs = gather_blocks(v_sel, idx).reshape(b, G, Q_CHUNK, topk * SEL_BLOCK, dh)
        pos = (idx[..., None] * SEL_BLOCK + jnp.arange(SEL_BLOCK)).reshape(b, G, Q_CHUNK, topk * SEL_BLOCK)
        bias_s = table[g_idx, h_idx, rel_bucket(tq[:, None] - pos)[:, :, None]]
        ls = jnp.einsum('bghqd,bgqkd->bghqk', qc, ks).astype(f32) * scale + bias_s
        ps = masked_softmax(ls, (pos <= tq[:, None])[:, :, None])
        o_sel = jnp.einsum('bghqk,bgqkd->bghqd', ps.astype(vs.dtype), vs)
        kw = lax.dynamic_slice_in_dim(k_win_p, t0, WINDOW + Q_CHUNK, axis=2)
        vw = lax.dynamic_slice_in_dim(v_win_p, t0, WINDOW + Q_CHUNK, axis=2)
        kp = t0 - WINDOW + jnp.arange(WINDOW + Q_CHUNK)
        dist = tq[:, None] - kp[None, :]
        mask_w = (dist >= 0) & (dist < WINDOW) & (kp[None, :] >= 0)
        lw = (jnp.einsum('bghqd,bgkd->bghqk', qc, kw).astype(f32) * scale
              + table[:, :, rel_bucket(dist)])
        pw = masked_softmax(lw, mask_w)
        ow = jnp.einsum('bghqk,bgkd->bghqd', pw.astype(vw.dtype), vw)
        out = gc[..., 0:1] * oc + gc[..., 1:2] * o_sel + gc[..., 2:3] * ow
        return out.astype(hn.dtype)

    o = lax.map(chunk, jnp.arange(t // Q_CHUNK))
    o = o.transpose(1, 0, 4, 2, 3, 5).reshape(b, t, NSA_HEADS * dh)
    return o @ w_o


def hier_moe(h, ln_g, w_gr, b_gr, w_er, b_er, w1, w3, w2):
    bt, t, c = h.shape
    n = bt * t
    f32 = jnp.float32
    xf = rms_norm(h, ln_g).reshape(n, c)
    gp = jax.nn.softmax((xf @ w_gr).astype(f32) + b_gr.astype(f32), axis=-1)
    grp_w, grp = lax.top_k(gp, 1)
    el = ((xf @ w_er).astype(f32) + b_er.astype(f32)).reshape(n, MOE_GROUPS, MOE_EXPERTS_PER_GROUP)
    el = jnp.take_along_axis(el, grp[:, :, None], axis=1)[:, 0]
    ew, ei = lax.top_k(jax.nn.softmax(el, axis=-1), MOE_TOPK)
    weight = grp_w * ew / jnp.sum(ew, -1, keepdims=True)
    expert = grp * MOE_EXPERTS_PER_GROUP + ei
    n_as = n * MOE_TOPK
    flat_e = expert.reshape(n_as)
    flat_t = jnp.repeat(jnp.arange(n), MOE_TOPK)
    flat_w = weight.reshape(n_as)
    order = jnp.argsort(flat_e)
    se, st, sw = flat_e[order], flat_t[order], flat_w[order]
    counts = jnp.bincount(flat_e, length=MOE_EXPERTS)
    starts = jnp.cumsum(counts) - counts
    pcounts = (counts + MOE_BLOCK - 1) // MOE_BLOCK * MOE_BLOCK
    pend = jnp.cumsum(pcounts)
    pstarts = pend - pcounts
    dest = pstarts[se] + jnp.arange(n_as) - starts[se]
    p = n_as + MOE_EXPERTS * MOE_BLOCK
    n_blk = p // MOE_BLOCK
    buf_t = jnp.zeros((p,), jnp.int32).at[dest].set(st)
    buf_w = jnp.zeros((p,), f32).at[dest].set(sw)
    blk_e = jnp.clip(jnp.searchsorted(pend, jnp.arange(n_blk) * MOE_BLOCK, side='right'), 0, MOE_EXPERTS - 1)
    xbuf = xf[buf_t].reshape(n_blk, MOE_BLOCK, c)

    def expert_block(args):
        xb, e = args
        return (jax.nn.silu(xb @ w1[e]) * (xb @ w3[e])) @ w2[e]

    yb = lax.map(expert_block, (xbuf, blk_e)).reshape(p, c)
    y = jnp.zeros((n, c), yb.dtype).at[buf_t].add(yb * buf_w[:, None].astype(yb.dtype))
    return y.reshape(bt, t, c)


def setup_inputs(seed: int = 0) -> dict:
    key = jax.random.key(seed)
    ks = iter(jax.random.split(key, 64))
    f32 = jnp.float32
    D = D_MODEL
    NA, NB = N_A_LAYERS, N_B_LAYERS
    G, dh, H = NSA_KV_GROUPS, NSA_HEAD_DIM, NSA_HEADS

    def nrm(shape, scale):
        return jax.random.normal(next(ks), shape, f32) * scale

    def gain(shape):
        return 1.0 + nrm(shape, 0.05)

    frac = jnp.arange(D, dtype=f32) / (D - 1)
    inp = {}
    inp['x'] = nrm((BATCH, SEQ, D), 1.0)
    inp['a_ln'] = gain((NA, D))
    inp['a_mu'] = jax.random.uniform(next(ks), (NA, 6, D), f32)
    inp['a_wr'] = nrm((NA, D, D), D ** -0.5)
    inp['a_wk'] = nrm((NA, D, D), D ** -0.5)
    inp['a_wv'] = nrm((NA, D, D), D ** -0.5)
    inp['a_wo'] = nrm((NA, D, D), D ** -0.5)
    inp['a_w0'] = (-6.5 + 5.0 * frac ** 0.85)[None] + nrm((NA, D), 0.1)
    inp['a_w1'] = nrm((NA, D, RWKV_DECAY_LORA), D ** -0.5)
    inp['a_w2'] = nrm((NA, RWKV_DECAY_LORA, D), 0.1 * RWKV_DECAY_LORA ** -0.5)
    inp['a_a0'] = nrm((NA, D), 0.1)
    inp['a_a1'] = nrm((NA, D, RWKV_AAA_LORA), D ** -0.5)
    inp['a_a2'] = nrm((NA, RWKV_AAA_LORA, D), 0.5 * RWKV_AAA_LORA ** -0.5)
    inp['a_g1'] = nrm((NA, D, RWKV_GATE_LORA), D ** -0.5)
    inp['a_g2'] = nrm((NA, RWKV_GATE_LORA, D), RWKV_GATE_LORA ** -0.5)
    inp['a_kk'] = 0.85 + nrm((NA, D), 0.05)
    inp['a_ka'] = gain((NA, D))
    inp['a_rk'] = nrm((NA, RWKV_HEADS, RWKV_HEAD), 0.1)
    inp['a_lnx_w'] = gain((NA, D))
    inp['a_lnx_b'] = nrm((NA, D), 0.01)
    inp['kv_ln'] = gain((D,))
    inp['kv_w'] = nrm((D, NSA_KV_PARTS * G * dh), D ** -0.5)
    inp['cmp_pe_k'] = nrm((G, CMP_BLOCK, dh), 0.5)
    inp['cmp_pe_v'] = nrm((G, CMP_BLOCK, dh), 0.5)
    inp['cmp_k_w1'] = nrm((CMP_BLOCK * dh, CMP_HIDDEN), (CMP_BLOCK * dh) ** -0.5)
    inp['cmp_k_w2'] = nrm((CMP_HIDDEN, dh), CMP_HIDDEN ** -0.5)
    inp['cmp_v_w1'] = nrm((CMP_BLOCK * dh, CMP_HIDDEN), (CMP_BLOCK * dh) ** -0.5)
    inp['cmp_v_w2'] = nrm((CMP_HIDDEN, dh), CMP_HIDDEN ** -0.5)
    inp['rel_bias'] = nrm((REL_BUCKETS, H), 0.5)
    inp['b_ln'] = gain((NB, D))
    inp['b_wqg'] = nrm((NB, D, H * dh + N_BRANCH * H), D ** -0.5)
    inp['b_wo'] = nrm((NB, H * dh, D), (H * dh) ** -0.5)
    inp['m_ln'] = gain((DEPTH, D))
    inp['m_wg'] = nrm((DEPTH, D, MOE_GROUPS), D ** -0.5)
    inp['m_bg'] = nrm((DEPTH, MOE_GROUPS), 0.01)
    inp['m_we'] = nrm((DEPTH, D, MOE_EXPERTS), D ** -0.5)
    inp['m_be'] = nrm((DEPTH, MOE_EXPERTS), 0.01)
    inp['m_w1'] = nrm((DEPTH, MOE_EXPERTS, D, MOE_HIDDEN), D ** -0.5)
    inp['m_w3'] = nrm((DEPTH, MOE_EXPERTS, D, MOE_HIDDEN), D ** -0.5)
    inp['m_w2'] = nrm((DEPTH, MOE_EXPERTS, MOE_HIDDEN, D), MOE_HIDDEN ** -0.5)
    inp['final_ln'] = gain((D,))
    return inp


def reference(x, a_ln, a_mu, a_wr, a_wk, a_wv, a_wo, a_w0, a_w1, a_w2, a_a0, a_a1, a_a2,
              a_g1, a_g2, a_kk, a_ka, a_rk, a_lnx_w, a_lnx_b,
              kv_ln, kv_w, cmp_pe_k, cmp_pe_v, cmp_k_w1, cmp_k_w2, cmp_v_w1, cmp_v_w2,
              rel_bias, b_ln, b_wqg, b_wo,
              m_ln, m_wg, m_bg, m_we, m_be, m_w1, m_w3, m_w2, final_ln):
    h = x
    shared = None
    for layer in range(DEPTH):
        if layer < N_A_LAYERS:
            i = layer
            h = h + rwkv7_time_mix(rms_norm(h, a_ln[i]), a_mu[i], a_wr[i], a_wk[i], a_wv[i], a_wo[i],
                                   a_w0[i], a_w1[i], a_w2[i], a_a0[i], a_a1[i], a_a2[i],
                                   a_g1[i], a_g2[i], a_kk[i], a_ka[i], a_rk[i], a_lnx_w[i], a_lnx_b[i])
        else:
            j = layer - N_A_LAYERS
            if j == 0:
                shared = nsa_shared_kv(h, kv_ln, kv_w, cmp_pe_k, cmp_pe_v,
                                       cmp_k_w1, cmp_k_w2, cmp_v_w1, cmp_v_w2)
            k_cmp, v_cmp, k_sel, v_sel, k_win, v_win = shared
            h = h + nsa_attention(rms_norm(h, b_ln[j]), b_wqg[j], b_wo[j], rel_bias,
                                  k_cmp, v_cmp, k_sel, v_sel, k_win, v_win)
        h = h + hier_moe(h, m_ln[layer], m_wg[layer], m_bg[layer], m_we[layer], m_be[layer],
                         m_w1[layer], m_w3[layer], m_w2[layer])
    return rms_norm(h, final_ln)
```

```cpp
#include <hip/hip_runtime.h>
#include <cstdio>
#include <cstdint>

#define GAS __attribute__((address_space(1)))
#define LAS __attribute__((address_space(3)))
typedef unsigned short bf16_t;
typedef short bf16x8 __attribute__((ext_vector_type(8)));
typedef float f32x4 __attribute__((ext_vector_type(4)));
typedef float f32x2 __attribute__((ext_vector_type(2)));
typedef unsigned u32x4 __attribute__((ext_vector_type(4)));
typedef unsigned u32x2 __attribute__((ext_vector_type(2)));

#ifndef N_LAUNCH_MODE
#define N_LAUNCH_MODE 1
#endif

constexpr int NT = 65536, DM = 1024, SEQ = 2048, NB = 32;
constexpr int P_MAX = 139264;
constexpr size_t MiB = 1u << 20;
constexpr size_t WS_CTL = 0, CTL_BYTES = 1 * MiB;
constexpr size_t WS_RFRAG = 1 * MiB;
constexpr size_t WS_W2F = 3 * MiB;
constexpr size_t WS_CIDX = 3 * MiB + 256 * 1024;
constexpr size_t WS_PEBP = 3 * MiB + 512 * 1024;
constexpr size_t WS_TEXP = 2 * MiB;
constexpr size_t WS_WR = 8 * MiB, WS_WK = 10 * MiB, WS_WV = 12 * MiB, WS_WO = 14 * MiB;
constexpr size_t WS_WL1 = 16 * MiB;
constexpr size_t WS_W2WA = 18 * MiB;
constexpr size_t WS_W2G = 19 * MiB;
constexpr size_t WS_WKVQG = 20 * MiB;
constexpr size_t WS_WOB = 26 * MiB;
constexpr size_t WS_WC1 = 28 * MiB;
constexpr size_t WS_BT1 = 32 * MiB;
constexpr size_t WS_BT2 = 160 * MiB;
constexpr size_t WS_S0 = 224 * MiB, WS_S1 = 352 * MiB, WS_S2 = 480 * MiB, WS_S3 = 608 * MiB, WS_S4 = 736 * MiB, WS_S5 = 864 * MiB;
constexpr size_t WS_GATES = 993 * MiB;
constexpr size_t WS_ASG = 1014 * MiB;
constexpr size_t WS_ROWW = 1016 * MiB;
constexpr size_t WS_RIDX = 1017 * MiB;
constexpr size_t WS_RSTD = 1018 * MiB;
constexpr size_t WS_ROWRS = 1019 * MiB;
constexpr size_t WS_H = WS_S0;
constexpr size_t WS_NEED = 1024 * MiB;
constexpr size_t WS_KV = 352 * MiB, WS_Q = 544 * MiB, WS_ACMP = 672 * MiB, WS_HC = 800 * MiB, WS_OATT = 816 * MiB;
constexpr size_t WS_KCB = 1006 * MiB, WS_VCT = 1008 * MiB;
constexpr int CW_BAR = 4096;
constexpr int CW_CNT = 16384;

typedef __bf16 bf16x2n __attribute__((ext_vector_type(2)));
__device__ __forceinline__ unsigned cvtpk(float lo, float hi) { const f32x2 v = {lo, hi}; return __builtin_bit_cast(unsigned, __builtin_convertvector(v, bf16x2n)); }
__device__ __forceinline__ unsigned f2bf(float f) { return cvtpk(f, f) & 0xffffu; }
__device__ __forceinline__ unsigned pk2(float lo, float hi) { return cvtpk(lo, hi); }
__device__ __forceinline__ float bflo(unsigned u) { return __builtin_bit_cast(float, u << 16); }
__device__ __forceinline__ float bfhi(unsigned u) { return __builtin_bit_cast(float, u & 0xffff0000u); }
__device__ __forceinline__ float bf2f(bf16_t b) { return __builtin_bit_cast(float, ((unsigned)b) << 16); }
template <int CTRL> __device__ __forceinline__ float dppf(float v) { return __int_as_float(__builtin_amdgcn_update_dpp(0, __float_as_int(v), CTRL, 0xf, 0xf, true)); }
#define DPP_XOR1 0xB1
#define DPP_XOR2 0x4E
#define DPP_HALF_MIRROR 0x141
#define DPP_MIRROR 0x140
#define DPP_ROR8 0x128
__device__ __forceinline__ float wave_sum(float v) {
    v += dppf<DPP_XOR1>(v); v += dppf<DPP_XOR2>(v); v += dppf<DPP_HALF_MIRROR>(v); v += dppf<DPP_MIRROR>(v);
    { const auto r = __builtin_amdgcn_permlane16_swap(__float_as_uint(v), __float_as_uint(v), false, false); v = __uint_as_float(r[0]) + __uint_as_float(r[1]); }
    { const auto r = __builtin_amdgcn_permlane32_swap(__float_as_uint(v), __float_as_uint(v), false, false); v = __uint_as_float(r[0]) + __uint_as_float(r[1]); }
    return v;
}
__device__ __forceinline__ float fexp_(float x) { return __builtin_amdgcn_exp2f(x * 1.44269504089f); }
__device__ __forceinline__ float sigmoidf_(float x) { return __builtin_amdgcn_rcpf(1.f + fexp_(-x)); }
__device__ __forceinline__ float tanhf_(float x) { return 1.f - 2.f * __builtin_amdgcn_rcpf(1.f + fexp_(2.f * x)); }
__device__ __forceinline__ float gelu_tanh_(float x) { return 0.5f * x * (1.f + tanhf_(0.7978845608f * (x + 0.044715f * x * x * x))); }
#define LDS_WAIT() asm volatile("s_waitcnt lgkmcnt(0)" ::: "memory")

__device__ const unsigned char BKT[129] = {0, 1, 2, 3, 4, 5, 6, 7, 8, 9, 10, 11, 12, 13, 14, 15, 16, 16, 16, 17, 17, 18, 18, 18, 19, 19, 19, 20, 20, 20, 20, 21, 21, 21, 21, 22, 22, 22, 22, 22, 23, 23, 23, 23, 23, 23, 24, 24, 24, 24, 24, 24, 25, 25, 25, 25, 25, 25, 25, 26, 26, 26, 26, 26, 26, 26, 26, 27, 27, 27, 27, 27, 27, 27, 27, 27, 27, 28, 28, 28, 28, 28, 28, 28, 28, 28, 28, 29, 29, 29, 29, 29, 29, 29, 29, 29, 29, 29, 29, 30, 30, 30, 30, 30, 30, 30, 30, 30, 30, 30, 30, 30, 30, 31, 31, 31, 31, 31, 31, 31, 31, 31, 31, 31, 31, 31, 31, 31, 31};

#define XB_TMO      128
#define XB_XCNT(j)  (256  + 64 * (j))
#define XB_XSUB(j)  (1280 + 64 * (j))
#define XB_XGEN(j)  (2304 + 64 * (j))
#define XB_TOP      3328
#define XB_TOPGEN   3392
#define XCD_BAR_WORDS 3456
#define XB_SPIN_CAP (1u << 22)
__device__ __forceinline__ unsigned xb_ld(unsigned* p)              { return __hip_atomic_load(p, __ATOMIC_RELAXED, __HIP_MEMORY_SCOPE_AGENT); }
__device__ __forceinline__ unsigned xb_add(unsigned* p, unsigned v) { return __hip_atomic_fetch_add(p, v, __ATOMIC_RELAXED, __HIP_MEMORY_SCOPE_AGENT); }
__device__ __forceinline__ unsigned xb_xcc_id() { return (unsigned)__builtin_amdgcn_s_getreg((3 << 11) | 20) & 0xFu; }
#define XB_SPIN(cond, bar) do { unsigned _sp = 0; while (cond) { __builtin_amdgcn_s_sleep(1); \
    if ((++_sp & 255u) == 0u) { if (xb_ld(&(bar)[XB_TMO])) break; if (_sp > XB_SPIN_CAP) { atomicAdd(&(bar)[XB_TMO], 1u); break; } } } } while (0)
struct XcdBarrier { unsigned* bar; unsigned x; volatile LAS unsigned* st; };
__device__ __forceinline__ XcdBarrier xcd_barrier_post(unsigned* bar, volatile LAS unsigned* st) {
    XcdBarrier b; b.bar = bar; b.x = xb_xcc_id(); b.st = st;
    if (threadIdx.x == 0) (void)xb_add(&bar[XB_XCNT(b.x)], 1u);
    return b;
}
__device__ __forceinline__ void xcd_barrier_complete(unsigned* bar, unsigned x, unsigned& nloc, unsigned& nx) {
    const unsigned G = gridDim.x * gridDim.y * gridDim.z;
    unsigned sum, cnt, mine, sp = 0u;
    for (;;) {
        sum = 0u; cnt = 0u; mine = 0u;
#pragma unroll
        for (unsigned j = 0; j < 16; ++j) { const unsigned c = xb_ld(&bar[XB_XCNT(j)]); sum += c; cnt += (c > 0u) ? 1u : 0u; mine = (j == x) ? c : mine; }
        if (sum == G) break;
        __builtin_amdgcn_s_sleep(1);
        if ((++sp & 255u) == 0u) { if (xb_ld(&bar[XB_TMO])) break; if (sp > XB_SPIN_CAP) { atomicAdd(&bar[XB_TMO], 1u); break; } }
    }
    nloc = mine > 0u ? mine : 1u; nx = cnt > 0u ? cnt : 1u;
}
__device__ __forceinline__ void xcd_barrier(const XcdBarrier& b) {
    asm volatile("s_waitcnt vmcnt(0)" ::: "memory");
    __syncthreads();
    if (threadIdx.x == 0) {
        unsigned* bar = b.bar;
        __builtin_amdgcn_s_waitcnt(0);
        unsigned nloc = b.st[0], nx = b.st[1];
        if (nloc == 0u) { xcd_barrier_complete(bar, b.x, nloc, nx); b.st[0] = nloc; b.st[1] = nx; }
        const unsigned old = xb_add(&bar[XB_XSUB(b.x)], 1u);
        const unsigned gen = old / nloc;
        if (old + 1u == (gen + 1u) * nloc) {
            __builtin_amdgcn_fence(__ATOMIC_RELEASE, "agent");
            asm volatile("s_waitcnt vmcnt(0)" ::: "memory");
            const unsigned og = xb_add(&bar[XB_TOP], 1u);
            const unsigned tg = og / nx;
            if (og + 1u == (tg + 1u) * nx) xb_add(&bar[XB_TOPGEN], 1u);
            else XB_SPIN(xb_ld(&bar[XB_TOPGEN]) == tg, bar);
            __builtin_amdgcn_fence(__ATOMIC_ACQUIRE, "agent");
            xb_add(&bar[XB_XGEN(b.x)], 1u);
            asm volatile("s_waitcnt vmcnt(0)" ::: "memory");
        } else {
            XB_SPIN(xb_ld(&bar[XB_XGEN(b.x)]) == gen, bar);
            __builtin_amdgcn_fence(__ATOMIC_ACQUIRE, "agent");
            asm volatile("s_waitcnt vmcnt(0)" ::: "memory");
        }
    }
    __syncthreads();
}

namespace pg8 {
constexpr int BM = 256, BK = 64, HALF = 128, HTB = HALF * BK * 2, STAGE_BYTES = 8 * HTB, NXCD = 8, WGM = 8;
__host__ __device__ __forceinline__ int lds_byte(int r, int c) { const int st = (r >> 4) * 2 + (c >> 5), rr = r & 15, cc = c & 31, ob = rr * 64 + cc * 2; return st * 1024 + (ob ^ (((ob >> 9) & 1) << 5)); }
__host__ __device__ __forceinline__ void stage_rc(int b, int& R, int& C) { const int st = b / 1024, sb = b % 1024, swz = sb ^ (((sb >> 9) & 1) << 5); R = (st >> 1) * 16 + swz / 64; C = (st & 1) * 32 + (swz % 64) / 2; }
__host__ __device__ __forceinline__ int perm32(int rho) { const int n = rho >> 4, i = rho & 15; return 8 * (i >> 2) + 4 * n + (i & 3); }
struct Unit { int pm, pn; };
struct Gemm { const bf16_t* A; const bf16_t* Bt; int K, lda, apad, kwrap; const int* gidx; int ahm; };
struct StaticOrder {
    int nM, nN, nwg, G, c;
    __device__ void init(int M, int N, int G_, int c_) { nM = M / BM; nN = N / BM; nwg = nM * nN; G = G_; c = c_; }
    __device__ bool next(int i, Unit& u) const {
        const long L = (long)i * G + c; if (L >= nwg) return false;
        int wgid = (int)L; { const int q = nwg / NXCD, r = nwg % NXCD, xcd = wgid % NXCD, off = wgid / NXCD; wgid = (xcd < r ? xcd * (q + 1) : r * (q + 1) + (xcd - r) * q) + off; }
        const int nig = WGM * nN, gid = wgid / nig, fm = gid * WGM, gsz = (nM - fm) < WGM ? (nM - fm) : WGM;
        u.pm = fm + ((wgid % nig) % gsz); u.pn = (wgid % nig) / gsz; return true;
    }
};
struct MoeOrder {
    const int* xl; int nunits, ncu, cu; mutable int pre;
    __device__ __forceinline__ void init(const int* texp, int G_, int c_) { const int x = c_ & 7; cu = c_ >> 3; ncu = G_ >> 3; xl = texp + 2048 + x * 640; nunits = texp[1008 + x] * 4; pre = (cu < nunits) ? xl[cu >> 2] : 0; }
    __device__ __forceinline__ bool next(int i, Unit& u) const {
        const int L = i * ncu + cu; if (L >= nunits) return false;
        const int ent = pre; u.pm = ent & 0xffff; u.pn = (ent >> 16) * 4 + (L & 3);
        const int L2 = L + ncu; pre = (L2 < nunits) ? xl[L2 >> 2] : 0; return true;
    }
};
struct CmpOrder {
    int G, c;
    __device__ bool next(int i, Unit& u) const { const long L = (long)i * G + c; if (L >= 128) return false; u.pm = (int)L; u.pn = (int)(L >> 6); return true; }
};

template <class Epi, class Sched, bool GATHER = false, bool ALIGN_EPI = true, bool SP2 = true>
__device__ __forceinline__ void gemm_phase(LAS unsigned char* lds, const Gemm g, const Sched& S, const Epi& E) {
    const int tid = threadIdx.x, wid = __builtin_amdgcn_readfirstlane(tid >> 6), lane = tid & 63, wr = wid >> 2, wc = wid & 3, fr = lane & 15, fq = lane >> 4;
    const int K = g.K, nt = K / BK, lda = g.lda, kwrap = g.kwrap;
    unsigned voffA[2], voffB[2];
#pragma unroll
    for (int i = 0; i < 2; ++i) { int R, C; stage_rc(tid * 16 + i * 8192, R, C); const int Rb = Epi::PERM ? ((R & ~31) + perm32(R & 31)) : R;
        voffA[i] = (unsigned)(R * lda + C) * 2u; voffB[i] = (unsigned)(Rb * K + C) * 2u; }
    const long kstep = (long)(BK * 2); const long kstepA = g.ahm == 2 ? 3072l : g.ahm ? (long)SEQ * 128 : kstep;
    const long hstepA = (long)HALF * lda * 2, hstepB = (long)HALF * K * 2;
    const long tstepB = 2 * hstepB;
    const unsigned ldsw = (unsigned)wid * 1024u;
    const int aoff = lds_byte(wr * 64 + fr, fq * 8), boff = lds_byte(wc * 32 + fr, fq * 8);
#define PG8_KOFFA(t) (((t) < kwrap) ? (long)(t) * kstepA : (long)((t) - kwrap) * kstepA - (long)lda * 2)
#define PG8_ATILE(pm) (g.ahm ? (const char*)g.A + ((long)((pm) >> 3) * (K / 64) * SEQ + (long)((pm) & 7) * 256) * 128 : (const char*)g.A + ((long)(pm) * 256 + (g.apad ? (((pm) >> 3) + 1) : 0)) * (long)lda * 2)
#define PG8_SA(b, h) (((b) * 2 + (h)) * HTB)
#define PG8_SB(b, h) ((4 + (b) * 2 + (h)) * HTB)
#define PG8_STAGE(bufoff, gbase, voff) do { _Pragma("unroll") for (int _i = 0; _i < 2; ++_i) \
        __builtin_amdgcn_global_load_lds((const unsigned*)((const char*)(gbase) + (voff)[_i]), (LAS unsigned*)(lds + (bufoff) + ldsw + _i * 8192), 16, 0, 0); } while (0)
#define PG8_STAGE_A(bufoff, nx, h, ko) do { if constexpr (GATHER) { _Pragma("unroll") for (int _i = 0; _i < 2; ++_i) \
            __builtin_amdgcn_global_load_lds((const unsigned*)((const char*)g.A + (ko) + ((nx) ? gon[h][_i] : goc[h][_i])), (LAS unsigned*)(lds + (bufoff) + ldsw + _i * 8192), 16, 0, 0); } \
        else PG8_STAGE(bufoff, ((nx) ? nA : cA) + (h) * hstepA + (ko), voffA); } while (0)
#define PG8_GIDX(dst, pm_) do { if constexpr (GATHER) { _Pragma("unroll") for (int _h = 0; _h < 2; ++_h) _Pragma("unroll") for (int _i = 0; _i < 2; ++_i) \
            dst[_h][_i] = (unsigned)g.gidx[(pm_) * 256 + _h * 128 + (int)(voffA[_i] / (unsigned)(lda * 2))] * (unsigned)(lda * 2) + voffA[_i] % (unsigned)(lda * 2); } } while (0)
#define PG8_LDA(dst, b, h) do { _Pragma("unroll") for (int m = 0; m < 4; ++m) _Pragma("unroll") for (int k = 0; k < 2; ++k) dst[m][k] = *(const LAS bf16x8*)(lds + PG8_SA(b, h) + aoff + m * 2048 + k * 1024); } while (0)
#define PG8_LDB(dst, b, h) do { _Pragma("unroll") for (int n = 0; n < 2; ++n) _Pragma("unroll") for (int k = 0; k < 2; ++k) dst[n][k] = *(const LAS bf16x8*)(lds + PG8_SB(b, h) + boff + n * 2048 + k * 1024); } while (0)
#define PG8_MMA(ai, bj, At, Bt) do { __builtin_amdgcn_s_setprio(1); _Pragma("unroll") for (int m = 0; m < 4; ++m) _Pragma("unroll") for (int n = 0; n < 2; ++n) _Pragma("unroll") for (int k = 0; k < 2; ++k) \
        acc[ai][bj][m][n] = __builtin_amdgcn_mfma_f32_16x16x32_bf16(Bt[n][k], At[m][k], acc[ai][bj][m][n], 0, 0, 0); __builtin_amdgcn_s_setprio(0); } while (0)
#define PG8_WAIT_V(n) asm volatile("s_waitcnt vmcnt(" #n ")" ::: "memory")
#define PG8_WAIT_L(n) asm volatile("s_waitcnt lgkmcnt(" #n ")" ::: "memory")
#define PG8_BAR __builtin_amdgcn_s_barrier()
#define PG8_SCHED __builtin_amdgcn_sched_barrier(0)
    Unit cur, nxt; int ui = 0;
    if (!S.next(0, cur)) return;
    f32x4 acc[2][2][4][2];
#pragma unroll
    for (int a = 0; a < 2; ++a)
#pragma unroll
        for (int b = 0; b < 2; ++b)
#pragma unroll
            for (int m = 0; m < 4; ++m)
#pragma unroll
                for (int n = 0; n < 2; ++n) acc[a][b][m][n] = (f32x4){0.f, 0.f, 0.f, 0.f};
    bf16x8 At[4][2], B0[2][2], B1[2][2];
    const char* cA = PG8_ATILE(cur.pm); const char* cB = (const char*)g.Bt + (long)cur.pn * tstepB; const char* nA = cA;
    unsigned goc[2][2], gon[2][2];
#pragma unroll
    for (int _h = 0; _h < 2; ++_h)
#pragma unroll
        for (int _i = 0; _i < 2; ++_i) { goc[_h][_i] = 0u; gon[_h][_i] = 0u; }
    PG8_GIDX(goc, cur.pm);
    if constexpr (SP2) {
        PG8_STAGE(PG8_SB(0, 0), cB, voffB); PG8_STAGE(PG8_SB(0, 1), cB + hstepB, voffB); PG8_STAGE_A(PG8_SA(0, 0), false, 0, 0); PG8_STAGE_A(PG8_SA(0, 1), false, 1, 0);
        if (wr == 1) PG8_BAR;
        PG8_WAIT_V(2); PG8_BAR;
        PG8_STAGE(PG8_SB(1, 0), cB + kstep, voffB); PG8_STAGE_A(PG8_SA(1, 0), false, 0, kstepA); PG8_STAGE(PG8_SB(1, 1), cB + hstepB + kstep, voffB);
        PG8_WAIT_V(6); PG8_BAR;
    } else {
        PG8_STAGE(PG8_SB(0, 0), cB, voffB); PG8_STAGE_A(PG8_SA(0, 0), false, 0, 0); PG8_STAGE(PG8_SB(0, 1), cB + hstepB, voffB); PG8_STAGE_A(PG8_SA(0, 1), false, 1, 0);
        if (wr == 1) PG8_BAR;
        PG8_WAIT_V(4); PG8_BAR;
        PG8_STAGE(PG8_SB(1, 0), cB + kstep, voffB); PG8_STAGE_A(PG8_SA(1, 0), false, 0, kstepA); PG8_STAGE(PG8_SB(1, 1), cB + hstepB + kstep, voffB);
        PG8_WAIT_V(6); PG8_BAR;
    }
    for (;;) {
        const bool has_next = S.next(ui + 1, nxt);
        nA = has_next ? PG8_ATILE(nxt.pm) : cA; const char* nB = has_next ? (const char*)g.Bt + (long)nxt.pn * tstepB : cB;
        if constexpr (GATHER) { if (has_next) PG8_GIDX(gon, nxt.pm); else {
#pragma unroll
            for (int _h = 0; _h < 2; ++_h)
#pragma unroll
                for (int _i = 0; _i < 2; ++_i) gon[_h][_i] = goc[_h][_i]; } }
#pragma unroll 1
        for (int t = 0; t < nt; t += 2) {
            const bool last = (t == nt - 2);
            const long k1 = PG8_KOFFA(t + 1), k2 = last ? 0 : PG8_KOFFA(t + 2), k3 = last ? kstepA : PG8_KOFFA(t + 3);
            const char* b2 = last ? nB : cB + (long)(t + 2) * kstep; const char* b3 = b2 + kstep;
            if constexpr (SP2) {
            PG8_LDB(B0, 0, 0); PG8_LDB(B1, 0, 1); PG8_SCHED; PG8_LDA(At, 0, 0); PG8_STAGE_A(PG8_SA(1, 1), false, 1, k1);
            PG8_WAIT_V(8); PG8_WAIT_L(0); PG8_BAR; PG8_MMA(0, 0, At, B0); PG8_MMA(0, 1, At, B1); PG8_BAR; PG8_SCHED;
            PG8_LDA(At, 0, 1); PG8_STAGE(PG8_SB(0, 0), b2, voffB); PG8_STAGE(PG8_SB(0, 1), b2 + hstepB, voffB); PG8_STAGE_A(PG8_SA(0, 0), last, 0, k2);
            PG8_WAIT_V(8); PG8_WAIT_L(0); PG8_BAR; PG8_MMA(1, 0, At, B0); PG8_MMA(1, 1, At, B1); PG8_BAR; PG8_SCHED;
            PG8_LDB(B0, 1, 0); PG8_LDB(B1, 1, 1); PG8_SCHED; PG8_LDA(At, 1, 0); PG8_STAGE_A(PG8_SA(0, 1), last, 1, k2);
            PG8_WAIT_V(8); PG8_WAIT_L(0); PG8_BAR; PG8_MMA(0, 0, At, B0); PG8_MMA(0, 1, At, B1); PG8_BAR; PG8_SCHED;
            PG8_LDA(At, 1, 1); PG8_STAGE(PG8_SB(1, 0), b3, voffB); PG8_STAGE(PG8_SB(1, 1), b3 + hstepB, voffB); PG8_STAGE_A(PG8_SA(1, 0), last, 0, k3);
            PG8_WAIT_V(8); PG8_WAIT_L(0); PG8_BAR; PG8_MMA(1, 0, At, B0); PG8_MMA(1, 1, At, B1); PG8_BAR; PG8_SCHED;
            } else {
            PG8_LDB(B0, 0, 0); PG8_SCHED; PG8_LDA(At, 0, 0); PG8_STAGE_A(PG8_SA(1, 1), false, 1, k1);
            PG8_WAIT_L(8); PG8_BAR; PG8_WAIT_L(0); PG8_MMA(0, 0, At, B0); PG8_BAR; PG8_SCHED;
            PG8_LDB(B1, 0, 1); PG8_STAGE(PG8_SB(0, 0), b2, voffB);
            PG8_BAR; PG8_WAIT_L(0); PG8_MMA(0, 1, At, B1); PG8_BAR;
            PG8_LDA(At, 0, 1); PG8_STAGE_A(PG8_SA(0, 0), last, 0, k2);
            PG8_BAR; PG8_WAIT_L(0); PG8_MMA(1, 0, At, B0); PG8_BAR; PG8_SCHED;
            PG8_STAGE(PG8_SB(0, 1), b2 + hstepB, voffB);
            PG8_WAIT_V(6); PG8_BAR; PG8_MMA(1, 1, At, B1); PG8_BAR;
            PG8_LDB(B0, 1, 0); PG8_SCHED; PG8_LDA(At, 1, 0); PG8_STAGE_A(PG8_SA(0, 1), last, 1, k2);
            PG8_WAIT_L(8); PG8_BAR; PG8_WAIT_L(0); PG8_MMA(0, 0, At, B0); PG8_BAR; PG8_SCHED;
            PG8_LDB(B1, 1, 1); PG8_STAGE(PG8_SB(1, 0), b3, voffB);
            PG8_BAR; PG8_WAIT_L(0); PG8_MMA(0, 1, At, B1); PG8_BAR;
            PG8_LDA(At, 1, 1); PG8_STAGE_A(PG8_SA(1, 0), last, 0, k3);
            PG8_BAR; PG8_WAIT_L(0); PG8_MMA(1, 0, At, B0); PG8_BAR; PG8_SCHED;
            PG8_STAGE(PG8_SB(1, 1), b3 + hstepB, voffB);
            PG8_WAIT_V(6); PG8_BAR; PG8_MMA(1, 1, At, B1); PG8_BAR;
            }
        }
        if constexpr (ALIGN_EPI) { if (wr == 0) PG8_BAR; }
        E(acc, cur, wr, wc, fr, fq);
        if (!has_next) break;
#pragma unroll
        for (int a = 0; a < 2; ++a)
#pragma unroll
            for (int b = 0; b < 2; ++b)
#pragma unroll
                for (int m = 0; m < 4; ++m)
#pragma unroll
                    for (int n = 0; n < 2; ++n) acc[a][b][m][n] = (f32x4){0.f, 0.f, 0.f, 0.f};
        cur = nxt; cA = nA; cB = nB; ++ui;
        if constexpr (GATHER) {
#pragma unroll
            for (int _h = 0; _h < 2; ++_h)
#pragma unroll
                for (int _i = 0; _i < 2; ++_i) goc[_h][_i] = gon[_h][_i]; }
        if constexpr (ALIGN_EPI) { if (wr == 1) PG8_BAR; }
    }
    PG8_WAIT_V(0);
    if constexpr (!ALIGN_EPI) { if (wr == 0) PG8_BAR; }
    PG8_BAR;
#undef PG8_STAGE_A
#undef PG8_GIDX
#undef PG8_KOFFA
#undef PG8_ATILE
#undef PG8_SA
#undef PG8_SB
#undef PG8_STAGE
#undef PG8_LDA
#undef PG8_LDB
#undef PG8_MMA
#undef PG8_WAIT_V
#undef PG8_WAIT_L
#undef PG8_BAR
#undef PG8_SCHED
}

#define EPI_LOOP_ROWS for (int ai = 0; ai < 2; ++ai) _Pragma("unroll") for (int m = 0; m < 4; ++m)
__device__ __forceinline__ u32x4 pack8(const f32x4 v0, const f32x4 v1) { u32x4 w; w.x = pk2(v0[0], v0[1]); w.y = pk2(v0[2], v0[3]); w.z = pk2(v1[0], v1[1]); w.w = pk2(v1[2], v1[3]); return w; }

__device__ __forceinline__ size_t hm_off(int row, int col) { return ((size_t)((row >> 11) * 16 + (col >> 6)) * SEQ + (row & 2047)) * 64 + (col & 63); }
struct EpiBf16 {
    static constexpr bool PERM = true;
    bf16_t* O; int ldc; float scale; int hm;
    __device__ __forceinline__ void operator()(const f32x4 (&acc)[2][2][4][2], const Unit& u, int wr, int wc, int fr, int fq) const {
        const int row0 = u.pm * BM + wr * 64 + fr, col0 = u.pn * BM + wc * 32 + 8 * fq;
#pragma unroll
        EPI_LOOP_ROWS { const int row = row0 + ai * HALF + m * 16;
#pragma unroll
            for (int bj = 0; bj < 2; ++bj) { bf16_t* p = hm ? O + hm_off(row, col0 + bj * HALF) : O + (size_t)row * ldc + col0 + bj * HALF;
                __builtin_nontemporal_store(pack8(acc[ai][bj][m][0] * scale, acc[ai][bj][m][1] * scale), (u32x4*)p); } }
    }
};
struct EpiLora1 {
    static constexpr bool PERM = true;
    bf16_t* O;
    __device__ __forceinline__ void operator()(const f32x4 (&acc)[2][2][4][2], const Unit& u, int wr, int wc, int fr, int fq) const {
        const int row0 = u.pm * BM + wr * 64 + fr, col0 = u.pn * BM + wc * 32 + 8 * fq;
#pragma unroll
        EPI_LOOP_ROWS { bf16_t* rowp = O + (size_t)(row0 + ai * HALF + m * 16) * 512 + col0;
#pragma unroll
            for (int bj = 0; bj < 2; ++bj) { const int c = col0 + bj * HALF; f32x4 v0 = acc[ai][bj][m][0], v1 = acc[ai][bj][m][1];
                if (c < 64) {
#pragma unroll
                    for (int j = 0; j < 4; ++j) { v0[j] = tanhf_(v0[j]); v1[j] = tanhf_(v1[j]); }
                } else if (c < 128) {
                } else if (c < 288) {
#pragma unroll
                    for (int j = 0; j < 4; ++j) { v0[j] = sigmoidf_(v0[j]); v1[j] = sigmoidf_(v1[j]); }
                } else { v0 = (f32x4){0.f, 0.f, 0.f, 0.f}; v1 = v0; }
                *(u32x4*)(rowp + bj * HALF) = pack8(v0, v1); } }
    }
};
struct EpiLora2WA {
    static constexpr bool PERM = true;
    bf16_t* LW; bf16_t* AA; const float* w0; const float* a0;
    __device__ __forceinline__ void operator()(const f32x4 (&acc)[2][2][4][2], const Unit& u, int wr, int wc, int fr, int fq) const {
        const int row0 = u.pm * BM + wr * 64 + fr; const bool isw = u.pn < 4; const int col0 = (u.pn & 3) * BM + wc * 32 + 8 * fq;
        bf16_t* O = isw ? LW : AA; const float* bias = isw ? w0 : a0; const float mul = isw ? -0.60653065971f : 1.0f;
#pragma unroll
        for (int bj = 0; bj < 2; ++bj) { const f32x4 b0 = *(const f32x4*)(bias + col0 + bj * HALF), b1 = *(const f32x4*)(bias + col0 + bj * HALF + 4);
#pragma unroll
            EPI_LOOP_ROWS { bf16_t* rowp = O + hm_off(row0 + ai * HALF + m * 16, col0 + bj * HALF); f32x4 v0 = acc[ai][bj][m][0] + b0, v1 = acc[ai][bj][m][1] + b1;
#pragma unroll
                for (int j = 0; j < 4; ++j) { v0[j] = mul * sigmoidf_(v0[j]); v1[j] = mul * sigmoidf_(v1[j]); }
                __builtin_nontemporal_store(pack8(v0, v1), (u32x4*)rowp); } }
    }
};
struct EpiResX {
    static constexpr bool PERM = true;
    const float* x; bf16_t* h;
    __device__ __forceinline__ void operator()(const f32x4 (&acc)[2][2][4][2], const Unit& u, int wr, int wc, int fr, int fq) const {
        const int row0 = u.pm * BM + wr * 64 + fr, col0 = u.pn * BM + wc * 32 + 8 * fq;
#pragma unroll
        for (int ai = 0; ai < 2; ++ai) {
            f32x4 xb[4][2][2];
#pragma unroll
            for (int m = 0; m < 4; ++m)
#pragma unroll
                for (int bj = 0; bj < 2; ++bj) { const float* p = x + (size_t)(row0 + ai * HALF + m * 16) * 1024 + col0 + bj * HALF; xb[m][bj][0] = *(const f32x4*)p; xb[m][bj][1] = *(const f32x4*)(p + 4); }
#pragma unroll
            for (int m = 0; m < 4; ++m) { const size_t off = (size_t)(row0 + ai * HALF + m * 16) * 1024 + col0;
#pragma unroll
                for (int bj = 0; bj < 2; ++bj) *(u32x4*)(h + off + bj * HALF) = pack8(acc[ai][bj][m][0] + xb[m][bj][0], acc[ai][bj][m][1] + xb[m][bj][1]); } }
    }
};
struct EpiResH {
    static constexpr bool PERM = true;
    bf16_t* h;
    __device__ __forceinline__ void operator()(const f32x4 (&acc)[2][2][4][2], const Unit& u, int wr, int wc, int fr, int fq) const {
        const int row0 = u.pm * BM + wr * 64 + fr, col0 = u.pn * BM + wc * 32 + 8 * fq;
        u32x4 hb[2][4][2];
#pragma unroll
        EPI_LOOP_ROWS { const size_t off = (size_t)(row0 + ai * HALF + m * 16) * 1024 + col0;
#pragma unroll
            for (int bj = 0; bj < 2; ++bj) hb[ai][m][bj] = *(const u32x4*)(h + off + bj * HALF); }
#pragma unroll
        EPI_LOOP_ROWS { const size_t off = (size_t)(row0 + ai * HALF + m * 16) * 1024 + col0;
#pragma unroll
            for (int bj = 0; bj < 2; ++bj) { const u32x4 b = hb[ai][m][bj];
                const f32x4 b0 = {bflo(b.x), bfhi(b.x), bflo(b.y), bfhi(b.y)}, b1 = {bflo(b.z), bfhi(b.z), bflo(b.w), bfhi(b.w)};
                *(u32x4*)(h + off + bj * HALF) = pack8(acc[ai][bj][m][0] + b0, acc[ai][bj][m][1] + b1); } }
    }
};
struct EpiKvqg {
    static constexpr bool PERM = true;
    bf16_t* KV; bf16_t* Q; float* GT; const float* rs;
    __device__ __forceinline__ void operator()(const f32x4 (&acc)[2][2][4][2], const Unit& u, int wr, int wc, int fr, int fq) const {
        const int row0 = u.pm * BM + wr * 64 + fr;
        float rsv[2][4];
#pragma unroll
        EPI_LOOP_ROWS rsv[ai][m] = rs[row0 + ai * HALF + m * 16];
        if (u.pn < 10) {
            const bool iskv = u.pn < 6; bf16_t* O = iskv ? KV : Q; const int ldc = iskv ? 1536 : 1024; const float sc = iskv ? 1.0f : 0.18033688011f;
            const int col0 = (iskv ? u.pn : u.pn - 6) * BM + wc * 32 + 8 * fq;
#pragma unroll
            EPI_LOOP_ROWS { const int row = row0 + ai * HALF + m * 16; const float scr_ = sc * rsv[ai][m]; bf16_t* rowp = O + (size_t)row * ldc + col0;
#pragma unroll
                for (int bj = 0; bj < 2; ++bj) __builtin_nontemporal_store(pack8(acc[ai][bj][m][0] * scr_, acc[ai][bj][m][1] * scr_), (u32x4*)(rowp + bj * HALF)); }
        } else {
            const int c0 = wc * 32 + 8 * fq;
            if (c0 < 48) {
#pragma unroll
                EPI_LOOP_ROWS { const int row = row0 + ai * HALF + m * 16; const float rr_ = rsv[ai][m]; float* rowp = GT + (size_t)row * 48 + c0; f32x4 v0 = acc[ai][0][m][0] * rr_, v1 = acc[ai][0][m][1] * rr_;
#pragma unroll
                    for (int j = 0; j < 4; ++j) { v0[j] = sigmoidf_(v0[j]); v1[j] = sigmoidf_(v1[j]); }
                    *(f32x4*)(rowp) = v0; *(f32x4*)(rowp + 4) = v1; }
            }
        }
    }
};
struct EpiMoe1 {
    static constexpr bool PERM = true;
    bf16_t* H; const float* rs;
    __device__ __forceinline__ void operator()(const f32x4 (&acc)[2][2][4][2], const Unit& u, int wr, int wc, int fr, int fq) const {
        const int row0 = u.pm * BM + wr * 64 + fr, col0 = (u.pn & 3) * 128 + wc * 32 + 8 * fq;
        float rsv[2][4];
#pragma unroll
        EPI_LOOP_ROWS rsv[ai][m] = rs[row0 + ai * HALF + m * 16];
#pragma unroll
        EPI_LOOP_ROWS { const int row = row0 + ai * HALF + m * 16; const float r_ = rsv[ai][m]; bf16_t* rowp = H + (size_t)row * 512 + col0; f32x4 v0, v1;
#pragma unroll
            for (int j = 0; j < 4; ++j) { const float g0 = acc[ai][0][m][0][j] * r_, g1 = acc[ai][0][m][1][j] * r_; v0[j] = g0 * sigmoidf_(g0) * (acc[ai][1][m][0][j] * r_); v1[j] = g1 * sigmoidf_(g1) * (acc[ai][1][m][1][j] * r_); }
            __builtin_nontemporal_store(pack8(v0, v1), (u32x4*)(rowp)); }
    }
};
struct EpiMoe2 {
    static constexpr bool PERM = true;
    bf16_t* Y; const float* roww;
    __device__ __forceinline__ void operator()(const f32x4 (&acc)[2][2][4][2], const Unit& u, int wr, int wc, int fr, int fq) const {
        const bool up = (fr & 8) != 0;
        const int rowb = u.pm * BM + wr * 64 + (fr & 7), colp = (u.pn & 3) * BM + wc * 64 + 8 * fq;
#pragma unroll
        EPI_LOOP_ROWS { const u32x4 a0 = pack8(acc[ai][0][m][0], acc[ai][0][m][1]), a1 = pack8(acc[ai][1][m][0], acc[ai][1][m][1]); u32x4 x1;
            x1.x = (unsigned)__builtin_amdgcn_update_dpp(0, (int)a1.x, 0x128, 0xf, 0xf, true); x1.y = (unsigned)__builtin_amdgcn_update_dpp(0, (int)a1.y, 0x128, 0xf, 0xf, true);
            x1.z = (unsigned)__builtin_amdgcn_update_dpp(0, (int)a1.z, 0x128, 0xf, 0xf, true); x1.w = (unsigned)__builtin_amdgcn_update_dpp(0, (int)a1.w, 0x128, 0xf, 0xf, true);
            bf16_t* r0p = Y + (size_t)(rowb + ai * HALF + m * 16) * 1024 + colp;
            __builtin_nontemporal_store(up ? x1 : a0, (u32x4*)(r0p + (up ? 32 : 0)));
            __builtin_nontemporal_store(up ? a0 : x1, (u32x4*)(r0p + 8 * 1024 + (up ? 0 : 32))); }
    }
};
struct EpiCmp {
    static constexpr bool PERM = true;
    bf16_t* O; const float* pb;
    __device__ __forceinline__ void operator()(const f32x4 (&acc)[2][2][4][2], const Unit& u, int wr, int wc, int fr, int fq) const {
        const int row0 = u.pm * BM + wr * 64 + fr, col0 = wc * 32 + 8 * fq;
        f32x4 bias[2][2][2];
#pragma unroll
        for (int ai = 0; ai < 2; ++ai)
#pragma unroll
            for (int bj = 0; bj < 2; ++bj)
#pragma unroll
                for (int hf = 0; hf < 2; ++hf) { const float* p = pb + (size_t)((u.pm >> 6) * 4 + ((2 * u.pm + ai) & 3)) * 256 + col0 + bj * HALF + 4 * hf;
                    bias[ai][bj][hf] = (*(const f32x4*)p + *(const f32x4*)(p + 2048)) + (*(const f32x4*)(p + 4096) + *(const f32x4*)(p + 6144)); }
#pragma unroll
        EPI_LOOP_ROWS { bf16_t* rowp = O + (size_t)(row0 + ai * HALF + m * 16) * 256 + col0;
#pragma unroll
            for (int bj = 0; bj < 2; ++bj) { f32x4 v0 = acc[ai][bj][m][0] + bias[ai][bj][0], v1 = acc[ai][bj][m][1] + bias[ai][bj][1];
#pragma unroll
                for (int j = 0; j < 4; ++j) { v0[j] = gelu_tanh_(v0[j]); v1[j] = gelu_tanh_(v1[j]); }
                *(u32x4*)(rowp + bj * HALF) = pack8(v0, v1); } }
    }
};
}

struct Args { const float* in[41]; float* out; unsigned char* ws; int ph_lo, ph_hi; };
enum { I_X = 0, I_ALN, I_AMU, I_AWR, I_AWK, I_AWV, I_AWO, I_AW0, I_AW1, I_AW2, I_AA0, I_AA1, I_AA2, I_AG1, I_AG2, I_AKK, I_AKA, I_ARK, I_ALNXW, I_ALNXB,
       I_KVLN, I_KVW, I_PEK, I_PEV, I_CKW1, I_CKW2, I_CVW1, I_CVW2, I_RELB, I_BLN, I_BWQG, I_BWO, I_MLN, I_MWG, I_MBG, I_MWE, I_MBE, I_MW1, I_MW3, I_MW2, I_FLN };

struct Fr { LAS unsigned char* lds; int tid, lane, wave, G, gw, ngw; };

__device__ __forceinline__ void tr_item(const float* W, int N, int Klim, int Nlim, int k0, int n0, bf16_t* out, long orow0, int ldo, int kout0,
                                        const float* sc, int scmode, LAS float* scr, int lane) {
    f32x4 ld[8];
#pragma unroll
    for (int i = 0; i < 8; ++i) { const int kk = 8 * i + (lane >> 3), k = k0 + kk, n = n0 + 4 * (lane & 7);
        ld[i] = (k < Klim && n < Nlim) ? *(const f32x4*)(W + (size_t)k * N + n) : (f32x4){0.f, 0.f, 0.f, 0.f}; }
#pragma unroll
    for (int i = 0; i < 8; ++i) { const int kk = 8 * i + (lane >> 3), k = k0 + kk; f32x4 v = ld[i];
        if (scmode && k < Klim) { const float sv = sc[k]; v = v * (scmode == 1 ? sv : 1.f - sv); }
        LAS float* d = scr + kk * 33 + 4 * (lane & 7); d[0] = v.x; d[1] = v.y; d[2] = v.z; d[3] = v.w; }
    LDS_WAIT(); asm volatile("" ::: "memory");
    const int c = lane & 7;
#pragma unroll
    for (int j = 0; j < 4; ++j) { const int n = (lane >> 3) + 8 * j; const LAS float* s = scr + (8 * c) * 33 + n;
        u32x4 o; o.x = pk2(s[0 * 33], s[1 * 33]); o.y = pk2(s[2 * 33], s[3 * 33]); o.z = pk2(s[4 * 33], s[5 * 33]); o.w = pk2(s[6 * 33], s[7 * 33]);
        *(u32x4*)(out + (size_t)(orow0 + n) * ldo + kout0 + 8 * c) = o; }
    LDS_WAIT(); asm volatile("" ::: "memory");
}
__device__ __forceinline__ void conv_mat(const Fr& F, const float* W, int K, int N, bf16_t* out, long orow0, int ldo, int kout0, const float* sc, int scmode, LAS float* scr) {
    const int nkb = (K + 63) / 64, nnb = (N + 31) / 32, nit = nkb * nnb;
    for (int it = F.gw; it < nit; it += F.ngw) { const int kb = it / nnb, nb = it % nnb;
        tr_item(W, N, K, N, kb * 64, nb * 32, out, orow0 + nb * 32, ldo, kout0 + kb * 64, sc, scmode, scr, F.lane); }
}
__device__ __forceinline__ void zero_rect(const Fr& F, bf16_t* out, int rows, int cols8, int ldo) {
    const long tot = (long)rows * cols8;
    for (long i = (long)F.gw * 64 + F.lane; i < tot; i += (long)F.ngw * 64) { const long r = i / cols8, c = i % cols8; *(u32x4*)(out + r * ldo + c * 8) = (u32x4){0u, 0u, 0u, 0u}; }
}
__device__ __forceinline__ bf16x8 pack8c(const float (&v)[8]) { u32x4 w; w.x = cvtpk(v[0], v[1]); w.y = cvtpk(v[2], v[3]); w.z = cvtpk(v[4], v[5]); w.w = cvtpk(v[6], v[7]); return __builtin_bit_cast(bf16x8, w); }
__device__ __forceinline__ void phase_conv(const Fr& F, const Args& a) {
    unsigned char* ws = a.ws;
    LAS float* scr = (LAS float*)(F.lds + F.wave * 8704);
    const float* mu = a.in[I_AMU];
    conv_mat(F, a.in[I_AWR], 1024, 1024, (bf16_t*)(ws + WS_WR), 0, 1024, 0, nullptr, 0, scr);
    conv_mat(F, a.in[I_AWK], 1024, 1024, (bf16_t*)(ws + WS_WK), 0, 1024, 0, nullptr, 0, scr);
    conv_mat(F, a.in[I_AWV], 1024, 1024, (bf16_t*)(ws + WS_WV), 0, 1024, 0, nullptr, 0, scr);
    conv_mat(F, a.in[I_AWO], 1024, 1024, (bf16_t*)(ws + WS_WO), 0, 1024, 0, nullptr, 0, scr);
    {
        bf16_t* o = (bf16_t*)(ws + WS_WL1);
        conv_mat(F, a.in[I_AW1], 1024, 64, o, 0, 2048, 0, mu + 1 * 1024, 2, scr);    conv_mat(F, a.in[I_AW1], 1024, 64, o, 0, 2048, 1024, mu + 1 * 1024, 1, scr);
        conv_mat(F, a.in[I_AA1], 1024, 64, o, 64, 2048, 0, mu + 4 * 1024, 2, scr);   conv_mat(F, a.in[I_AA1], 1024, 64, o, 64, 2048, 1024, mu + 4 * 1024, 1, scr);
        conv_mat(F, a.in[I_AG1], 1024, 160, o, 128, 2048, 0, mu + 5 * 1024, 2, scr); conv_mat(F, a.in[I_AG1], 1024, 160, o, 128, 2048, 1024, mu + 5 * 1024, 1, scr);
        zero_rect(F, o + (size_t)288 * 2048, 224, 256, 2048);
    }
    {
        bf16_t* o = (bf16_t*)(ws + WS_W2WA);
        conv_mat(F, a.in[I_AW2], 64, 1024, o, 0, 128, 0, nullptr, 0, scr);
        zero_rect(F, o + 64, 1024, 8, 128);
        conv_mat(F, a.in[I_AA2], 64, 1024, o, 1024, 128, 64, nullptr, 0, scr);
        zero_rect(F, o + (size_t)1024 * 128, 1024, 8, 128);
    }
    {
        bf16_t* o = (bf16_t*)(ws + WS_W2G);
        conv_mat(F, a.in[I_AG2], 160, 1024, o, 0, 256, 0, nullptr, 0, scr);
        zero_rect(F, o + 192, 1024, 8, 256);
    }
    {
        bf16_t* o = (bf16_t*)(ws + WS_WKVQG);
        conv_mat(F, a.in[I_KVW], 1024, 1536, o, 0, 1024, 0, a.in[I_KVLN], 1, scr);
        conv_mat(F, a.in[I_BWQG], 1024, 1072, o, 1536, 1024, 0, a.in[I_BLN], 1, scr);
        zero_rect(F, o + (size_t)2624 * 1024, 192, 128, 1024);
    }
    conv_mat(F, a.in[I_BWO], 1024, 1024, (bf16_t*)(ws + WS_WOB), 0, 1024, 0, nullptr, 0, scr);
    conv_mat(F, a.in[I_CKW1], 2048, 256, (bf16_t*)(ws + WS_WC1), 0, 2048, 0, nullptr, 0, scr);
    conv_mat(F, a.in[I_CVW1], 2048, 256, (bf16_t*)(ws + WS_WC1) + (size_t)256 * 2048, 0, 2048, 0, nullptr, 0, scr);
    {
        bf16_t* o1 = (bf16_t*)(ws + WS_BT1); bf16_t* o2 = (bf16_t*)(ws + WS_BT2);
        for (int it = F.gw; it < 64 * 256; it += F.ngw) { const int mat = it >> 8, r = it & 255, kb = r >> 4, nb = r & 15, n0 = nb * 32;
            const long orow = (long)mat * 1024 + (n0 >> 7) * 256 + (n0 & 127);
            const float* gm = a.in[I_MLN] + (mat >> 5) * 1024;
            tr_item(a.in[I_MW1] + (size_t)mat * 1024 * 512, 512, 1024, 512, kb * 64, n0, o1, orow, 1024, kb * 64, gm, 1, scr, F.lane);
            tr_item(a.in[I_MW3] + (size_t)mat * 1024 * 512, 512, 1024, 512, kb * 64, n0, o1, orow + 128, 1024, kb * 64, gm, 1, scr, F.lane); }
        for (int it = F.gw; it < 64 * 256; it += F.ngw) { const int mat = it >> 8, r = it & 255, kb = r >> 5, nb = r & 31;
            tr_item(a.in[I_MW2] + (size_t)mat * 512 * 1024, 1024, 512, 1024, kb * 64, nb * 32, o2, (long)mat * 1024 + nb * 32, 512, kb * 64, nullptr, 0, scr, F.lane); }
    }
    {
        int* ci = (int*)(ws + WS_CIDX);
        for (int r = F.gw * 64 + F.lane; r < 2 * 16384; r += F.ngw * 64) { const int grp = r >> 14, rr = r & 16383, bg = rr >> 7, n = rr & 127; ci[r] = ((bg >> 2) * SEQ + 16 * n) * 24 + grp * 4 + (bg & 3); }
        if (F.wave == 0 && blockIdx.x < 128) { const int id = blockIdx.x, grp = id >> 6, nb = (id >> 2) & 15, kq = id & 3, i = F.lane & 15, q = F.lane >> 4;
            const float* pe = a.in[grp ? I_PEV : I_PEK] + (size_t)(i & 3) * 2048 + kq * 512 + 8 * q; const float* w = a.in[grp ? I_CVW1 : I_CKW1] + (size_t)(kq * 512 + 8 * q) * 256 + 16 * nb + i;
            f32x4 acc = (f32x4){0.f, 0.f, 0.f, 0.f};
#pragma unroll 2
            for (int sk = 0; sk < 16; ++sk) { const f32x4 p0 = *(const f32x4*)(pe + 32 * sk), p1 = *(const f32x4*)(pe + 32 * sk + 4);
                float wv[8];
#pragma unroll
                for (int e = 0; e < 8; ++e) wv[e] = w[(size_t)(32 * sk + e) * 256];
                const float pv[8] = {p0.x, p0.y, p0.z, p0.w, p1.x, p1.y, p1.z, p1.w}; float pl[8];
#pragma unroll
                for (int e = 0; e < 8; ++e) pl[e] = pv[e] - bflo(f2bf(pv[e]));
                const bf16x8 ah = pack8c(pv), al = pack8c(pl), bw = pack8c(wv);
                acc = __builtin_amdgcn_mfma_f32_16x16x32_bf16(ah, bw, acc, 0, 0, 0); acc = __builtin_amdgcn_mfma_f32_16x16x32_bf16(al, bw, acc, 0, 0, 0); }
            if (F.lane < 16) { float* pb = (float*)(ws + WS_PEBP) + ((size_t)(kq * 2 + grp) * 4) * 256 + 16 * nb + i;
#pragma unroll
                for (int rg = 0; rg < 4; ++rg) pb[rg * 256] = acc[rg]; }
        }
    }
    {
        bf16_t* o = (bf16_t*)(ws + WS_W2F);
        for (int i = F.gw * 64 + F.lane; i < 2 * 16384; i += F.ngw * 64) { const int e = i & 7, ln = (i >> 3) & 63, nb = (i >> 9) & 3, sk = (i >> 11) & 7, grp = i >> 14;
            const int k = 32 * sk + 8 * (ln >> 4) + e, n = 16 * nb + (ln & 15); const float v = a.in[grp ? I_CVW2 : I_CKW2][k * 64 + n];
            const unsigned hi = f2bf(v), lo = f2bf(v - bflo(hi));
            bf16_t* ob = o + ((size_t)((grp * 8 + sk) * 2) * 4 + nb) * 512 + ln * 8 + e; ob[0] = (bf16_t)hi; ob[4 * 512] = (bf16_t)lo; }
    }
    {
        bf16_t* o = (bf16_t*)(ws + WS_RFRAG);
        for (int i = F.gw * 64 + F.lane; i < 2 * 49152; i += F.ngw * 64) { const int layer = i / 49152, r = i % 49152, e = r & 7, ln = (r >> 3) & 63, nt = (r >> 9) % 3, s = r / 1536;
            const int k = 32 * s + 8 * (ln >> 4) + e, n = 16 * nt + (ln & 15);
            float v = 0.f; if (n < 4) v = a.in[I_MWG][((size_t)layer * 1024 + k) * 4 + n]; else if (n < 36) v = a.in[I_MWE][((size_t)layer * 1024 + k) * 32 + (n - 4)];
            v *= a.in[I_MLN][layer * 1024 + k];
            const unsigned hi = f2bf(v); const float r1 = v - bflo(hi); const unsigned lo = f2bf(r1); const float r2 = r1 - bflo(lo); const unsigned lo2 = f2bf(r2);
            bf16_t* ob = o + ((size_t)(layer * 32 + s) * 9 + nt) * 512 + ln * 8 + e;
            ob[0] = (bf16_t)hi; ob[3 * 512] = (bf16_t)lo; ob[6 * 512] = (bf16_t)lo2; }
    }
}

__device__ __forceinline__ void phase_r1(const Fr& F, const Args& a) {
    unsigned char* ws = a.ws; const float* x = a.in[I_X];
    bf16_t* XN = (bf16_t*)(ws + WS_S5); bf16_t* XR = (bf16_t*)(ws + WS_S0); bf16_t* XK = (bf16_t*)(ws + WS_S1); bf16_t* XV = (bf16_t*)(ws + WS_S2);
    f32x4 gn[4], mr[4], mk[4], mv[4];
#pragma unroll
    for (int j = 0; j < 4; ++j) { const int c = 256 * j + 4 * F.lane; gn[j] = *(const f32x4*)(a.in[I_ALN] + c); mr[j] = *(const f32x4*)(a.in[I_AMU] + 0 * 1024 + c);
        mk[j] = *(const f32x4*)(a.in[I_AMU] + 2 * 1024 + c); mv[j] = *(const f32x4*)(a.in[I_AMU] + 3 * 1024 + c); }
    for (int run = F.gw; run < NT / 32; run += F.ngw) {
        const int m0 = run * 32, b = m0 >> 11, t0 = m0 & 2047;
        f32x4 pv[4];
        if (t0 == 0) {
#pragma unroll
            for (int j = 0; j < 4; ++j) { pv[j] = (f32x4){0.f, 0.f, 0.f, 0.f}; *(u32x2*)(XN + (size_t)(b * 2049) * 1024 + 256 * j + 4 * F.lane) = (u32x2){0u, 0u}; }
        } else {
            const f32x4* xr = (const f32x4*)(x + (size_t)(m0 - 1) * 1024) + F.lane; float s = 0.f;
#pragma unroll
            for (int j = 0; j < 4; ++j) { pv[j] = xr[64 * j]; s += (pv[j].x * pv[j].x + pv[j].y * pv[j].y) + (pv[j].z * pv[j].z + pv[j].w * pv[j].w); }
            const float rstd = 1.f / sqrtf(wave_sum(s) * (1.f / 1024.f) + 1e-6f);
#pragma unroll
            for (int j = 0; j < 4; ++j) pv[j] = pv[j] * rstd * gn[j];
        }
        f32x4 nx[4];
        { const f32x4* xr = (const f32x4*)(x + (size_t)m0 * 1024) + F.lane;
#pragma unroll
          for (int j = 0; j < 4; ++j) nx[j] = xr[64 * j]; }
        for (int i = 0; i < 32; ++i) {
            const int m = m0 + i;
            f32x4 v[4]; float s = 0.f;
#pragma unroll
            for (int j = 0; j < 4; ++j) v[j] = nx[j];
            if (i < 31) { const f32x4* xr = (const f32x4*)(x + (size_t)(m + 1) * 1024) + F.lane;
#pragma unroll
                for (int j = 0; j < 4; ++j) nx[j] = xr[64 * j]; }
#pragma unroll
            for (int j = 0; j < 4; ++j) s += (v[j].x * v[j].x + v[j].y * v[j].y) + (v[j].z * v[j].z + v[j].w * v[j].w);
            const float rstd = 1.f / sqrtf(wave_sum(s) * (1.f / 1024.f) + 1e-6f);
            const size_t prow = (size_t)(m + b + 1) * 1024, row = (size_t)m * 1024;
#pragma unroll
            for (int j = 0; j < 4; ++j) { const int c = 256 * j + 4 * F.lane;
                const f32x4 cur = v[j] * rstd * gn[j], xx = pv[j] - cur;
                *(u32x2*)(XN + prow + c) = (u32x2){pk2(cur.x, cur.y), pk2(cur.z, cur.w)};
                const f32x4 r_ = cur + xx * mr[j], k_ = cur + xx * mk[j], v_ = cur + xx * mv[j];
                *(u32x2*)(XR + row + c) = (u32x2){pk2(r_.x, r_.y), pk2(r_.z, r_.w)};
                *(u32x2*)(XK + row + c) = (u32x2){pk2(k_.x, k_.y), pk2(k_.z, k_.w)};
                *(u32x2*)(XV + row + c) = (u32x2){pk2(v_.x, v_.y), pk2(v_.z, v_.w)};
                pv[j] = cur; }
        }
    }
}

typedef float f32x16 __attribute__((ext_vector_type(16)));
__device__ __forceinline__ bf16x8 pack8f(float a0, float a1, float a2, float a3, float a4, float a5, float a6, float a7) {
    u32x4 w; w.x = cvtpk(a0, a1); w.y = cvtpk(a2, a3); w.z = cvtpk(a4, a5); w.w = cvtpk(a6, a7); return __builtin_bit_cast(bf16x8, w); }
__device__ __forceinline__ bf16x8 packacc(const f32x16& v, int s2) { return pack8f(v[8 * s2], v[8 * s2 + 1], v[8 * s2 + 2], v[8 * s2 + 3], v[8 * s2 + 4], v[8 * s2 + 5], v[8 * s2 + 6], v[8 * s2 + 7]); }
__device__ __forceinline__ int swap23(int w) { return (w & ~12) | ((w & 4) << 1) | ((w & 8) >> 1); }
constexpr int SC_AT = 0, SC_RT = 4096, SC_BJ = 8192, SC_KJ = 12288, SC_VI = 16384, SC_BT = 20480, SC_KT = 24576, SC_TT = 20480, SC_AAKT = 22528, SC_ABRT = 24576, SC_AKRT = 26624,
              SC_GL = 28672, SC_SS = 28928, SC_SLOT = 29184, SC_YB = 4 * SC_SLOT, SC_BON = SC_YB + 32768;
template <int HALF, int BIT>
__device__ __forceinline__ void reduce32_stage(float (&v)[32], int lane) {
    const bool up = (lane & BIT) != 0; const int addr = (lane ^ BIT) << 2;
#pragma unroll
    for (int i = 0; i < HALF; ++i) { const float keep = up ? v[i + HALF] : v[i], send = up ? v[i] : v[i + HALF];
        v[i] = keep + __int_as_float(__builtin_amdgcn_ds_bpermute(addr, __float_as_int(send))); }
}
__device__ __forceinline__ float reduce32(float (&v)[32], int lane) {
#pragma unroll
    for (int i = 0; i < 16; ++i) { const auto r = __builtin_amdgcn_permlane32_swap(__float_as_uint(v[i]), __float_as_uint(v[i + 16]), false, false); v[i] = __uint_as_float(r[0]) + __uint_as_float(r[1]); }
#pragma unroll
    for (int i = 0; i < 8; ++i) { const auto r = __builtin_amdgcn_permlane16_swap(__float_as_uint(v[i]), __float_as_uint(v[i + 8]), false, false); v[i] = __uint_as_float(r[0]) + __uint_as_float(r[1]); }
    { const bool up = (lane & 8) != 0;
#pragma unroll
      for (int i = 0; i < 4; ++i) { const float keep = up ? v[i + 4] : v[i], send = up ? v[i] : v[i + 4]; v[i] = keep + dppf<DPP_ROR8>(send); } }
    reduce32_stage<2, 4>(v, lane);
    { const bool up = (lane & 2) != 0; const float keep = up ? v[1] : v[0], send = up ? v[0] : v[1]; v[0] = keep + dppf<DPP_XOR2>(send); }
    return v[0] + dppf<DPP_XOR1>(v[0]);
}
#define SC_RAW(area, t) bf2f(*(const LAS bf16_t*)(slot + (area) + (t) * 128 + lane * 2))
#define SC_BARRIER() do { asm volatile("s_waitcnt lgkmcnt(0)" ::: "memory"); __builtin_amdgcn_s_barrier(); asm volatile("" ::: "memory"); } while (0)
struct ScanRaw { u32x4 v[10]; unsigned lwp[16]; };
__device__ __forceinline__ void scan_load(const Args& a, ScanRaw& R, int chain, int t0, int half, int lane) {
    unsigned char* ws = a.ws; const int tb = 16 * half;
    const unsigned char* Rb = ws + WS_S3; const unsigned char* LWb = ws + WS_S0; const unsigned char* Kb = ws + WS_S4; const unsigned char* Vb = (const unsigned char*)a.out; const unsigned char* Ab = ws + WS_S1;
    const size_t rowb = ((size_t)chain * SEQ + t0) * 128;
#pragma unroll
    for (int q = 0; q < 2; ++q) { const size_t o = rowb + (size_t)(tb + 8 * q) * 128 + lane * 16;
        R.v[5 * q + 0] = *(const u32x4*)(Ab + o); R.v[5 * q + 1] = *(const u32x4*)(Rb + o); R.v[5 * q + 2] = *(const u32x4*)(LWb + o); R.v[5 * q + 3] = *(const u32x4*)(Kb + o); R.v[5 * q + 4] = *(const u32x4*)(Vb + o); }
    if (half) {
#pragma unroll
        for (int m = 0; m < 16; ++m) R.lwp[m] = (unsigned)*(const bf16_t*)(LWb + rowb + (size_t)m * 128 + lane * 2); }
}
__device__ __forceinline__ void scan_pre(const Fr& F, const Args& a, LAS unsigned char* slot, LAS float* bon, LAS unsigned char* ysc, int chain, int t0, int half, ScanRaw& R, bool more, float kkc, float kac, float rkc) {
    unsigned char* ws = a.ws;
    int lane = F.lane; asm volatile("" : "+v"(lane));
    { unsigned so = (unsigned)(size_t)slot; asm volatile("" : "+s"(so)); slot = (LAS unsigned char*)(size_t)so; }
    const int b = chain >> 4, hd = chain & 15, ch = hd * 64 + lane, r = lane & 31, h = lane >> 5, tb = 16 * half;
    float cum = 0.f;
    if (half) {
#pragma unroll
        for (int m = 0; m < 16; ++m) cum += bflo(R.lwp[m]); }
    {
#pragma unroll
        for (int q = 0; q < 2; ++q) { const int lo2 = (tb + 8 * q) * 128 + lane * 16;
            *(LAS u32x4*)(slot + SC_AT + lo2) = R.v[5 * q + 0]; *(LAS u32x4*)(slot + SC_RT + lo2) = R.v[5 * q + 1]; *(LAS u32x4*)(slot + SC_BT + lo2) = R.v[5 * q + 2]; *(LAS u32x4*)(slot + SC_KT + lo2) = R.v[5 * q + 3]; *(LAS u32x4*)(slot + SC_BJ + lo2) = R.v[5 * q + 4]; }
        LDS_WAIT();
        if (more) scan_load(a, R, chain, t0 + 64, half, lane);
    }
    float kq[16], aq[16], rq[16];
    {
        float q[32];
#pragma unroll
        for (int tt = 0; tt < 16; ++tt) { const float k = SC_RAW(SC_KT, tb + tt), av = SC_RAW(SC_AT, tb + tt), rv = SC_RAW(SC_RT, tb + tt); kq[tt] = k; aq[tt] = av; rq[tt] = rv;
            const float kkv = k * kkc; q[tt] = kkv * kkv; q[16 + tt] = rv * (k * (1.f + (av - 1.f) * kac)) * rkc; }
        const float s1 = reduce32(q, lane); const int idx = (lane >> 1) & 31;
        if ((lane & 1) == 0) { if (idx < 16) ((LAS float*)(slot + SC_SS))[tb + idx] = s1; else bon[tb + idx - 16] = s1; }
    }
    unsigned vv[8];
#pragma unroll
    for (int m = 0; m < 8; ++m) vv[m] = (unsigned)*(const LAS bf16_t*)(slot + SC_BJ + (tb + 2 * m) * 128 + lane * 2) | ((unsigned)*(const LAS bf16_t*)(slot + SC_BJ + (tb + 2 * m + 1) * 128 + lane * 2) << 16);
    LDS_WAIT(); asm volatile("" ::: "memory");
    const int pj = (lane & 48) | swap23(lane & 15);
    const int pjc = pj >> 3, pjw = (pj & 7) * 2;
    unsigned bj[8], kj[8]; float gprev = half ? fexp_(cum) : 1.f, gl = 1.f;
    f32x4 ssv[4];
#pragma unroll
    for (int q4 = 0; q4 < 4; ++q4) ssv[q4] = *(const LAS f32x4*)(slot + SC_SS + (tb + 4 * q4) * 4);
    const bool odd = (lane & 1) != 0; const int pjwe = pjw & ~2;
#define SC_PAIR_STORE(area, x) do { const float _snd = odd ? x[0] : x[1]; const float _rcv = dppf<DPP_XOR1>(_snd); *(LAS unsigned*)(slot + (area) + ro) = cvtpk(odd ? _rcv : x[0], odd ? x[1] : _rcv); } while (0)
#pragma unroll
    for (int tp = 0; tp < 8; ++tp) { const int t0 = tb + 2 * tp;
        float atv[2], rtv[2], btv[2], ktv[2];
#pragma unroll
        for (int u = 0; u < 2; ++u) { const int tt = 2 * tp + u;
            const float k = kq[tt], av = aq[tt], rv = rq[tt], lw = SC_RAW(SC_BT, tb + tt);
            cum += lw; const float g = fexp_(cum), ginv = __builtin_amdgcn_rcpf(g);
            const float ss = ssv[tt >> 2][tt & 3];
            const float kk = k * kkc * __builtin_amdgcn_rsqf(fmaxf(ss, 1e-24f)); const float kp = k * (1.f + (av - 1.f) * kac);
            atv[u] = -kk * gprev; btv[u] = kk * av * ginv; ktv[u] = kp * ginv; rtv[u] = rv * g;
            gprev = g; gl = g; }
        bj[tp] = cvtpk(btv[0], btv[1]); kj[tp] = cvtpk(ktv[0], ktv[1]);
        const int ro = (t0 + (odd ? 1 : 0)) * 128 + ((pjc ^ ((t0 >> 1) & 7)) << 4) + pjwe;
        SC_PAIR_STORE(SC_AT, atv); SC_PAIR_STORE(SC_RT, rtv); SC_PAIR_STORE(SC_BT, btv); SC_PAIR_STORE(SC_KT, ktv);
    }
#undef SC_PAIR_STORE
    SC_BARRIER();
#pragma unroll
    for (int cc = 0; cc < 2; ++cc) { const int c = 2 * half + cc, m0 = 2 * cc; const int ro = lane * 64 + ((c ^ ((lane >> 2) & 3)) << 4);
        *(LAS u32x4*)(slot + SC_BJ + ro) = (u32x4){bj[m0], bj[m0 + 1], bj[m0 + 4], bj[m0 + 5]};
        *(LAS u32x4*)(slot + SC_KJ + ro) = (u32x4){kj[m0], kj[m0 + 1], kj[m0 + 4], kj[m0 + 5]};
        *(LAS u32x4*)(slot + SC_VI + ro) = (u32x4){vv[m0], vv[m0 + 1], vv[m0 + 4], vv[m0 + 5]}; }
    if (half) ((LAS float*)(slot + SC_GL))[lane] = gl;
    const int swz = (r >> 1) & 7;
    f32x16 D0, D1, D2;
#pragma unroll
    for (int i = 0; i < 16; ++i) { D0[i] = 0.f; D1[i] = 0.f; D2[i] = 0.f; }
    if (half == 0) {
#pragma unroll
        for (int ks = 0; ks < 4; ++ks) { const int ao = r * 128 + (((2 * ks + h) ^ swz) << 4);
            D0 = __builtin_amdgcn_mfma_f32_32x32x16_bf16(*(const LAS bf16x8*)(slot + SC_BT + ao), *(const LAS bf16x8*)(slot + SC_AT + ao), D0, 0, 0, 0); }
    } else {
#pragma unroll
        for (int ks = 0; ks < 4; ++ks) { const int ao = r * 128 + (((2 * ks + h) ^ swz) << 4);
            const bf16x8 bA = *(const LAS bf16x8*)(slot + SC_BT + ao), kA = *(const LAS bf16x8*)(slot + SC_KT + ao), aB = *(const LAS bf16x8*)(slot + SC_AT + ao), rB = *(const LAS bf16x8*)(slot + SC_RT + ao);
            D0 = __builtin_amdgcn_mfma_f32_32x32x16_bf16(kA, aB, D0, 0, 0, 0); D1 = __builtin_amdgcn_mfma_f32_32x32x16_bf16(bA, rB, D1, 0, 0, 0); D2 = __builtin_amdgcn_mfma_f32_32x32x16_bf16(kA, rB, D2, 0, 0, 0); }
    }
    SC_BARRIER();
    if (half == 0) {
        const int sw4 = (r >> 2) & 3; int bo[2];
#pragma unroll
        for (int s2 = 0; s2 < 2; ++s2) bo[s2] = r * 64 + (((2 * s2 + h) ^ sw4) << 4);
        const int pcol = (r & 16) | swap23(r & 15), pcc = pcol >> 3, pcw = (pcol & 7) * 2;
        f32x16 Mx, Tx;
#pragma unroll
        for (int reg = 0; reg < 16; ++reg) { const int sr = (reg & 3) + 8 * (reg >> 2) + 4 * h; const float av = (sr < r) ? D0[reg] : 0.f; Mx[reg] = av; Tx[reg] = av + ((sr == r) ? 1.f : 0.f); }
#pragma unroll
        for (int it = 0; it < 4; ++it) {
#pragma unroll
            for (int reg = 0; reg < 16; ++reg) { const int sr = (reg & 3) + 8 * (reg >> 2) + 4 * h; const int ad = sr * 64 + ((pcc ^ ((sr >> 2) & 3)) << 4) + pcw;
                *(LAS bf16_t*)(ysc + ad) = (bf16_t)f2bf(Mx[reg]); *(LAS bf16_t*)(ysc + 2048 + ad) = (bf16_t)f2bf(Tx[reg]); }
            LDS_WAIT(); asm volatile("" ::: "memory");
            bf16x8 mb[2], m2b[2];
#pragma unroll
            for (int s2 = 0; s2 < 2; ++s2) mb[s2] = packacc(Mx, s2);
            f32x16 M2;
#pragma unroll
            for (int i = 0; i < 16; ++i) M2[i] = 0.f;
#pragma unroll
            for (int s2 = 0; s2 < 2; ++s2) M2 = __builtin_amdgcn_mfma_f32_32x32x16_bf16(*(const LAS bf16x8*)(ysc + bo[s2]), mb[s2], M2, 0, 0, 0);
#pragma unroll
            for (int s2 = 0; s2 < 2; ++s2) m2b[s2] = packacc(M2, s2);
#pragma unroll
            for (int s2 = 0; s2 < 2; ++s2) Tx = __builtin_amdgcn_mfma_f32_32x32x16_bf16(*(const LAS bf16x8*)(ysc + 2048 + bo[s2]), m2b[s2], Tx, 0, 0, 0);
            Mx = M2;
            LDS_WAIT(); asm volatile("" ::: "memory");
        }
#pragma unroll
        for (int g = 0; g < 4; ++g) { const int ro = r * 64 + (((2 * (g >> 1) + h) ^ sw4) << 4) + 8 * (g & 1);
            *(LAS u32x2*)(slot + SC_TT + ro) = (u32x2){cvtpk(Tx[4 * g], Tx[4 * g + 1]), cvtpk(Tx[4 * g + 2], Tx[4 * g + 3])}; }
    } else {
#pragma unroll
        for (int reg = 0; reg < 16; ++reg) { const int sr = (reg & 3) + 8 * (reg >> 2) + 4 * h; D0[reg] = (sr < r) ? D0[reg] : 0.f; D1[reg] = (sr <= r) ? D1[reg] : 0.f; D2[reg] = (sr <= r) ? D2[reg] : 0.f; }
        const int sw4 = (r >> 2) & 3;
#pragma unroll
        for (int g = 0; g < 4; ++g) { const int ro = r * 64 + (((2 * (g >> 1) + h) ^ sw4) << 4) + 8 * (g & 1);
            *(LAS u32x2*)(slot + SC_AAKT + ro) = (u32x2){cvtpk(D0[4 * g], D0[4 * g + 1]), cvtpk(D0[4 * g + 2], D0[4 * g + 3])};
            *(LAS u32x2*)(slot + SC_ABRT + ro) = (u32x2){cvtpk(D1[4 * g], D1[4 * g + 1]), cvtpk(D1[4 * g + 2], D1[4 * g + 3])};
            *(LAS u32x2*)(slot + SC_AKRT + ro) = (u32x2){cvtpk(D2[4 * g], D2[4 * g + 1]), cvtpk(D2[4 * g + 2], D2[4 * g + 3])}; }
    }
}
__device__ __forceinline__ void scan_seq(LAS unsigned char* slot, LAS bf16_t* yb, int ib, int lane, f32x16 (&Z)[2]) {
    asm volatile("" : "+v"(lane));
    { unsigned so = (unsigned)(size_t)slot; asm volatile("" : "+s"(so)); slot = (LAS unsigned char*)(size_t)so; }
    const int r = lane & 31, h = lane >> 5, swz = (r >> 1) & 7, sw4 = (r >> 2) & 3;
    int ao[4], bo[2];
#pragma unroll
    for (int ks = 0; ks < 4; ++ks) ao[ks] = r * 128 + (((2 * ks + h) ^ swz) << 4);
#pragma unroll
    for (int s2 = 0; s2 < 2; ++s2) bo[s2] = r * 64 + (((2 * s2 + h) ^ sw4) << 4);
    bf16x8 zb[4], vB[2], xb[2], pb[2];
#pragma unroll
    for (int jb = 0; jb < 2; ++jb)
#pragma unroll
        for (int s2 = 0; s2 < 2; ++s2) zb[2 * jb + s2] = packacc(Z[jb], s2);
#pragma unroll
    for (int s2 = 0; s2 < 2; ++s2) vB[s2] = *(const LAS bf16x8*)(slot + SC_VI + ib * 2048 + bo[s2]);
    f32x16 X, P, Y;
#pragma unroll
    for (int i = 0; i < 16; ++i) { X[i] = 0.f; P[i] = 0.f; Y[i] = 0.f; }
#pragma unroll
    for (int ks = 0; ks < 4; ++ks) X = __builtin_amdgcn_mfma_f32_32x32x16_bf16(*(const LAS bf16x8*)(slot + SC_AT + ao[ks]), zb[ks], X, 0, 0, 0);
#pragma unroll
    for (int s2 = 0; s2 < 2; ++s2) X = __builtin_amdgcn_mfma_f32_32x32x16_bf16(*(const LAS bf16x8*)(slot + SC_AAKT + bo[s2]), vB[s2], X, 0, 0, 0);
#pragma unroll
    for (int s2 = 0; s2 < 2; ++s2) xb[s2] = packacc(X, s2);
#pragma unroll
    for (int s2 = 0; s2 < 2; ++s2) P = __builtin_amdgcn_mfma_f32_32x32x16_bf16(*(const LAS bf16x8*)(slot + SC_TT + bo[s2]), xb[s2], P, 0, 0, 0);
#pragma unroll
    for (int s2 = 0; s2 < 2; ++s2) pb[s2] = packacc(P, s2);
#pragma unroll
    for (int ks = 0; ks < 4; ++ks) Y = __builtin_amdgcn_mfma_f32_32x32x16_bf16(*(const LAS bf16x8*)(slot + SC_RT + ao[ks]), zb[ks], Y, 0, 0, 0);
#pragma unroll
    for (int s2 = 0; s2 < 2; ++s2) { Y = __builtin_amdgcn_mfma_f32_32x32x16_bf16(*(const LAS bf16x8*)(slot + SC_ABRT + bo[s2]), pb[s2], Y, 0, 0, 0);
        Y = __builtin_amdgcn_mfma_f32_32x32x16_bf16(*(const LAS bf16x8*)(slot + SC_AKRT + bo[s2]), vB[s2], Y, 0, 0, 0); }
#pragma unroll
    for (int jb = 0; jb < 2; ++jb) {
#pragma unroll
        for (int s2 = 0; s2 < 2; ++s2) { Z[jb] = __builtin_amdgcn_mfma_f32_32x32x16_bf16(*(const LAS bf16x8*)(slot + SC_BJ + jb * 2048 + bo[s2]), pb[s2], Z[jb], 0, 0, 0);
            Z[jb] = __builtin_amdgcn_mfma_f32_32x32x16_bf16(*(const LAS bf16x8*)(slot + SC_KJ + jb * 2048 + bo[s2]), vB[s2], Z[jb], 0, 0, 0); }
#pragma unroll
        for (int g = 0; g < 4; ++g) { const f32x4 gl4 = *(const LAS f32x4*)(slot + SC_GL + (32 * jb + 8 * g + 4 * h) * 4);
            Z[jb][4 * g] *= gl4.x; Z[jb][4 * g + 1] *= gl4.y; Z[jb][4 * g + 2] *= gl4.z; Z[jb][4 * g + 3] *= gl4.w; } }
#pragma unroll
    for (int reg = 0; reg < 16; ++reg) yb[((reg & 3) + 8 * (reg >> 2) + 4 * h) * 64 + ib * 32 + r] = (bf16_t)f2bf(Y[reg]);
}
__device__ __forceinline__ void phase_scan(const Fr& F, const Args& a) {
    unsigned char* ws = a.ws; const bf16_t* Vb = (const bf16_t*)a.out; const bf16_t* Gb = (const bf16_t*)(ws + WS_S2); bf16_t* YG = (bf16_t*)(ws + WS_S5);
    LAS bf16_t* YB = (LAS bf16_t*)(F.lds + SC_YB);
    LAS float* BON = (LAS float*)(F.lds + SC_BON);
    const int w = F.wave, lane = F.lane;
    for (int cp = blockIdx.x; cp < 256; cp += F.G) {
        f32x16 Z[2];
#pragma unroll
        for (int i = 0; i < 16; ++i) { Z[0][i] = 0.f; Z[1][i] = 0.f; }
        ScanRaw R; scan_load(a, R, 2 * cp + ((w & 3) >> 1), 32 * (w & 1), w >> 2, lane);
        const int chp = ((2 * cp + ((w & 3) >> 1)) & 15) * 64 + lane; float kkc = a.in[I_AKK][chp], kac = a.in[I_AKA][chp], rkc = a.in[I_ARK][chp];
        asm volatile("" : "+v"(kkc), "+v"(kac), "+v"(rkc));
#pragma unroll 1
        for (int bt = 0; bt <= 32; ++bt) {
            SC_BARRIER();
            if (bt < 32) { const int sl = w & 3;
                scan_pre(F, a, F.lds + sl * SC_SLOT, BON + (bt & 1) * 128 + (sl >> 1) * 64 + (sl & 1) * 32, F.lds + SC_YB + (bt & 1) * 16384 + sl * 4096, 2 * cp + (sl >> 1), 64 * bt + 32 * (sl & 1), w >> 2, R, bt < 31, kkc, kac, rkc); }
            SC_BARRIER();
            if (w >= 4) { if (bt < 32) { const int cl = (w - 4) >> 1, ib = (w - 4) & 1;
                scan_seq(F.lds + (2 * cl) * SC_SLOT, YB + (bt & 1) * 8192 + cl * 4096, ib, lane, Z);
                scan_seq(F.lds + (2 * cl + 1) * SC_SLOT, YB + (bt & 1) * 8192 + cl * 4096 + 2048, ib, lane, Z); } }
            else if (bt >= 1) {
                const int cl = w >> 1, chain = 2 * cp + cl, b = chain >> 4, hd = chain & 15, ch = hd * 64 + lane; const float lw_ = a.in[I_ALNXW][ch], lb_ = a.in[I_ALNXB][ch];
                LAS f32x2* ST = (LAS f32x2*)(F.lds + SC_BON + 1024) + w * 32;
                const int tb = 32 * (w & 1); const LAS bf16_t* yp = YB + ((bt - 1) & 1) * 8192 + cl * 4096 + tb * 64 + lane;
                const size_t go = ((size_t)chain * SEQ + 64 * (bt - 1) + tb) * 64 + lane; const bf16_t* vp = Vb + go; const bf16_t* gp = Gb + go; bf16_t* op = YG + go;
                const LAS float* bp = BON + ((bt - 1) & 1) * 128 + cl * 64 + tb;
#pragma unroll 1
                for (int hh = 0; hh < 2; ++hh) {
                    unsigned vg[16];
#pragma unroll
                    for (int tt = 0; tt < 16; ++tt) vg[tt] = (unsigned)vp[(16 * hh + tt) * 64] | ((unsigned)gp[(16 * hh + tt) * 64] << 16);
                    float yq[16];
                    {
                        float q[32];
#pragma unroll
                        for (int tt = 0; tt < 16; ++tt) { const float y = bf2f(yp[(16 * hh + tt) * 64]); yq[tt] = y; q[tt] = y; q[16 + tt] = y * y; }
                        const float s1 = reduce32(q, lane); const int idx = (lane >> 1) & 31;
                        LAS float* STf = (LAS float*)ST;
                        if ((lane & 1) == 0) STf[idx] = s1;
                    }
                    LDS_WAIT(); asm volatile("" ::: "memory");
                    f32x4 sm[4], sq[4], bv4[4];
#pragma unroll
                    for (int q4 = 0; q4 < 4; ++q4) { sm[q4] = ((const LAS f32x4*)ST)[q4]; sq[q4] = ((const LAS f32x4*)ST)[4 + q4]; bv4[q4] = *(const LAS f32x4*)(bp + 16 * hh + 4 * q4); }
#pragma unroll
                    for (int tt = 0; tt < 16; ++tt) { const int t = 16 * hh + tt; const float mean = sm[tt >> 2][tt & 3] * (1.f / 64.f); const float var = fmaxf(sq[tt >> 2][tt & 3] * (1.f / 64.f) - mean * mean, 0.f);
                        float o = (yq[tt] - mean) * __builtin_amdgcn_rsqf(var + 64e-5f) * lw_ + lb_ + bv4[tt >> 2][tt & 3] * bflo(vg[tt]);
                        o *= bfhi(vg[tt]); op[t * 64] = (bf16_t)f2bf(o); }
                    LDS_WAIT(); asm volatile("" ::: "memory");
                }
            }
        }
    }
}

template <int MODE>
__device__ __forceinline__ float load_row_hb(const Fr& F, const bf16_t* hrow, const bf16_t* Y, const int* asg, int m, float (&v)[16]) {
    int p0 = 0, p1 = 0; if (MODE == 1) { p0 = asg[m * 8 + 6]; p1 = asg[m * 8 + 7]; }
    float s = 0.f;
#pragma unroll
    for (int j = 0; j < 2; ++j) { const u32x4 hv = *(const u32x4*)(hrow + 512 * j + 8 * F.lane);
        float* o = v + 8 * j; o[0] = bflo(hv.x); o[1] = bfhi(hv.x); o[2] = bflo(hv.y); o[3] = bfhi(hv.y); o[4] = bflo(hv.z); o[5] = bfhi(hv.z); o[6] = bflo(hv.w); o[7] = bfhi(hv.w);
        if (MODE == 1) { const u32x4 y0 = *(const u32x4*)(Y + (size_t)p0 * 1024 + 512 * j + 8 * F.lane), y1 = *(const u32x4*)(Y + (size_t)p1 * 1024 + 512 * j + 8 * F.lane);
            o[0] += bflo(y0.x) + bflo(y1.x); o[1] += bfhi(y0.x) + bfhi(y1.x); o[2] += bflo(y0.y) + bflo(y1.y); o[3] += bfhi(y0.y) + bfhi(y1.y);
            o[4] += bflo(y0.z) + bflo(y1.z); o[5] += bfhi(y0.z) + bfhi(y1.z); o[6] += bflo(y0.w) + bflo(y1.w); o[7] += bfhi(y0.w) + bfhi(y1.w); }
#pragma unroll
        for (int e = 0; e < 8; ++e) s += o[e] * o[e]; }
    return 1.f / sqrtf(wave_sum(s) * (1.f / 1024.f) + 1e-6f);
}

struct RowRaw { u32x4 h[2], y0[2], y1[2]; };
__device__ __forceinline__ int y_chunk_col(int c) { const int ci = c & 31; return (c >> 5) * 256 + (((ci >> 2) & 3) * 8 + (ci >> 4) * 4 + (ci & 3)) * 8; }
__device__ __forceinline__ void row_issue(const Fr& F, const bf16_t* hrow, const bf16_t* Y, int p0, int p1, RowRaw& R) {
#pragma unroll
    for (int j = 0; j < 2; ++j) { const int yc = y_chunk_col(64 * j + F.lane);
        R.h[j] = *(const u32x4*)(hrow + 512 * j + 8 * F.lane); R.y0[j] = *(const u32x4*)(Y + (size_t)p0 * 1024 + yc); R.y1[j] = *(const u32x4*)(Y + (size_t)p1 * 1024 + yc); }
}
__device__ __forceinline__ float row_finish(const RowRaw& R, float (&v)[16], float w0, float w1) {
    float s = 0.f;
#pragma unroll
    for (int j = 0; j < 2; ++j) { const u32x4 hv = R.h[j], y0 = R.y0[j], y1 = R.y1[j]; float* o = v + 8 * j;
        o[0] = bflo(hv.x) + (w0 * bflo(y0.x) + w1 * bflo(y1.x)); o[1] = bfhi(hv.x) + (w0 * bfhi(y0.x) + w1 * bfhi(y1.x)); o[2] = bflo(hv.y) + (w0 * bflo(y0.y) + w1 * bflo(y1.y)); o[3] = bfhi(hv.y) + (w0 * bfhi(y0.y) + w1 * bfhi(y1.y));
        o[4] = bflo(hv.z) + (w0 * bflo(y0.z) + w1 * bflo(y1.z)); o[5] = bfhi(hv.z) + (w0 * bfhi(y0.z) + w1 * bfhi(y1.z)); o[6] = bflo(hv.w) + (w0 * bflo(y0.w) + w1 * bflo(y1.w)); o[7] = bfhi(hv.w) + (w0 * bfhi(y0.w) + w1 * bfhi(y1.w));
#pragma unroll
        for (int e = 0; e < 8; ++e) s += o[e] * o[e]; }
    return 1.f / sqrtf(wave_sum(s) * (1.f / 1024.f) + 1e-6f);
}
constexpr int RB = 4;
#define ROWS_ISSUE(Hbase) int p0[RB], p1[RB]; float rw0[RB], rw1[RB]; RowRaw R[RB]; \
        _Pragma("unroll") for (int r = 0; r < RB; ++r) { const int mr = m + r * F.ngw; p0[r] = 0; p1[r] = 0; rw0[r] = 0.f; rw1[r] = 0.f; if (mr < NT) { const u32x4 _as = *(const u32x4*)(asg + mr * 8 + 4); \
            const unsigned _wx = _as.x, _wy = _as.y; rw0[r] = __uint_as_float(_wx); rw1[r] = __uint_as_float(_wy); p0[r] = (int)_as.z; p1[r] = (int)_as.w; } } \
        _Pragma("unroll") for (int r = 0; r < RB; ++r) { const int mr = m + r * F.ngw; if (mr < NT) row_issue(F, (Hbase) + (size_t)mr * 1024, Y, p0[r], p1[r], R[r]); }
__device__ __forceinline__ void phase_m1(const Fr& F, const Args& a, int layer) {
    unsigned char* ws = a.ws; const bf16_t* h = (const bf16_t*)(ws + WS_H); float* RS = (float*)(ws + WS_RSTD);
    int* asg = (int*)(ws + WS_ASG);
    const bf16_t* wfb = (const bf16_t*)(ws + WS_RFRAG) + (size_t)layer * 32 * 9 * 512;
    unsigned* cnt = (unsigned*)(ws + WS_CTL) + CW_CNT + layer * 32 * 64;
    LAS float* Lg = (LAS float*)F.lds + F.wave * 1600;
    LAS float* Lr = Lg + 1536;
    for (int task = F.gw; task < NT / 32; task += F.ngw) {
        const int m0 = task * 32;
        f32x4 acc[2][3];
#pragma unroll
        for (int rb = 0; rb < 2; ++rb)
#pragma unroll
            for (int nt = 0; nt < 3; ++nt) acc[rb][nt] = (f32x4){0.f, 0.f, 0.f, 0.f};
        const int i = F.lane & 15, q = F.lane >> 4; const bf16_t* hr = h + (size_t)(m0 + i) * 1024 + 8 * q;
        float ss0 = 0.f, ss1 = 0.f;
#pragma unroll 4
        for (int s = 0; s < 32; ++s) {
            const bf16x8 a0 = *(const bf16x8*)(hr + 32 * s), a1 = *(const bf16x8*)(hr + 16 * 1024 + 32 * s);
            const bf16_t* wp = wfb + (size_t)s * 9 * 512 + F.lane * 8;
#pragma unroll
            for (int tn = 0; tn < 9; ++tn) { const bf16x8 b = *(const bf16x8*)(wp + tn * 512);
                acc[0][tn % 3] = __builtin_amdgcn_mfma_f32_16x16x32_bf16(a0, b, acc[0][tn % 3], 0, 0, 0); acc[1][tn % 3] = __builtin_amdgcn_mfma_f32_16x16x32_bf16(a1, b, acc[1][tn % 3], 0, 0, 0); }
            const u32x4 u0 = __builtin_bit_cast(u32x4, a0), u1 = __builtin_bit_cast(u32x4, a1);
#pragma unroll
            for (int e = 0; e < 4; ++e) { const float x0 = bflo(u0[e]), y0 = bfhi(u0[e]), x1 = bflo(u1[e]), y1 = bfhi(u1[e]); ss0 += x0 * x0 + y0 * y0; ss1 += x1 * x1 + y1 * y1; }
        }
        {
            auto r16 = __builtin_amdgcn_permlane16_swap(__float_as_uint(ss0), __float_as_uint(ss0), false, false); ss0 = __uint_as_float(r16[0]) + __uint_as_float(r16[1]);
            auto r32 = __builtin_amdgcn_permlane32_swap(__float_as_uint(ss0), __float_as_uint(ss0), false, false); ss0 = __uint_as_float(r32[0]) + __uint_as_float(r32[1]);
            r16 = __builtin_amdgcn_permlane16_swap(__float_as_uint(ss1), __float_as_uint(ss1), false, false); ss1 = __uint_as_float(r16[0]) + __uint_as_float(r16[1]);
            r32 = __builtin_amdgcn_permlane32_swap(__float_as_uint(ss1), __float_as_uint(ss1), false, false); ss1 = __uint_as_float(r32[0]) + __uint_as_float(r32[1]);
            const float rs0 = 1.f / sqrtf(ss0 * (1.f / 1024.f) + 1e-6f), rs1 = 1.f / sqrtf(ss1 * (1.f / 1024.f) + 1e-6f);
            if (F.lane < 16) { RS[m0 + i] = rs0; RS[m0 + 16 + i] = rs1; Lr[i] = rs0; Lr[16 + i] = rs1; }
        }
        LDS_WAIT(); asm volatile("" ::: "memory");
#pragma unroll
        for (int rb = 0; rb < 2; ++rb) { const f32x4 rs = *(const LAS f32x4*)(Lr + 16 * rb + 4 * q);
#pragma unroll
            for (int nt = 0; nt < 3; ++nt)
#pragma unroll
                for (int rg = 0; rg < 4; ++rg) Lg[(16 * rb + 4 * q + rg) * 48 + 16 * nt + i] = acc[rb][nt][rg] * rs[rg]; }
        LDS_WAIT(); asm volatile("" ::: "memory");
        if (F.lane < 32) {
            const int m = m0 + F.lane; const LAS float* lg = Lg + F.lane * 48;
            float gl[4]; float gmax = -3.0e38f; int grp = 0;
#pragma unroll
            for (int j = 0; j < 4; ++j) { gl[j] = lg[j] + a.in[I_MBG][layer * 4 + j]; if (gl[j] > gmax) { gmax = gl[j]; grp = j; } }
            float gs = 0.f;
#pragma unroll
            for (int j = 0; j < 4; ++j) gs += __expf(gl[j] - gmax);
            const float grp_w = 1.f / gs;
            float v1 = -3.0e38f, v2 = -3.0e38f; int i1 = 0, i2 = 0;
            for (int j = 0; j < 8; ++j) { const float e = lg[4 + grp * 8 + j] + a.in[I_MBE][layer * 32 + grp * 8 + j];
                if (e > v1) { v2 = v1; i2 = i1; v1 = e; i1 = j; } else if (e > v2) { v2 = e; i2 = j; } }
            const float r2 = __expf(v2 - v1); const float w1 = grp_w / (1.f + r2), w2 = grp_w * r2 / (1.f + r2);
            const int e1 = grp * 8 + i1, e2 = grp * 8 + i2;
            const unsigned s1 = __hip_atomic_fetch_add(cnt + e1 * 64, 1u, __ATOMIC_RELAXED, __HIP_MEMORY_SCOPE_AGENT);
            const unsigned s2 = __hip_atomic_fetch_add(cnt + e2 * 64, 1u, __ATOMIC_RELAXED, __HIP_MEMORY_SCOPE_AGENT);
            int* r = asg + (size_t)m * 8; r[0] = e1; r[1] = e2; r[2] = (int)s1; r[3] = (int)s2; r[4] = __builtin_bit_cast(int, w1); r[5] = __builtin_bit_cast(int, w2);
        }
        LDS_WAIT(); asm volatile("" ::: "memory");
    }
}

__device__ __forceinline__ void phase_m2(const Fr& F, const Args& a, int layer) {
    unsigned char* ws = a.ws;
    int* asg = (int*)(ws + WS_ASG); float* roww = (float*)(ws + WS_ROWW);
    int* texp = (int*)(ws + WS_TEXP);
    unsigned* cnt = (unsigned*)(ws + WS_CTL) + CW_CNT + layer * 32 * 64;
    LAS int* sb = (LAS int*)F.lds;
    if (F.tid < 32) sb[64 + F.tid] = (int)__hip_atomic_load(cnt + F.tid * 64, __ATOMIC_RELAXED, __HIP_MEMORY_SCOPE_AGENT);
    __syncthreads();
    if (F.tid == 0) { int acc = 0; for (int e = 0; e < 32; ++e) { sb[e] = acc; acc += (sb[64 + e] + 255) & ~255; } sb[32] = acc; }
    __syncthreads();
    if (blockIdx.x == 0) {
        const int ntiles = sb[32] >> 8;
        for (int t = F.tid; t < ntiles; t += 512) { int e = 0; for (int j = 1; j < 32; ++j) if ((t << 8) >= sb[j]) e = j; texp[t] = e; }
        if (F.tid == 0) texp[1023] = ntiles;
        if (F.tid < 8) { int n = 0; for (int q = 0; q < 4; ++q) { const int e = F.tid + 8 * q; for (int t = sb[e] >> 8; t < (sb[e + 1] >> 8); ++t) texp[2048 + F.tid * 640 + n++] = t | (e << 16); } texp[1008 + F.tid] = n; }
    }
    int* ridx = (int*)(ws + WS_RIDX); float* rowrs = (float*)(ws + WS_ROWRS); const float* RS = (const float*)(ws + WS_RSTD);
    for (int as = blockIdx.x * 512 + F.tid; as < NT * 2; as += F.G * 512) {
        const int m = as >> 1, k = as & 1; const int e = asg[m * 8 + k], slot = asg[m * 8 + 2 + k]; const int p = sb[e] + slot;
        ridx[p] = m; rowrs[p] = RS[m]; roww[p] = __builtin_bit_cast(float, asg[m * 8 + 4 + k]); asg[m * 8 + 6 + k] = p; }
    for (int idx = blockIdx.x * 512 + F.tid; idx < 32 * 256; idx += F.G * 512) {
        const int e = idx >> 8, r = idx & 255; const int p = sb[e] + sb[64 + e] + r;
        if (p < sb[e + 1]) { ridx[p] = 0; rowrs[p] = 0.f; roww[p] = 0.f; } }
}

__device__ __forceinline__ void phase_n1(const Fr& F, const Args& a) {
    unsigned char* ws = a.ws; bf16_t* H = (bf16_t*)(ws + WS_H); const bf16_t* Y = (const bf16_t*)(ws + WS_S1); const int* asg = (const int*)(ws + WS_ASG); float* RS = (float*)(ws + WS_RSTD);
    for (int m = F.gw; m < NT; m += RB * F.ngw) {
        ROWS_ISSUE(H)
#pragma unroll
        for (int r = 0; r < RB; ++r) { const int mr = m + r * F.ngw; if (mr < NT) {
            float v[16]; bf16_t* hrow = H + (size_t)mr * 1024; const float rstd = row_finish(R[r], v, rw0[r], rw1[r]);
#pragma unroll
            for (int j = 0; j < 2; ++j) *(u32x4*)(hrow + 512 * j + 8 * F.lane) = (u32x4){pk2(v[8 * j], v[8 * j + 1]), pk2(v[8 * j + 2], v[8 * j + 3]), pk2(v[8 * j + 4], v[8 * j + 5]), pk2(v[8 * j + 6], v[8 * j + 7])};
            if (F.lane == 0) RS[mr] = rstd; } }
    }
}
__device__ __forceinline__ void phase_final(const Fr& F, const Args& a) {
    unsigned char* ws = a.ws; const bf16_t* H = (const bf16_t*)(ws + WS_H); const bf16_t* Y = (const bf16_t*)(ws + WS_S1); const int* asg = (const int*)(ws + WS_ASG); const float* gain = a.in[I_FLN];
    for (int m = F.gw; m < NT; m += RB * F.ngw) {
        ROWS_ISSUE(H)
#pragma unroll
        for (int r = 0; r < RB; ++r) { const int mr = m + r * F.ngw; if (mr < NT) {
            float v[16]; const float rstd = row_finish(R[r], v, rw0[r], rw1[r]); float* orow = a.out + (size_t)mr * 1024;
#pragma unroll
            for (int j = 0; j < 2; ++j) { const int c = 512 * j + 8 * F.lane; const f32x4 g0 = *(const f32x4*)(gain + c), g1 = *(const f32x4*)(gain + c + 4);
                *(f32x4*)(orow + c) = (f32x4){v[8 * j] * rstd * g0.x, v[8 * j + 1] * rstd * g0.y, v[8 * j + 2] * rstd * g0.z, v[8 * j + 3] * rstd * g0.w};
                *(f32x4*)(orow + c + 4) = (f32x4){v[8 * j + 4] * rstd * g1.x, v[8 * j + 5] * rstd * g1.y, v[8 * j + 6] * rstd * g1.z, v[8 * j + 7] * rstd * g1.w}; } } }
    }
}

__device__ __forceinline__ void phase_cmp_gather(const Fr& F, const Args& a) {
    unsigned char* ws = a.ws; const bf16_t* KV = (const bf16_t*)(ws + WS_KV); bf16_t* AC = (bf16_t*)(ws + WS_ACMP);
    for (int r = F.gw; r < 2 * 16384; r += F.ngw) {
        const int grp = r >> 14, rr = r & 16383, bg = rr >> 7, n = rr & 127, b = bg >> 2, g = bg & 3;
        const float* pe = a.in[grp ? I_PEV : I_PEK] + (size_t)g * 32 * 64;
        bf16_t* dst = AC + (size_t)r * 2048;
        for (int l2 = 0; l2 < 16; ++l2) { const int l = 2 * l2 + (F.lane >> 5), d = 2 * (F.lane & 31);
            unsigned o = 0u;
            if (n < 127) { const unsigned kv = *(const unsigned*)(KV + (size_t)(b * SEQ + 16 * n + l) * 1536 + (grp * 4 + g) * 64 + d);
                o = pk2(bflo(kv) + pe[l * 64 + d], bfhi(kv) + pe[l * 64 + d + 1]); }
            *(unsigned*)(dst + l * 64 + d) = o; }
    }
}
__device__ __forceinline__ int perm16pos(int w) { return w < 4 ? w : (w < 8 ? w + 4 : (w < 12 ? w - 4 : w)); }
__device__ __forceinline__ void phase_cmp2(const Fr& F, const Args& a, int task0, int tstep, int tend) {
    unsigned char* ws = a.ws; const bf16_t* HC = (const bf16_t*)(ws + WS_HC); bf16_t* KCB = (bf16_t*)(ws + WS_KCB); bf16_t* VCT = (bf16_t*)(ws + WS_VCT); const bf16_t* WF = (const bf16_t*)(ws + WS_W2F);
    const int i = F.lane & 15, q = F.lane >> 4;
    for (int task = task0; task < tend; task += tstep) {
        const int r0 = task * 16, grp = r0 >> 14, rr = r0 & 16383, bg = rr >> 7, n0 = rr & 127;
        f32x4 acc[4];
#pragma unroll
        for (int nb = 0; nb < 4; ++nb) acc[nb] = (f32x4){0.f, 0.f, 0.f, 0.f};
        const bf16_t* hr = HC + (size_t)(r0 + i) * 256 + 8 * q; const bf16_t* wp = WF + (size_t)grp * 8 * 8 * 512 + F.lane * 8;
#pragma unroll
        for (int sk = 0; sk < 8; ++sk) { const bf16x8 av = *(const bf16x8*)(hr + 32 * sk);
#pragma unroll
            for (int tn = 0; tn < 8; ++tn) acc[tn & 3] = __builtin_amdgcn_mfma_f32_16x16x32_bf16(av, *(const bf16x8*)(wp + (sk * 8 + tn) * 512), acc[tn & 3], 0, 0, 0); }
#pragma unroll
        for (int nb = 0; nb < 4; ++nb) { const int col = 16 * nb + i; f32x4 v = acc[nb];
#pragma unroll
            for (int rg = 0; rg < 4; ++rg) if (n0 + 4 * q + rg == 127) v[rg] = 0.f;
            if (grp == 0) {
#pragma unroll
                for (int rg = 0; rg < 4; ++rg) KCB[((size_t)bg * 128 + n0 + 4 * q + rg) * 64 + col] = (bf16_t)f2bf(v[rg]); }
            else *(u32x2*)(VCT + ((size_t)bg * 64 + col) * 128 + n0 + perm16pos(4 * q)) = (u32x2){cvtpk(v[0], v[1]), cvtpk(v[2], v[3])}; }
    }
}
__device__ __forceinline__ void phase_vt(const Fr& F, const Args& a, int gw, int ngw) {
    unsigned char* ws = a.ws; const bf16_t* KV = (const bf16_t*)(ws + WS_KV); bf16_t* VT = (bf16_t*)a.out;
    LAS unsigned* T2 = (LAS unsigned*)(F.lds) + F.wave * 2080;
    for (int task = gw; task < 8192; task += ngw) {
        const int tile = task & 31, g = (task >> 5) & 3, pg = (task >> 7) & 1, b = task >> 8;
        const u32x4* src = (const u32x4*)(KV + (size_t)(b * SEQ + 64 * tile + F.lane) * 1536 + ((pg ? 5 : 3) * 4 + g) * 64);
#pragma unroll
        for (int i = 0; i < 8; ++i) { const u32x4 v = src[i]; T2[(4 * i + 0) * 65 + F.lane] = v.x; T2[(4 * i + 1) * 65 + F.lane] = v.y; T2[(4 * i + 2) * 65 + F.lane] = v.z; T2[(4 * i + 3) * 65 + F.lane] = v.w; }
        LDS_WAIT(); asm volatile("" ::: "memory");
        const int d = F.lane, dp = d >> 1; const bool hi = d & 1;
        u32x4* dst = (u32x4*)(VT + ((size_t)((b * 2 + pg) * 4 + g) * 64 + d) * 2048 + 64 * tile);
#pragma unroll
        for (int G = 0; G < 4; ++G) {
            unsigned e[16];
#pragma unroll
            for (int p = 0; p < 16; ++p) { const int key = 16 * G + ((p < 4) ? p : (p < 8) ? p + 4 : (p < 12) ? p - 4 : p); const unsigned u = T2[dp * 65 + key]; e[p] = hi ? (u >> 16) : (u & 0xffffu); }
            dst[2 * G] = (u32x4){e[0] | (e[1] << 16), e[2] | (e[3] << 16), e[4] | (e[5] << 16), e[6] | (e[7] << 16)};
            dst[2 * G + 1] = (u32x4){e[8] | (e[9] << 16), e[10] | (e[11] << 16), e[12] | (e[13] << 16), e[14] | (e[15] << 16)};
        }
        LDS_WAIT(); asm volatile("" ::: "memory");
    }
}
__device__ __forceinline__ void dma16(const void* g, LAS void* l) { __builtin_amdgcn_global_load_lds((const unsigned*)g, (LAS unsigned*)l, 16, 0, 0); }
#define ATT_NEG (-__builtin_inff())
__device__ __forceinline__ unsigned xor32u(unsigned x) { const auto r = __builtin_amdgcn_permlane32_swap(x, x, false, false); return (threadIdx.x & 32) ? r[0] : r[1]; }
__device__ __forceinline__ float xor32(float x) { return __uint_as_float(xor32u(__float_as_uint(x))); }
template <int KM>
__device__ __forceinline__ void att_fix(f32x16 (&S)[2], int dbase, unsigned maxd, bool colsel, const LAS float* dBl) {
#pragma unroll
    for (int blk = 0; blk < 2; ++blk) {
        float bv[16];
#pragma unroll
        for (int rr = 0; rr < 16; ++rr) { const int koff = 32 * blk + (rr & 3) + 8 * (rr >> 2); const unsigned di = min((unsigned)(dbase - KM * koff), 128u); bv[rr] = dBl[di]; }
#pragma unroll
        for (int rr = 0; rr < 16; ++rr) asm volatile("" : "+v"(bv[rr]));
#pragma unroll
        for (int rr = 0; rr < 16; ++rr) { const int koff = 32 * blk + (rr & 3) + 8 * (rr >> 2); const int dist = dbase - KM * koff;
            const bool ok = ((unsigned)dist < maxd) && colsel; S[blk][rr] = ok ? S[blk][rr] + bv[rr] : ATT_NEG; } }
}
template <int KM>
__device__ __forceinline__ void att_fixcb(f32x16& S, int dbase, const LAS float* dBl) {
    float bv[16];
#pragma unroll
    for (int rr = 0; rr < 16; ++rr) { const int koff = (rr & 3) + 8 * (rr >> 2); const unsigned di = min((unsigned)(dbase - KM * koff), 128u); bv[rr] = dBl[di]; }
#pragma unroll
    for (int rr = 0; rr < 16; ++rr) asm volatile("" : "+v"(bv[rr]));
#pragma unroll
    for (int rr = 0; rr < 16; ++rr) { const int koff = (rr & 3) + 8 * (rr >> 2); const int dist = dbase - KM * koff; S[rr] = (dist >= 0) ? S[rr] + bv[rr] : ATT_NEG; }
}
__device__ __forceinline__ void att_fix1(f32x16 (&S)[2], int dbase, unsigned maxd, const LAS float* bp) {
#pragma unroll
    for (int blk = 0; blk < 2; ++blk) {
        f32x4 bv[4];
#pragma unroll
        for (int q = 0; q < 4; ++q) bv[q] = *(const LAS f32x4*)(bp + 56 - 32 * blk - 8 * q);
#pragma unroll
        for (int q = 0; q < 4; ++q) asm volatile("" : "+v"(bv[q]));
#pragma unroll
        for (int rr = 0; rr < 16; ++rr) { const int koff = 32 * blk + (rr & 3) + 8 * (rr >> 2); const int dist = dbase - koff;
            S[blk][rr] = ((unsigned)dist < maxd) ? S[blk][rr] + bv[rr >> 2][3 - (rr & 3)] : ATT_NEG; } }
}
__device__ __forceinline__ void att_scores(LAS unsigned char* ktile, const int (&aoff)[4], const bf16x8 (&qf)[4], f32x16 (&S)[2]) {
#pragma unroll
    for (int blk = 0; blk < 2; ++blk)
#pragma unroll
        for (int i = 0; i < 16; ++i) S[blk][i] = 0.f;
    bf16x8 kf[2][4];
#pragma unroll
    for (int s = 0; s < 4; ++s)
#pragma unroll
        for (int blk = 0; blk < 2; ++blk) kf[blk][s] = *(const LAS bf16x8*)(ktile + blk * 4096 + aoff[s]);
#pragma unroll
    for (int s = 0; s < 4; ++s) {
        S[0] = __builtin_amdgcn_mfma_f32_32x32x16_bf16(kf[0][s], qf[s], S[0], 0, 0, 0); S[1] = __builtin_amdgcn_mfma_f32_32x32x16_bf16(kf[1][s], qf[s], S[1], 0, 0, 0);
        __builtin_amdgcn_sched_barrier(0); }
}
__device__ __forceinline__ void att_scores_init(LAS unsigned char* ktile, const int (&aoff)[4], const bf16x8 (&qf)[4], f32x16 (&S)[2], const LAS float* ip) {
#pragma unroll
    for (int blk = 0; blk < 2; ++blk)
#pragma unroll
        for (int q = 0; q < 4; ++q) { const f32x4 v = *(const LAS f32x4*)(ip + 32 * blk + 8 * q); S[blk][4 * q] = v.x; S[blk][4 * q + 1] = v.y; S[blk][4 * q + 2] = v.z; S[blk][4 * q + 3] = v.w; }
    bf16x8 kf[2][4];
#pragma unroll
    for (int s = 0; s < 4; ++s)
#pragma unroll
        for (int blk = 0; blk < 2; ++blk) kf[blk][s] = *(const LAS bf16x8*)(ktile + blk * 4096 + aoff[s]);
#pragma unroll
    for (int s = 0; s < 4; ++s) {
        S[0] = __builtin_amdgcn_mfma_f32_32x32x16_bf16(kf[0][s], qf[s], S[0], 0, 0, 0); S[1] = __builtin_amdgcn_mfma_f32_32x32x16_bf16(kf[1][s], qf[s], S[1], 0, 0, 0);
        __builtin_amdgcn_sched_barrier(0); }
}
__device__ __forceinline__ void att_pv(LAS unsigned char* vtile, const int (&aoff)[4], const f32x16 (&P)[2], f32x16 (&O)[2]) {
    bf16x8 pb[2][2];
#pragma unroll
    for (int blk = 0; blk < 2; ++blk)
#pragma unroll
        for (int s2 = 0; s2 < 2; ++s2) pb[blk][s2] = pack8f(P[blk][8 * s2], P[blk][8 * s2 + 1], P[blk][8 * s2 + 2], P[blk][8 * s2 + 3], P[blk][8 * s2 + 4], P[blk][8 * s2 + 5], P[blk][8 * s2 + 6], P[blk][8 * s2 + 7]);
#pragma unroll
    for (int dt = 0; dt < 2; ++dt)
#pragma unroll
        for (int blk = 0; blk < 2; ++blk)
#pragma unroll
            for (int s2 = 0; s2 < 2; ++s2) { const bf16x8 A = *(const LAS bf16x8*)(vtile + dt * 4096 + aoff[2 * blk + s2]); O[dt] = __builtin_amdgcn_mfma_f32_32x32x16_bf16(A, pb[blk][s2], O[dt], 0, 0, 0); }
}
#define ATT_LHI 1.8446744e19f
#define ATT_TBL_NEG (4 * 2832)
#define ATT_TBL_ZERO (4 * 2832 + 64)
__device__ __forceinline__ float att_colmax(const f32x16 (&S)[2]) {
    float mx = S[0][0];
#pragma unroll
    for (int blk = 0; blk < 2; ++blk)
#pragma unroll
        for (int rr = 0; rr < 16; ++rr) mx = fmaxf(mx, S[blk][rr]);
    return fmaxf(mx, xor32(mx));
}
__device__ __forceinline__ void att_tile(LAS unsigned char* tile, const int (&aoff)[4], const bf16x8 (&qf)[4], f32x16 (&O)[2], float& m, float& l, bool& pending, bool& shifted,
                                         int fixmode, int dbase, bool colsel, const LAS float* dBl, const LAS float* tblbase) {
    f32x16 S[2];
    const LAS float* ip = colsel ? (fixmode == 2 ? dBl - dbase : tblbase + ATT_TBL_ZERO) : tblbase + ATT_TBL_NEG;
    if (fixmode == 0) att_scores(tile, aoff, qf, S); else att_scores_init(tile, aoff, qf, S, ip);
    if (shifted) { S[0] = S[0] - m; S[1] = S[1] - m; }
    if (pending) {
        const float mxc = att_colmax(S); const float dl = (mxc > -1e29f && fabsf(mxc) > 32.f) ? mxc : 0.f;
        if (__any(dl != 0.f)) { m += dl; S[0] = S[0] - dl; S[1] = S[1] - dl; shifted = true; }
        pending = false;
    }
    float ln = l;
#pragma unroll
    for (int blk = 0; blk < 2; ++blk)
#pragma unroll
        for (int rr = 0; rr < 16; ++rr) { const float p = __builtin_amdgcn_exp2f(S[blk][rr]); S[blk][rr] = p; ln += p; }
    if (__any(ln > ATT_LHI)) {
        if (fixmode == 0) att_scores(tile, aoff, qf, S); else att_scores_init(tile, aoff, qf, S, ip);
        if (shifted) { S[0] = S[0] - m; S[1] = S[1] - m; }
        const float mxc = att_colmax(S), lnc = fmaxf(ln, xor32(ln));
        const float dl = (lnc > ATT_LHI) ? fmaxf(mxc, 32.f) : 0.f, corr = __builtin_amdgcn_exp2f(-dl);
        m += dl; l *= corr; O[0] = O[0] * corr; O[1] = O[1] * corr; S[0] = S[0] - dl; S[1] = S[1] - dl; shifted = true;
        ln = l;
#pragma unroll
        for (int blk = 0; blk < 2; ++blk)
#pragma unroll
            for (int rr = 0; rr < 16; ++rr) { const float p = __builtin_amdgcn_exp2f(S[blk][rr]); S[blk][rr] = p; ln += p; }
    }
    l = ln;
    att_pv(tile + 8192, aoff, S, O);
}
__device__ __forceinline__ void phase_attn(const Fr& F, const Args& a) {
    unsigned char* ws = a.ws;
    const bf16_t* QB = (const bf16_t*)(ws + WS_Q); const unsigned char* KV = ws + WS_KV; const unsigned char* VT = (const unsigned char*)a.out; const float* GT = (const float*)(ws + WS_GATES);
    const unsigned char* KCB = ws + WS_KCB; const unsigned char* VCT = ws + WS_VCT; bf16_t* OB = (bf16_t*)(ws + WS_OATT);
    LAS unsigned char* RING = F.lds; LAS unsigned char* CMPA = F.lds + 65536; LAS float* dB = (LAS float*)(F.lds + 98304);
    const int w = F.wave, lane = F.lane, r = lane & 31, h = lane >> 5, hh = lane & 3, tl = r >> 2, swz = (r >> 1) & 7;
    int aoff[4];
#pragma unroll
    for (int s = 0; s < 4; ++s) aoff[s] = r * 128 + (((2 * s + h) ^ swz) * 16);
    const int drow = 8 * w + (lane >> 3), dchunk = ((lane & 7) ^ ((drow >> 1) & 7)) * 16;
    const LAS float* dBl = dB + hh * 132;
    LAS float* DB4 = (LAS float*)(F.lds + 102400);
    const LAS float* dB4l = DB4 + hh * 2832 + (tl & 3) * 708 + (tl & 3) + 576;
    int gprev = -1;
    const bool xcdord = F.G == 256;
    for (int unit = blockIdx.x, uk = 0; xcdord ? uk < 16 : unit < 4096; unit += F.G, ++uk) {
        const int bg = xcdord ? (int)(blockIdx.x & 7) + 8 * uk : unit & 127, qt = xcdord ? ((uk & 1) ? 31 - (int)(blockIdx.x >> 3) : (int)(blockIdx.x >> 3)) : (unit >> 7) ^ ((unit >> 8) & 1);
        const int b = bg >> 2, g = bg & 3, t0 = 64 * qt;
        __syncthreads();
        if (g != gprev) for (int i = F.tid; i < 4 * 129; i += 512) { const int hq = i / 129, d = i % 129;
            dB[hq * 132 + d] = (d < 128) ? (a.in[I_RELB][BKT[d] * 16 + 4 * g + hq] - a.in[I_RELB][31 * 16 + 4 * g + hq]) * 1.44269504089f : 0.f; }
        if (g != gprev) for (int i = F.tid; i < 4 * 2832 + 128; i += 512) { const int hq = i / 2832, rem = i % 2832, cc = rem / 708, d = 576 - (rem % 708 - cc);
            float v;
            if (i >= 4 * 2832) v = (i < 4 * 2832 + 64) ? ATT_NEG : 0.f;
            else v = (d < 0 || d >= 512) ? ATT_NEG : (d < 128 ? (a.in[I_RELB][BKT[d] * 16 + 4 * g + hq] - a.in[I_RELB][31 * 16 + 4 * g + hq]) * 1.44269504089f : 0.f);
            DB4[i] = v; }
        gprev = g;
        const unsigned char* kwin = KV + ((size_t)(b * SEQ) * 1536 + (16 + g) * 64) * 2; const unsigned char* ksel = KV + ((size_t)(b * SEQ) * 1536 + (8 + g) * 64) * 2;
        const unsigned char* vsel = VT + ((size_t)((b * 2 + 0) * 4 + g) * 64) * 4096; const unsigned char* vwin = VT + ((size_t)((b * 2 + 1) * 4 + g) * 64) * 4096;
        const int nwin = min(qt, 8) + 1, ktlo = qt - nwin + 1, nst = nwin + qt + 1, ncmp = (qt >= 16) ? 2 : 1;
#define ATT_STAGE(i_, buf_) do { const int _i = (i_); const bool _isw = _i < nwin; const int _kt = _isw ? qt - _i : _i - nwin; \
            const unsigned char* _kp = (_isw ? kwin : ksel) + ((size_t)(64 * _kt + drow) * 1536) * 2 + dchunk; \
            const unsigned char* _vp = (_isw ? vwin : vsel) + (size_t)drow * 4096 + (size_t)_kt * 128 + dchunk; \
            dma16(_kp, (buf_) + w * 1024); dma16(_vp, (buf_) + 8192 + w * 1024); } while (0)
        for (int i = 0; i < ncmp; ++i) { dma16(KCB + ((size_t)(bg * 128 + 64 * i + drow) * 64) * 2 + dchunk, CMPA + i * 8192 + w * 1024);
            dma16(VCT + ((size_t)(bg * 64 + drow) * 128) * 2 + i * 128 + dchunk, CMPA + 16384 + i * 8192 + w * 1024); }
        const int tcol = t0 + 8 * w + tl; const size_t mtok = (size_t)b * SEQ + tcol; const int head = 4 * g + hh;
        bf16x8 qf[4];
#pragma unroll
        for (int s = 0; s < 4; ++s) qf[s] = *(const bf16x8*)(QB + mtok * 1024 + head * 64 + 16 * s + 8 * h);
        const float g0 = GT[mtok * 48 + head * 3 + 0], g1 = GT[mtok * 48 + head * 3 + 1], g2 = GT[mtok * 48 + head * 3 + 2];
        asm volatile("s_waitcnt vmcnt(0)" ::: "memory"); __syncthreads();
        ATT_STAGE(0, RING); ATT_STAGE(1, RING + 16384); if (nst > 2) ATT_STAGE(2, RING + 32768);
        f32x16 OUT[2], O[2];
        unsigned selmask;
        {
            f32x16 C[4];
            att_scores(CMPA, aoff, qf, *(f32x16 (*)[2])&C[0]);
            if (ncmp == 2) att_scores(CMPA + 8192, aoff, qf, *(f32x16 (*)[2])&C[2]);
            else {
#pragma unroll
                for (int i = 0; i < 16; ++i) { C[2][i] = ATT_NEG; C[3][i] = ATT_NEG; } }
#pragma unroll
            for (int cb = 0; cb < 4; ++cb) { const int tw = t0 + 8 * w, lo = tw - 31 - 16 * (32 * cb + 31), hi = tw + 7 - 31 - 512 * cb;
                if (cb < 2 * ncmp && lo < 128) {
                    if (hi < 0) {
#pragma unroll
                        for (int i = 0; i < 16; ++i) C[cb][i] = ATT_NEG; }
                    else att_fixcb<16>(C[cb], tcol - 31 - 64 * h - 512 * cb, dBl); } }
            float mx = C[0][0];
#pragma unroll
            for (int cb = 0; cb < 4; ++cb)
#pragma unroll
                for (int rr = 0; rr < 16; ++rr) mx = fmaxf(mx, C[cb][rr]);
            mx = fmaxf(mx, xor32(mx)); mx = fmaxf(mx, -1e30f);
            float ls = 0.f;
#pragma unroll
            for (int cb = 0; cb < 4; ++cb)
#pragma unroll
                for (int rr = 0; rr < 16; ++rr) { const float p = __builtin_amdgcn_exp2f(C[cb][rr] - mx); C[cb][rr] = p; ls += p; }
            ls += xor32(ls);
            const float inv = ls > 0.f ? 1.f / ls : 0.f;
#pragma unroll
            for (int cb = 0; cb < 4; ++cb) C[cb] = C[cb] * inv;
#pragma unroll
            for (int i = 0; i < 16; ++i) { OUT[0][i] = 0.f; OUT[1][i] = 0.f; }
            att_pv(CMPA + 16384, aoff, *(const f32x16 (*)[2])&C[0], OUT);
            if (ncmp == 2) att_pv(CMPA + 16384 + 8192, aoff, *(const f32x16 (*)[2])&C[2], OUT);
            OUT[0] = OUT[0] * g0; OUT[1] = OUT[1] * g0;
            if (qt <= 7) selmask = (2u << qt) - 1u;
            else {
                float imp[16], lastv[16];
#pragma unroll
                for (int cb = 0; cb < 4; ++cb)
#pragma unroll
                    for (int rq = 0; rq < 4; ++rq) { imp[4 * cb + rq] = (C[cb][4 * rq] + C[cb][4 * rq + 1]) + (C[cb][4 * rq + 2] + C[cb][4 * rq + 3]); lastv[4 * cb + rq] = C[cb][4 * rq + 3]; }
                unsigned key[16];
#pragma unroll
                for (int q = 0; q < 16; ++q) lastv[q] = xor32(lastv[q]);
#pragma unroll
                for (int q = 0; q < 16; ++q) { const float prev = (q >= 1) ? lastv[q - 1] : 0.f; float v = imp[q] + (h ? lastv[q] : prev);
                    v += dppf<DPP_XOR1>(v); v += dppf<DPP_XOR2>(v);
                    const int j = 2 * q + h; const bool cand = (j >= 1) && (j <= qt - 2);
                    key[q] = cand ? ((__builtin_bit_cast(unsigned, v) & ~31u) | (unsigned)(31 - j)) : 0u; }
                selmask = 1u | (1u << qt) | (1u << (qt - 1));
#pragma unroll 1
                for (int rnd = 0; rnd < 5; ++rnd) {
                    unsigned best = 0u;
#pragma unroll
                    for (int q = 0; q < 16; ++q) best = max(best, key[q]);
                    best = max(best, xor32u(best));
                    if (best != 0u) selmask |= 1u << (31 - (best & 31u));
#pragma unroll
                    for (int q = 0; q < 16; ++q) key[q] = (key[q] == best) ? 0u : key[q];
                }
            }
        }
        unsigned wor = selmask; wor |= (unsigned)__shfl_xor((int)wor, 4); wor |= (unsigned)__shfl_xor((int)wor, 8); wor |= (unsigned)__shfl_xor((int)wor, 16);
        wor = (unsigned)__builtin_amdgcn_readfirstlane((int)wor);
        unsigned wand = selmask; wand &= (unsigned)__shfl_xor((int)wand, 4); wand &= (unsigned)__shfl_xor((int)wand, 8); wand &= (unsigned)__shfl_xor((int)wand, 16);
        wand = (unsigned)__builtin_amdgcn_readfirstlane((int)wand);
        float m = 0.f, l = 0.f; bool pending = true, shifted = false;
        unsigned wall = 0xffffffffu; asm volatile("" : "+s"(wall));
#pragma unroll
        for (int i = 0; i < 16; ++i) { O[0][i] = 0.f; O[1][i] = 0.f; }
#define ATT_FINALIZE(gate_) do { const float _lt = l + xor32(l); const float _sc = _lt > 0.f ? (gate_) / _lt : 0.f; \
            OUT[0] = OUT[0] + O[0] * _sc; OUT[1] = OUT[1] + O[1] * _sc; m = 0.f; l = 0.f; pending = true; shifted = false; \
            _Pragma("unroll") for (int _i = 0; _i < 16; ++_i) { O[0][_i] = 0.f; O[1][_i] = 0.f; } } while (0)
#define ATT_TILE_SYNC(i_) do { const int _ahead = nst - 1 - (i_); \
            if (_ahead >= 2) asm volatile("s_waitcnt vmcnt(4) lgkmcnt(0)" ::: "memory"); else if (_ahead == 1) asm volatile("s_waitcnt vmcnt(2) lgkmcnt(0)" ::: "memory"); else asm volatile("s_waitcnt vmcnt(0) lgkmcnt(0)" ::: "memory"); \
            __builtin_amdgcn_s_barrier(); asm volatile("" ::: "memory"); \
            if ((i_) + 3 < nst) ATT_STAGE((i_) + 3, RING + (((i_) + 3) & 3) * 16384); } while (0)
#pragma unroll 1
        for (int i = 0; i < nwin; ++i) {
            ATT_TILE_SYNC(i);
            const int kt = qt - i; const int fm = (kt >= qt - 2 || kt == qt - 8) ? 2 : 0;
            if ((wall >> i) & 1u)
            att_tile(RING + (i & 3) * 16384, aoff, qf, O, m, l, pending, shifted, fm, tcol - 64 * kt - 4 * h, true, dB4l, DB4);
        }
        ATT_FINALIZE(g2);
#pragma unroll 1
        for (int i = nwin; i < nst; ++i) {
            ATT_TILE_SYNC(i);
            const int j = i - nwin;
            if ((wor >> j) & 1u) { const bool cs = (selmask >> j) & 1u; const int fm = (j >= qt - 2) ? 2 : (((wand >> j) & 1u) ? 0 : 1);
                att_tile(RING + (i & 3) * 16384, aoff, qf, O, m, l, pending, shifted, fm, tcol - 64 * j - 4 * h, cs, dB4l, DB4); }
        }
#undef ATT_TILE_SYNC
        ATT_FINALIZE(g1);
        bf16_t* orow = OB + mtok * 1024 + head * 64 + 4 * h;
#pragma unroll
        for (int dt = 0; dt < 2; ++dt)
#pragma unroll
            for (int rq = 0; rq < 4; ++rq) { u32x2 v; v.x = cvtpk(OUT[dt][4 * rq], OUT[dt][4 * rq + 1]); v.y = cvtpk(OUT[dt][4 * rq + 2], OUT[dt][4 * rq + 3]); *(u32x2*)(orow + 32 * dt + 8 * rq) = v; }
#undef ATT_STAGE
#undef ATT_FINALIZE
    }
}
constexpr int LDS_BYTES = 155648;
constexpr int LDS_MISC = LDS_BYTES - 256;
constexpr int NPH = 21;

__global__ void __launch_bounds__(512, 2) fwd(Args a) {
    extern __shared__ __attribute__((aligned(16))) unsigned char lds_raw[];
    Fr F; F.lds = (LAS unsigned char*)lds_raw; F.tid = threadIdx.x; F.lane = F.tid & 63; F.wave = __builtin_amdgcn_readfirstlane(F.tid >> 6); F.G = gridDim.x;
    F.gw = blockIdx.x * 8 + F.wave; F.ngw = F.G * 8;
    unsigned char* ws = a.ws;
    volatile LAS unsigned* MISC = (volatile LAS unsigned*)(F.lds + LDS_MISC);
    if (F.tid < 64) MISC[F.tid] = 0u;
    __syncthreads();
    const int lo = a.ph_lo, hi = a.ph_hi;
    XcdBarrier bar; bar.bar = (unsigned*)(ws + WS_CTL) + CW_BAR; bar.x = 0; bar.st = nullptr;
    if (hi - lo > 1) bar = xcd_barrier_post((unsigned*)(ws + WS_CTL) + CW_BAR, MISC + 8);


#ifndef REPEAT_MASK
#define REPEAT_MASK 0u
#endif
#ifdef ONLY_PH
#define IN(k) ((k) == ONLY_PH && lo <= (k) && (k) < hi)
#else
#define IN(k) (lo <= (k) && (k) < hi)
#endif
#define REP(k) for (int _rep = 0; _rep < (((REPEAT_MASK >> (k)) & 1u) ? 2 : 1); ++_rep)
#define SEAM(k) do { if (IN(k) && IN((k) + 1)) xcd_barrier(bar); } while (0)
    using namespace pg8;
    const int c = (int)blockIdx.x;

    if (IN(0)) { phase_conv(F, a); if ((REPEAT_MASK >> 30) & 1u) { __syncthreads(); phase_conv(F, a); } phase_r1(F, a); if ((REPEAT_MASK >> 31) & 1u) { __syncthreads(); phase_r1(F, a); } }
    SEAM(0);
    if (IN(1)) REP(1) {
        { Gemm g{(const bf16_t*)(ws + WS_S0), (const bf16_t*)(ws + WS_WR), 1024, 1024, 0, 1 << 20, nullptr, 0}; StaticOrder S; S.init(NT, 1024, F.G, c); EpiBf16 E{(bf16_t*)(ws + WS_S3), 1024, 1.f, 1}; gemm_phase(F.lds, g, S, E);
#ifdef DUP_P1
        gemm_phase(F.lds, g, S, E);
#endif
        }
        { Gemm g{(const bf16_t*)(ws + WS_S1), (const bf16_t*)(ws + WS_WK), 1024, 1024, 0, 1 << 20, nullptr, 0}; StaticOrder S; S.init(NT, 1024, F.G, c); EpiBf16 E{(bf16_t*)(ws + WS_S4), 1024, 1.f, 1}; gemm_phase(F.lds, g, S, E); }
        { Gemm g{(const bf16_t*)(ws + WS_S2), (const bf16_t*)(ws + WS_WV), 1024, 1024, 0, 1 << 20, nullptr, 0}; StaticOrder S; S.init(NT, 1024, F.G, c); EpiBf16 E{(bf16_t*)a.out, 1024, 1.f, 1}; gemm_phase(F.lds, g, S, E); }
        { Gemm g{(const bf16_t*)(ws + WS_S5), (const bf16_t*)(ws + WS_WL1), 2048, 1024, 1, 16, nullptr, 0}; StaticOrder S; S.init(NT, 512, F.G, c); EpiLora1 E{(bf16_t*)((unsigned char*)a.out + 128 * MiB)}; gemm_phase(F.lds, g, S, E); }
    }
    SEAM(1);
    if (IN(2)) REP(2) {
        const bf16_t* T1 = (const bf16_t*)((unsigned char*)a.out + 128 * MiB);
        { int kwa = 128; asm volatile("" : "+s"(kwa));
          Gemm g{T1, (const bf16_t*)(ws + WS_W2WA), kwa, 512, 0, 1 << 20, nullptr, 0}; StaticOrder S; S.init(NT, 2048, F.G, c); EpiLora2WA E{(bf16_t*)(ws + WS_S0), (bf16_t*)(ws + WS_S1), a.in[I_AW0], a.in[I_AA0]}; gemm_phase(F.lds, g, S, E); }
        { Gemm g{T1 + 128, (const bf16_t*)(ws + WS_W2G), 256, 512, 0, 1 << 20, nullptr, 0}; StaticOrder S; S.init(NT, 1024, F.G, c); EpiBf16 E{(bf16_t*)(ws + WS_S2), 1024, 1.f, 1}; gemm_phase(F.lds, g, S, E); }
    }
    SEAM(2);
    if (IN(3)) REP(3) phase_scan(F, a);
    SEAM(3);
    if (IN(4)) REP(4) { Gemm g{(const bf16_t*)(ws + WS_S5), (const bf16_t*)(ws + WS_WO), 1024, 64, 0, 1 << 20, nullptr, 1}; StaticOrder S; S.init(NT, 1024, F.G, c); EpiResX E{a.in[I_X], (bf16_t*)(ws + WS_H)}; gemm_phase(F.lds, g, S, E);
#ifdef DUP_PH4
        gemm_phase(F.lds, g, S, E);
#endif
    }
    SEAM(4);
#define MOE_PHASES(layer, pb) \
    if (IN(pb)) phase_m1(F, a, layer); \
    SEAM(pb); \
    if (IN((pb) + 1)) phase_m2(F, a, layer); \
    SEAM((pb) + 1); \
    if (IN((pb) + 2)) REP((pb) + 2) { const int* texp = (const int*)(ws + WS_TEXP); Gemm g{(const bf16_t*)(ws + WS_H), (const bf16_t*)(ws + WS_BT1) + (size_t)(layer) * 32 * 1024 * 1024, 1024, 1024, 0, 1 << 20, (const int*)(ws + WS_RIDX), 0}; \
        MoeOrder S; S.init(texp, F.G, c); EpiMoe1 E{(bf16_t*)(ws + WS_S4), (const float*)(ws + WS_ROWRS)}; gemm_phase<EpiMoe1, MoeOrder, true>(F.lds, g, S, E); } \
    SEAM((pb) + 2); \
    if (IN((pb) + 3)) REP((pb) + 3) { const int* texp = (const int*)(ws + WS_TEXP); Gemm g{(const bf16_t*)(ws + WS_S4), (const bf16_t*)(ws + WS_BT2) + (size_t)(layer) * 32 * 1024 * 512, 512, 512, 0, 1 << 20, nullptr, 0}; \
        MoeOrder S; S.init(texp, F.G, c); EpiMoe2 E{(bf16_t*)(ws + WS_S1), (const float*)(ws + WS_ROWW)}; gemm_phase(F.lds, g, S, E); } \
    SEAM((pb) + 3);

    MOE_PHASES(0, 5)
    if (IN(9)) phase_n1(F, a);
    SEAM(9);
    if (IN(10)) REP(10) { Gemm g{(const bf16_t*)(ws + WS_H), (const bf16_t*)(ws + WS_WKVQG), 1024, 1024, 0, 1 << 20, nullptr, 0}; StaticOrder S; S.init(NT, 2816, F.G, c);
        EpiKvqg E{(bf16_t*)(ws + WS_KV), (bf16_t*)(ws + WS_Q), (float*)(ws + WS_GATES), (const float*)(ws + WS_RSTD)}; gemm_phase(F.lds, g, S, E); }
    SEAM(10);
    if (IN(11)) { if (F.G <= 128) phase_vt(F, a, F.gw, F.ngw); }
    if (F.G <= 128) SEAM(11);
    if (IN(12)) { Gemm g{(const bf16_t*)(ws + WS_KV), (const bf16_t*)(ws + WS_WC1), 2048, 64, 0, 1 << 20, (const int*)(ws + WS_CIDX), 2}; CmpOrder S{F.G, c}; EpiCmp E{(bf16_t*)(ws + WS_HC), (const float*)(ws + WS_PEBP)}; gemm_phase<EpiCmp, CmpOrder, true>(F.lds, g, S, E);
        if (F.G > 128 && c >= 128) phase_vt(F, a, (c - 128) * 8 + F.wave, (F.G - 128) * 8);
        if (F.G > 128 && c < 128) { __builtin_amdgcn_fence(__ATOMIC_ACQUIRE, "agent"); phase_cmp2(F, a, c * 16 + F.wave, 8, c * 16 + 16); } }
    if (F.G <= 128) SEAM(12);
    if (IN(13) && F.G <= 128) phase_cmp2(F, a, F.gw, F.ngw, 2048);
    SEAM(13);
    if (IN(14)) REP(14) phase_attn(F, a);
    SEAM(14);
    if (IN(15)) { Gemm g{(const bf16_t*)(ws + WS_OATT), (const bf16_t*)(ws + WS_WOB), 1024, 1024, 0, 1 << 20, nullptr, 0}; StaticOrder S; S.init(NT, 1024, F.G, c); EpiResH E{(bf16_t*)(ws + WS_H)}; gemm_phase(F.lds, g, S, E); }
    SEAM(15);
    MOE_PHASES(1, 16)
    if (IN(20)) phase_final(F, a);
#undef IN
#undef SEAM
}

extern "C" void kernel_launch(void* const* d_in, const int* in_sizes, int n_in, void* d_out, int out_size, void* d_ws, size_t ws_size, hipStream_t stream) {
    static int grid = 0;
    if (grid == 0) {
        if (n_in != 41 || out_size != NT * DM || ws_size < WS_NEED) { fprintf(stderr, "kernel_launch: unexpected problem (n_in %d, out %d, ws %zu); nothing launched\n", n_in, out_size, ws_size); grid = -1; return; }
        int dev = 0, cus = 0, per_cu = 0;
        if (hipGetDevice(&dev) != hipSuccess || hipDeviceGetAttribute(&cus, hipDeviceAttributeMultiprocessorCount, dev) != hipSuccess) { grid = -1; return; }
        if (hipFuncSetAttribute((const void*)fwd, hipFuncAttributeMaxDynamicSharedMemorySize, LDS_BYTES) != hipSuccess) { fprintf(stderr, "kernel_launch: hipFuncSetAttribute failed\n"); grid = -1; return; }
        if (hipOccupancyMaxActiveBlocksPerMultiprocessor(&per_cu, (const void*)fwd, 512, LDS_BYTES) != hipSuccess || per_cu < 1)
            fprintf(stderr, "kernel_launch: occupancy query reports %d workgroups per CU\n", per_cu);
        (void)hipGetLastError();
        grid = cus;
    }
    if (grid < 0) return;
    (void)hipMemsetAsync((char*)d_ws + WS_CTL, 0, CTL_BYTES, stream);
    Args a{};
    for (int i = 0; i < 41; ++i) a.in[i] = (const float*)d_in[i];
    a.out = (float*)d_out; a.ws = (unsigned char*)d_ws;
#if N_LAUNCH_MODE == 1
    a.ph_lo = 0; a.ph_hi = NPH;
    hipLaunchKernelGGL(fwd, dim3(grid), dim3(512), LDS_BYTES, stream, a);
#else
    for (int p = 0; p < NPH; ++p) { a.ph_lo = p; a.ph_hi = p + 1; hipLaunchKernelGGL(fwd, dim3(grid), dim3(512), LDS_BYTES, stream, a); }
#endif
}
```

```cpp
#include <hip/hip_runtime.h>
#include <cstdio>
#include <cstdint>

#define GAS __attribute__((address_space(1)))
#define LAS __attribute__((address_space(3)))
typedef unsigned short bf16_t;
typedef short bf16x8 __attribute__((ext_vector_type(8)));
typedef float f32x4 __attribute__((ext_vector_type(4)));
typedef float f32x2 __attribute__((ext_vector_type(2)));
typedef unsigned u32x4 __attribute__((ext_vector_type(4)));
typedef unsigned u32x2 __attribute__((ext_vector_type(2)));

#ifndef N_LAUNCH_MODE
#define N_LAUNCH_MODE 1
#endif

constexpr int NT = 65536, DM = 1024, SEQ = 2048, NB = 32;
constexpr int P_MAX = 139264;
constexpr size_t MiB = 1u << 20;
constexpr size_t WS_CTL = 0, CTL_BYTES = 1 * MiB;
constexpr size_t WS_RFRAG = 1 * MiB;
constexpr size_t WS_W2F = 3 * MiB;
constexpr size_t WS_CIDX = 3 * MiB + 256 * 1024;
constexpr size_t WS_PEBP = 3 * MiB + 512 * 1024;
constexpr size_t WS_TEXP = 2 * MiB;
constexpr size_t WS_WR = 8 * MiB, WS_WK = 10 * MiB, WS_WV = 12 * MiB, WS_WO = 14 * MiB;
constexpr size_t WS_WL1 = 16 * MiB;
constexpr size_t WS_W2WA = 18 * MiB;
constexpr size_t WS_W2G = 19 * MiB;
constexpr size_t WS_WKVQG = 20 * MiB;
constexpr size_t WS_WOB = 26 * MiB;
constexpr size_t WS_WC1 = 28 * MiB;
constexpr size_t WS_BT1 = 32 * MiB;
constexpr size_t WS_BT2 = 160 * MiB;
constexpr size_t WS_S0 = 224 * MiB, WS_S1 = 352 * MiB, WS_S2 = 480 * MiB, WS_S3 = 608 * MiB, WS_S4 = 736 * MiB, WS_S5 = 864 * MiB;
constexpr size_t WS_GATES = 993 * MiB;
constexpr size_t WS_ASG = 1014 * MiB;
constexpr size_t WS_ROWW = 1016 * MiB;
constexpr size_t WS_RIDX = 1017 * MiB;
constexpr size_t WS_RSTD = 1018 * MiB;
constexpr size_t WS_ROWRS = 1019 * MiB;
constexpr size_t WS_H = WS_S0;
constexpr size_t WS_NEED = 1024 * MiB;
constexpr size_t WS_KV = 352 * MiB, WS_Q = 544 * MiB, WS_ACMP = 672 * MiB, WS_HC = 800 * MiB, WS_OATT = 816 * MiB;
constexpr size_t WS_KCB = 1006 * MiB, WS_VCT = 1008 * MiB;
constexpr int CW_BAR = 4096;
constexpr int CW_CNT = 16384;

typedef __bf16 bf16x2n __attribute__((ext_vector_type(2)));
__device__ __forceinline__ unsigned cvtpk(float lo, float hi) { const f32x2 v = {lo, hi}; return __builtin_bit_cast(unsigned, __builtin_convertvector(v, bf16x2n)); }
__device__ __forceinline__ unsigned f2bf(float f) { return cvtpk(f, f) & 0xffffu; }
__device__ __forceinline__ unsigned pk2(float lo, float hi) { return cvtpk(lo, hi); }
__device__ __forceinline__ float bflo(unsigned u) { return __builtin_bit_cast(float, u << 16); }
__device__ __forceinline__ float bfhi(unsigned u) { return __builtin_bit_cast(float, u & 0xffff0000u); }
__device__ __forceinline__ float bf2f(bf16_t b) { return __builtin_bit_cast(float, ((unsigned)b) << 16); }
template <int CTRL> __device__ __forceinline__ float dppf(float v) { return __int_as_float(__builtin_amdgcn_update_dpp(0, __float_as_int(v), CTRL, 0xf, 0xf, true)); }
#define DPP_XOR1 0xB1
#define DPP_XOR2 0x4E
#define DPP_HALF_MIRROR 0x141
#define DPP_MIRROR 0x140
#define DPP_ROR8 0x128
__device__ __forceinline__ float wave_sum(float v) {
    v += dppf<DPP_XOR1>(v); v += dppf<DPP_XOR2>(v); v += dppf<DPP_HALF_MIRROR>(v); v += dppf<DPP_MIRROR>(v);
    { const auto r = __builtin_amdgcn_permlane16_swap(__float_as_uint(v), __float_as_uint(v), false, false); v = __uint_as_float(r[0]) + __uint_as_float(r[1]); }
    { const auto r = __builtin_amdgcn_permlane32_swap(__float_as_uint(v), __float_as_uint(v), false, false); v = __uint_as_float(r[0]) + __uint_as_float(r[1]); }
    return v;
}
__device__ __forceinline__ float fexp_(float x) { return __builtin_amdgcn_exp2f(x * 1.44269504089f); }
__device__ __forceinline__ float sigmoidf_(float x) { return __builtin_amdgcn_rcpf(1.f + fexp_(-x)); }
__device__ __forceinline__ float tanhf_(float x) { return 1.f - 2.f * __builtin_amdgcn_rcpf(1.f + fexp_(2.f * x)); }
__device__ __forceinline__ float gelu_tanh_(float x) { return 0.5f * x * (1.f + tanhf_(0.7978845608f * (x + 0.044715f * x * x * x))); }
#define LDS_WAIT() asm volatile("s_waitcnt lgkmcnt(0)" ::: "memory")

__device__ const unsigned char BKT[129] = {0, 1, 2, 3, 4, 5, 6, 7, 8, 9, 10, 11, 12, 13, 14, 15, 16, 16, 16, 17, 17, 18, 18, 18, 19, 19, 19, 20, 20, 20, 20, 21, 21, 21, 21, 22, 22, 22, 22, 22, 23, 23, 23, 23, 23, 23, 24, 24, 24, 24, 24, 24, 25, 25, 25, 25, 25, 25, 25, 26, 26, 26, 26, 26, 26, 26, 26, 27, 27, 27, 27, 27, 27, 27, 27, 27, 27, 28, 28, 28, 28, 28, 28, 28, 28, 28, 28, 29, 29, 29, 29, 29, 29, 29, 29, 29, 29, 29, 29, 30, 30, 30, 30, 30, 30, 30, 30, 30, 30, 30, 30, 30, 30, 31, 31, 31, 31, 31, 31, 31, 31, 31, 31, 31, 31, 31, 31, 31, 31};

#define XB_TMO      128
#define XB_XCNT(j)  (256  + 64 * (j))
#define XB_XSUB(j)  (1280 + 64 * (j))
#define XB_XGEN(j)  (2304 + 64 * (j))
#define XB_TOP      3328
#define XB_TOPGEN   3392
#define XCD_BAR_WORDS 3456
#define XB_SPIN_CAP (1u << 22)
__device__ __forceinline__ unsigned xb_ld(unsigned* p)              { return __hip_atomic_load(p, __ATOMIC_RELAXED, __HIP_MEMORY_SCOPE_AGENT); }
__device__ __forceinline__ unsigned xb_add(unsigned* p, unsigned v) { return __hip_atomic_fetch_add(p, v, __ATOMIC_RELAXED, __HIP_MEMORY_SCOPE_AGENT); }
__device__ __forceinline__ unsigned xb_xcc_id() { return (unsigned)__builtin_amdgcn_s_getreg((3 << 11) | 20) & 0xFu; }
#define XB_SPIN(cond, bar) do { unsigned _sp = 0; while (cond) { __builtin_amdgcn_s_sleep(1); \
    if ((++_sp & 255u) == 0u) { if (xb_ld(&(bar)[XB_TMO])) break; if (_sp > XB_SPIN_CAP) { atomicAdd(&(bar)[XB_TMO], 1u); break; } } } } while (0)
struct XcdBarrier { unsigned* bar; unsigned x; volatile LAS unsigned* st; };
__device__ __forceinline__ XcdBarrier xcd_barrier_post(unsigned* bar, volatile LAS unsigned* st) {
    XcdBarrier b; b.bar = bar; b.x = xb_xcc_id(); b.st = st;
    if (threadIdx.x == 0) (void)xb_add(&bar[XB_XCNT(b.x)], 1u);
    return b;
}
__device__ __forceinline__ void xcd_barrier_complete(unsigned* bar, unsigned x, unsigned& nloc, unsigned& nx) {
    const unsigned G = gridDim.x * gridDim.y * gridDim.z;
    unsigned sum, cnt, mine, sp = 0u;
    for (;;) {
        sum = 0u; cnt = 0u; mine = 0u;
#pragma unroll
        for (unsigned j = 0; j < 16; ++j) { const unsigned c = xb_ld(&bar[XB_XCNT(j)]); sum += c; cnt += (c > 0u) ? 1u : 0u; mine = (j == x) ? c : mine; }
        if (sum == G) break;
        __builtin_amdgcn_s_sleep(1);
        if ((++sp & 255u) == 0u) { if (xb_ld(&bar[XB_TMO])) break; if (sp > XB_SPIN_CAP) { atomicAdd(&bar[XB_TMO], 1u); break; } }
    }
    nloc = mine > 0u ? mine : 1u; nx = cnt > 0u ? cnt : 1u;
}
__device__ __forceinline__ void xcd_barrier(const XcdBarrier& b) {
    asm volatile("s_waitcnt vmcnt(0)" ::: "memory");
    __syncthreads();
    if (threadIdx.x == 0) {
        unsigned* bar = b.bar;
        __builtin_amdgcn_s_waitcnt(0);
        unsigned nloc = b.st[0], nx = b.st[1];
        if (nloc == 0u) { xcd_barrier_complete(bar, b.x, nloc, nx); b.st[0] = nloc; b.st[1] = nx; }
        const unsigned old = xb_add(&bar[XB_XSUB(b.x)], 1u);
        const unsigned gen = old / nloc;
        if (old + 1u == (gen + 1u) * nloc) {
            __builtin_amdgcn_fence(__ATOMIC_RELEASE, "agent");
            asm volatile("s_waitcnt vmcnt(0)" ::: "memory");
            const unsigned og = xb_add(&bar[XB_TOP], 1u);
            const unsigned tg = og / nx;
            if (og + 1u == (tg + 1u) * nx) xb_add(&bar[XB_TOPGEN], 1u);
            else XB_SPIN(xb_ld(&bar[XB_TOPGEN]) == tg, bar);
            __builtin_amdgcn_fence(__ATOMIC_ACQUIRE, "agent");
            xb_add(&bar[XB_XGEN(b.x)], 1u);
            asm volatile("s_waitcnt vmcnt(0)" ::: "memory");
        } else {
            XB_SPIN(xb_ld(&bar[XB_XGEN(b.x)]) == gen, bar);
            __builtin_amdgcn_fence(__ATOMIC_ACQUIRE, "agent");
            asm volatile("s_waitcnt vmcnt(0)" ::: "memory");
        }
    }
    __syncthreads();
}

namespace pg8 {
constexpr int BM = 256, BK = 64, HALF = 128, HTB = HALF * BK * 2, STAGE_BYTES = 8 * HTB, NXCD = 8, WGM = 8;
__host__ __device__ __forceinline__ int lds_byte(int r, int c) { const int st = (r >> 4) * 2 + (c >> 5), rr = r & 15, cc = c & 31, ob = rr * 64 + cc * 2; return st * 1024 + (ob ^ (((ob >> 9) & 1) << 5)); }
__host__ __device__ __forceinline__ void stage_rc(int b, int& R, int& C) { const int st = b / 1024, sb = b % 1024, swz = sb ^ (((sb >> 9) & 1) << 5); R = (st >> 1) * 16 + swz / 64; C = (st & 1) * 32 + (swz % 64) / 2; }
__host__ __device__ __forceinline__ int perm32(int rho) { const int n = rho >> 4, i = rho & 15; return 8 * (i >> 2) + 4 * n + (i & 3); }
struct Unit { int pm, pn; };
struct Gemm { const bf16_t* A; const bf16_t* Bt; int K, lda, apad, kwrap; const int* gidx; int ahm; };
struct StaticOrder {
    int nM, nN, nwg, G, c;
    __device__ void init(int M, int N, int G_, int c_) { nM = M / BM; nN = N / BM; nwg = nM * nN; G = G_; c = c_; }
    __device__ bool next(int i, Unit& u) const {
        const long L = (long)i * G + c; if (L >= nwg) return false;
        int wgid = (int)L; { const int q = nwg / NXCD, r = nwg % NXCD, xcd = wgid % NXCD, off = wgid / NXCD; wgid = (xcd < r ? xcd * (q + 1) : r * (q + 1) + (xcd - r) * q) + off; }
        const int nig = WGM * nN, gid = wgid / nig, fm = gid * WGM, gsz = (nM - fm) < WGM ? (nM - fm) : WGM;
        u.pm = fm + ((wgid % nig) % gsz); u.pn = (wgid % nig) / gsz; return true;
    }
};
struct MoeOrder {
    const int* xl; int nunits, ncu, cu; mutable int pre;
    __device__ __forceinline__ void init(const int* texp, int G_, int c_) { const int x = c_ & 7; cu = c_ >> 3; ncu = G_ >> 3; xl = texp + 2048 + x * 640; nunits = texp[1008 + x] * 4; pre = (cu < nunits) ? xl[cu >> 2] : 0; }
    __device__ __forceinline__ bool next(int i, Unit& u) const {
        const int L = i * ncu + cu; if (L >= nunits) return false;
        const int ent = pre; u.pm = ent & 0xffff; u.pn = (ent >> 16) * 4 + (L & 3);
        const int L2 = L + ncu; pre = (L2 < nunits) ? xl[L2 >> 2] : 0; return true;
    }
};
struct CmpOrder {
    int G, c;
    __device__ bool next(int i, Unit& u) const { const long L = (long)i * G + c; if (L >= 128) return false; u.pm = (int)L; u.pn = (int)(L >> 6); return true; }
};

template <class Epi, class Sched, bool GATHER = false, bool ALIGN_EPI = true, bool SP2 = true>
__device__ __forceinline__ void gemm_phase(LAS unsigned char* lds, const Gemm g, const Sched& S, const Epi& E) {
    const int tid = threadIdx.x, wid = __builtin_amdgcn_readfirstlane(tid >> 6), lane = tid & 63, wr = wid >> 2, wc = wid & 3, fr = lane & 15, fq = lane >> 4;
    const int K = g.K, nt = K / BK, lda = g.lda, kwrap = g.kwrap;
    unsigned voffA[2], voffB[2];
#pragma unroll
    for (int i = 0; i < 2; ++i) { int R, C; stage_rc(tid * 16 + i * 8192, R, C); const int Rb = Epi::PERM ? ((R & ~31) + perm32(R & 31)) : R;
        voffA[i] = (unsigned)(R * lda + C) * 2u; voffB[i] = (unsigned)(Rb * K + C) * 2u; }
    const long kstep = (long)(BK * 2); const long kstepA = g.ahm == 2 ? 3072l : g.ahm ? (long)SEQ * 128 : kstep;
    const long hstepA = (long)HALF * lda * 2, hstepB = (long)HALF * K * 2;
    const long tstepB = 2 * hstepB;
    const unsigned ldsw = (unsigned)wid * 1024u;
    const int aoff = lds_byte(wr * 64 + fr, fq * 8), boff = lds_byte(wc * 32 + fr, fq * 8);
#define PG8_KOFFA(t) (((t) < kwrap) ? (long)(t) * kstepA : (long)((t) - kwrap) * kstepA - (long)lda * 2)
#define PG8_ATILE(pm) (g.ahm ? (const char*)g.A + ((long)((pm) >> 3) * (K / 64) * SEQ + (long)((pm) & 7) * 256) * 128 : (const char*)g.A + ((long)(pm) * 256 + (g.apad ? (((pm) >> 3) + 1) : 0)) * (long)lda * 2)
#define PG8_SA(b, h) (((b) * 2 + (h)) * HTB)
#define PG8_SB(b, h) ((4 + (b) * 2 + (h)) * HTB)
#define PG8_STAGE(bufoff, gbase, voff) do { _Pragma("unroll") for (int _i = 0; _i < 2; ++_i) \
        __builtin_amdgcn_global_load_lds((const unsigned*)((const char*)(gbase) + (voff)[_i]), (LAS unsigned*)(lds + (bufoff) + ldsw + _i * 8192), 16, 0, 0); } while (0)
#define PG8_STAGE_A(bufoff, nx, h, ko) do { if constexpr (GATHER) { _Pragma("unroll") for (int _i = 0; _i < 2; ++_i) \
            __builtin_amdgcn_global_load_lds((const unsigned*)((const char*)g.A + (ko) + ((nx) ? gon[h][_i] : goc[h][_i])), (LAS unsigned*)(lds + (bufoff) + ldsw + _i * 8192), 16, 0, 0); } \
        else PG8_STAGE(bufoff, ((nx) ? nA : cA) + (h) * hstepA + (ko), voffA); } while (0)
#define PG8_GIDX(dst, pm_) do { if constexpr (GATHER) { _Pragma("unroll") for (int _h = 0; _h < 2; ++_h) _Pragma("unroll") for (int _i = 0; _i < 2; ++_i) \
            dst[_h][_i] = (unsigned)g.gidx[(pm_) * 256 + _h * 128 + (int)(voffA[_i] / (unsigned)(lda * 2))] * (unsigned)(lda * 2) + voffA[_i] % (unsigned)(lda * 2); } } while (0)
#define PG8_LDA(dst, b, h) do { _Pragma("unroll") for (int m = 0; m < 4; ++m) _Pragma("unroll") for (int k = 0; k < 2; ++k) dst[m][k] = *(const LAS bf16x8*)(lds + PG8_SA(b, h) + aoff + m * 2048 + k * 1024); } while (0)
#define PG8_LDB(dst, b, h) do { _Pragma("unroll") for (int n = 0; n < 2; ++n) _Pragma("unroll") for (int k = 0; k < 2; ++k) dst[n][k] = *(const LAS bf16x8*)(lds + PG8_SB(b, h) + boff + n * 2048 + k * 1024); } while (0)
#define PG8_MMA(ai, bj, At, Bt) do { __builtin_amdgcn_s_setprio(1); _Pragma("unroll") for (int m = 0; m < 4; ++m) _Pragma("unroll") for (int n = 0; n < 2; ++n) _Pragma("unroll") for (int k = 0; k < 2; ++k) \
        acc[ai][bj][m][n] = __builtin_amdgcn_mfma_f32_16x16x32_bf16(Bt[n][k], At[m][k], acc[ai][bj][m][n], 0, 0, 0); __builtin_amdgcn_s_setprio(0); } while (0)
#define PG8_WAIT_V(n) asm volatile("s_waitcnt vmcnt(" #n ")" ::: "memory")
#define PG8_WAIT_L(n) asm volatile("s_waitcnt lgkmcnt(" #n ")" ::: "memory")
#define PG8_BAR __builtin_amdgcn_s_barrier()
#define PG8_SCHED __builtin_amdgcn_sched_barrier(0)
    Unit cur, nxt; int ui = 0;
    if (!S.next(0, cur)) return;
    f32x4 acc[2][2][4][2];
#pragma unroll
    for (int a = 0; a < 2; ++a)
#pragma unroll
        for (int b = 0; b < 2; ++b)
#pragma unroll
            for (int m = 0; m < 4; ++m)
#pragma unroll
                for (int n = 0; n < 2; ++n) acc[a][b][m][n] = (f32x4){0.f, 0.f, 0.f, 0.f};
    bf16x8 At[4][2], B0[2][2], B1[2][2];
    const char* cA = PG8_ATILE(cur.pm); const char* cB = (const char*)g.Bt + (long)cur.pn * tstepB; const char* nA = cA;
    unsigned goc[2][2], gon[2][2];
#pragma unroll
    for (int _h = 0; _h < 2; ++_h)
#pragma unroll
        for (int _i = 0; _i < 2; ++_i) { goc[_h][_i] = 0u; gon[_h][_i] = 0u; }
    PG8_GIDX(goc, cur.pm);
    if constexpr (SP2) {
        PG8_STAGE(PG8_SB(0, 0), cB, voffB); PG8_STAGE(PG8_SB(0, 1), cB + hstepB, voffB); PG8_STAGE_A(PG8_SA(0, 0), false, 0, 0); PG8_STAGE_A(PG8_SA(0, 1), false, 1, 0);
        if (wr == 1) PG8_BAR;
        PG8_WAIT_V(2); PG8_BAR;
        PG8_STAGE(PG8_SB(1, 0), cB + kstep, voffB); PG8_STAGE_A(PG8_SA(1, 0), false, 0, kstepA); PG8_STAGE(PG8_SB(1, 1), cB + hstepB + kstep, voffB);
        PG8_WAIT_V(6); PG8_BAR;
    } else {
        PG8_STAGE(PG8_SB(0, 0), cB, voffB); PG8_STAGE_A(PG8_SA(0, 0), false, 0, 0); PG8_STAGE(PG8_SB(0, 1), cB + hstepB, voffB); PG8_STAGE_A(PG8_SA(0, 1), false, 1, 0);
        if (wr == 1) PG8_BAR;
        PG8_WAIT_V(4); PG8_BAR;
        PG8_STAGE(PG8_SB(1, 0), cB + kstep, voffB); PG8_STAGE_A(PG8_SA(1, 0), false, 0, kstepA); PG8_STAGE(PG8_SB(1, 1), cB + hstepB + kstep, voffB);
        PG8_WAIT_V(6); PG8_BAR;
    }
    for (;;) {
        const bool has_next = S.next(ui + 1, nxt);
        nA = has_next ? PG8_ATILE(nxt.pm) : cA; const char* nB = has_next ? (const char*)g.Bt + (long)nxt.pn * tstepB : cB;
        if constexpr (GATHER) { if (has_next) PG8_GIDX(gon, nxt.pm); else {
#pragma unroll
            for (int _h = 0; _h < 2; ++_h)
#pragma unroll
                for (int _i = 0; _i < 2; ++_i) gon[_h][_i] = goc[_h][_i]; } }
#pragma unroll 1
        for (int t = 0; t < nt; t += 2) {
            const bool last = (t == nt - 2);
            const long k1 = PG8_KOFFA(t + 1), k2 = last ? 0 : PG8_KOFFA(t + 2), k3 = last ? kstepA : PG8_KOFFA(t + 3);
            const char* b2 = last ? nB : cB + (long)(t + 2) * kstep; const char* b3 = b2 + kstep;
            if constexpr (SP2) {
            PG8_LDB(B0, 0, 0); PG8_LDB(B1, 0, 1); PG8_SCHED; PG8_LDA(At, 0, 0); PG8_STAGE_A(PG8_SA(1, 1), false, 1, k1);
            PG8_WAIT_V(8); PG8_WAIT_L(0); PG8_BAR; PG8_MMA(0, 0, At, B0); PG8_MMA(0, 1, At, B1); PG8_BAR; PG8_SCHED;
            PG8_LDA(At, 0, 1); PG8_STAGE(PG8_SB(0, 0), b2, voffB); PG8_STAGE(PG8_SB(0, 1), b2 + hstepB, voffB); PG8_STAGE_A(PG8_SA(0, 0), last, 0, k2);
            PG8_WAIT_V(8); PG8_WAIT_L(0); PG8_BAR; PG8_MMA(1, 0, At, B0); PG8_MMA(1, 1, At, B1); PG8_BAR; PG8_SCHED;
            PG8_LDB(B0, 1, 0); PG8_LDB(B1, 1, 1); PG8_SCHED; PG8_LDA(At, 1, 0); PG8_STAGE_A(PG8_SA(0, 1), last, 1, k2);
            PG8_WAIT_V(8); PG8_WAIT_L(0); PG8_BAR; PG8_MMA(0, 0, At, B0); PG8_MMA(0, 1, At, B1); PG8_BAR; PG8_SCHED;
            PG8_LDA(At, 1, 1); PG8_STAGE(PG8_SB(1, 0), b3, voffB); PG8_STAGE(PG8_SB(1, 1), b3 + hstepB, voffB); PG8_STAGE_A(PG8_SA(1, 0), last, 0, k3);
            PG8_WAIT_V(8); PG8_WAIT_L(0); PG8_BAR; PG8_MMA(1, 0, At, B0); PG8_MMA(1, 1, At, B1); PG8_BAR; PG8_SCHED;
            } else {
            PG8_LDB(B0, 0, 0); PG8_SCHED; PG8_LDA(At, 0, 0); PG8_STAGE_A(PG8_SA(1, 1), false, 1, k1);
            PG8_WAIT_L(8); PG8_BAR; PG8_WAIT_L(0); PG8_MMA(0, 0, At, B0); PG8_BAR; PG8_SCHED;
            PG8_LDB(B1, 0, 1); PG8_STAGE(PG8_SB(0, 0), b2, voffB);
            PG8_BAR; PG8_WAIT_L(0); PG8_MMA(0, 1, At, B1); PG8_BAR;
            PG8_LDA(At, 0, 1); PG8_STAGE_A(PG8_SA(0, 0), last, 0, k2);
            PG8_BAR; PG8_WAIT_L(0); PG8_MMA(1, 0, At, B0); PG8_BAR; PG8_SCHED;
            PG8_STAGE(PG8_SB(0, 1), b2 + hstepB, voffB);
            PG8_WAIT_V(6); PG8_BAR; PG8_MMA(1, 1, At, B1); PG8_BAR;
            PG8_LDB(B0, 1, 0); PG8_SCHED; PG8_LDA(At, 1, 0); PG8_STAGE_A(PG8_SA(0, 1), last, 1, k2);
            PG8_WAIT_L(8); PG8_BAR; PG8_WAIT_L(0); PG8_MMA(0, 0, At, B0); PG8_BAR; PG8_SCHED;
            PG8_LDB(B1, 1, 1); PG8_STAGE(PG8_SB(1, 0), b3, voffB);
            PG8_BAR; PG8_WAIT_L(0); PG8_MMA(0, 1, At, B1); PG8_BAR;
            PG8_LDA(At, 1, 1); PG8_STAGE_A(PG8_SA(1, 0), last, 0, k3);
            PG8_BAR; PG8_WAIT_L(0); PG8_MMA(1, 0, At, B0); PG8_BAR; PG8_SCHED;
            PG8_STAGE(PG8_SB(1, 1), b3 + hstepB, voffB);
            PG8_WAIT_V(6); PG8_BAR; PG8_MMA(1, 1, At, B1); PG8_BAR;
            }
        }
        if constexpr (ALIGN_EPI) { if (wr == 0) PG8_BAR; }
        E(acc, cur, wr, wc, fr, fq);
        if (!has_next) break;
#pragma unroll
        for (int a = 0; a < 2; ++a)
#pragma unroll
            for (int b = 0; b < 2; ++b)
#pragma unroll
                for (int m = 0; m < 4; ++m)
#pragma unroll
                    for (int n = 0; n < 2; ++n) acc[a][b][m][n] = (f32x4){0.f, 0.f, 0.f, 0.f};
        cur = nxt; cA = nA; cB = nB; ++ui;
        if constexpr (GATHER) {
#pragma unroll
            for (int _h = 0; _h < 2; ++_h)
#pragma unroll
                for (int _i = 0; _i < 2; ++_i) goc[_h][_i] = gon[_h][_i]; }
        if constexpr (ALIGN_EPI) { if (wr == 1) PG8_BAR; }
    }
    PG8_WAIT_V(0);
    if constexpr (!ALIGN_EPI) { if (wr == 0) PG8_BAR; }
    PG8_BAR;
#undef PG8_STAGE_A
#undef PG8_GIDX
#undef PG8_KOFFA
#undef PG8_ATILE
#undef PG8_SA
#undef PG8_SB
#undef PG8_STAGE
#undef PG8_LDA
#undef PG8_LDB
#undef PG8_MMA
#undef PG8_WAIT_V
#undef PG8_WAIT_L
#undef PG8_BAR
#undef PG8_SCHED
}

#define EPI_LOOP_ROWS for (int ai = 0; ai < 2; ++ai) _Pragma("unroll") for (int m = 0; m < 4; ++m)
__device__ __forceinline__ u32x4 pack8(const f32x4 v0, const f32x4 v1) { u32x4 w; w.x = pk2(v0[0], v0[1]); w.y = pk2(v0[2], v0[3]); w.z = pk2(v1[0], v1[1]); w.w = pk2(v1[2], v1[3]); return w; }

__device__ __forceinline__ size_t hm_off(int row, int col) { return ((size_t)((row >> 11) * 16 + (col >> 6)) * SEQ + (row & 2047)) * 64 + (col & 63); }
struct EpiBf16 {
    static constexpr bool PERM = true;
    bf16_t* O; int ldc; float scale; int hm;
    __device__ __forceinline__ void operator()(const f32x4 (&acc)[2][2][4][2], const Unit& u, int wr, int wc, int fr, int fq) const {
        const int row0 = u.pm * BM + wr * 64 + fr, col0 = u.pn * BM + wc * 32 + 8 * fq;
#pragma unroll
        EPI_LOOP_ROWS { const int row = row0 + ai * HALF + m * 16;
#pragma unroll
            for (int bj = 0; bj < 2; ++bj) { bf16_t* p = hm ? O + hm_off(row, col0 + bj * HALF) : O + (size_t)row * ldc + col0 + bj * HALF;
                *(u32x4*)p = pack8(acc[ai][bj][m][0] * scale, acc[ai][bj][m][1] * scale); } }
    }
};
struct EpiLora1 {
    static constexpr bool PERM = true;
    bf16_t* O;
    __device__ __forceinline__ void operator()(const f32x4 (&acc)[2][2][4][2], const Unit& u, int wr, int wc, int fr, int fq) const {
        const int row0 = u.pm * BM + wr * 64 + fr, col0 = u.pn * BM + wc * 32 + 8 * fq;
#pragma unroll
        EPI_LOOP_ROWS { bf16_t* rowp = O + (size_t)(row0 + ai * HALF + m * 16) * 512 + col0;
#pragma unroll
            for (int bj = 0; bj < 2; ++bj) { const int c = col0 + bj * HALF; f32x4 v0 = acc[ai][bj][m][0], v1 = acc[ai][bj][m][1];
                if (c < 64) {
#pragma unroll
                    for (int j = 0; j < 4; ++j) { v0[j] = tanhf_(v0[j]); v1[j] = tanhf_(v1[j]); }
                } else if (c < 128) {
                } else if (c < 288) {
#pragma unroll
                    for (int j = 0; j < 4; ++j) { v0[j] = sigmoidf_(v0[j]); v1[j] = sigmoidf_(v1[j]); }
                } else { v0 = (f32x4){0.f, 0.f, 0.f, 0.f}; v1 = v0; }
                *(u32x4*)(rowp + bj * HALF) = pack8(v0, v1); } }
    }
};
struct EpiLora2WA {
    static constexpr bool PERM = true;
    bf16_t* LW; bf16_t* AA; const float* w0; const float* a0;
    __device__ __forceinline__ void operator()(const f32x4 (&acc)[2][2][4][2], const Unit& u, int wr, int wc, int fr, int fq) const {
        const int row0 = u.pm * BM + wr * 64 + fr; const bool isw = u.pn < 4; const int col0 = (u.pn & 3) * BM + wc * 32 + 8 * fq;
        bf16_t* O = isw ? LW : AA; const float* bias = isw ? w0 : a0; const float mul = isw ? -0.60653065971f : 1.0f;
#pragma unroll
        for (int bj = 0; bj < 2; ++bj) { const f32x4 b0 = *(const f32x4*)(bias + col0 + bj * HALF), b1 = *(const f32x4*)(bias + col0 + bj * HALF + 4);
#pragma unroll
            EPI_LOOP_ROWS { bf16_t* rowp = O + hm_off(row0 + ai * HALF + m * 16, col0 + bj * HALF); f32x4 v0 = acc[ai][bj][m][0] + b0, v1 = acc[ai][bj][m][1] + b1;
#pragma unroll
                for (int j = 0; j < 4; ++j) { v0[j] = mul * sigmoidf_(v0[j]); v1[j] = mul * sigmoidf_(v1[j]); }
                *(u32x4*)rowp = pack8(v0, v1); } }
    }
};
struct EpiResX {
    static constexpr bool PERM = true;
    const float* x; bf16_t* h;
    __device__ __forceinline__ void operator()(const f32x4 (&acc)[2][2][4][2], const Unit& u, int wr, int wc, int fr, int fq) const {
        const int row0 = u.pm * BM + wr * 64 + fr, col0 = u.pn * BM + wc * 32 + 8 * fq;
#pragma unroll
        for (int ai = 0; ai < 2; ++ai) {
            f32x4 xb[4][2][2];
#pragma unroll
            for (int m = 0; m < 4; ++m)
#pragma unroll
                for (int bj = 0; bj < 2; ++bj) { const float* p = x + (size_t)(row0 + ai * HALF + m * 16) * 1024 + col0 + bj * HALF; xb[m][bj][0] = *(const f32x4*)p; xb[m][bj][1] = *(const f32x4*)(p + 4); }
#pragma unroll
            for (int m = 0; m < 4; ++m) { const size_t off = (size_t)(row0 + ai * HALF + m * 16) * 1024 + col0;
#pragma unroll
                for (int bj = 0; bj < 2; ++bj) *(u32x4*)(h + off + bj * HALF) = pack8(acc[ai][bj][m][0] + xb[m][bj][0], acc[ai][bj][m][1] + xb[m][bj][1]); } }
    }
};
struct EpiResH {
    static constexpr bool PERM = true;
    bf16_t* h;
    __device__ __forceinline__ void operator()(const f32x4 (&acc)[2][2][4][2], const Unit& u, int wr, int wc, int fr, int fq) const {
        const int row0 = u.pm * BM + wr * 64 + fr, col0 = u.pn * BM + wc * 32 + 8 * fq;
        u32x4 hb[2][4][2];
#pragma unroll
        EPI_LOOP_ROWS { const size_t off = (size_t)(row0 + ai * HALF + m * 16) * 1024 + col0;
#pragma unroll
            for (int bj = 0; bj < 2; ++bj) hb[ai][m][bj] = *(const u32x4*)(h + off + bj * HALF); }
#pragma unroll
        EPI_LOOP_ROWS { const size_t off = (size_t)(row0 + ai * HALF + m * 16) * 1024 + col0;
#pragma unroll
            for (int bj = 0; bj < 2; ++bj) { const u32x4 b = hb[ai][m][bj];
                const f32x4 b0 = {bflo(b.x), bfhi(b.x), bflo(b.y), bfhi(b.y)}, b1 = {bflo(b.z), bfhi(b.z), bflo(b.w), bfhi(b.w)};
                *(u32x4*)(h + off + bj * HALF) = pack8(acc[ai][bj][m][0] + b0, acc[ai][bj][m][1] + b1); } }
    }
};
struct EpiKvqg {
    static constexpr bool PERM = true;
    bf16_t* KV; bf16_t* Q; float* GT; const float* rs;
    __device__ __forceinline__ void operator()(const f32x4 (&acc)[2][2][4][2], const Unit& u, int wr, int wc, int fr, int fq) const {
        const int row0 = u.pm * BM + wr * 64 + fr;
        float rsv[2][4];
#pragma unroll
        EPI_LOOP_ROWS rsv[ai][m] = rs[row0 + ai * HALF + m * 16];
        if (u.pn < 10) {
            const bool iskv = u.pn < 6; bf16_t* O = iskv ? KV : Q; const int ldc = iskv ? 1536 : 1024; const float sc = iskv ? 1.0f : 0.18033688011f;
            const int col0 = (iskv ? u.pn : u.pn - 6) * BM + wc * 32 + 8 * fq;
#pragma unroll
            EPI_LOOP_ROWS { const int row = row0 + ai * HALF + m * 16; const float scr_ = sc * rsv[ai][m]; bf16_t* rowp = O + (size_t)row * ldc + col0;
#pragma unroll
                for (int bj = 0; bj < 2; ++bj) *(u32x4*)(rowp + bj * HALF) = pack8(acc[ai][bj][m][0] * scr_, acc[ai][bj][m][1] * scr_); }
        } else {
            const int c0 = wc * 32 + 8 * fq;
            if (c0 < 48) {
#pragma unroll
                EPI_LOOP_ROWS { const int row = row0 + ai * HALF + m * 16; const float rr_ = rsv[ai][m]; float* rowp = GT + (size_t)row * 48 + c0; f32x4 v0 = acc[ai][0][m][0] * rr_, v1 = acc[ai][0][m][1] * rr_;
#pragma unroll
                    for (int j = 0; j < 4; ++j) { v0[j] = sigmoidf_(v0[j]); v1[j] = sigmoidf_(v1[j]); }
                    *(f32x4*)(rowp) = v0; *(f32x4*)(rowp + 4) = v1; }
            }
        }
    }
};
struct EpiMoe1 {
    static constexpr bool PERM = true;
    bf16_t* H; const float* rs;
    __device__ __forceinline__ void operator()(const f32x4 (&acc)[2][2][4][2], const Unit& u, int wr, int wc, int fr, int fq) const {
        const int row0 = u.pm * BM + wr * 64 + fr, col0 = (u.pn & 3) * 128 + wc * 32 + 8 * fq;
        float rsv[2][4];
#pragma unroll
        EPI_LOOP_ROWS rsv[ai][m] = rs[row0 + ai * HALF + m * 16];
#pragma unroll
        EPI_LOOP_ROWS { const int row = row0 + ai * HALF + m * 16; const float r_ = rsv[ai][m]; bf16_t* rowp = H + (size_t)row * 512 + col0; f32x4 v0, v1;
#pragma unroll
            for (int j = 0; j < 4; ++j) { const float g0 = acc[ai][0][m][0][j] * r_, g1 = acc[ai][0][m][1][j] * r_; v0[j] = g0 * sigmoidf_(g0) * (acc[ai][1][m][0][j] * r_); v1[j] = g1 * sigmoidf_(g1) * (acc[ai][1][m][1][j] * r_); }
            *(u32x4*)(rowp) = pack8(v0, v1); }
    }
};
struct EpiMoe2 {
    static constexpr bool PERM = true;
    bf16_t* Y; const float* roww;
    __device__ __forceinline__ void operator()(const f32x4 (&acc)[2][2][4][2], const Unit& u, int wr, int wc, int fr, int fq) const {
        const bool up = (fr & 8) != 0;
        const int rowb = u.pm * BM + wr * 64 + (fr & 7), colp = (u.pn & 3) * BM + wc * 64 + 8 * fq;
#pragma unroll
        EPI_LOOP_ROWS { const u32x4 a0 = pack8(acc[ai][0][m][0], acc[ai][0][m][1]), a1 = pack8(acc[ai][1][m][0], acc[ai][1][m][1]); u32x4 x1;
            x1.x = (unsigned)__builtin_amdgcn_update_dpp(0, (int)a1.x, 0x128, 0xf, 0xf, true); x1.y = (unsigned)__builtin_amdgcn_update_dpp(0, (int)a1.y, 0x128, 0xf, 0xf, true);
            x1.z = (unsigned)__builtin_amdgcn_update_dpp(0, (int)a1.z, 0x128, 0xf, 0xf, true); x1.w = (unsigned)__builtin_amdgcn_update_dpp(0, (int)a1.w, 0x128, 0xf, 0xf, true);
            bf16_t* r0p = Y + (size_t)(rowb + ai * HALF + m * 16) * 1024 + colp;
            *(u32x4*)(r0p + (up ? 32 : 0)) = up ? x1 : a0;
            *(u32x4*)(r0p + 8 * 1024 + (up ? 0 : 32)) = up ? a0 : x1; }
    }
};
struct EpiCmp {
    static constexpr bool PERM = true;
    bf16_t* O; const float* pb;
    __device__ __forceinline__ void operator()(const f32x4 (&acc)[2][2][4][2], const Unit& u, int wr, int wc, int fr, int fq) const {
        const int row0 = u.pm * BM + wr * 64 + fr, col0 = wc * 32 + 8 * fq;
        f32x4 bias[2][2][2];
#pragma unroll
        for (int ai = 0; ai < 2; ++ai)
#pragma unroll
            for (int bj = 0; bj < 2; ++bj)
#pragma unroll
                for (int hf = 0; hf < 2; ++hf) { const float* p = pb + (size_t)((u.pm >> 6) * 4 + ((2 * u.pm + ai) & 3)) * 256 + col0 + bj * HALF + 4 * hf;
                    bias[ai][bj][hf] = (*(const f32x4*)p + *(const f32x4*)(p + 2048)) + (*(const f32x4*)(p + 4096) + *(const f32x4*)(p + 6144)); }
#pragma unroll
        EPI_LOOP_ROWS { bf16_t* rowp = O + (size_t)(row0 + ai * HALF + m * 16) * 256 + col0;
#pragma unroll
            for (int bj = 0; bj < 2; ++bj) { f32x4 v0 = acc[ai][bj][m][0] + bias[ai][bj][0], v1 = acc[ai][bj][m][1] + bias[ai][bj][1];
#pragma unroll
                for (int j = 0; j < 4; ++j) { v0[j] = gelu_tanh_(v0[j]); v1[j] = gelu_tanh_(v1[j]); }
                *(u32x4*)(rowp + bj * HALF) = pack8(v0, v1); } }
    }
};
}

struct Args { const float* in[41]; float* out; unsigned char* ws; int ph_lo, ph_hi; };
enum { I_X = 0, I_ALN, I_AMU, I_AWR, I_AWK, I_AWV, I_AWO, I_AW0, I_AW1, I_AW2, I_AA0, I_AA1, I_AA2, I_AG1, I_AG2, I_AKK, I_AKA, I_ARK, I_ALNXW, I_ALNXB,
       I_KVLN, I_KVW, I_PEK, I_PEV, I_CKW1, I_CKW2, I_CVW1, I_CVW2, I_RELB, I_BLN, I_BWQG, I_BWO, I_MLN, I_MWG, I_MBG, I_MWE, I_MBE, I_MW1, I_MW3, I_MW2, I_FLN };

struct Fr { LAS unsigned char* lds; int tid, lane, wave, G, gw, ngw; };

__device__ __forceinline__ void tr_item(const float* W, int N, int Klim, int Nlim, int k0, int n0, bf16_t* out, long orow0, int ldo, int kout0,
                                        const float* sc, int scmode, LAS float* scr, int lane) {
    f32x4 ld[8];
#pragma unroll
    for (int i = 0; i < 8; ++i) { const int kk = 8 * i + (lane >> 3), k = k0 + kk, n = n0 + 4 * (lane & 7);
        ld[i] = (k < Klim && n < Nlim) ? *(const f32x4*)(W + (size_t)k * N + n) : (f32x4){0.f, 0.f, 0.f, 0.f}; }
#pragma unroll
    for (int i = 0; i < 8; ++i) { const int kk = 8 * i + (lane >> 3), k = k0 + kk; f32x4 v = ld[i];
        if (scmode && k < Klim) { const float sv = sc[k]; v = v * (scmode == 1 ? sv : 1.f - sv); }
        LAS float* d = scr + kk * 33 + 4 * (lane & 7); d[0] = v.x; d[1] = v.y; d[2] = v.z; d[3] = v.w; }
    LDS_WAIT(); asm volatile("" ::: "memory");
    const int c = lane & 7;
#pragma unroll
    for (int j = 0; j < 4; ++j) { const int n = (lane >> 3) + 8 * j; const LAS float* s = scr + (8 * c) * 33 + n;
        u32x4 o; o.x = pk2(s[0 * 33], s[1 * 33]); o.y = pk2(s[2 * 33], s[3 * 33]); o.z = pk2(s[4 * 33], s[5 * 33]); o.w = pk2(s[6 * 33], s[7 * 33]);
        *(u32x4*)(out + (size_t)(orow0 + n) * ldo + kout0 + 8 * c) = o; }
    LDS_WAIT(); asm volatile("" ::: "memory");
}
__device__ __forceinline__ void conv_mat(const Fr& F, const float* W, int K, int N, bf16_t* out, long orow0, int ldo, int kout0, const float* sc, int scmode, LAS float* scr) {
    const int nkb = (K + 63) / 64, nnb = (N + 31) / 32, nit = nkb * nnb;
    for (int it = F.gw; it < nit; it += F.ngw) { const int kb = it / nnb, nb = it % nnb;
        tr_item(W, N, K, N, kb * 64, nb * 32, out, orow0 + nb * 32, ldo, kout0 + kb * 64, sc, scmode, scr, F.lane); }
}
__device__ __forceinline__ void zero_rect(const Fr& F, bf16_t* out, int rows, int cols8, int ldo) {
    const long tot = (long)rows * cols8;
    for (long i = (long)F.gw * 64 + F.lane; i < tot; i += (long)F.ngw * 64) { const long r = i / cols8, c = i % cols8; *(u32x4*)(out + r * ldo + c * 8) = (u32x4){0u, 0u, 0u, 0u}; }
}
__device__ __forceinline__ bf16x8 pack8c(const float (&v)[8]) { u32x4 w; w.x = cvtpk(v[0], v[1]); w.y = cvtpk(v[2], v[3]); w.z = cvtpk(v[4], v[5]); w.w = cvtpk(v[6], v[7]); return __builtin_bit_cast(bf16x8, w); }
__device__ __forceinline__ void phase_conv(const Fr& F, const Args& a) {
    unsigned char* ws = a.ws;
    LAS float* scr = (LAS float*)(F.lds + F.wave * 8704);
    const float* mu = a.in[I_AMU];
    conv_mat(F, a.in[I_AWR], 1024, 1024, (bf16_t*)(ws + WS_WR), 0, 1024, 0, nullptr, 0, scr);
    conv_mat(F, a.in[I_AWK], 1024, 1024, (bf16_t*)(ws + WS_WK), 0, 1024, 0, nullptr, 0, scr);
    conv_mat(F, a.in[I_AWV], 1024, 1024, (bf16_t*)(ws + WS_WV), 0, 1024, 0, nullptr, 0, scr);
    conv_mat(F, a.in[I_AWO], 1024, 1024, (bf16_t*)(ws + WS_WO), 0, 1024, 0, nullptr, 0, scr);
    {
        bf16_t* o = (bf16_t*)(ws + WS_WL1);
        conv_mat(F, a.in[I_AW1], 1024, 64, o, 0, 2048, 0, mu + 1 * 1024, 2, scr);    conv_mat(F, a.in[I_AW1], 1024, 64, o, 0, 2048, 1024, mu + 1 * 1024, 1, scr);
        conv_mat(F, a.in[I_AA1], 1024, 64, o, 64, 2048, 0, mu + 4 * 1024, 2, scr);   conv_mat(F, a.in[I_AA1], 1024, 64, o, 64, 2048, 1024, mu + 4 * 1024, 1, scr);
        conv_mat(F, a.in[I_AG1], 1024, 160, o, 128, 2048, 0, mu + 5 * 1024, 2, scr); conv_mat(F, a.in[I_AG1], 1024, 160, o, 128, 2048, 1024, mu + 5 * 1024, 1, scr);
        zero_rect(F, o + (size_t)288 * 2048, 224, 256, 2048);
    }
    {
        bf16_t* o = (bf16_t*)(ws + WS_W2WA);
        conv_mat(F, a.in[I_AW2], 64, 1024, o, 0, 128, 0, nullptr, 0, scr);
        zero_rect(F, o + 64, 1024, 8, 128);
        conv_mat(F, a.in[I_AA2], 64, 1024, o, 1024, 128, 64, nullptr, 0, scr);
        zero_rect(F, o + (size_t)1024 * 128, 1024, 8, 128);
    }
    {
        bf16_t* o = (bf16_t*)(ws + WS_W2G);
        conv_mat(F, a.in[I_AG2], 160, 1024, o, 0, 256, 0, nullptr, 0, scr);
        zero_rect(F, o + 192, 1024, 8, 256);
    }
    {
        bf16_t* o = (bf16_t*)(ws + WS_WKVQG);
        conv_mat(F, a.in[I_KVW], 1024, 1536, o, 0, 1024, 0, a.in[I_KVLN], 1, scr);
        conv_mat(F, a.in[I_BWQG], 1024, 1072, o, 1536, 1024, 0, a.in[I_BLN], 1, scr);
        zero_rect(F, o + (size_t)2624 * 1024, 192, 128, 1024);
    }
    conv_mat(F, a.in[I_BWO], 1024, 1024, (bf16_t*)(ws + WS_WOB), 0, 1024, 0, nullptr, 0, scr);
    conv_mat(F, a.in[I_CKW1], 2048, 256, (bf16_t*)(ws + WS_WC1), 0, 2048, 0, nullptr, 0, scr);
    conv_mat(F, a.in[I_CVW1], 2048, 256, (bf16_t*)(ws + WS_WC1) + (size_t)256 * 2048, 0, 2048, 0, nullptr, 0, scr);
    {
        bf16_t* o1 = (bf16_t*)(ws + WS_BT1); bf16_t* o2 = (bf16_t*)(ws + WS_BT2);
        for (int it = F.gw; it < 64 * 256; it += F.ngw) { const int mat = it >> 8, r = it & 255, kb = r >> 4, nb = r & 15, n0 = nb * 32;
            const long orow = (long)mat * 1024 + (n0 >> 7) * 256 + (n0 & 127);
            const float* gm = a.in[I_MLN] + (mat >> 5) * 1024;
            tr_item(a.in[I_MW1] + (size_t)mat * 1024 * 512, 512, 1024, 512, kb * 64, n0, o1, orow, 1024, kb * 64, gm, 1, scr, F.lane);
            tr_item(a.in[I_MW3] + (size_t)mat * 1024 * 512, 512, 1024, 512, kb * 64, n0, o1, orow + 128, 1024, kb * 64, gm, 1, scr, F.lane); }
        for (int it = F.gw; it < 64 * 256; it += F.ngw) { const int mat = it >> 8, r = it & 255, kb = r >> 5, nb = r & 31;
            tr_item(a.in[I_MW2] + (size_t)mat * 512 * 1024, 1024, 512, 1024, kb * 64, nb * 32, o2, (long)mat * 1024 + nb * 32, 512, kb * 64, nullptr, 0, scr, F.lane); }
    }
    {
        int* ci = (int*)(ws + WS_CIDX);
        for (int r = F.gw * 64 + F.lane; r < 2 * 16384; r += F.ngw * 64) { const int grp = r >> 14, rr = r & 16383, bg = rr >> 7, n = rr & 127; ci[r] = ((bg >> 2) * SEQ + 16 * n) * 24 + grp * 4 + (bg & 3); }
        if (F.wave == 0 && blockIdx.x < 128) { const int id = blockIdx.x, grp = id >> 6, nb = (id >> 2) & 15, kq = id & 3, i = F.lane & 15, q = F.lane >> 4;
            const float* pe = a.in[grp ? I_PEV : I_PEK] + (size_t)(i & 3) * 2048 + kq * 512 + 8 * q; const float* w = a.in[grp ? I_CVW1 : I_CKW1] + (size_t)(kq * 512 + 8 * q) * 256 + 16 * nb + i;
            f32x4 acc = (f32x4){0.f, 0.f, 0.f, 0.f};
#pragma unroll 2
            for (int sk = 0; sk < 16; ++sk) { const f32x4 p0 = *(const f32x4*)(pe + 32 * sk), p1 = *(const f32x4*)(pe + 32 * sk + 4);
                float wv[8];
#pragma unroll
                for (int e = 0; e < 8; ++e) wv[e] = w[(size_t)(32 * sk + e) * 256];
                const float pv[8] = {p0.x, p0.y, p0.z, p0.w, p1.x, p1.y, p1.z, p1.w}; float pl[8];
#pragma unroll
                for (int e = 0; e < 8; ++e) pl[e] = pv[e] - bflo(f2bf(pv[e]));
                const bf16x8 ah = pack8c(pv), al = pack8c(pl), bw = pack8c(wv);
                acc = __builtin_amdgcn_mfma_f32_16x16x32_bf16(ah, bw, acc, 0, 0, 0); acc = __builtin_amdgcn_mfma_f32_16x16x32_bf16(al, bw, acc, 0, 0, 0); }
            if (F.lane < 16) { float* pb = (float*)(ws + WS_PEBP) + ((size_t)(kq * 2 + grp) * 4) * 256 + 16 * nb + i;
#pragma unroll
                for (int rg = 0; rg < 4; ++rg) pb[rg * 256] = acc[rg]; }
        }
    }
    {
        bf16_t* o = (bf16_t*)(ws + WS_W2F);
        for (int i = F.gw * 64 + F.lane; i < 2 * 16384; i += F.ngw * 64) { const int e = i & 7, ln = (i >> 3) & 63, nb = (i >> 9) & 3, sk = (i >> 11) & 7, grp = i >> 14;
            const int k = 32 * sk + 8 * (ln >> 4) + e, n = 16 * nb + (ln & 15); const float v = a.in[grp ? I_CVW2 : I_CKW2][k * 64 + n];
            const unsigned hi = f2bf(v), lo = f2bf(v - bflo(hi));
            bf16_t* ob = o + ((size_t)((grp * 8 + sk) * 2) * 4 + nb) * 512 + ln * 8 + e; ob[0] = (bf16_t)hi; ob[4 * 512] = (bf16_t)lo; }
    }
    {
        bf16_t* o = (bf16_t*)(ws + WS_RFRAG);
        for (int i = F.gw * 64 + F.lane; i < 2 * 49152; i += F.ngw * 64) { const int layer = i / 49152, r = i % 49152, e = r & 7, ln = (r >> 3) & 63, nt = (r >> 9) % 3, s = r / 1536;
            const int k = 32 * s + 8 * (ln >> 4) + e, n = 16 * nt + (ln & 15);
            float v = 0.f; if (n < 4) v = a.in[I_MWG][((size_t)layer * 1024 + k) * 4 + n]; else if (n < 36) v = a.in[I_MWE][((size_t)layer * 1024 + k) * 32 + (n - 4)];
            v *= a.in[I_MLN][layer * 1024 + k];
            const unsigned hi = f2bf(v); const float r1 = v - bflo(hi); const unsigned lo = f2bf(r1); const float r2 = r1 - bflo(lo); const unsigned lo2 = f2bf(r2);
            bf16_t* ob = o + ((size_t)(layer * 32 + s) * 9 + nt) * 512 + ln * 8 + e;
            ob[0] = (bf16_t)hi; ob[3 * 512] = (bf16_t)lo; ob[6 * 512] = (bf16_t)lo2; }
    }
}

__device__ __forceinline__ void phase_r1(const Fr& F, const Args& a) {
    unsigned char* ws = a.ws; const float* x = a.in[I_X];
    bf16_t* XN = (bf16_t*)(ws + WS_S5); bf16_t* XR = (bf16_t*)(ws + WS_S0); bf16_t* XK = (bf16_t*)(ws + WS_S1); bf16_t* XV = (bf16_t*)(ws + WS_S2);
    f32x4 gn[4], mr[4], mk[4], mv[4];
#pragma unroll
    for (int j = 0; j < 4; ++j) { const int c = 256 * j + 4 * F.lane; gn[j] = *(const f32x4*)(a.in[I_ALN] + c); mr[j] = *(const f32x4*)(a.in[I_AMU] + 0 * 1024 + c);
        mk[j] = *(const f32x4*)(a.in[I_AMU] + 2 * 1024 + c); mv[j] = *(const f32x4*)(a.in[I_AMU] + 3 * 1024 + c); }
    for (int run = F.gw; run < NT / 32; run += F.ngw) {
        const int m0 = run * 32, b = m0 >> 11, t0 = m0 & 2047;
        f32x4 pv[4];
        if (t0 == 0) {
#pragma unroll
            for (int j = 0; j < 4; ++j) { pv[j] = (f32x4){0.f, 0.f, 0.f, 0.f}; *(u32x2*)(XN + (size_t)(b * 2049) * 1024 + 256 * j + 4 * F.lane) = (u32x2){0u, 0u}; }
        } else {
            const f32x4* xr = (const f32x4*)(x + (size_t)(m0 - 1) * 1024) + F.lane; float s = 0.f;
#pragma unroll
            for (int j = 0; j < 4; ++j) { pv[j] = xr[64 * j]; s += (pv[j].x * pv[j].x + pv[j].y * pv[j].y) + (pv[j].z * pv[j].z + pv[j].w * pv[j].w); }
            const float rstd = 1.f / sqrtf(wave_sum(s) * (1.f / 1024.f) + 1e-6f);
#pragma unroll
            for (int j = 0; j < 4; ++j) pv[j] = pv[j] * rstd * gn[j];
        }
        f32x4 nx[4];
        { const f32x4* xr = (const f32x4*)(x + (size_t)m0 * 1024) + F.lane;
#pragma unroll
          for (int j = 0; j < 4; ++j) nx[j] = xr[64 * j]; }
        for (int i = 0; i < 32; ++i) {
            const int m = m0 + i;
            f32x4 v[4]; float s = 0.f;
#pragma unroll
            for (int j = 0; j < 4; ++j) v[j] = nx[j];
            if (i < 31) { const f32x4* xr = (const f32x4*)(x + (size_t)(m + 1) * 1024) + F.lane;
#pragma unroll
                for (int j = 0; j < 4; ++j) nx[j] = xr[64 * j]; }
#pragma unroll
            for (int j = 0; j < 4; ++j) s += (v[j].x * v[j].x + v[j].y * v[j].y) + (v[j].z * v[j].z + v[j].w * v[j].w);
            const float rstd = 1.f / sqrtf(wave_sum(s) * (1.f / 1024.f) + 1e-6f);
            const size_t prow = (size_t)(m + b + 1) * 1024, row = (size_t)m * 1024;
#pragma unroll
            for (int j = 0; j < 4; ++j) { const int c = 256 * j + 4 * F.lane;
                const f32x4 cur = v[j] * rstd * gn[j], xx = pv[j] - cur;
                *(u32x2*)(XN + prow + c) = (u32x2){pk2(cur.x, cur.y), pk2(cur.z, cur.w)};
                const f32x4 r_ = cur + xx * mr[j], k_ = cur + xx * mk[j], v_ = cur + xx * mv[j];
                *(u32x2*)(XR + row + c) = (u32x2){pk2(r_.x, r_.y), pk2(r_.z, r_.w)};
                *(u32x2*)(XK + row + c) = (u32x2){pk2(k_.x, k_.y), pk2(k_.z, k_.w)};
                *(u32x2*)(XV + row + c) = (u32x2){pk2(v_.x, v_.y), pk2(v_.z, v_.w)};
                pv[j] = cur; }
        }
    }
}

typedef float f32x16 __attribute__((ext_vector_type(16)));
__device__ __forceinline__ bf16x8 pack8f(float a0, float a1, float a2, float a3, float a4, float a5, float a6, float a7) {
    u32x4 w; w.x = cvtpk(a0, a1); w.y = cvtpk(a2, a3); w.z = cvtpk(a4, a5); w.w = cvtpk(a6, a7); return __builtin_bit_cast(bf16x8, w); }
__device__ __forceinline__ bf16x8 packacc(const f32x16& v, int s2) { return pack8f(v[8 * s2], v[8 * s2 + 1], v[8 * s2 + 2], v[8 * s2 + 3], v[8 * s2 + 4], v[8 * s2 + 5], v[8 * s2 + 6], v[8 * s2 + 7]); }
__device__ __forceinline__ int swap23(int w) { return (w & ~12) | ((w & 4) << 1) | ((w & 8) >> 1); }
constexpr int SC_AT = 0, SC_RT = 4096, SC_BJ = 8192, SC_KJ = 12288, SC_VI = 16384, SC_BT = 20480, SC_KT = 24576, SC_TT = 20480, SC_AAKT = 22528, SC_ABRT = 24576, SC_AKRT = 26624,
              SC_GL = 28672, SC_SS = 28928, SC_SLOT = 29184, SC_YB = 4 * SC_SLOT, SC_BON = SC_YB + 32768;
template <int HALF, int BIT>
__device__ __forceinline__ void reduce32_stage(float (&v)[32], int lane) {
    const bool up = (lane & BIT) != 0; const int addr = (lane ^ BIT) << 2;
#pragma unroll
    for (int i = 0; i < HALF; ++i) { const float keep = up ? v[i + HALF] : v[i], send = up ? v[i] : v[i + HALF];
        v[i] = keep + __int_as_float(__builtin_amdgcn_ds_bpermute(addr, __float_as_int(send))); }
}
__device__ __forceinline__ float reduce32(float (&v)[32], int lane) {
#pragma unroll
    for (int i = 0; i < 16; ++i) { const auto r = __builtin_amdgcn_permlane32_swap(__float_as_uint(v[i]), __float_as_uint(v[i + 16]), false, false); v[i] = __uint_as_float(r[0]) + __uint_as_float(r[1]); }
#pragma unroll
    for (int i = 0; i < 8; ++i) { const auto r = __builtin_amdgcn_permlane16_swap(__float_as_uint(v[i]), __float_as_uint(v[i + 8]), false, false); v[i] = __uint_as_float(r[0]) + __uint_as_float(r[1]); }
    { const bool up = (lane & 8) != 0;
#pragma unroll
      for (int i = 0; i < 4; ++i) { const float keep = up ? v[i + 4] : v[i], send = up ? v[i] : v[i + 4]; v[i] = keep + dppf<DPP_ROR8>(send); } }
    reduce32_stage<2, 4>(v, lane);
    { const bool up = (lane & 2) != 0; const float keep = up ? v[1] : v[0], send = up ? v[0] : v[1]; v[0] = keep + dppf<DPP_XOR2>(send); }
    return v[0] + dppf<DPP_XOR1>(v[0]);
}
#define SC_RAW(area, t) bf2f(*(const LAS bf16_t*)(slot + (area) + (t) * 128 + lane * 2))
#define SC_BARRIER() do { asm volatile("s_waitcnt lgkmcnt(0)" ::: "memory"); __builtin_amdgcn_s_barrier(); asm volatile("" ::: "memory"); } while (0)
struct ScanRaw { u32x4 v[10]; unsigned lwp[16]; };
__device__ __forceinline__ void scan_load(const Args& a, ScanRaw& R, int chain, int t0, int half, int lane) {
    unsigned char* ws = a.ws; const int tb = 16 * half;
    const unsigned char* Rb = ws + WS_S3; const unsigned char* LWb = ws + WS_S0; const unsigned char* Kb = ws + WS_S4; const unsigned char* Vb = (const unsigned char*)a.out; const unsigned char* Ab = ws + WS_S1;
    const size_t rowb = ((size_t)chain * SEQ + t0) * 128;
#pragma unroll
    for (int q = 0; q < 2; ++q) { const size_t o = rowb + (size_t)(tb + 8 * q) * 128 + lane * 16;
        R.v[5 * q + 0] = *(const u32x4*)(Ab + o); R.v[5 * q + 1] = *(const u32x4*)(Rb + o); R.v[5 * q + 2] = *(const u32x4*)(LWb + o); R.v[5 * q + 3] = *(const u32x4*)(Kb + o); R.v[5 * q + 4] = *(const u32x4*)(Vb + o); }
    if (half) {
#pragma unroll
        for (int m = 0; m < 16; ++m) R.lwp[m] = (unsigned)*(const bf16_t*)(LWb + rowb + (size_t)m * 128 + lane * 2); }
}
__device__ __forceinline__ void scan_pre(const Fr& F, const Args& a, LAS unsigned char* slot, LAS float* bon, LAS unsigned char* ysc, int chain, int t0, int half, ScanRaw& R, bool more, float kkc, float kac, float rkc) {
    unsigned char* ws = a.ws;
    int lane = F.lane; asm volatile("" : "+v"(lane));
    { unsigned so = (unsigned)(size_t)slot; asm volatile("" : "+s"(so)); slot = (LAS unsigned char*)(size_t)so; }
    const int b = chain >> 4, hd = chain & 15, ch = hd * 64 + lane, r = lane & 31, h = lane >> 5, tb = 16 * half;
    float cum = 0.f;
    if (half) {
#pragma unroll
        for (int m = 0; m < 16; ++m) cum += bflo(R.lwp[m]); }
    {
#pragma unroll
        for (int q = 0; q < 2; ++q) { const int lo2 = (tb + 8 * q) * 128 + lane * 16;
            *(LAS u32x4*)(slot + SC_AT + lo2) = R.v[5 * q + 0]; *(LAS u32x4*)(slot + SC_RT + lo2) = R.v[5 * q + 1]; *(LAS u32x4*)(slot + SC_BT + lo2) = R.v[5 * q + 2]; *(LAS u32x4*)(slot + SC_KT + lo2) = R.v[5 * q + 3]; *(LAS u32x4*)(slot + SC_BJ + lo2) = R.v[5 * q + 4]; }
        LDS_WAIT();
        if (more) scan_load(a, R, chain, t0 + 64, half, lane);
    }
    float kq[16], aq[16], rq[16];
    {
        float q[32];
#pragma unroll
        for (int tt = 0; tt < 16; ++tt) { const float k = SC_RAW(SC_KT, tb + tt), av = SC_RAW(SC_AT, tb + tt), rv = SC_RAW(SC_RT, tb + tt); kq[tt] = k; aq[tt] = av; rq[tt] = rv;
            const float kkv = k * kkc; q[tt] = kkv * kkv; q[16 + tt] = rv * (k * (1.f + (av - 1.f) * kac)) * rkc; }
        const float s1 = reduce32(q, lane); const int idx = (lane >> 1) & 31;
        if ((lane & 1) == 0) { if (idx < 16) ((LAS float*)(slot + SC_SS))[tb + idx] = s1; else bon[tb + idx - 16] = s1; }
    }
    unsigned vv[8];
#pragma unroll
    for (int m = 0; m < 8; ++m) vv[m] = (unsigned)*(const LAS bf16_t*)(slot + SC_BJ + (tb + 2 * m) * 128 + lane * 2) | ((unsigned)*(const LAS bf16_t*)(slot + SC_BJ + (tb + 2 * m + 1) * 128 + lane * 2) << 16);
    LDS_WAIT(); asm volatile("" ::: "memory");
    const int pj = (lane & 48) | swap23(lane & 15);
    const int pjc = pj >> 3, pjw = (pj & 7) * 2;
    unsigned bj[8], kj[8]; float gprev = half ? fexp_(cum) : 1.f, gl = 1.f;
    f32x4 ssv[4];
#pragma unroll
    for (int q4 = 0; q4 < 4; ++q4) ssv[q4] = *(const LAS f32x4*)(slot + SC_SS + (tb + 4 * q4) * 4);
    const bool odd = (lane & 1) != 0; const int pjwe = pjw & ~2;
#define SC_PAIR_STORE(area, x) do { const float _snd = odd ? x[0] : x[1]; const float _rcv = dppf<DPP_XOR1>(_snd); *(LAS unsigned*)(slot + (area) + ro) = cvtpk(odd ? _rcv : x[0], odd ? x[1] : _rcv); } while (0)
#pragma unroll
    for (int tp = 0; tp < 8; ++tp) { const int t0 = tb + 2 * tp;
        float atv[2], rtv[2], btv[2], ktv[2];
#pragma unroll
        for (int u = 0; u < 2; ++u) { const int tt = 2 * tp + u;
            const float k = kq[tt], av = aq[tt], rv = rq[tt], lw = SC_RAW(SC_BT, tb + tt);
            cum += lw; const float g = fexp_(cum), ginv = __builtin_amdgcn_rcpf(g);
            const float ss = ssv[tt >> 2][tt & 3];
            const float kk = k * kkc * __builtin_amdgcn_rsqf(fmaxf(ss, 1e-24f)); const float kp = k * (1.f + (av - 1.f) * kac);
            atv[u] = -kk * gprev; btv[u] = kk * av * ginv; ktv[u] = kp * ginv; rtv[u] = rv * g;
            gprev = g; gl = g; }
        bj[tp] = cvtpk(btv[0], btv[1]); kj[tp] = cvtpk(ktv[0], ktv[1]);
        const int ro = (t0 + (odd ? 1 : 0)) * 128 + ((pjc ^ ((t0 >> 1) & 7)) << 4) + pjwe;
        SC_PAIR_STORE(SC_AT, atv); SC_PAIR_STORE(SC_RT, rtv); SC_PAIR_STORE(SC_BT, btv); SC_PAIR_STORE(SC_KT, ktv);
    }
#undef SC_PAIR_STORE
    SC_BARRIER();
#pragma unroll
    for (int cc = 0; cc < 2; ++cc) { const int c = 2 * half + cc, m0 = 2 * cc; const int ro = lane * 64 + ((c ^ ((lane >> 2) & 3)) << 4);
        *(LAS u32x4*)(slot + SC_BJ + ro) = (u32x4){bj[m0], bj[m0 + 1], bj[m0 + 4], bj[m0 + 5]};
        *(LAS u32x4*)(slot + SC_KJ + ro) = (u32x4){kj[m0], kj[m0 + 1], kj[m0 + 4], kj[m0 + 5]};
        *(LAS u32x4*)(slot + SC_VI + ro) = (u32x4){vv[m0], vv[m0 + 1], vv[m0 + 4], vv[m0 + 5]}; }
    if (half) ((LAS float*)(slot + SC_GL))[lane] = gl;
    const int swz = (r >> 1) & 7;
    f32x16 D0, D1, D2;
#pragma unroll
    for (int i = 0; i < 16; ++i) { D0[i] = 0.f; D1[i] = 0.f; D2[i] = 0.f; }
    if (half == 0) {
#pragma unroll
        for (int ks = 0; ks < 4; ++ks) { const int ao = r * 128 + (((2 * ks + h) ^ swz) << 4);
            D0 = __builtin_amdgcn_mfma_f32_32x32x16_bf16(*(const LAS bf16x8*)(slot + SC_BT + ao), *(const LAS bf16x8*)(slot + SC_AT + ao), D0, 0, 0, 0); }
    } else {
#pragma unroll
        for (int ks = 0; ks < 4; ++ks) { const int ao = r * 128 + (((2 * ks + h) ^ swz) << 4);
            const bf16x8 bA = *(const LAS bf16x8*)(slot + SC_BT + ao), kA = *(const LAS bf16x8*)(slot + SC_KT + ao), aB = *(const LAS bf16x8*)(slot + SC_AT + ao), rB = *(const LAS bf16x8*)(slot + SC_RT + ao);
            D0 = __builtin_amdgcn_mfma_f32_32x32x16_bf16(kA, aB, D0, 0, 0, 0); D1 = __builtin_amdgcn_mfma_f32_32x32x16_bf16(bA, rB, D1, 0, 0, 0); D2 = __builtin_amdgcn_mfma_f32_32x32x16_bf16(kA, rB, D2, 0, 0, 0); }
    }
    SC_BARRIER();
    if (half == 0) {
        const int sw4 = (r >> 2) & 3; int bo[2];
#pragma unroll
        for (int s2 = 0; s2 < 2; ++s2) bo[s2] = r * 64 + (((2 * s2 + h) ^ sw4) << 4);
        const int pcol = (r & 16) | swap23(r & 15), pcc = pcol >> 3, pcw = (pcol & 7) * 2;
        f32x16 Mx, Tx;
#pragma unroll
        for (int reg = 0; reg < 16; ++reg) { const int sr = (reg & 3) + 8 * (reg >> 2) + 4 * h; const float av = (sr < r) ? D0[reg] : 0.f; Mx[reg] = av; Tx[reg] = av + ((sr == r) ? 1.f : 0.f); }
#pragma unroll
        for (int it = 0; it < 4; ++it) {
#pragma unroll
            for (int reg = 0; reg < 16; ++reg) { const int sr = (reg & 3) + 8 * (reg >> 2) + 4 * h; const int ad = sr * 64 + ((pcc ^ ((sr >> 2) & 3)) << 4) + pcw;
                *(LAS bf16_t*)(ysc + ad) = (bf16_t)f2bf(Mx[reg]); *(LAS bf16_t*)(ysc + 2048 + ad) = (bf16_t)f2bf(Tx[reg]); }
            LDS_WAIT(); asm volatile("" ::: "memory");
            bf16x8 mb[2], m2b[2];
#pragma unroll
            for (int s2 = 0; s2 < 2; ++s2) mb[s2] = packacc(Mx, s2);
            f32x16 M2;
#pragma unroll
            for (int i = 0; i < 16; ++i) M2[i] = 0.f;
#pragma unroll
            for (int s2 = 0; s2 < 2; ++s2) M2 = __builtin_amdgcn_mfma_f32_32x32x16_bf16(*(const LAS bf16x8*)(ysc + bo[s2]), mb[s2], M2, 0, 0, 0);
#pragma unroll
            for (int s2 = 0; s2 < 2; ++s2) m2b[s2] = packacc(M2, s2);
#pragma unroll
            for (int s2 = 0; s2 < 2; ++s2) Tx = __builtin_amdgcn_mfma_f32_32x32x16_bf16(*(const LAS bf16x8*)(ysc + 2048 + bo[s2]), m2b[s2], Tx, 0, 0, 0);
            Mx = M2;
            LDS_WAIT(); asm volatile("" ::: "memory");
        }
#pragma unroll
        for (int g = 0; g < 4; ++g) { const int ro = r * 64 + (((2 * (g >> 1) + h) ^ sw4) << 4) + 8 * (g & 1);
            *(LAS u32x2*)(slot + SC_TT + ro) = (u32x2){cvtpk(Tx[4 * g], Tx[4 * g + 1]), cvtpk(Tx[4 * g + 2], Tx[4 * g + 3])}; }
    } else {
#pragma unroll
        for (int reg = 0; reg < 16; ++reg) { const int sr = (reg & 3) + 8 * (reg >> 2) + 4 * h; D0[reg] = (sr < r) ? D0[reg] : 0.f; D1[reg] = (sr <= r) ? D1[reg] : 0.f; D2[reg] = (sr <= r) ? D2[reg] : 0.f; }
        const int sw4 = (r >> 2) & 3;
#pragma unroll
        for (int g = 0; g < 4; ++g) { const int ro = r * 64 + (((2 * (g >> 1) + h) ^ sw4) << 4) + 8 * (g & 1);
            *(LAS u32x2*)(slot + SC_AAKT + ro) = (u32x2){cvtpk(D0[4 * g], D0[4 * g + 1]), cvtpk(D0[4 * g + 2], D0[4 * g + 3])};
            *(LAS u32x2*)(slot + SC_ABRT + ro) = (u32x2){cvtpk(D1[4 * g], D1[4 * g + 1]), cvtpk(D1[4 * g + 2], D1[4 * g + 3])};
            *(LAS u32x2*)(slot + SC_AKRT + ro) = (u32x2){cvtpk(D2[4 * g], D2[4 * g + 1]), cvtpk(D2[4 * g + 2], D2[4 * g + 3])}; }
    }
}
__device__ __forceinline__ void scan_seq(LAS unsigned char* slot, LAS bf16_t* yb, int ib, int lane, f32x16 (&Z)[2]) {
    asm volatile("" : "+v"(lane));
    { unsigned so = (unsigned)(size_t)slot; asm volatile("" : "+s"(so)); slot = (LAS unsigned char*)(size_t)so; }
    const int r = lane & 31, h = lane >> 5, swz = (r >> 1) & 7, sw4 = (r >> 2) & 3;
    int ao[4], bo[2];
#pragma unroll
    for (int ks = 0; ks < 4; ++ks) ao[ks] = r * 128 + (((2 * ks + h) ^ swz) << 4);
#pragma unroll
    for (int s2 = 0; s2 < 2; ++s2) bo[s2] = r * 64 + (((2 * s2 + h) ^ sw4) << 4);
    bf16x8 zb[4], vB[2], xb[2], pb[2];
#pragma unroll
    for (int jb = 0; jb < 2; ++jb)
#pragma unroll
        for (int s2 = 0; s2 < 2; ++s2) zb[2 * jb + s2] = packacc(Z[jb], s2);
#pragma unroll
    for (int s2 = 0; s2 < 2; ++s2) vB[s2] = *(const LAS bf16x8*)(slot + SC_VI + ib * 2048 + bo[s2]);
    f32x16 X, P, Y;
#pragma unroll
    for (int i = 0; i < 16; ++i) { X[i] = 0.f; P[i] = 0.f; Y[i] = 0.f; }
#pragma unroll
    for (int ks = 0; ks < 4; ++ks) X = __builtin_amdgcn_mfma_f32_32x32x16_bf16(*(const LAS bf16x8*)(slot + SC_AT + ao[ks]), zb[ks], X, 0, 0, 0);
#pragma unroll
    for (int s2 = 0; s2 < 2; ++s2) X = __builtin_amdgcn_mfma_f32_32x32x16_bf16(*(const LAS bf16x8*)(slot + SC_AAKT + bo[s2]), vB[s2], X, 0, 0, 0);
#pragma unroll
    for (int s2 = 0; s2 < 2; ++s2) xb[s2] = packacc(X, s2);
#pragma unroll
    for (int s2 = 0; s2 < 2; ++s2) P = __builtin_amdgcn_mfma_f32_32x32x16_bf16(*(const LAS bf16x8*)(slot + SC_TT + bo[s2]), xb[s2], P, 0, 0, 0);
#pragma unroll
    for (int s2 = 0; s2 < 2; ++s2) pb[s2] = packacc(P, s2);
#pragma unroll
    for (int ks = 0; ks < 4; ++ks) Y = __builtin_amdgcn_mfma_f32_32x32x16_bf16(*(const LAS bf16x8*)(slot + SC_RT + ao[ks]), zb[ks], Y, 0, 0, 0);
#pragma unroll
    for (int s2 = 0; s2 < 2; ++s2) { Y = __builtin_amdgcn_mfma_f32_32x32x16_bf16(*(const LAS bf16x8*)(slot + SC_ABRT + bo[s2]), pb[s2], Y, 0, 0, 0);
        Y = __builtin_amdgcn_mfma_f32_32x32x16_bf16(*(const LAS bf16x8*)(slot + SC_AKRT + bo[s2]), vB[s2], Y, 0, 0, 0); }
#pragma unroll
    for (int jb = 0; jb < 2; ++jb) {
#pragma unroll
        for (int s2 = 0; s2 < 2; ++s2) { Z[jb] = __builtin_amdgcn_mfma_f32_32x32x16_bf16(*(const LAS bf16x8*)(slot + SC_BJ + jb * 2048 + bo[s2]), pb[s2], Z[jb], 0, 0, 0);
            Z[jb] = __builtin_amdgcn_mfma_f32_32x32x16_bf16(*(const LAS bf16x8*)(slot + SC_KJ + jb * 2048 + bo[s2]), vB[s2], Z[jb], 0, 0, 0); }
#pragma unroll
        for (int g = 0; g < 4; ++g) { const f32x4 gl4 = *(const LAS f32x4*)(slot + SC_GL + (32 * jb + 8 * g + 4 * h) * 4);
            Z[jb][4 * g] *= gl4.x; Z[jb][4 * g + 1] *= gl4.y; Z[jb][4 * g + 2] *= gl4.z; Z[jb][4 * g + 3] *= gl4.w; } }
#pragma unroll
    for (int reg = 0; reg < 16; ++reg) yb[((reg & 3) + 8 * (reg >> 2) + 4 * h) * 64 + ib * 32 + r] = (bf16_t)f2bf(Y[reg]);
}
__device__ __forceinline__ void phase_scan(const Fr& F, const Args& a) {
    unsigned char* ws = a.ws; const bf16_t* Vb = (const bf16_t*)a.out; const bf16_t* Gb = (const bf16_t*)(ws + WS_S2); bf16_t* YG = (bf16_t*)(ws + WS_S5);
    LAS bf16_t* YB = (LAS bf16_t*)(F.lds + SC_YB);
    LAS float* BON = (LAS float*)(F.lds + SC_BON);
    const int w = F.wave, lane = F.lane;
    for (int cp = blockIdx.x; cp < 256; cp += F.G) {
        f32x16 Z[2];
#pragma unroll
        for (int i = 0; i < 16; ++i) { Z[0][i] = 0.f; Z[1][i] = 0.f; }
        ScanRaw R; scan_load(a, R, 2 * cp + ((w & 3) >> 1), 32 * (w & 1), w >> 2, lane);
        const int chp = ((2 * cp + ((w & 3) >> 1)) & 15) * 64 + lane; float kkc = a.in[I_AKK][chp], kac = a.in[I_AKA][chp], rkc = a.in[I_ARK][chp];
        asm volatile("" : "+v"(kkc), "+v"(kac), "+v"(rkc));
#pragma unroll 1
        for (int bt = 0; bt <= 32; ++bt) {
            SC_BARRIER();
            if (bt < 32) { const int sl = w & 3;
                scan_pre(F, a, F.lds + sl * SC_SLOT, BON + (bt & 1) * 128 + (sl >> 1) * 64 + (sl & 1) * 32, F.lds + SC_YB + (bt & 1) * 16384 + sl * 4096, 2 * cp + (sl >> 1), 64 * bt + 32 * (sl & 1), w >> 2, R, bt < 31, kkc, kac, rkc); }
            SC_BARRIER();
            if (w >= 4) { if (bt < 32) { const int cl = (w - 4) >> 1, ib = (w - 4) & 1;
                scan_seq(F.lds + (2 * cl) * SC_SLOT, YB + (bt & 1) * 8192 + cl * 4096, ib, lane, Z);
                scan_seq(F.lds + (2 * cl + 1) * SC_SLOT, YB + (bt & 1) * 8192 + cl * 4096 + 2048, ib, lane, Z); } }
            else if (bt >= 1) {
                const int cl = w >> 1, chain = 2 * cp + cl, b = chain >> 4, hd = chain & 15, ch = hd * 64 + lane; const float lw_ = a.in[I_ALNXW][ch], lb_ = a.in[I_ALNXB][ch];
                LAS f32x2* ST = (LAS f32x2*)(F.lds + SC_BON + 1024) + w * 32;
                const int tb = 32 * (w & 1); const LAS bf16_t* yp = YB + ((bt - 1) & 1) * 8192 + cl * 4096 + tb * 64 + lane;
                const size_t go = ((size_t)chain * SEQ + 64 * (bt - 1) + tb) * 64 + lane; const bf16_t* vp = Vb + go; const bf16_t* gp = Gb + go; bf16_t* op = YG + go;
                const LAS float* bp = BON + ((bt - 1) & 1) * 128 + cl * 64 + tb;
#pragma unroll 1
                for (int hh = 0; hh < 2; ++hh) {
                    unsigned vg[16];
#pragma unroll
                    for (int tt = 0; tt < 16; ++tt) vg[tt] = (unsigned)vp[(16 * hh + tt) * 64] | ((unsigned)gp[(16 * hh + tt) * 64] << 16);
                    float yq[16];
                    {
                        float q[32];
#pragma unroll
                        for (int tt = 0; tt < 16; ++tt) { const float y = bf2f(yp[(16 * hh + tt) * 64]); yq[tt] = y; q[tt] = y; q[16 + tt] = y * y; }
                        const float s1 = reduce32(q, lane); const int idx = (lane >> 1) & 31;
                        LAS float* STf = (LAS float*)ST;
                        if ((lane & 1) == 0) STf[idx] = s1;
                    }
                    LDS_WAIT(); asm volatile("" ::: "memory");
                    f32x4 sm[4], sq[4], bv4[4];
#pragma unroll
                    for (int q4 = 0; q4 < 4; ++q4) { sm[q4] = ((const LAS f32x4*)ST)[q4]; sq[q4] = ((const LAS f32x4*)ST)[4 + q4]; bv4[q4] = *(const LAS f32x4*)(bp + 16 * hh + 4 * q4); }
#pragma unroll
                    for (int tt = 0; tt < 16; ++tt) { const int t = 16 * hh + tt; const float mean = sm[tt >> 2][tt & 3] * (1.f / 64.f); const float var = fmaxf(sq[tt >> 2][tt & 3] * (1.f / 64.f) - mean * mean, 0.f);
                        float o = (yq[tt] - mean) * __builtin_amdgcn_rsqf(var + 64e-5f) * lw_ + lb_ + bv4[tt >> 2][tt & 3] * bflo(vg[tt]);
                        o *= bfhi(vg[tt]); op[t * 64] = (bf16_t)f2bf(o); }
                    LDS_WAIT(); asm volatile("" ::: "memory");
                }
            }
        }
    }
}

template <int MODE>
__device__ __forceinline__ float load_row_hb(const Fr& F, const bf16_t* hrow, const bf16_t* Y, const int* asg, int m, float (&v)[16]) {
    int p0 = 0, p1 = 0; if (MODE == 1) { p0 = asg[m * 8 + 6]; p1 = asg[m * 8 + 7]; }
    float s = 0.f;
#pragma unroll
    for (int j = 0; j < 2; ++j) { const u32x4 hv = *(const u32x4*)(hrow + 512 * j + 8 * F.lane);
        float* o = v + 8 * j; o[0] = bflo(hv.x); o[1] = bfhi(hv.x); o[2] = bflo(hv.y); o[3] = bfhi(hv.y); o[4] = bflo(hv.z); o[5] = bfhi(hv.z); o[6] = bflo(hv.w); o[7] = bfhi(hv.w);
        if (MODE == 1) { const u32x4 y0 = *(const u32x4*)(Y + (size_t)p0 * 1024 + 512 * j + 8 * F.lane), y1 = *(const u32x4*)(Y + (size_t)p1 * 1024 + 512 * j + 8 * F.lane);
            o[0] += bflo(y0.x) + bflo(y1.x); o[1] += bfhi(y0.x) + bfhi(y1.x); o[2] += bflo(y0.y) + bflo(y1.y); o[3] += bfhi(y0.y) + bfhi(y1.y);
            o[4] += bflo(y0.z) + bflo(y1.z); o[5] += bfhi(y0.z) + bfhi(y1.z); o[6] += bflo(y0.w) + bflo(y1.w); o[7] += bfhi(y0.w) + bfhi(y1.w); }
#pragma unroll
        for (int e = 0; e < 8; ++e) s += o[e] * o[e]; }
    return 1.f / sqrtf(wave_sum(s) * (1.f / 1024.f) + 1e-6f);
}

struct RowRaw { u32x4 h[2], y0[2], y1[2]; };
__device__ __forceinline__ int y_chunk_col(int c) { const int ci = c & 31; return (c >> 5) * 256 + (((ci >> 2) & 3) * 8 + (ci >> 4) * 4 + (ci & 3)) * 8; }
__device__ __forceinline__ void row_issue(const Fr& F, const bf16_t* hrow, const bf16_t* Y, int p0, int p1, RowRaw& R) {
#pragma unroll
    for (int j = 0; j < 2; ++j) { const int yc = y_chunk_col(64 * j + F.lane);
        R.h[j] = *(const u32x4*)(hrow + 512 * j + 8 * F.lane); R.y0[j] = *(const u32x4*)(Y + (size_t)p0 * 1024 + yc); R.y1[j] = *(const u32x4*)(Y + (size_t)p1 * 1024 + yc); }
}
__device__ __forceinline__ float row_finish(const RowRaw& R, float (&v)[16], float w0, float w1) {
    float s = 0.f;
#pragma unroll
    for (int j = 0; j < 2; ++j) { const u32x4 hv = R.h[j], y0 = R.y0[j], y1 = R.y1[j]; float* o = v + 8 * j;
        o[0] = bflo(hv.x) + (w0 * bflo(y0.x) + w1 * bflo(y1.x)); o[1] = bfhi(hv.x) + (w0 * bfhi(y0.x) + w1 * bfhi(y1.x)); o[2] = bflo(hv.y) + (w0 * bflo(y0.y) + w1 * bflo(y1.y)); o[3] = bfhi(hv.y) + (w0 * bfhi(y0.y) + w1 * bfhi(y1.y));
        o[4] = bflo(hv.z) + (w0 * bflo(y0.z) + w1 * bflo(y1.z)); o[5] = bfhi(hv.z) + (w0 * bfhi(y0.z) + w1 * bfhi(y1.z)); o[6] = bflo(hv.w) + (w0 * bflo(y0.w) + w1 * bflo(y1.w)); o[7] = bfhi(hv.w) + (w0 * bfhi(y0.w) + w1 * bfhi(y1.w));
#pragma unroll
        for (int e = 0; e < 8; ++e) s += o[e] * o[e]; }
    return 1.f / sqrtf(wave_sum(s) * (1.f / 1024.f) + 1e-6f);
}
constexpr int RB = 4;
#define ROWS_ISSUE(Hbase) int p0[RB], p1[RB]; float rw0[RB], rw1[RB]; RowRaw R[RB]; \
        _Pragma("unroll") for (int r = 0; r < RB; ++r) { const int mr = m + r * F.ngw; p0[r] = 0; p1[r] = 0; rw0[r] = 0.f; rw1[r] = 0.f; if (mr < NT) { const u32x4 _as = *(const u32x4*)(asg + mr * 8 + 4); \
            const unsigned _wx = _as.x, _wy = _as.y; rw0[r] = __uint_as_float(_wx); rw1[r] = __uint_as_float(_wy); p0[r] = (int)_as.z; p1[r] = (int)_as.w; } } \
        _Pragma("unroll") for (int r = 0; r < RB; ++r) { const int mr = m + r * F.ngw; if (mr < NT) row_issue(F, (Hbase) + (size_t)mr * 1024, Y, p0[r], p1[r], R[r]); }
__device__ __forceinline__ void phase_m1(const Fr& F, const Args& a, int layer) {
    unsigned char* ws = a.ws; const bf16_t* h = (const bf16_t*)(ws + WS_H); float* RS = (float*)(ws + WS_RSTD);
    int* asg = (int*)(ws + WS_ASG);
    const bf16_t* wfb = (const bf16_t*)(ws + WS_RFRAG) + (size_t)layer * 32 * 9 * 512;
    unsigned* cnt = (unsigned*)(ws + WS_CTL) + CW_CNT + layer * 32 * 64;
    LAS float* Lg = (LAS float*)F.lds + F.wave * 1600;
    LAS float* Lr = Lg + 1536;
    for (int task = F.gw; task < NT / 32; task += F.ngw) {
        const int m0 = task * 32;
        f32x4 acc[2][3];
#pragma unroll
        for (int rb = 0; rb < 2; ++rb)
#pragma unroll
            for (int nt = 0; nt < 3; ++nt) acc[rb][nt] = (f32x4){0.f, 0.f, 0.f, 0.f};
        const int i = F.lane & 15, q = F.lane >> 4; const bf16_t* hr = h + (size_t)(m0 + i) * 1024 + 8 * q;
        float ss0 = 0.f, ss1 = 0.f;
#pragma unroll 4
        for (int s = 0; s < 32; ++s) {
            const bf16x8 a0 = *(const bf16x8*)(hr + 32 * s), a1 = *(const bf16x8*)(hr + 16 * 1024 + 32 * s);
            const bf16_t* wp = wfb + (size_t)s * 9 * 512 + F.lane * 8;
#pragma unroll
            for (int tn = 0; tn < 9; ++tn) { const bf16x8 b = *(const bf16x8*)(wp + tn * 512);
                acc[0][tn % 3] = __builtin_amdgcn_mfma_f32_16x16x32_bf16(a0, b, acc[0][tn % 3], 0, 0, 0); acc[1][tn % 3] = __builtin_amdgcn_mfma_f32_16x16x32_bf16(a1, b, acc[1][tn % 3], 0, 0, 0); }
            const u32x4 u0 = __builtin_bit_cast(u32x4, a0), u1 = __builtin_bit_cast(u32x4, a1);
#pragma unroll
            for (int e = 0; e < 4; ++e) { const float x0 = bflo(u0[e]), y0 = bfhi(u0[e]), x1 = bflo(u1[e]), y1 = bfhi(u1[e]); ss0 += x0 * x0 + y0 * y0; ss1 += x1 * x1 + y1 * y1; }
        }
        {
            auto r16 = __builtin_amdgcn_permlane16_swap(__float_as_uint(ss0), __float_as_uint(ss0), false, false); ss0 = __uint_as_float(r16[0]) + __uint_as_float(r16[1]);
            auto r32 = __builtin_amdgcn_permlane32_swap(__float_as_uint(ss0), __float_as_uint(ss0), false, false); ss0 = __uint_as_float(r32[0]) + __uint_as_float(r32[1]);
            r16 = __builtin_amdgcn_permlane16_swap(__float_as_uint(ss1), __float_as_uint(ss1), false, false); ss1 = __uint_as_float(r16[0]) + __uint_as_float(r16[1]);
            r32 = __builtin_amdgcn_permlane32_swap(__float_as_uint(ss1), __float_as_uint(ss1), false, false); ss1 = __uint_as_float(r32[0]) + __uint_as_float(r32[1]);
            const float rs0 = 1.f / sqrtf(ss0 * (1.f / 1024.f) + 1e-6f), rs1 = 1.f / sqrtf(ss1 * (1.f / 1024.f) + 1e-6f);
            if (F.lane < 16) { RS[m0 + i] = rs0; RS[m0 + 16 + i] = rs1; Lr[i] = rs0; Lr[16 + i] = rs1; }
        }
        LDS_WAIT(); asm volatile("" ::: "memory");
#pragma unroll
        for (int rb = 0; rb < 2; ++rb) { const f32x4 rs = *(const LAS f32x4*)(Lr + 16 * rb + 4 * q);
#pragma unroll
            for (int nt = 0; nt < 3; ++nt)
#pragma unroll
                for (int rg = 0; rg < 4; ++rg) Lg[(16 * rb + 4 * q + rg) * 48 + 16 * nt + i] = acc[rb][nt][rg] * rs[rg]; }
        LDS_WAIT(); asm volatile("" ::: "memory");
        if (F.lane < 32) {
            const int m = m0 + F.lane; const LAS float* lg = Lg + F.lane * 48;
            float gl[4]; float gmax = -3.0e38f; int grp = 0;
#pragma unroll
            for (int j = 0; j < 4; ++j) { gl[j] = lg[j] + a.in[I_MBG][layer * 4 + j]; if (gl[j] > gmax) { gmax = gl[j]; grp = j; } }
            float gs = 0.f;
#pragma unroll
            for (int j = 0; j < 4; ++j) gs += __expf(gl[j] - gmax);
            const float grp_w = 1.f / gs;
            float v1 = -3.0e38f, v2 = -3.0e38f; int i1 = 0, i2 = 0;
            for (int j = 0; j < 8; ++j) { const float e = lg[4 + grp * 8 + j] + a.in[I_MBE][layer * 32 + grp * 8 + j];
                if (e > v1) { v2 = v1; i2 = i1; v1 = e; i1 = j; } else if (e > v2) { v2 = e; i2 = j; } }
            const float r2 = __expf(v2 - v1); const float w1 = grp_w / (1.f + r2), w2 = grp_w * r2 / (1.f + r2);
            const int e1 = grp * 8 + i1, e2 = grp * 8 + i2;
            const unsigned s1 = __hip_atomic_fetch_add(cnt + e1 * 64, 1u, __ATOMIC_RELAXED, __HIP_MEMORY_SCOPE_AGENT);
            const unsigned s2 = __hip_atomic_fetch_add(cnt + e2 * 64, 1u, __ATOMIC_RELAXED, __HIP_MEMORY_SCOPE_AGENT);
            int* r = asg + (size_t)m * 8; r[0] = e1; r[1] = e2; r[2] = (int)s1; r[3] = (int)s2; r[4] = __builtin_bit_cast(int, w1); r[5] = __builtin_bit_cast(int, w2);
        }
        LDS_WAIT(); asm volatile("" ::: "memory");
    }
}

__device__ __forceinline__ void phase_m2(const Fr& F, const Args& a, int layer) {
    unsigned char* ws = a.ws;
    int* asg = (int*)(ws + WS_ASG); float* roww = (float*)(ws + WS_ROWW);
    int* texp = (int*)(ws + WS_TEXP);
    unsigned* cnt = (unsigned*)(ws + WS_CTL) + CW_CNT + layer * 32 * 64;
    LAS int* sb = (LAS int*)F.lds;
    if (F.tid < 32) sb[64 + F.tid] = (int)__hip_atomic_load(cnt + F.tid * 64, __ATOMIC_RELAXED, __HIP_MEMORY_SCOPE_AGENT);
    __syncthreads();
    if (F.tid == 0) { int acc = 0; for (int e = 0; e < 32; ++e) { sb[e] = acc; acc += (sb[64 + e] + 255) & ~255; } sb[32] = acc; }
    __syncthreads();
    if (blockIdx.x == 0) {
        const int ntiles = sb[32] >> 8;
        for (int t = F.tid; t < ntiles; t += 512) { int e = 0; for (int j = 1; j < 32; ++j) if ((t << 8) >= sb[j]) e = j; texp[t] = e; }
        if (F.tid == 0) texp[1023] = ntiles;
        if (F.tid < 8) { int n = 0; for (int q = 0; q < 4; ++q) { const int e = F.tid + 8 * q; for (int t = sb[e] >> 8; t < (sb[e + 1] >> 8); ++t) texp[2048 + F.tid * 640 + n++] = t | (e << 16); } texp[1008 + F.tid] = n; }
    }
    int* ridx = (int*)(ws + WS_RIDX); float* rowrs = (float*)(ws + WS_ROWRS); const float* RS = (const float*)(ws + WS_RSTD);
    for (int as = blockIdx.x * 512 + F.tid; as < NT * 2; as += F.G * 512) {
        const int m = as >> 1, k = as & 1; const int e = asg[m * 8 + k], slot = asg[m * 8 + 2 + k]; const int p = sb[e] + slot;
        ridx[p] = m; rowrs[p] = RS[m]; roww[p] = __builtin_bit_cast(float, asg[m * 8 + 4 + k]); asg[m * 8 + 6 + k] = p; }
    for (int idx = blockIdx.x * 512 + F.tid; idx < 32 * 256; idx += F.G * 512) {
        const int e = idx >> 8, r = idx & 255; const int p = sb[e] + sb[64 + e] + r;
        if (p < sb[e + 1]) { ridx[p] = 0; rowrs[p] = 0.f; roww[p] = 0.f; } }
}

__device__ __forceinline__ void phase_n1(const Fr& F, const Args& a) {
    unsigned char* ws = a.ws; bf16_t* H = (bf16_t*)(ws + WS_H); const bf16_t* Y = (const bf16_t*)(ws + WS_S1); const int* asg = (const int*)(ws + WS_ASG); float* RS = (float*)(ws + WS_RSTD);
    for (int m = F.gw; m < NT; m += RB * F.ngw) {
        ROWS_ISSUE(H)
#pragma unroll
        for (int r = 0; r < RB; ++r) { const int mr = m + r * F.ngw; if (mr < NT) {
            float v[16]; bf16_t* hrow = H + (size_t)mr * 1024; const float rstd = row_finish(R[r], v, rw0[r], rw1[r]);
#pragma unroll
            for (int j = 0; j < 2; ++j) *(u32x4*)(hrow + 512 * j + 8 * F.lane) = (u32x4){pk2(v[8 * j], v[8 * j + 1]), pk2(v[8 * j + 2], v[8 * j + 3]), pk2(v[8 * j + 4], v[8 * j + 5]), pk2(v[8 * j + 6], v[8 * j + 7])};
            if (F.lane == 0) RS[mr] = rstd; } }
    }
}
__device__ __forceinline__ void phase_final(const Fr& F, const Args& a) {
    unsigned char* ws = a.ws; const bf16_t* H = (const bf16_t*)(ws + WS_H); const bf16_t* Y = (const bf16_t*)(ws + WS_S1); const int* asg = (const int*)(ws + WS_ASG); const float* gain = a.in[I_FLN];
    for (int m = F.gw; m < NT; m += RB * F.ngw) {
        ROWS_ISSUE(H)
#pragma unroll
        for (int r = 0; r < RB; ++r) { const int mr = m + r * F.ngw; if (mr < NT) {
            float v[16]; const float rstd = row_finish(R[r], v, rw0[r], rw1[r]); float* orow = a.out + (size_t)mr * 1024;
#pragma unroll
            for (int j = 0; j < 2; ++j) { const int c = 512 * j + 8 * F.lane; const f32x4 g0 = *(const f32x4*)(gain + c), g1 = *(const f32x4*)(gain + c + 4);
                *(f32x4*)(orow + c) = (f32x4){v[8 * j] * rstd * g0.x, v[8 * j + 1] * rstd * g0.y, v[8 * j + 2] * rstd * g0.z, v[8 * j + 3] * rstd * g0.w};
                *(f32x4*)(orow + c + 4) = (f32x4){v[8 * j + 4] * rstd * g1.x, v[8 * j + 5] * rstd * g1.y, v[8 * j + 6] * rstd * g1.z, v[8 * j + 7] * rstd * g1.w}; } } }
    }
}

__device__ __forceinline__ void phase_cmp_gather(const Fr& F, const Args& a) {
    unsigned char* ws = a.ws; const bf16_t* KV = (const bf16_t*)(ws + WS_KV); bf16_t* AC = (bf16_t*)(ws + WS_ACMP);
    for (int r = F.gw; r < 2 * 16384; r += F.ngw) {
        const int grp = r >> 14, rr = r & 16383, bg = rr >> 7, n = rr & 127, b = bg >> 2, g = bg & 3;
        const float* pe = a.in[grp ? I_PEV : I_PEK] + (size_t)g * 32 * 64;
        bf16_t* dst = AC + (size_t)r * 2048;
        for (int l2 = 0; l2 < 16; ++l2) { const int l = 2 * l2 + (F.lane >> 5), d = 2 * (F.lane & 31);
            unsigned o = 0u;
            if (n < 127) { const unsigned kv = *(const unsigned*)(KV + (size_t)(b * SEQ + 16 * n + l) * 1536 + (grp * 4 + g) * 64 + d);
                o = pk2(bflo(kv) + pe[l * 64 + d], bfhi(kv) + pe[l * 64 + d + 1]); }
            *(unsigned*)(dst + l * 64 + d) = o; }
    }
}
__device__ __forceinline__ int perm16pos(int w) { return w < 4 ? w : (w < 8 ? w + 4 : (w < 12 ? w - 4 : w)); }
__device__ __forceinline__ void phase_cmp2(const Fr& F, const Args& a, int task0, int tstep, int tend) {
    unsigned char* ws = a.ws; const bf16_t* HC = (const bf16_t*)(ws + WS_HC); bf16_t* KCB = (bf16_t*)(ws + WS_KCB); bf16_t* VCT = (bf16_t*)(ws + WS_VCT); const bf16_t* WF = (const bf16_t*)(ws + WS_W2F);
    const int i = F.lane & 15, q = F.lane >> 4;
    for (int task = task0; task < tend; task += tstep) {
        const int r0 = task * 16, grp = r0 >> 14, rr = r0 & 16383, bg = rr >> 7, n0 = rr & 127;
        f32x4 acc[4];
#pragma unroll
        for (int nb = 0; nb < 4; ++nb) acc[nb] = (f32x4){0.f, 0.f, 0.f, 0.f};
        const bf16_t* hr = HC + (size_t)(r0 + i) * 256 + 8 * q; const bf16_t* wp = WF + (size_t)grp * 8 * 8 * 512 + F.lane * 8;
#pragma unroll
        for (int sk = 0; sk < 8; ++sk) { const bf16x8 av = *(const bf16x8*)(hr + 32 * sk);
#pragma unroll
            for (int tn = 0; tn < 8; ++tn) acc[tn & 3] = __builtin_amdgcn_mfma_f32_16x16x32_bf16(av, *(const bf16x8*)(wp + (sk * 8 + tn) * 512), acc[tn & 3], 0, 0, 0); }
#pragma unroll
        for (int nb = 0; nb < 4; ++nb) { const int col = 16 * nb + i; f32x4 v = acc[nb];
#pragma unroll
            for (int rg = 0; rg < 4; ++rg) if (n0 + 4 * q + rg == 127) v[rg] = 0.f;
            if (grp == 0) {
#pragma unroll
                for (int rg = 0; rg < 4; ++rg) KCB[((size_t)bg * 128 + n0 + 4 * q + rg) * 64 + col] = (bf16_t)f2bf(v[rg]); }
            else *(u32x2*)(VCT + ((size_t)bg * 64 + col) * 128 + n0 + perm16pos(4 * q)) = (u32x2){cvtpk(v[0], v[1]), cvtpk(v[2], v[3])}; }
    }
}
__device__ __forceinline__ void phase_vt(const Fr& F, const Args& a, int gw, int ngw) {
    unsigned char* ws = a.ws; const bf16_t* KV = (const bf16_t*)(ws + WS_KV); bf16_t* VT = (bf16_t*)a.out;
    LAS unsigned* T2 = (LAS unsigned*)(F.lds) + F.wave * 2080;
    for (int task = gw; task < 8192; task += ngw) {
        const int tile = task & 31, g = (task >> 5) & 3, pg = (task >> 7) & 1, b = task >> 8;
        const u32x4* src = (const u32x4*)(KV + (size_t)(b * SEQ + 64 * tile + F.lane) * 1536 + ((pg ? 5 : 3) * 4 + g) * 64);
#pragma unroll
        for (int i = 0; i < 8; ++i) { const u32x4 v = src[i]; T2[(4 * i + 0) * 65 + F.lane] = v.x; T2[(4 * i + 1) * 65 + F.lane] = v.y; T2[(4 * i + 2) * 65 + F.lane] = v.z; T2[(4 * i + 3) * 65 + F.lane] = v.w; }
        LDS_WAIT(); asm volatile("" ::: "memory");
        const int d = F.lane, dp = d >> 1; const bool hi = d & 1;
        u32x4* dst = (u32x4*)(VT + ((size_t)((b * 2 + pg) * 4 + g) * 64 + d) * 2048 + 64 * tile);
#pragma unroll
        for (int G = 0; G < 4; ++G) {
            unsigned e[16];
#pragma unroll
            for (int p = 0; p < 16; ++p) { const int key = 16 * G + ((p < 4) ? p : (p < 8) ? p + 4 : (p < 12) ? p - 4 : p); const unsigned u = T2[dp * 65 + key]; e[p] = hi ? (u >> 16) : (u & 0xffffu); }
            dst[2 * G] = (u32x4){e[0] | (e[1] << 16), e[2] | (e[3] << 16), e[4] | (e[5] << 16), e[6] | (e[7] << 16)};
            dst[2 * G + 1] = (u32x4){e[8] | (e[9] << 16), e[10] | (e[11] << 16), e[12] | (e[13] << 16), e[14] | (e[15] << 16)};
        }
        LDS_WAIT(); asm volatile("" ::: "memory");
    }
}
__device__ __forceinline__ void dma16(const void* g, LAS void* l) { __builtin_amdgcn_global_load_lds((const unsigned*)g, (LAS unsigned*)l, 16, 0, 0); }
#define ATT_NEG (-__builtin_inff())
__device__ __forceinline__ unsigned xor32u(unsigned x) { const auto r = __builtin_amdgcn_permlane32_swap(x, x, false, false); return (threadIdx.x & 32) ? r[0] : r[1]; }
__device__ __forceinline__ float xor32(float x) { return __uint_as_float(xor32u(__float_as_uint(x))); }
template <int KM>
__device__ __forceinline__ void att_fix(f32x16 (&S)[2], int dbase, unsigned maxd, bool colsel, const LAS float* dBl) {
#pragma unroll
    for (int blk = 0; blk < 2; ++blk) {
        float bv[16];
#pragma unroll
        for (int rr = 0; rr < 16; ++rr) { const int koff = 32 * blk + (rr & 3) + 8 * (rr >> 2); const unsigned di = min((unsigned)(dbase - KM * koff), 128u); bv[rr] = dBl[di]; }
#pragma unroll
        for (int rr = 0; rr < 16; ++rr) asm volatile("" : "+v"(bv[rr]));
#pragma unroll
        for (int rr = 0; rr < 16; ++rr) { const int koff = 32 * blk + (rr & 3) + 8 * (rr >> 2); const int dist = dbase - KM * koff;
            const bool ok = ((unsigned)dist < maxd) && colsel; S[blk][rr] = ok ? S[blk][rr] + bv[rr] : ATT_NEG; } }
}
template <int KM>
__device__ __forceinline__ void att_fixcb(f32x16& S, int dbase, const LAS float* dBl) {
    float bv[16];
#pragma unroll
    for (int rr = 0; rr < 16; ++rr) { const int koff = (rr & 3) + 8 * (rr >> 2); const unsigned di = min((unsigned)(dbase - KM * koff), 128u); bv[rr] = dBl[di]; }
#pragma unroll
    for (int rr = 0; rr < 16; ++rr) asm volatile("" : "+v"(bv[rr]));
#pragma unroll
    for (int rr = 0; rr < 16; ++rr) { const int koff = (rr & 3) + 8 * (rr >> 2); const int dist = dbase - KM * koff; S[rr] = (dist >= 0) ? S[rr] + bv[rr] : ATT_NEG; }
}
__device__ __forceinline__ void att_fix1(f32x16 (&S)[2], int dbase, unsigned maxd, const LAS float* bp) {
#pragma unroll
    for (int blk = 0; blk < 2; ++blk) {
        f32x4 bv[4];
#pragma unroll
        for (int q = 0; q < 4; ++q) bv[q] = *(const LAS f32x4*)(bp + 56 - 32 * blk - 8 * q);
#pragma unroll
        for (int q = 0; q < 4; ++q) asm volatile("" : "+v"(bv[q]));
#pragma unroll
        for (int rr = 0; rr < 16; ++rr) { const int koff = 32 * blk + (rr & 3) + 8 * (rr >> 2); const int dist = dbase - koff;
            S[blk][rr] = ((unsigned)dist < maxd) ? S[blk][rr] + bv[rr >> 2][3 - (rr & 3)] : ATT_NEG; } }
}
__device__ __forceinline__ void att_scores(LAS unsigned char* ktile, const int (&aoff)[4], const bf16x8 (&qf)[4], f32x16 (&S)[2]) {
#pragma unroll
    for (int blk = 0; blk < 2; ++blk)
#pragma unroll
        for (int i = 0; i < 16; ++i) S[blk][i] = 0.f;
    bf16x8 kf[2][4];
#pragma unroll
    for (int s = 0; s < 4; ++s)
#pragma unroll
        for (int blk = 0; blk < 2; ++blk) kf[blk][s] = *(const LAS bf16x8*)(ktile + blk * 4096 + aoff[s]);
#pragma unroll
    for (int s = 0; s < 4; ++s) {
        S[0] = __builtin_amdgcn_mfma_f32_32x32x16_bf16(kf[0][s], qf[s], S[0], 0, 0, 0); S[1] = __builtin_amdgcn_mfma_f32_32x32x16_bf16(kf[1][s], qf[s], S[1], 0, 0, 0);
        __builtin_amdgcn_sched_barrier(0); }
}
__device__ __forceinline__ void att_scores_init(LAS unsigned char* ktile, const int (&aoff)[4], const bf16x8 (&qf)[4], f32x16 (&S)[2], const LAS float* ip) {
#pragma unroll
    for (int blk = 0; blk < 2; ++blk)
#pragma unroll
        for (int q = 0; q < 4; ++q) { const f32x4 v = *(const LAS f32x4*)(ip + 32 * blk + 8 * q); S[blk][4 * q] = v.x; S[blk][4 * q + 1] = v.y; S[blk][4 * q + 2] = v.z; S[blk][4 * q + 3] = v.w; }
    bf16x8 kf[2][4];
#pragma unroll
    for (int s = 0; s < 4; ++s)
#pragma unroll
        for (int blk = 0; blk < 2; ++blk) kf[blk][s] = *(const LAS bf16x8*)(ktile + blk * 4096 + aoff[s]);
#pragma unroll
    for (int s = 0; s < 4; ++s) {
        S[0] = __builtin_amdgcn_mfma_f32_32x32x16_bf16(kf[0][s], qf[s], S[0], 0, 0, 0); S[1] = __builtin_amdgcn_mfma_f32_32x32x16_bf16(kf[1][s], qf[s], S[1], 0, 0, 0);
        __builtin_amdgcn_sched_barrier(0); }
}
__device__ __forceinline__ void att_pv(LAS unsigned char* vtile, const int (&aoff)[4], const f32x16 (&P)[2], f32x16 (&O)[2]) {
    bf16x8 pb[2][2];
#pragma unroll
    for (int blk = 0; blk < 2; ++blk)
#pragma unroll
        for (int s2 = 0; s2 < 2; ++s2) pb[blk][s2] = pack8f(P[blk][8 * s2], P[blk][8 * s2 + 1], P[blk][8 * s2 + 2], P[blk][8 * s2 + 3], P[blk][8 * s2 + 4], P[blk][8 * s2 + 5], P[blk][8 * s2 + 6], P[blk][8 * s2 + 7]);
#pragma unroll
    for (int dt = 0; dt < 2; ++dt)
#pragma unroll
        for (int blk = 0; blk < 2; ++blk)
#pragma unroll
            for (int s2 = 0; s2 < 2; ++s2) { const bf16x8 A = *(const LAS bf16x8*)(vtile + dt * 4096 + aoff[2 * blk + s2]); O[dt] = __builtin_amdgcn_mfma_f32_32x32x16_bf16(A, pb[blk][s2], O[dt], 0, 0, 0); }
}
#define ATT_LHI 1.8446744e19f
#define ATT_TBL_NEG (4 * 2832)
#define ATT_TBL_ZERO (4 * 2832 + 64)
__device__ __forceinline__ float att_colmax(const f32x16 (&S)[2]) {
    float mx = S[0][0];
#pragma unroll
    for (int blk = 0; blk < 2; ++blk)
#pragma unroll
        for (int rr = 0; rr < 16; ++rr) mx = fmaxf(mx, S[blk][rr]);
    return fmaxf(mx, xor32(mx));
}
__device__ __forceinline__ void att_tile(LAS unsigned char* tile, const int (&aoff)[4], const bf16x8 (&qf)[4], f32x16 (&O)[2], float& m, float& l, bool& pending, bool& shifted,
                                         int fixmode, int dbase, bool colsel, const LAS float* dBl, const LAS float* tblbase) {
    f32x16 S[2];
    const LAS float* ip = colsel ? (fixmode == 2 ? dBl - dbase : tblbase + ATT_TBL_ZERO) : tblbase + ATT_TBL_NEG;
    if (fixmode == 0) att_scores(tile, aoff, qf, S); else att_scores_init(tile, aoff, qf, S, ip);
    if (shifted) { S[0] = S[0] - m; S[1] = S[1] - m; }
    if (pending) {
        const float mxc = att_colmax(S); const float dl = (mxc > -1e29f && fabsf(mxc) > 32.f) ? mxc : 0.f;
        if (__any(dl != 0.f)) { m += dl; S[0] = S[0] - dl; S[1] = S[1] - dl; shifted = true; }
        pending = false;
    }
    float ln = l;
#pragma unroll
    for (int blk = 0; blk < 2; ++blk)
#pragma unroll
        for (int rr = 0; rr < 16; ++rr) { const float p = __builtin_amdgcn_exp2f(S[blk][rr]); S[blk][rr] = p; ln += p; }
    if (__any(ln > ATT_LHI)) {
        if (fixmode == 0) att_scores(tile, aoff, qf, S); else att_scores_init(tile, aoff, qf, S, ip);
        if (shifted) { S[0] = S[0] - m; S[1] = S[1] - m; }
        const float mxc = att_colmax(S), lnc = fmaxf(ln, xor32(ln));
        const float dl = (lnc > ATT_LHI) ? fmaxf(mxc, 32.f) : 0.f, corr = __builtin_amdgcn_exp2f(-dl);
        m += dl; l *= corr; O[0] = O[0] * corr; O[1] = O[1] * corr; S[0] = S[0] - dl; S[1] = S[1] - dl; shifted = true;
        ln = l;
#pragma unroll
        for (int blk = 0; blk < 2; ++blk)
#pragma unroll
            for (int rr = 0; rr < 16; ++rr) { const float p = __builtin_amdgcn_exp2f(S[blk][rr]); S[blk][rr] = p; ln += p; }
    }
    l = ln;
    att_pv(tile + 8192, aoff, S, O);
}
__device__ __forceinline__ void phase_attn(const Fr& F, const Args& a) {
    unsigned char* ws = a.ws;
    const bf16_t* QB = (const bf16_t*)(ws + WS_Q); const unsigned char* KV = ws + WS_KV; const unsigned char* VT = (const unsigned char*)a.out; const float* GT = (const float*)(ws + WS_GATES);
    const unsigned char* KCB = ws + WS_KCB; const unsigned char* VCT = ws + WS_VCT; bf16_t* OB = (bf16_t*)(ws + WS_OATT);
    LAS unsigned char* RING = F.lds; LAS unsigned char* CMPA = F.lds + 65536; LAS float* dB = (LAS float*)(F.lds + 98304);
    const int w = F.wave, lane = F.lane, r = lane & 31, h = lane >> 5, hh = lane & 3, tl = r >> 2, swz = (r >> 1) & 7;
    int aoff[4];
#pragma unroll
    for (int s = 0; s < 4; ++s) aoff[s] = r * 128 + (((2 * s + h) ^ swz) * 16);
    const int drow = 8 * w + (lane >> 3), dchunk = ((lane & 7) ^ ((drow >> 1) & 7)) * 16;
    const LAS float* dBl = dB + hh * 132;
    LAS float* DB4 = (LAS float*)(F.lds + 102400);
    const LAS float* dB4l = DB4 + hh * 2832 + (tl & 3) * 708 + (tl & 3) + 576;
    int gprev = -1;
    const bool xcdord = F.G == 256;
    if (w >= 4) __builtin_amdgcn_s_setprio(1);
    for (int unit = blockIdx.x, uk = 0; xcdord ? uk < 16 : unit < 4096; unit += F.G, ++uk) {
        const int bg = xcdord ? (int)(blockIdx.x & 7) + 8 * uk : unit & 127, qt = xcdord ? ((uk & 1) ? 31 - (int)(blockIdx.x >> 3) : (int)(blockIdx.x >> 3)) : (unit >> 7) ^ ((unit >> 8) & 1);
        const int b = bg >> 2, g = bg & 3, t0 = 64 * qt;
        __syncthreads();
        if (g != gprev) for (int i = F.tid; i < 4 * 129; i += 512) { const int hq = i / 129, d = i % 129;
            dB[hq * 132 + d] = (d < 128) ? (a.in[I_RELB][BKT[d] * 16 + 4 * g + hq] - a.in[I_RELB][31 * 16 + 4 * g + hq]) * 1.44269504089f : 0.f; }
        if (g != gprev) for (int i = F.tid; i < 4 * 2832 + 128; i += 512) { const int hq = i / 2832, rem = i % 2832, cc = rem / 708, d = 576 - (rem % 708 - cc);
            float v;
            if (i >= 4 * 2832) v = (i < 4 * 2832 + 64) ? ATT_NEG : 0.f;
            else v = (d < 0 || d >= 512) ? ATT_NEG : (d < 128 ? (a.in[I_RELB][BKT[d] * 16 + 4 * g + hq] - a.in[I_RELB][31 * 16 + 4 * g + hq]) * 1.44269504089f : 0.f);
            DB4[i] = v; }
        gprev = g;
        const unsigned char* kwin = KV + ((size_t)(b * SEQ) * 1536 + (16 + g) * 64) * 2; const unsigned char* ksel = KV + ((size_t)(b * SEQ) * 1536 + (8 + g) * 64) * 2;
        const unsigned char* vsel = VT + ((size_t)((b * 2 + 0) * 4 + g) * 64) * 4096; const unsigned char* vwin = VT + ((size_t)((b * 2 + 1) * 4 + g) * 64) * 4096;
        const int nwin = min(qt, 8) + 1, ktlo = qt - nwin + 1, nst = nwin + qt + 1, ncmp = (qt >= 16) ? 2 : 1;
#define ATT_STAGE(i_, buf_) do { const int _i = (i_); const bool _isw = _i < nwin; const int _kt = _isw ? qt - _i : _i - nwin; \
            const unsigned char* _kp = (_isw ? kwin : ksel) + ((size_t)(64 * _kt + drow) * 1536) * 2 + dchunk; \
            const unsigned char* _vp = (_isw ? vwin : vsel) + (size_t)drow * 4096 + (size_t)_kt * 128 + dchunk; \
            dma16(_kp, (buf_) + w * 1024); dma16(_vp, (buf_) + 8192 + w * 1024); } while (0)
        for (int i = 0; i < ncmp; ++i) { dma16(KCB + ((size_t)(bg * 128 + 64 * i + drow) * 64) * 2 + dchunk, CMPA + i * 8192 + w * 1024);
            dma16(VCT + ((size_t)(bg * 64 + drow) * 128) * 2 + i * 128 + dchunk, CMPA + 16384 + i * 8192 + w * 1024); }
        const int tcol = t0 + 8 * w + tl; const size_t mtok = (size_t)b * SEQ + tcol; const int head = 4 * g + hh;
        bf16x8 qf[4];
#pragma unroll
        for (int s = 0; s < 4; ++s) qf[s] = *(const bf16x8*)(QB + mtok * 1024 + head * 64 + 16 * s + 8 * h);
        const float g0 = GT[mtok * 48 + head * 3 + 0], g1 = GT[mtok * 48 + head * 3 + 1], g2 = GT[mtok * 48 + head * 3 + 2];
        asm volatile("s_waitcnt vmcnt(0)" ::: "memory"); __syncthreads();
        ATT_STAGE(0, RING); ATT_STAGE(1, RING + 16384); if (nst > 2) ATT_STAGE(2, RING + 32768);
        f32x16 OUT[2], O[2];
        unsigned selmask;
        {
            f32x16 C[4];
            att_scores(CMPA, aoff, qf, *(f32x16 (*)[2])&C[0]);
            if (ncmp == 2) att_scores(CMPA + 8192, aoff, qf, *(f32x16 (*)[2])&C[2]);
            else {
#pragma unroll
                for (int i = 0; i < 16; ++i) { C[2][i] = ATT_NEG; C[3][i] = ATT_NEG; } }
#pragma unroll
            for (int cb = 0; cb < 4; ++cb) { const int tw = t0 + 8 * w, lo = tw - 31 - 16 * (32 * cb + 31), hi = tw + 7 - 31 - 512 * cb;
                if (cb < 2 * ncmp && lo < 128) {
                    if (hi < 0) {
#pragma unroll
                        for (int i = 0; i < 16; ++i) C[cb][i] = ATT_NEG; }
                    else att_fixcb<16>(C[cb], tcol - 31 - 64 * h - 512 * cb, dBl); } }
            float mx = C[0][0];
#pragma unroll
            for (int cb = 0; cb < 4; ++cb)
#pragma unroll
                for (int rr = 0; rr < 16; ++rr) mx = fmaxf(mx, C[cb][rr]);
            mx = fmaxf(mx, xor32(mx)); mx = fmaxf(mx, -1e30f);
            float ls = 0.f;
#pragma unroll
            for (int cb = 0; cb < 4; ++cb)
#pragma unroll
                for (int rr = 0; rr < 16; ++rr) { const float p = __builtin_amdgcn_exp2f(C[cb][rr] - mx); C[cb][rr] = p; ls += p; }
            ls += xor32(ls);
            const float inv = ls > 0.f ? 1.f / ls : 0.f;
#pragma unroll
            for (int cb = 0; cb < 4; ++cb) C[cb] = C[cb] * inv;
#pragma unroll
            for (int i = 0; i < 16; ++i) { OUT[0][i] = 0.f; OUT[1][i] = 0.f; }
            att_pv(CMPA + 16384, aoff, *(const f32x16 (*)[2])&C[0], OUT);
            if (ncmp == 2) att_pv(CMPA + 16384 + 8192, aoff, *(const f32x16 (*)[2])&C[2], OUT);
            OUT[0] = OUT[0] * g0; OUT[1] = OUT[1] * g0;
            if (qt <= 7) selmask = (2u << qt) - 1u;
            else {
                float imp[16], lastv[16];
#pragma unroll
                for (int cb = 0; cb < 4; ++cb)
#pragma unroll
                    for (int rq = 0; rq < 4; ++rq) { imp[4 * cb + rq] = (C[cb][4 * rq] + C[cb][4 * rq + 1]) + (C[cb][4 * rq + 2] + C[cb][4 * rq + 3]); lastv[4 * cb + rq] = C[cb][4 * rq + 3]; }
                unsigned key[16];
#pragma unroll
                for (int q = 0; q < 16; ++q) lastv[q] = xor32(lastv[q]);
#pragma unroll
                for (int q = 0; q < 16; ++q) { const float prev = (q >= 1) ? lastv[q - 1] : 0.f; float v = imp[q] + (h ? lastv[q] : prev);
                    v += dppf<DPP_XOR1>(v); v += dppf<DPP_XOR2>(v);
                    const int j = 2 * q + h; const bool cand = (j >= 1) && (j <= qt - 2);
                    key[q] = cand ? ((__builtin_bit_cast(unsigned, v) & ~31u) | (unsigned)(31 - j)) : 0u; }
                selmask = 1u | (1u << qt) | (1u << (qt - 1));
#pragma unroll 1
                for (int rnd = 0; rnd < 5; ++rnd) {
                    unsigned best = 0u;
#pragma unroll
                    for (int q = 0; q < 16; ++q) best = max(best, key[q]);
                    best = max(best, xor32u(best));
                    if (best != 0u) selmask |= 1u << (31 - (best & 31u));
#pragma unroll
                    for (int q = 0; q < 16; ++q) key[q] = (key[q] == best) ? 0u : key[q];
                }
            }
        }
        unsigned wor = selmask; wor |= (unsigned)__shfl_xor((int)wor, 4); wor |= (unsigned)__shfl_xor((int)wor, 8); wor |= (unsigned)__shfl_xor((int)wor, 16);
        wor = (unsigned)__builtin_amdgcn_readfirstlane((int)wor);
        unsigned wand = selmask; wand &= (unsigned)__shfl_xor((int)wand, 4); wand &= (unsigned)__shfl_xor((int)wand, 8); wand &= (unsigned)__shfl_xor((int)wand, 16);
        wand = (unsigned)__builtin_amdgcn_readfirstlane((int)wand);
        float m = 0.f, l = 0.f; bool pending = true, shifted = false;
        unsigned wall = 0xffffffffu; asm volatile("" : "+s"(wall));
#pragma unroll
        for (int i = 0; i < 16; ++i) { O[0][i] = 0.f; O[1][i] = 0.f; }
#define ATT_FINALIZE(gate_) do { const float _lt = l + xor32(l); const float _sc = _lt > 0.f ? (gate_) / _lt : 0.f; \
            OUT[0] = OUT[0] + O[0] * _sc; OUT[1] = OUT[1] + O[1] * _sc; m = 0.f; l = 0.f; pending = true; shifted = false; \
            _Pragma("unroll") for (int _i = 0; _i < 16; ++_i) { O[0][_i] = 0.f; O[1][_i] = 0.f; } } while (0)
#define ATT_TILE_SYNC(i_) do { const int _ahead = nst - 1 - (i_); \
            if (_ahead >= 2) asm volatile("s_waitcnt vmcnt(4) lgkmcnt(0)" ::: "memory"); else if (_ahead == 1) asm volatile("s_waitcnt vmcnt(2) lgkmcnt(0)" ::: "memory"); else asm volatile("s_waitcnt vmcnt(0) lgkmcnt(0)" ::: "memory"); \
            __builtin_amdgcn_s_barrier(); asm volatile("" ::: "memory"); \
            if ((i_) + 3 < nst) ATT_STAGE((i_) + 3, RING + (((i_) + 3) & 3) * 16384); } while (0)
#pragma unroll 1
        for (int i = 0; i < nwin; ++i) {
            ATT_TILE_SYNC(i);
            const int kt = qt - i; const int fm = (kt >= qt - 2 || kt == qt - 8) ? 2 : 0;
            if ((wall >> i) & 1u)
            att_tile(RING + (i & 3) * 16384, aoff, qf, O, m, l, pending, shifted, fm, tcol - 64 * kt - 4 * h, true, dB4l, DB4);
        }
        ATT_FINALIZE(g2);
#pragma unroll 1
        for (int i = nwin; i < nst; ++i) {
            ATT_TILE_SYNC(i);
            const int j = i - nwin;
            if ((wor >> j) & 1u) { const bool cs = (selmask >> j) & 1u; const int fm = (j >= qt - 2) ? 2 : (((wand >> j) & 1u) ? 0 : 1);
                att_tile(RING + (i & 3) * 16384, aoff, qf, O, m, l, pending, shifted, fm, tcol - 64 * j - 4 * h, cs, dB4l, DB4); }
        }
#undef ATT_TILE_SYNC
        ATT_FINALIZE(g1);
        bf16_t* orow = OB + mtok * 1024 + head * 64 + 4 * h;
#pragma unroll
        for (int dt = 0; dt < 2; ++dt)
#pragma unroll
            for (int rq = 0; rq < 4; ++rq) { u32x2 v; v.x = cvtpk(OUT[dt][4 * rq], OUT[dt][4 * rq + 1]); v.y = cvtpk(OUT[dt][4 * rq + 2], OUT[dt][4 * rq + 3]); *(u32x2*)(orow + 32 * dt + 8 * rq) = v; }
#undef ATT_STAGE
#undef ATT_FINALIZE
    }
    __builtin_amdgcn_s_setprio(0);
}
constexpr int LDS_BYTES = 155648;
constexpr int LDS_MISC = LDS_BYTES - 256;
constexpr int NPH = 21;

__global__ void __launch_bounds__(512, 2) fwd(Args a) {
    extern __shared__ __attribute__((aligned(16))) unsigned char lds_raw[];
    Fr F; F.lds = (LAS unsigned char*)lds_raw; F.tid = threadIdx.x; F.lane = F.tid & 63; F.wave = __builtin_amdgcn_readfirstlane(F.tid >> 6); F.G = gridDim.x;
    F.gw = blockIdx.x * 8 + F.wave; F.ngw = F.G * 8;
    unsigned char* ws = a.ws;
    volatile LAS unsigned* MISC = (volatile LAS unsigned*)(F.lds + LDS_MISC);
    if (F.tid < 64) MISC[F.tid] = 0u;
    __syncthreads();
    const int lo = a.ph_lo, hi = a.ph_hi;
    XcdBarrier bar; bar.bar = (unsigned*)(ws + WS_CTL) + CW_BAR; bar.x = 0; bar.st = nullptr;
    if (hi - lo > 1) bar = xcd_barrier_post((unsigned*)(ws + WS_CTL) + CW_BAR, MISC + 8);


#ifndef REPEAT_MASK
#define REPEAT_MASK 0u
#endif
#ifdef ONLY_PH
#define IN(k) ((k) == ONLY_PH && lo <= (k) && (k) < hi)
#else
#define IN(k) (lo <= (k) && (k) < hi)
#endif
#define REP(k) for (int _rep = 0; _rep < (((REPEAT_MASK >> (k)) & 1u) ? 2 : 1); ++_rep)
#define SEAM(k) do { if (IN(k) && IN((k) + 1)) xcd_barrier(bar); } while (0)
    using namespace pg8;
    const int c = (int)blockIdx.x;

    if (IN(0)) { phase_conv(F, a); if ((REPEAT_MASK >> 30) & 1u) { __syncthreads(); phase_conv(F, a); } phase_r1(F, a); if ((REPEAT_MASK >> 31) & 1u) { __syncthreads(); phase_r1(F, a); } }
    SEAM(0);
    if (IN(1)) REP(1) {
        { Gemm g{(const bf16_t*)(ws + WS_S0), (const bf16_t*)(ws + WS_WR), 1024, 1024, 0, 1 << 20, nullptr, 0}; StaticOrder S; S.init(NT, 1024, F.G, c); EpiBf16 E{(bf16_t*)(ws + WS_S3), 1024, 1.f, 1}; gemm_phase(F.lds, g, S, E);
#ifdef DUP_P1
        gemm_phase(F.lds, g, S, E);
#endif
        }
        { Gemm g{(const bf16_t*)(ws + WS_S1), (const bf16_t*)(ws + WS_WK), 1024, 1024, 0, 1 << 20, nullptr, 0}; StaticOrder S; S.init(NT, 1024, F.G, c); EpiBf16 E{(bf16_t*)(ws + WS_S4), 1024, 1.f, 1}; gemm_phase(F.lds, g, S, E); }
        { Gemm g{(const bf16_t*)(ws + WS_S2), (const bf16_t*)(ws + WS_WV), 1024, 1024, 0, 1 << 20, nullptr, 0}; StaticOrder S; S.init(NT, 1024, F.G, c); EpiBf16 E{(bf16_t*)a.out, 1024, 1.f, 1}; gemm_phase(F.lds, g, S, E); }
        { Gemm g{(const bf16_t*)(ws + WS_S5), (const bf16_t*)(ws + WS_WL1), 2048, 1024, 1, 16, nullptr, 0}; StaticOrder S; S.init(NT, 512, F.G, c); EpiLora1 E{(bf16_t*)((unsigned char*)a.out + 128 * MiB)}; gemm_phase(F.lds, g, S, E); }
    }
    SEAM(1);
    if (IN(2)) REP(2) {
        const bf16_t* T1 = (const bf16_t*)((unsigned char*)a.out + 128 * MiB);
        { int kwa = 128; asm volatile("" : "+s"(kwa));
          Gemm g{T1, (const bf16_t*)(ws + WS_W2WA), kwa, 512, 0, 1 << 20, nullptr, 0}; StaticOrder S; S.init(NT, 2048, F.G, c); EpiLora2WA E{(bf16_t*)(ws + WS_S0), (bf16_t*)(ws + WS_S1), a.in[I_AW0], a.in[I_AA0]}; gemm_phase(F.lds, g, S, E); }
        { Gemm g{T1 + 128, (const bf16_t*)(ws + WS_W2G), 256, 512, 0, 1 << 20, nullptr, 0}; StaticOrder S; S.init(NT, 1024, F.G, c); EpiBf16 E{(bf16_t*)(ws + WS_S2), 1024, 1.f, 1}; gemm_phase(F.lds, g, S, E); }
    }
    SEAM(2);
    if (IN(3)) REP(3) phase_scan(F, a);
    SEAM(3);
    if (IN(4)) REP(4) { Gemm g{(const bf16_t*)(ws + WS_S5), (const bf16_t*)(ws + WS_WO), 1024, 64, 0, 1 << 20, nullptr, 1}; StaticOrder S; S.init(NT, 1024, F.G, c); EpiResX E{a.in[I_X], (bf16_t*)(ws + WS_H)}; gemm_phase(F.lds, g, S, E);
#ifdef DUP_PH4
        gemm_phase(F.lds, g, S, E);
#endif
    }
    SEAM(4);
#define MOE_PHASES(layer, pb) \
    if (IN(pb)) phase_m1(F, a, layer); \
    SEAM(pb); \
    if (IN((pb) + 1)) phase_m2(F, a, layer); \
    SEAM((pb) + 1); \
    if (IN((pb) + 2)) REP((pb) + 2) { const int* texp = (const int*)(ws + WS_TEXP); Gemm g{(const bf16_t*)(ws + WS_H), (const bf16_t*)(ws + WS_BT1) + (size_t)(layer) * 32 * 1024 * 1024, 1024, 1024, 0, 1 << 20, (const int*)(ws + WS_RIDX), 0}; \
        MoeOrder S; S.init(texp, F.G, c); EpiMoe1 E{(bf16_t*)(ws + WS_S4), (const float*)(ws + WS_ROWRS)}; gemm_phase<EpiMoe1, MoeOrder, true>(F.lds, g, S, E); } \
    SEAM((pb) + 2); \
    if (IN((pb) + 3)) REP((pb) + 3) { const int* texp = (const int*)(ws + WS_TEXP); Gemm g{(const bf16_t*)(ws + WS_S4), (const bf16_t*)(ws + WS_BT2) + (size_t)(layer) * 32 * 1024 * 512, 512, 512, 0, 1 << 20, nullptr, 0}; \
        MoeOrder S; S.init(texp, F.G, c); EpiMoe2 E{(bf16_t*)(ws + WS_S1), (const float*)(ws + WS_ROWW)}; gemm_phase(F.lds, g, S, E); } \
    SEAM((pb) + 3);

    MOE_PHASES(0, 5)
    if (IN(9)) phase_n1(F, a);
    SEAM(9);
    if (IN(10)) REP(10) { Gemm g{(const bf16_t*)(ws + WS_H), (const bf16_t*)(ws + WS_WKVQG), 1024, 1024, 0, 1 << 20, nullptr, 0}; StaticOrder S; S.init(NT, 2816, F.G, c);
        EpiKvqg E{(bf16_t*)(ws + WS_KV), (bf16_t*)(ws + WS_Q), (float*)(ws + WS_GATES), (const float*)(ws + WS_RSTD)}; gemm_phase(F.lds, g, S, E); }
    SEAM(10);
    if (IN(11)) { if (F.G <= 128) phase_vt(F, a, F.gw, F.ngw); }
    if (F.G <= 128) SEAM(11);
    if (IN(12)) { Gemm g{(const bf16_t*)(ws + WS_KV), (const bf16_t*)(ws + WS_WC1), 2048, 64, 0, 1 << 20, (const int*)(ws + WS_CIDX), 2}; CmpOrder S{F.G, c}; EpiCmp E{(bf16_t*)(ws + WS_HC), (const float*)(ws + WS_PEBP)}; gemm_phase<EpiCmp, CmpOrder, true>(F.lds, g, S, E);
        if (F.G > 128 && c >= 128) phase_vt(F, a, (c - 128) * 8 + F.wave, (F.G - 128) * 8);
        if (F.G > 128 && c < 128) { __builtin_amdgcn_fence(__ATOMIC_ACQUIRE, "agent"); phase_cmp2(F, a, c * 16 + F.wave, 8, c * 16 + 16); } }
    if (F.G <= 128) SEAM(12);
    if (IN(13) && F.G <= 128) phase_cmp2(F, a, F.gw, F.ngw, 2048);
    SEAM(13);
    if (IN(14)) REP(14) phase_attn(F, a);
    SEAM(14);
    if (IN(15)) { Gemm g{(const bf16_t*)(ws + WS_OATT), (const bf16_t*)(ws + WS_WOB), 1024, 1024, 0, 1 << 20, nullptr, 0}; StaticOrder S; S.init(NT, 1024, F.G, c); EpiResH E{(bf16_t*)(ws + WS_H)}; gemm_phase(F.lds, g, S, E); }
    SEAM(15);
    MOE_PHASES(1, 16)
    if (IN(20)) phase_final(F, a);
#undef IN
#undef SEAM
}

extern "C" void kernel_launch(void* const* d_in, const int* in_sizes, int n_in, void* d_out, int out_size, void* d_ws, size_t ws_size, hipStream_t stream) {
    static int grid = 0;
    if (grid == 0) {
        if (n_in != 41 || out_size != NT * DM || ws_size < WS_NEED) { fprintf(stderr, "kernel_launch: unexpected problem (n_in %d, out %d, ws %zu); nothing launched\n", n_in, out_size, ws_size); grid = -1; return; }
        int dev = 0, cus = 0, per_cu = 0;
        if (hipGetDevice(&dev) != hipSuccess || hipDeviceGetAttribute(&cus, hipDeviceAttributeMultiprocessorCount, dev) != hipSuccess) { grid = -1; return; }
        if (hipFuncSetAttribute((const void*)fwd, hipFuncAttributeMaxDynamicSharedMemorySize, LDS_BYTES) != hipSuccess) { fprintf(stderr, "kernel_launch: hipFuncSetAttribute failed\n"); grid = -1; return; }
        if (hipOccupancyMaxActiveBlocksPerMultiprocessor(&per_cu, (const void*)fwd, 512, LDS_BYTES) != hipSuccess || per_cu < 1)
            fprintf(stderr, "kernel_launch: occupancy query reports %d workgroups per CU\n", per_cu);
        (void)hipGetLastError();
        grid = cus;
    }
    if (grid < 0) return;
    (void)hipMemsetAsync((char*)d_ws + WS_CTL, 0, CTL_BYTES, stream);
    Args a{};
    for (int i = 0; i < 41; ++i) a.in[i] = (const float*)d_in[i];
    a.out = (float*)d_out; a.ws = (unsigned char*)d_ws;
#if N_LAUNCH_MODE == 1
    a.ph_lo = 0; a.ph_hi = NPH;
    hipLaunchKernelGGL(fwd, dim3(grid), dim3(512), LDS_BYTES, stream, a);
#else
    for (int p = 0; p < NPH; ++p) { a.ph_lo = p; a.ph_hi = p + 1; hipLaunchKernelGGL(fwd, dim3(grid), dim3(512), LDS_BYTES, stream, a); }
#endif
}
```

```cpp
#include <hip/hip_runtime.h>
#include <cstdio>
#include <cstdint>

#define GAS __attribute__((address_space(1)))
#define LAS __attribute__((address_space(3)))
typedef unsigned short bf16_t;
typedef short bf16x8 __attribute__((ext_vector_type(8)));
typedef float f32x4 __attribute__((ext_vector_type(4)));
typedef float f32x2 __attribute__((ext_vector_type(2)));
typedef unsigned u32x4 __attribute__((ext_vector_type(4)));
typedef unsigned u32x2 __attribute__((ext_vector_type(2)));

#ifndef N_LAUNCH_MODE
#define N_LAUNCH_MODE 1
#endif

constexpr int NT = 65536, DM = 1024, SEQ = 2048, NB = 32;
constexpr int P_MAX = 139264;
constexpr size_t MiB = 1u << 20;
constexpr size_t WS_CTL = 0, CTL_BYTES = 1 * MiB;
constexpr size_t WS_RFRAG = 1 * MiB;
constexpr size_t WS_W2F = 3 * MiB;
constexpr size_t WS_CIDX = 3 * MiB + 256 * 1024;
constexpr size_t WS_PEBP = 3 * MiB + 512 * 1024;
constexpr size_t WS_TEXP = 2 * MiB;
constexpr size_t WS_WR = 8 * MiB, WS_WK = 10 * MiB, WS_WV = 12 * MiB, WS_WO = 14 * MiB;
constexpr size_t WS_WL1 = 16 * MiB;
constexpr size_t WS_W2WA = 18 * MiB;
constexpr size_t WS_W2G = 19 * MiB;
constexpr size_t WS_WKVQG = 20 * MiB;
constexpr size_t WS_WOB = 26 * MiB;
constexpr size_t WS_WC1 = 28 * MiB;
constexpr size_t WS_BT1 = 32 * MiB;
constexpr size_t WS_BT2 = 160 * MiB;
constexpr size_t WS_S0 = 224 * MiB, WS_S1 = 352 * MiB, WS_S2 = 480 * MiB, WS_S3 = 608 * MiB, WS_S4 = 736 * MiB, WS_S5 = 864 * MiB;
constexpr size_t WS_GATES = 993 * MiB;
constexpr size_t WS_ASG = 1014 * MiB;
constexpr size_t WS_ROWW = 1016 * MiB;
constexpr size_t WS_RIDX = 1017 * MiB;
constexpr size_t WS_RSTD = 1018 * MiB;
constexpr size_t WS_ROWRS = 1019 * MiB;
constexpr size_t WS_H = WS_S0;
constexpr size_t WS_NEED = 1024 * MiB;
constexpr size_t WS_KV = 352 * MiB, WS_Q = 544 * MiB, WS_ACMP = 672 * MiB, WS_HC = 800 * MiB, WS_OATT = 816 * MiB;
constexpr size_t WS_KCB = 1006 * MiB, WS_VCT = 1008 * MiB;
constexpr int CW_BAR = 4096;
constexpr int CW_CNT = 16384;

typedef __bf16 bf16x2n __attribute__((ext_vector_type(2)));
__device__ __forceinline__ unsigned cvtpk(float lo, float hi) { const f32x2 v = {lo, hi}; return __builtin_bit_cast(unsigned, __builtin_convertvector(v, bf16x2n)); }
__device__ __forceinline__ unsigned f2bf(float f) { return cvtpk(f, f) & 0xffffu; }
__device__ __forceinline__ unsigned pk2(float lo, float hi) { return cvtpk(lo, hi); }
__device__ __forceinline__ float bflo(unsigned u) { return __builtin_bit_cast(float, u << 16); }
__device__ __forceinline__ float bfhi(unsigned u) { return __builtin_bit_cast(float, u & 0xffff0000u); }
__device__ __forceinline__ float bf2f(bf16_t b) { return __builtin_bit_cast(float, ((unsigned)b) << 16); }
template <int CTRL> __device__ __forceinline__ float dppf(float v) { return __int_as_float(__builtin_amdgcn_update_dpp(0, __float_as_int(v), CTRL, 0xf, 0xf, true)); }
#define DPP_XOR1 0xB1
#define DPP_XOR2 0x4E
#define DPP_HALF_MIRROR 0x141
#define DPP_MIRROR 0x140
#define DPP_ROR8 0x128
__device__ __forceinline__ float wave_sum(float v) {
    v += dppf<DPP_XOR1>(v); v += dppf<DPP_XOR2>(v); v += dppf<DPP_HALF_MIRROR>(v); v += dppf<DPP_MIRROR>(v);
    { const auto r = __builtin_amdgcn_permlane16_swap(__float_as_uint(v), __float_as_uint(v), false, false); v = __uint_as_float(r[0]) + __uint_as_float(r[1]); }
    { const auto r = __builtin_amdgcn_permlane32_swap(__float_as_uint(v), __float_as_uint(v), false, false); v = __uint_as_float(r[0]) + __uint_as_float(r[1]); }
    return v;
}
__device__ __forceinline__ float fexp_(float x) { return __builtin_amdgcn_exp2f(x * 1.44269504089f); }
__device__ __forceinline__ float sigmoidf_(float x) { return __builtin_amdgcn_rcpf(1.f + fexp_(-x)); }
__device__ __forceinline__ float tanhf_(float x) { return 1.f - 2.f * __builtin_amdgcn_rcpf(1.f + fexp_(2.f * x)); }
__device__ __forceinline__ float gelu_tanh_(float x) { return 0.5f * x * (1.f + tanhf_(0.7978845608f * (x + 0.044715f * x * x * x))); }
#define LDS_WAIT() asm volatile("s_waitcnt lgkmcnt(0)" ::: "memory")

__device__ const unsigned char BKT[129] = {0, 1, 2, 3, 4, 5, 6, 7, 8, 9, 10, 11, 12, 13, 14, 15, 16, 16, 16, 17, 17, 18, 18, 18, 19, 19, 19, 20, 20, 20, 20, 21, 21, 21, 21, 22, 22, 22, 22, 22, 23, 23, 23, 23, 23, 23, 24, 24, 24, 24, 24, 24, 25, 25, 25, 25, 25, 25, 25, 26, 26, 26, 26, 26, 26, 26, 26, 27, 27, 27, 27, 27, 27, 27, 27, 27, 27, 28, 28, 28, 28, 28, 28, 28, 28, 28, 28, 29, 29, 29, 29, 29, 29, 29, 29, 29, 29, 29, 29, 30, 30, 30, 30, 30, 30, 30, 30, 30, 30, 30, 30, 30, 30, 31, 31, 31, 31, 31, 31, 31, 31, 31, 31, 31, 31, 31, 31, 31, 31};

#define XB_TMO      128
#define XB_XCNT(j)  (256  + 64 * (j))
#define XB_XSUB(j)  (1280 + 64 * (j))
#define XB_XGEN(j)  (2304 + 64 * (j))
#define XB_TOP      3328
#define XB_TOPGEN   3392
#define XCD_BAR_WORDS 3456
#define XB_SPIN_CAP (1u << 22)
__device__ __forceinline__ unsigned xb_ld(unsigned* p)              { return __hip_atomic_load(p, __ATOMIC_RELAXED, __HIP_MEMORY_SCOPE_AGENT); }
__device__ __forceinline__ unsigned xb_add(unsigned* p, unsigned v) { return __hip_atomic_fetch_add(p, v, __ATOMIC_RELAXED, __HIP_MEMORY_SCOPE_AGENT); }
__device__ __forceinline__ unsigned xb_xcc_id() { return (unsigned)__builtin_amdgcn_s_getreg((3 << 11) | 20) & 0xFu; }
#define XB_SPIN(cond, bar) do { unsigned _sp = 0; while (cond) { __builtin_amdgcn_s_sleep(1); \
    if ((++_sp & 255u) == 0u) { if (xb_ld(&(bar)[XB_TMO])) break; if (_sp > XB_SPIN_CAP) { atomicAdd(&(bar)[XB_TMO], 1u); break; } } } } while (0)
struct XcdBarrier { unsigned* bar; unsigned x; volatile LAS unsigned* st; };
__device__ __forceinline__ XcdBarrier xcd_barrier_post(unsigned* bar, volatile LAS unsigned* st) {
    XcdBarrier b; b.bar = bar; b.x = xb_xcc_id(); b.st = st;
    if (threadIdx.x == 0) (void)xb_add(&bar[XB_XCNT(b.x)], 1u);
    return b;
}
__device__ __forceinline__ void xcd_barrier_complete(unsigned* bar, unsigned x, unsigned& nloc, unsigned& nx) {
    const unsigned G = gridDim.x * gridDim.y * gridDim.z;
    unsigned sum, cnt, mine, sp = 0u;
    for (;;) {
        sum = 0u; cnt = 0u; mine = 0u;
#pragma unroll
        for (unsigned j = 0; j < 16; ++j) { const unsigned c = xb_ld(&bar[XB_XCNT(j)]); sum += c; cnt += (c > 0u) ? 1u : 0u; mine = (j == x) ? c : mine; }
        if (sum == G) break;
        __builtin_amdgcn_s_sleep(1);
        if ((++sp & 255u) == 0u) { if (xb_ld(&bar[XB_TMO])) break; if (sp > XB_SPIN_CAP) { atomicAdd(&bar[XB_TMO], 1u); break; } }
    }
    nloc = mine > 0u ? mine : 1u; nx = cnt > 0u ? cnt : 1u;
}
__device__ __forceinline__ void xcd_barrier(const XcdBarrier& b) {
    asm volatile("s_waitcnt vmcnt(0)" ::: "memory");
    __syncthreads();
    if (threadIdx.x == 0) {
        unsigned* bar = b.bar;
        __builtin_amdgcn_s_waitcnt(0);
        unsigned nloc = b.st[0], nx = b.st[1];
        if (nloc == 0u) { xcd_barrier_complete(bar, b.x, nloc, nx); b.st[0] = nloc; b.st[1] = nx; }
        const unsigned old = xb_add(&bar[XB_XSUB(b.x)], 1u);
        const unsigned gen = old / nloc;
        if (old + 1u == (gen + 1u) * nloc) {
            __builtin_amdgcn_fence(__ATOMIC_RELEASE, "agent");
            asm volatile("s_waitcnt vmcnt(0)" ::: "memory");
            const unsigned og = xb_add(&bar[XB_TOP], 1u);
            const unsigned tg = og / nx;
            if (og + 1u == (tg + 1u) * nx) xb_add(&bar[XB_TOPGEN], 1u);
            else XB_SPIN(xb_ld(&bar[XB_TOPGEN]) == tg, bar);
            __builtin_amdgcn_fence(__ATOMIC_ACQUIRE, "agent");
            xb_add(&bar[XB_XGEN(b.x)], 1u);
            asm volatile("s_waitcnt vmcnt(0)" ::: "memory");
        } else {
            XB_SPIN(xb_ld(&bar[XB_XGEN(b.x)]) == gen, bar);
            __builtin_amdgcn_fence(__ATOMIC_ACQUIRE, "agent");
            asm volatile("s_waitcnt vmcnt(0)" ::: "memory");
        }
    }
    __syncthreads();
}

namespace pg8 {
constexpr int BM = 256, BK = 64, HALF = 128, HTB = HALF * BK * 2, STAGE_BYTES = 8 * HTB, NXCD = 8, WGM = 8;
__host__ __device__ __forceinline__ int lds_byte(int r, int c) { const int st = (r >> 4) * 2 + (c >> 5), rr = r & 15, cc = c & 31, ob = rr * 64 + cc * 2; return st * 1024 + (ob ^ (((ob >> 9) & 1) << 5)); }
__host__ __device__ __forceinline__ void stage_rc(int b, int& R, int& C) { const int st = b / 1024, sb = b % 1024, swz = sb ^ (((sb >> 9) & 1) << 5); R = (st >> 1) * 16 + swz / 64; C = (st & 1) * 32 + (swz % 64) / 2; }
__host__ __device__ __forceinline__ int perm32(int rho) { const int n = rho >> 4, i = rho & 15; return 8 * (i >> 2) + 4 * n + (i & 3); }
struct Unit { int pm, pn; };
struct Gemm { const bf16_t* A; const bf16_t* Bt; int K, lda, apad, kwrap; const int* gidx; int ahm; };
struct StaticOrder {
    int nM, nN, nwg, G, c;
    __device__ void init(int M, int N, int G_, int c_) { nM = M / BM; nN = N / BM; nwg = nM * nN; G = G_; c = c_; }
    __device__ bool next(int i, Unit& u) const {
        const long L = (long)i * G + c; if (L >= nwg) return false;
        int wgid = (int)L; { const int q = nwg / NXCD, r = nwg % NXCD, xcd = wgid % NXCD, off = wgid / NXCD; wgid = (xcd < r ? xcd * (q + 1) : r * (q + 1) + (xcd - r) * q) + off; }
        const int nig = WGM * nN, gid = wgid / nig, fm = gid * WGM, gsz = (nM - fm) < WGM ? (nM - fm) : WGM;
        u.pm = fm + ((wgid % nig) % gsz); u.pn = (wgid % nig) / gsz; return true;
    }
};
struct MoeOrder {
    const int* xl; int nunits, ncu, cu; mutable int pre;
    __device__ __forceinline__ void init(const int* texp, int G_, int c_) { const int x = c_ & 7; cu = c_ >> 3; ncu = G_ >> 3; xl = texp + 2048 + x * 640; nunits = texp[1008 + x] * 4; pre = (cu < nunits) ? xl[cu >> 2] : 0; }
    __device__ __forceinline__ bool next(int i, Unit& u) const {
        const int L = i * ncu + cu; if (L >= nunits) return false;
        const int ent = pre; u.pm = ent & 0xffff; u.pn = (ent >> 16) * 4 + (L & 3);
        const int L2 = L + ncu; pre = (L2 < nunits) ? xl[L2 >> 2] : 0; return true;
    }
};
struct CmpOrder {
    int G, c;
    __device__ bool next(int i, Unit& u) const { const long L = (long)i * G + c; if (L >= 128) return false; u.pm = (int)L; u.pn = (int)(L >> 6); return true; }
};

template <class Epi, class Sched, bool GATHER = false, bool ALIGN_EPI = true, bool SP2 = true>
__device__ __forceinline__ void gemm_phase(LAS unsigned char* lds, const Gemm g, const Sched& S, const Epi& E) {
    const int tid = threadIdx.x, wid = __builtin_amdgcn_readfirstlane(tid >> 6), lane = tid & 63, wr = wid >> 2, wc = wid & 3, fr = lane & 15, fq = lane >> 4;
    const int K = g.K, nt = K / BK, lda = g.lda, kwrap = g.kwrap;
    unsigned voffA[2], voffB[2];
#pragma unroll
    for (int i = 0; i < 2; ++i) { int R, C; stage_rc(tid * 16 + i * 8192, R, C); const int Rb = Epi::PERM ? ((R & ~31) + perm32(R & 31)) : R;
        voffA[i] = (unsigned)(R * lda + C) * 2u; voffB[i] = (unsigned)(Rb * K + C) * 2u; }
    const long kstep = (long)(BK * 2); const long kstepA = g.ahm == 2 ? 3072l : g.ahm ? (long)SEQ * 128 : kstep;
    const long hstepA = (long)HALF * lda * 2, hstepB = (long)HALF * K * 2;
    const long tstepB = 2 * hstepB;
    const unsigned ldsw = (unsigned)wid * 1024u;
    const int aoff = lds_byte(wr * 64 + fr, fq * 8), boff = lds_byte(wc * 32 + fr, fq * 8);
#define PG8_KOFFA(t) (((t) < kwrap) ? (long)(t) * kstepA : (long)((t) - kwrap) * kstepA - (long)lda * 2)
#define PG8_ATILE(pm) (g.ahm ? (const char*)g.A + ((long)((pm) >> 3) * (K / 64) * SEQ + (long)((pm) & 7) * 256) * 128 : (const char*)g.A + ((long)(pm) * 256 + (g.apad ? (((pm) >> 3) + 1) : 0)) * (long)lda * 2)
#define PG8_SA(b, h) (((b) * 2 + (h)) * HTB)
#define PG8_SB(b, h) ((4 + (b) * 2 + (h)) * HTB)
#define PG8_STAGE(bufoff, gbase, voff) do { _Pragma("unroll") for (int _i = 0; _i < 2; ++_i) \
        __builtin_amdgcn_global_load_lds((const unsigned*)((const char*)(gbase) + (voff)[_i]), (LAS unsigned*)(lds + (bufoff) + ldsw + _i * 8192), 16, 0, 0); } while (0)
#define PG8_STAGE_A(bufoff, nx, h, ko) do { if constexpr (GATHER) { _Pragma("unroll") for (int _i = 0; _i < 2; ++_i) \
            __builtin_amdgcn_global_load_lds((const unsigned*)((const char*)g.A + (ko) + ((nx) ? gon[h][_i] : goc[h][_i])), (LAS unsigned*)(lds + (bufoff) + ldsw + _i * 8192), 16, 0, 0); } \
        else PG8_STAGE(bufoff, ((nx) ? nA : cA) + (h) * hstepA + (ko), voffA); } while (0)
#define PG8_GIDX(dst, pm_) do { if constexpr (GATHER) { _Pragma("unroll") for (int _h = 0; _h < 2; ++_h) _Pragma("unroll") for (int _i = 0; _i < 2; ++_i) \
            dst[_h][_i] = (unsigned)g.gidx[(pm_) * 256 + _h * 128 + (int)(voffA[_i] / (unsigned)(lda * 2))] * (unsigned)(lda * 2) + voffA[_i] % (unsigned)(lda * 2); } } while (0)
#define PG8_LDA(dst, b, h) do { _Pragma("unroll") for (int m = 0; m < 4; ++m) _Pragma("unroll") for (int k = 0; k < 2; ++k) dst[m][k] = *(const LAS bf16x8*)(lds + PG8_SA(b, h) + aoff + m * 2048 + k * 1024); } while (0)
#define PG8_LDB(dst, b, h) do { _Pragma("unroll") for (int n = 0; n < 2; ++n) _Pragma("unroll") for (int k = 0; k < 2; ++k) dst[n][k] = *(const LAS bf16x8*)(lds + PG8_SB(b, h) + boff + n * 2048 + k * 1024); } while (0)
#define PG8_MMA(ai, bj, At, Bt) do { __builtin_amdgcn_s_setprio(1); _Pragma("unroll") for (int m = 0; m < 4; ++m) _Pragma("unroll") for (int n = 0; n < 2; ++n) _Pragma("unroll") for (int k = 0; k < 2; ++k) \
        acc[ai][bj][m][n] = __builtin_amdgcn_mfma_f32_16x16x32_bf16(Bt[n][k], At[m][k], acc[ai][bj][m][n], 0, 0, 0); __builtin_amdgcn_s_setprio(0); } while (0)
#define PG8_WAIT_V(n) asm volatile("s_waitcnt vmcnt(" #n ")" ::: "memory")
#define PG8_WAIT_L(n) asm volatile("s_waitcnt lgkmcnt(" #n ")" ::: "memory")
#define PG8_BAR __builtin_amdgcn_s_barrier()
#define PG8_SCHED __builtin_amdgcn_sched_barrier(0)
    Unit cur, nxt; int ui = 0;
    if (!S.next(0, cur)) return;
    f32x4 acc[2][2][4][2];
#pragma unroll
    for (int a = 0; a < 2; ++a)
#pragma unroll
        for (int b = 0; b < 2; ++b)
#pragma unroll
            for (int m = 0; m < 4; ++m)
#pragma unroll
                for (int n = 0; n < 2; ++n) acc[a][b][m][n] = (f32x4){0.f, 0.f, 0.f, 0.f};
    bf16x8 At[4][2], B0[2][2], B1[2][2];
    const char* cA = PG8_ATILE(cur.pm); const char* cB = (const char*)g.Bt + (long)cur.pn * tstepB; const char* nA = cA;
    unsigned goc[2][2], gon[2][2];
#pragma unroll
    for (int _h = 0; _h < 2; ++_h)
#pragma unroll
        for (int _i = 0; _i < 2; ++_i) { goc[_h][_i] = 0u; gon[_h][_i] = 0u; }
    PG8_GIDX(goc, cur.pm);
    if constexpr (SP2) {
        PG8_STAGE(PG8_SB(0, 0), cB, voffB); PG8_STAGE(PG8_SB(0, 1), cB + hstepB, voffB); PG8_STAGE_A(PG8_SA(0, 0), false, 0, 0); PG8_STAGE_A(PG8_SA(0, 1), false, 1, 0);
        if (wr == 1) PG8_BAR;
        PG8_WAIT_V(2); PG8_BAR;
        PG8_STAGE(PG8_SB(1, 0), cB + kstep, voffB); PG8_STAGE_A(PG8_SA(1, 0), false, 0, kstepA); PG8_STAGE(PG8_SB(1, 1), cB + hstepB + kstep, voffB);
        PG8_WAIT_V(6); PG8_BAR;
    } else {
        PG8_STAGE(PG8_SB(0, 0), cB, voffB); PG8_STAGE_A(PG8_SA(0, 0), false, 0, 0); PG8_STAGE(PG8_SB(0, 1), cB + hstepB, voffB); PG8_STAGE_A(PG8_SA(0, 1), false, 1, 0);
        if (wr == 1) PG8_BAR;
        PG8_WAIT_V(4); PG8_BAR;
        PG8_STAGE(PG8_SB(1, 0), cB + kstep, voffB); PG8_STAGE_A(PG8_SA(1, 0), false, 0, kstepA); PG8_STAGE(PG8_SB(1, 1), cB + hstepB + kstep, voffB);
        PG8_WAIT_V(6); PG8_BAR;
    }
    for (;;) {
        const bool has_next = S.next(ui + 1, nxt);
        nA = has_next ? PG8_ATILE(nxt.pm) : cA; const char* nB = has_next ? (const char*)g.Bt + (long)nxt.pn * tstepB : cB;
        if constexpr (GATHER) { if (has_next) PG8_GIDX(gon, nxt.pm); else {
#pragma unroll
            for (int _h = 0; _h < 2; ++_h)
#pragma unroll
                for (int _i = 0; _i < 2; ++_i) gon[_h][_i] = goc[_h][_i]; } }
#pragma unroll 1
        for (int t = 0; t < nt; t += 2) {
            const bool last = (t == nt - 2);
            const long k1 = PG8_KOFFA(t + 1), k2 = last ? 0 : PG8_KOFFA(t + 2), k3 = last ? kstepA : PG8_KOFFA(t + 3);
            const char* b2 = last ? nB : cB + (long)(t + 2) * kstep; const char* b3 = b2 + kstep;
            if constexpr (SP2) {
            PG8_LDB(B0, 0, 0); PG8_LDB(B1, 0, 1); PG8_SCHED; PG8_LDA(At, 0, 0); PG8_STAGE_A(PG8_SA(1, 1), false, 1, k1);
            PG8_WAIT_V(8); PG8_WAIT_L(0); PG8_BAR; PG8_MMA(0, 0, At, B0); PG8_MMA(0, 1, At, B1); PG8_BAR; PG8_SCHED;
            PG8_LDA(At, 0, 1); PG8_STAGE(PG8_SB(0, 0), b2, voffB); PG8_STAGE(PG8_SB(0, 1), b2 + hstepB, voffB); PG8_STAGE_A(PG8_SA(0, 0), last, 0, k2);
            PG8_WAIT_V(8); PG8_WAIT_L(0); PG8_BAR; PG8_MMA(1, 0, At, B0); PG8_MMA(1, 1, At, B1); PG8_BAR; PG8_SCHED;
            PG8_LDB(B0, 1, 0); PG8_LDB(B1, 1, 1); PG8_SCHED; PG8_LDA(At, 1, 0); PG8_STAGE_A(PG8_SA(0, 1), last, 1, k2);
            PG8_WAIT_V(8); PG8_WAIT_L(0); PG8_BAR; PG8_MMA(0, 0, At, B0); PG8_MMA(0, 1, At, B1); PG8_BAR; PG8_SCHED;
            PG8_LDA(At, 1, 1); PG8_STAGE(PG8_SB(1, 0), b3, voffB); PG8_STAGE(PG8_SB(1, 1), b3 + hstepB, voffB); PG8_STAGE_A(PG8_SA(1, 0), last, 0, k3);
            PG8_WAIT_V(8); PG8_WAIT_L(0); PG8_BAR; PG8_MMA(1, 0, At, B0); PG8_MMA(1, 1, At, B1); PG8_BAR; PG8_SCHED;
            } else {
            PG8_LDB(B0, 0, 0); PG8_SCHED; PG8_LDA(At, 0, 0); PG8_STAGE_A(PG8_SA(1, 1), false, 1, k1);
            PG8_WAIT_L(8); PG8_BAR; PG8_WAIT_L(0); PG8_MMA(0, 0, At, B0); PG8_BAR; PG8_SCHED;
            PG8_LDB(B1, 0, 1); PG8_STAGE(PG8_SB(0, 0), b2, voffB);
            PG8_BAR; PG8_WAIT_L(0); PG8_MMA(0, 1, At, B1); PG8_BAR;
            PG8_LDA(At, 0, 1); PG8_STAGE_A(PG8_SA(0, 0), last, 0, k2);
            PG8_BAR; PG8_WAIT_L(0); PG8_MMA(1, 0, At, B0); PG8_BAR; PG8_SCHED;
            PG8_STAGE(PG8_SB(0, 1), b2 + hstepB, voffB);
            PG8_WAIT_V(6); PG8_BAR; PG8_MMA(1, 1, At, B1); PG8_BAR;
            PG8_LDB(B0, 1, 0); PG8_SCHED; PG8_LDA(At, 1, 0); PG8_STAGE_A(PG8_SA(0, 1), last, 1, k2);
            PG8_WAIT_L(8); PG8_BAR; PG8_WAIT_L(0); PG8_MMA(0, 0, At, B0); PG8_BAR; PG8_SCHED;
            PG8_LDB(B1, 1, 1); PG8_STAGE(PG8_SB(1, 0), b3, voffB);
            PG8_BAR; PG8_WAIT_L(0); PG8_MMA(0, 1, At, B1); PG8_BAR;
            PG8_LDA(At, 1, 1); PG8_STAGE_A(PG8_SA(1, 0), last, 0, k3);
            PG8_BAR; PG8_WAIT_L(0); PG8_MMA(1, 0, At, B0); PG8_BAR; PG8_SCHED;
            PG8_STAGE(PG8_SB(1, 1), b3 + hstepB, voffB);
            PG8_WAIT_V(6); PG8_BAR; PG8_MMA(1, 1, At, B1); PG8_BAR;
            }
        }
        if constexpr (ALIGN_EPI) { if (wr == 0) PG8_BAR; }
        E(acc, cur, wr, wc, fr, fq);
        if (!has_next) break;
#pragma unroll
        for (int a = 0; a < 2; ++a)
#pragma unroll
            for (int b = 0; b < 2; ++b)
#pragma unroll
                for (int m = 0; m < 4; ++m)
#pragma unroll
                    for (int n = 0; n < 2; ++n) acc[a][b][m][n] = (f32x4){0.f, 0.f, 0.f, 0.f};
        cur = nxt; cA = nA; cB = nB; ++ui;
        if constexpr (GATHER) {
#pragma unroll
            for (int _h = 0; _h < 2; ++_h)
#pragma unroll
                for (int _i = 0; _i < 2; ++_i) goc[_h][_i] = gon[_h][_i]; }
        if constexpr (ALIGN_EPI) { if (wr == 1) PG8_BAR; }
    }
    PG8_WAIT_V(0);
    if constexpr (!ALIGN_EPI) { if (wr == 0) PG8_BAR; }
    PG8_BAR;
#undef PG8_STAGE_A
#undef PG8_GIDX
#undef PG8_KOFFA
#undef PG8_ATILE
#undef PG8_SA
#undef PG8_SB
#undef PG8_STAGE
#undef PG8_LDA
#undef PG8_LDB
#undef PG8_MMA
#undef PG8_WAIT_V
#undef PG8_WAIT_L
#undef PG8_BAR
#undef PG8_SCHED
}

#define EPI_LOOP_ROWS for (int ai = 0; ai < 2; ++ai) _Pragma("unroll") for (int m = 0; m < 4; ++m)
__device__ __forceinline__ u32x4 pack8(const f32x4 v0, const f32x4 v1) { u32x4 w; w.x = pk2(v0[0], v0[1]); w.y = pk2(v0[2], v0[3]); w.z = pk2(v1[0], v1[1]); w.w = pk2(v1[2], v1[3]); return w; }

__device__ __forceinline__ size_t hm_off(int row, int col) { return ((size_t)((row >> 11) * 16 + (col >> 6)) * SEQ + (row & 2047)) * 64 + (col & 63); }
struct EpiBf16 {
    static constexpr bool PERM = true;
    bf16_t* O; int ldc; float scale; int hm;
    __device__ __forceinline__ void operator()(const f32x4 (&acc)[2][2][4][2], const Unit& u, int wr, int wc, int fr, int fq) const {
        const int row0 = u.pm * BM + wr * 64 + fr, col0 = u.pn * BM + wc * 32 + 8 * fq;
#pragma unroll
        EPI_LOOP_ROWS { const int row = row0 + ai * HALF + m * 16;
#pragma unroll
            for (int bj = 0; bj < 2; ++bj) { bf16_t* p = hm ? O + hm_off(row, col0 + bj * HALF) : O + (size_t)row * ldc + col0 + bj * HALF;
                *(u32x4*)p = pack8(acc[ai][bj][m][0] * scale, acc[ai][bj][m][1] * scale); } }
    }
};
struct EpiLora1 {
    static constexpr bool PERM = true;
    bf16_t* O;
    __device__ __forceinline__ void operator()(const f32x4 (&acc)[2][2][4][2], const Unit& u, int wr, int wc, int fr, int fq) const {
        const int row0 = u.pm * BM + wr * 64 + fr, col0 = u.pn * BM + wc * 32 + 8 * fq;
#pragma unroll
        EPI_LOOP_ROWS { bf16_t* rowp = O + (size_t)(row0 + ai * HALF + m * 16) * 512 + col0;
#pragma unroll
            for (int bj = 0; bj < 2; ++bj) { const int c = col0 + bj * HALF; f32x4 v0 = acc[ai][bj][m][0], v1 = acc[ai][bj][m][1];
                if (c < 64) {
#pragma unroll
                    for (int j = 0; j < 4; ++j) { v0[j] = tanhf_(v0[j]); v1[j] = tanhf_(v1[j]); }
                } else if (c < 128) {
                } else if (c < 288) {
#pragma unroll
                    for (int j = 0; j < 4; ++j) { v0[j] = sigmoidf_(v0[j]); v1[j] = sigmoidf_(v1[j]); }
                } else { v0 = (f32x4){0.f, 0.f, 0.f, 0.f}; v1 = v0; }
                *(u32x4*)(rowp + bj * HALF) = pack8(v0, v1); } }
    }
};
struct EpiLora2WA {
    static constexpr bool PERM = true;
    bf16_t* LW; bf16_t* AA; const float* w0; const float* a0;
    __device__ __forceinline__ void operator()(const f32x4 (&acc)[2][2][4][2], const Unit& u, int wr, int wc, int fr, int fq) const {
        const int row0 = u.pm * BM + wr * 64 + fr; const bool isw = u.pn < 4; const int col0 = (u.pn & 3) * BM + wc * 32 + 8 * fq;
        bf16_t* O = isw ? LW : AA; const float* bias = isw ? w0 : a0; const float mul = isw ? -0.60653065971f : 1.0f;
#pragma unroll
        for (int bj = 0; bj < 2; ++bj) { const f32x4 b0 = *(const f32x4*)(bias + col0 + bj * HALF), b1 = *(const f32x4*)(bias + col0 + bj * HALF + 4);
#pragma unroll
            EPI_LOOP_ROWS { bf16_t* rowp = O + hm_off(row0 + ai * HALF + m * 16, col0 + bj * HALF); f32x4 v0 = acc[ai][bj][m][0] + b0, v1 = acc[ai][bj][m][1] + b1;
#pragma unroll
                for (int j = 0; j < 4; ++j) { v0[j] = mul * sigmoidf_(v0[j]); v1[j] = mul * sigmoidf_(v1[j]); }
                *(u32x4*)rowp = pack8(v0, v1); } }
    }
};
struct EpiResX {
    static constexpr bool PERM = true;
    const float* x; bf16_t* h;
    __device__ __forceinline__ void operator()(const f32x4 (&acc)[2][2][4][2], const Unit& u, int wr, int wc, int fr, int fq) const {
        const int row0 = u.pm * BM + wr * 64 + fr, col0 = u.pn * BM + wc * 32 + 8 * fq;
#pragma unroll
        for (int ai = 0; ai < 2; ++ai) {
            f32x4 xb[4][2][2];
#pragma unroll
            for (int m = 0; m < 4; ++m)
#pragma unroll
                for (int bj = 0; bj < 2; ++bj) { const float* p = x + (size_t)(row0 + ai * HALF + m * 16) * 1024 + col0 + bj * HALF; xb[m][bj][0] = *(const f32x4*)p; xb[m][bj][1] = *(const f32x4*)(p + 4); }
#pragma unroll
            for (int m = 0; m < 4; ++m) { const size_t off = (size_t)(row0 + ai * HALF + m * 16) * 1024 + col0;
#pragma unroll
                for (int bj = 0; bj < 2; ++bj) *(u32x4*)(h + off + bj * HALF) = pack8(acc[ai][bj][m][0] + xb[m][bj][0], acc[ai][bj][m][1] + xb[m][bj][1]); } }
    }
};
struct EpiResH {
    static constexpr bool PERM = true;
    bf16_t* h;
    __device__ __forceinline__ void operator()(const f32x4 (&acc)[2][2][4][2], const Unit& u, int wr, int wc, int fr, int fq) const {
        const int row0 = u.pm * BM + wr * 64 + fr, col0 = u.pn * BM + wc * 32 + 8 * fq;
        u32x4 hb[2][4][2];
#pragma unroll
        EPI_LOOP_ROWS { const size_t off = (size_t)(row0 + ai * HALF + m * 16) * 1024 + col0;
#pragma unroll
            for (int bj = 0; bj < 2; ++bj) hb[ai][m][bj] = *(const u32x4*)(h + off + bj * HALF); }
#pragma unroll
        EPI_LOOP_ROWS { const size_t off = (size_t)(row0 + ai * HALF + m * 16) * 1024 + col0;
#pragma unroll
            for (int bj = 0; bj < 2; ++bj) { const u32x4 b = hb[ai][m][bj];
                const f32x4 b0 = {bflo(b.x), bfhi(b.x), bflo(b.y), bfhi(b.y)}, b1 = {bflo(b.z), bfhi(b.z), bflo(b.w), bfhi(b.w)};
                *(u32x4*)(h + off + bj * HALF) = pack8(acc[ai][bj][m][0] + b0, acc[ai][bj][m][1] + b1); } }
    }
};
struct EpiKvqg {
    static constexpr bool PERM = true;
    bf16_t* KV; bf16_t* Q; float* GT; const float* rs;
    __device__ __forceinline__ void operator()(const f32x4 (&acc)[2][2][4][2], const Unit& u, int wr, int wc, int fr, int fq) const {
        const int row0 = u.pm * BM + wr * 64 + fr;
        float rsv[2][4];
#pragma unroll
        EPI_LOOP_ROWS rsv[ai][m] = rs[row0 + ai * HALF + m * 16];
        if (u.pn < 10) {
            const bool iskv = u.pn < 6; bf16_t* O = iskv ? KV : Q; const int ldc = iskv ? 1536 : 1024; const float sc = iskv ? 1.0f : 0.18033688011f;
            const int col0 = (iskv ? u.pn : u.pn - 6) * BM + wc * 32 + 8 * fq;
#pragma unroll
            EPI_LOOP_ROWS { const int row = row0 + ai * HALF + m * 16; const float scr_ = sc * rsv[ai][m]; bf16_t* rowp = O + (size_t)row * ldc + col0;
#pragma unroll
                for (int bj = 0; bj < 2; ++bj) *(u32x4*)(rowp + bj * HALF) = pack8(acc[ai][bj][m][0] * scr_, acc[ai][bj][m][1] * scr_); }
        } else {
            const int c0 = wc * 32 + 8 * fq;
            if (c0 < 48) {
#pragma unroll
                EPI_LOOP_ROWS { const int row = row0 + ai * HALF + m * 16; const float rr_ = rsv[ai][m]; float* rowp = GT + (size_t)row * 48 + c0; f32x4 v0 = acc[ai][0][m][0] * rr_, v1 = acc[ai][0][m][1] * rr_;
#pragma unroll
                    for (int j = 0; j < 4; ++j) { v0[j] = sigmoidf_(v0[j]); v1[j] = sigmoidf_(v1[j]); }
                    *(f32x4*)(rowp) = v0; *(f32x4*)(rowp + 4) = v1; }
            }
        }
    }
};
struct EpiMoe1 {
    static constexpr bool PERM = true;
    bf16_t* H; const float* rs;
    __device__ __forceinline__ void operator()(const f32x4 (&acc)[2][2][4][2], const Unit& u, int wr, int wc, int fr, int fq) const {
        const int row0 = u.pm * BM + wr * 64 + fr, col0 = (u.pn & 3) * 128 + wc * 32 + 8 * fq;
        float rsv[2][4];
#pragma unroll
        EPI_LOOP_ROWS rsv[ai][m] = rs[row0 + ai * HALF + m * 16];
#pragma unroll
        EPI_LOOP_ROWS { const int row = row0 + ai * HALF + m * 16; const float r_ = rsv[ai][m]; bf16_t* rowp = H + (size_t)row * 512 + col0; f32x4 v0, v1;
#pragma unroll
            for (int j = 0; j < 4; ++j) { const float g0 = acc[ai][0][m][0][j] * r_, g1 = acc[ai][0][m][1][j] * r_; v0[j] = g0 * sigmoidf_(g0) * (acc[ai][1][m][0][j] * r_); v1[j] = g1 * sigmoidf_(g1) * (acc[ai][1][m][1][j] * r_); }
            *(u32x4*)(rowp) = pack8(v0, v1); }
    }
};
struct EpiMoe2 {
    static constexpr bool PERM = true;
    bf16_t* Y; const float* roww;
    __device__ __forceinline__ void operator()(const f32x4 (&acc)[2][2][4][2], const Unit& u, int wr, int wc, int fr, int fq) const {
        const bool up = (fr & 8) != 0;
        const int rowb = u.pm * BM + wr * 64 + (fr & 7), colp = (u.pn & 3) * BM + wc * 64 + 8 * fq;
#pragma unroll
        EPI_LOOP_ROWS { const u32x4 a0 = pack8(acc[ai][0][m][0], acc[ai][0][m][1]), a1 = pack8(acc[ai][1][m][0], acc[ai][1][m][1]); u32x4 x1;
            x1.x = (unsigned)__builtin_amdgcn_update_dpp(0, (int)a1.x, 0x128, 0xf, 0xf, true); x1.y = (unsigned)__builtin_amdgcn_update_dpp(0, (int)a1.y, 0x128, 0xf, 0xf, true);
            x1.z = (unsigned)__builtin_amdgcn_update_dpp(0, (int)a1.z, 0x128, 0xf, 0xf, true); x1.w = (unsigned)__builtin_amdgcn_update_dpp(0, (int)a1.w, 0x128, 0xf, 0xf, true);
            bf16_t* r0p = Y + (size_t)(rowb + ai * HALF + m * 16) * 1024 + colp;
            *(u32x4*)(r0p + (up ? 32 : 0)) = up ? x1 : a0;
            *(u32x4*)(r0p + 8 * 1024 + (up ? 0 : 32)) = up ? a0 : x1; }
    }
};
struct EpiCmp {
    static constexpr bool PERM = true;
    bf16_t* O; const float* pb;
    __device__ __forceinline__ void operator()(const f32x4 (&acc)[2][2][4][2], const Unit& u, int wr, int wc, int fr, int fq) const {
        const int row0 = u.pm * BM + wr * 64 + fr, col0 = wc * 32 + 8 * fq;
        f32x4 bias[2][2][2];
#pragma unroll
        for (int ai = 0; ai < 2; ++ai)
#pragma unroll
            for (int bj = 0; bj < 2; ++bj)
#pragma unroll
                for (int hf = 0; hf < 2; ++hf) { const float* p = pb + (size_t)((u.pm >> 6) * 4 + ((2 * u.pm + ai) & 3)) * 256 + col0 + bj * HALF + 4 * hf;
                    bias[ai][bj][hf] = (*(const f32x4*)p + *(const f32x4*)(p + 2048)) + (*(const f32x4*)(p + 4096) + *(const f32x4*)(p + 6144)); }
#pragma unroll
        EPI_LOOP_ROWS { bf16_t* rowp = O + (size_t)(row0 + ai * HALF + m * 16) * 256 + col0;
#pragma unroll
            for (int bj = 0; bj < 2; ++bj) { f32x4 v0 = acc[ai][bj][m][0] + bias[ai][bj][0], v1 = acc[ai][bj][m][1] + bias[ai][bj][1];
#pragma unroll
                for (int j = 0; j < 4; ++j) { v0[j] = gelu_tanh_(v0[j]); v1[j] = gelu_tanh_(v1[j]); }
                *(u32x4*)(rowp + bj * HALF) = pack8(v0, v1); } }
    }
};
}

struct Args { const float* in[41]; float* out; unsigned char* ws; int ph_lo, ph_hi; };
enum { I_X = 0, I_ALN, I_AMU, I_AWR, I_AWK, I_AWV, I_AWO, I_AW0, I_AW1, I_AW2, I_AA0, I_AA1, I_AA2, I_AG1, I_AG2, I_AKK, I_AKA, I_ARK, I_ALNXW, I_ALNXB,
       I_KVLN, I_KVW, I_PEK, I_PEV, I_CKW1, I_CKW2, I_CVW1, I_CVW2, I_RELB, I_BLN, I_BWQG, I_BWO, I_MLN, I_MWG, I_MBG, I_MWE, I_MBE, I_MW1, I_MW3, I_MW2, I_FLN };

struct Fr { LAS unsigned char* lds; int tid, lane, wave, G, gw, ngw; };

__device__ __forceinline__ void tr_item(const float* W, int N, int Klim, int Nlim, int k0, int n0, bf16_t* out, long orow0, int ldo, int kout0,
                                        const float* sc, int scmode, LAS float* scr, int lane) {
    f32x4 ld[8];
#pragma unroll
    for (int i = 0; i < 8; ++i) { const int kk = 8 * i + (lane >> 3), k = k0 + kk, n = n0 + 4 * (lane & 7);
        ld[i] = (k < Klim && n < Nlim) ? *(const f32x4*)(W + (size_t)k * N + n) : (f32x4){0.f, 0.f, 0.f, 0.f}; }
#pragma unroll
    for (int i = 0; i < 8; ++i) { const int kk = 8 * i + (lane >> 3), k = k0 + kk; f32x4 v = ld[i];
        if (scmode && k < Klim) { const float sv = sc[k]; v = v * (scmode == 1 ? sv : 1.f - sv); }
        LAS float* d = scr + kk * 33 + 4 * (lane & 7); d[0] = v.x; d[1] = v.y; d[2] = v.z; d[3] = v.w; }
    LDS_WAIT(); asm volatile("" ::: "memory");
    const int c = lane & 7;
#pragma unroll
    for (int j = 0; j < 4; ++j) { const int n = (lane >> 3) + 8 * j; const LAS float* s = scr + (8 * c) * 33 + n;
        u32x4 o; o.x = pk2(s[0 * 33], s[1 * 33]); o.y = pk2(s[2 * 33], s[3 * 33]); o.z = pk2(s[4 * 33], s[5 * 33]); o.w = pk2(s[6 * 33], s[7 * 33]);
        *(u32x4*)(out + (size_t)(orow0 + n) * ldo + kout0 + 8 * c) = o; }
    LDS_WAIT(); asm volatile("" ::: "memory");
}
__device__ __forceinline__ void conv_mat(const Fr& F, const float* W, int K, int N, bf16_t* out, long orow0, int ldo, int kout0, const float* sc, int scmode, LAS float* scr) {
    const int nkb = (K + 63) / 64, nnb = (N + 31) / 32, nit = nkb * nnb;
    for (int it = F.gw; it < nit; it += F.ngw) { const int kb = it / nnb, nb = it % nnb;
        tr_item(W, N, K, N, kb * 64, nb * 32, out, orow0 + nb * 32, ldo, kout0 + kb * 64, sc, scmode, scr, F.lane); }
}
__device__ __forceinline__ void zero_rect(const Fr& F, bf16_t* out, int rows, int cols8, int ldo) {
    const long tot = (long)rows * cols8;
    for (long i = (long)F.gw * 64 + F.lane; i < tot; i += (long)F.ngw * 64) { const long r = i / cols8, c = i % cols8; *(u32x4*)(out + r * ldo + c * 8) = (u32x4){0u, 0u, 0u, 0u}; }
}
__device__ __forceinline__ bf16x8 pack8c(const float (&v)[8]) { u32x4 w; w.x = cvtpk(v[0], v[1]); w.y = cvtpk(v[2], v[3]); w.z = cvtpk(v[4], v[5]); w.w = cvtpk(v[6], v[7]); return __builtin_bit_cast(bf16x8, w); }
__device__ __forceinline__ void phase_conv(const Fr& F, const Args& a) {
    unsigned char* ws = a.ws;
    LAS float* scr = (LAS float*)(F.lds + F.wave * 8704);
    const float* mu = a.in[I_AMU];
    conv_mat(F, a.in[I_AWR], 1024, 1024, (bf16_t*)(ws + WS_WR), 0, 1024, 0, nullptr, 0, scr);
    conv_mat(F, a.in[I_AWK], 1024, 1024, (bf16_t*)(ws + WS_WK), 0, 1024, 0, nullptr, 0, scr);
    conv_mat(F, a.in[I_AWV], 1024, 1024, (bf16_t*)(ws + WS_WV), 0, 1024, 0, nullptr, 0, scr);
    conv_mat(F, a.in[I_AWO], 1024, 1024, (bf16_t*)(ws + WS_WO), 0, 1024, 0, nullptr, 0, scr);
    {
        bf16_t* o = (bf16_t*)(ws + WS_WL1);
        conv_mat(F, a.in[I_AW1], 1024, 64, o, 0, 2048, 0, mu + 1 * 1024, 2, scr);    conv_mat(F, a.in[I_AW1], 1024, 64, o, 0, 2048, 1024, mu + 1 * 1024, 1, scr);
        conv_mat(F, a.in[I_AA1], 1024, 64, o, 64, 2048, 0, mu + 4 * 1024, 2, scr);   conv_mat(F, a.in[I_AA1], 1024, 64, o, 64, 2048, 1024, mu + 4 * 1024, 1, scr);
        conv_mat(F, a.in[I_AG1], 1024, 160, o, 128, 2048, 0, mu + 5 * 1024, 2, scr); conv_mat(F, a.in[I_AG1], 1024, 160, o, 128, 2048, 1024, mu + 5 * 1024, 1, scr);
        zero_rect(F, o + (size_t)288 * 2048, 224, 256, 2048);
    }
    {
        bf16_t* o = (bf16_t*)(ws + WS_W2WA);
        conv_mat(F, a.in[I_AW2], 64, 1024, o, 0, 128, 0, nullptr, 0, scr);
        zero_rect(F, o + 64, 1024, 8, 128);
        conv_mat(F, a.in[I_AA2], 64, 1024, o, 1024, 128, 64, nullptr, 0, scr);
        zero_rect(F, o + (size_t)1024 * 128, 1024, 8, 128);
    }
    {
        bf16_t* o = (bf16_t*)(ws + WS_W2G);
        conv_mat(F, a.in[I_AG2], 160, 1024, o, 0, 256, 0, nullptr, 0, scr);
        zero_rect(F, o + 192, 1024, 8, 256);
    }
    {
        bf16_t* o = (bf16_t*)(ws + WS_WKVQG);
        conv_mat(F, a.in[I_KVW], 1024, 1536, o, 0, 1024, 0, a.in[I_KVLN], 1, scr);
        conv_mat(F, a.in[I_BWQG], 1024, 1072, o, 1536, 1024, 0, a.in[I_BLN], 1, scr);
        zero_rect(F, o + (size_t)2624 * 1024, 192, 128, 1024);
    }
    conv_mat(F, a.in[I_BWO], 1024, 1024, (bf16_t*)(ws + WS_WOB), 0, 1024, 0, nullptr, 0, scr);
    conv_mat(F, a.in[I_CKW1], 2048, 256, (bf16_t*)(ws + WS_WC1), 0, 2048, 0, nullptr, 0, scr);
    conv_mat(F, a.in[I_CVW1], 2048, 256, (bf16_t*)(ws + WS_WC1) + (size_t)256 * 2048, 0, 2048, 0, nullptr, 0, scr);
    {
        bf16_t* o1 = (bf16_t*)(ws + WS_BT1); bf16_t* o2 = (bf16_t*)(ws + WS_BT2);
        for (int it = F.gw; it < 64 * 256; it += F.ngw) { const int mat = it >> 8, r = it & 255, kb = r >> 4, nb = r & 15, n0 = nb * 32;
            const long orow = (long)mat * 1024 + (n0 >> 7) * 256 + (n0 & 127);
            const float* gm = a.in[I_MLN] + (mat >> 5) * 1024;
            tr_item(a.in[I_MW1] + (size_t)mat * 1024 * 512, 512, 1024, 512, kb * 64, n0, o1, orow, 1024, kb * 64, gm, 1, scr, F.lane);
            tr_item(a.in[I_MW3] + (size_t)mat * 1024 * 512, 512, 1024, 512, kb * 64, n0, o1, orow + 128, 1024, kb * 64, gm, 1, scr, F.lane); }
        for (int it = F.gw; it < 64 * 256; it += F.ngw) { const int mat = it >> 8, r = it & 255, kb = r >> 5, nb = r & 31;
            tr_item(a.in[I_MW2] + (size_t)mat * 512 * 1024, 1024, 512, 1024, kb * 64, nb * 32, o2, (long)mat * 1024 + nb * 32, 512, kb * 64, nullptr, 0, scr, F.lane); }
    }
    {
        int* ci = (int*)(ws + WS_CIDX);
        for (int r = F.gw * 64 + F.lane; r < 2 * 16384; r += F.ngw * 64) { const int grp = r >> 14, rr = r & 16383, bg = rr >> 7, n = rr & 127; ci[r] = ((bg >> 2) * SEQ + 16 * n) * 24 + grp * 4 + (bg & 3); }
        if (F.wave == 0 && blockIdx.x < 128) { const int id = blockIdx.x, grp = id >> 6, nb = (id >> 2) & 15, kq = id & 3, i = F.lane & 15, q = F.lane >> 4;
            const float* pe = a.in[grp ? I_PEV : I_PEK] + (size_t)(i & 3) * 2048 + kq * 512 + 8 * q; const float* w = a.in[grp ? I_CVW1 : I_CKW1] + (size_t)(kq * 512 + 8 * q) * 256 + 16 * nb + i;
            f32x4 acc = (f32x4){0.f, 0.f, 0.f, 0.f};
#pragma unroll 2
            for (int sk = 0; sk < 16; ++sk) { const f32x4 p0 = *(const f32x4*)(pe + 32 * sk), p1 = *(const f32x4*)(pe + 32 * sk + 4);
                float wv[8];
#pragma unroll
                for (int e = 0; e < 8; ++e) wv[e] = w[(size_t)(32 * sk + e) * 256];
                const float pv[8] = {p0.x, p0.y, p0.z, p0.w, p1.x, p1.y, p1.z, p1.w}; float pl[8];
#pragma unroll
                for (int e = 0; e < 8; ++e) pl[e] = pv[e] - bflo(f2bf(pv[e]));
                const bf16x8 ah = pack8c(pv), al = pack8c(pl), bw = pack8c(wv);
                acc = __builtin_amdgcn_mfma_f32_16x16x32_bf16(ah, bw, acc, 0, 0, 0); acc = __builtin_amdgcn_mfma_f32_16x16x32_bf16(al, bw, acc, 0, 0, 0); }
            if (F.lane < 16) { float* pb = (float*)(ws + WS_PEBP) + ((size_t)(kq * 2 + grp) * 4) * 256 + 16 * nb + i;
#pragma unroll
                for (int rg = 0; rg < 4; ++rg) pb[rg * 256] = acc[rg]; }
        }
    }
    {
        bf16_t* o = (bf16_t*)(ws + WS_W2F);
        for (int i = F.gw * 64 + F.lane; i < 2 * 16384; i += F.ngw * 64) { const int e = i & 7, ln = (i >> 3) & 63, nb = (i >> 9) & 3, sk = (i >> 11) & 7, grp = i >> 14;
            const int k = 32 * sk + 8 * (ln >> 4) + e, n = 16 * nb + (ln & 15); const float v = a.in[grp ? I_CVW2 : I_CKW2][k * 64 + n];
            const unsigned hi = f2bf(v), lo = f2bf(v - bflo(hi));
            bf16_t* ob = o + ((size_t)((grp * 8 + sk) * 2) * 4 + nb) * 512 + ln * 8 + e; ob[0] = (bf16_t)hi; ob[4 * 512] = (bf16_t)lo; }
    }
    {
        bf16_t* o = (bf16_t*)(ws + WS_RFRAG);
        for (int i = F.gw * 64 + F.lane; i < 2 * 49152; i += F.ngw * 64) { const int layer = i / 49152, r = i % 49152, e = r & 7, ln = (r >> 3) & 63, nt = (r >> 9) % 3, s = r / 1536;
            const int k = 32 * s + 8 * (ln >> 4) + e, n = 16 * nt + (ln & 15);
            float v = 0.f; if (n < 4) v = a.in[I_MWG][((size_t)layer * 1024 + k) * 4 + n]; else if (n < 36) v = a.in[I_MWE][((size_t)layer * 1024 + k) * 32 + (n - 4)];
            v *= a.in[I_MLN][layer * 1024 + k];
            const unsigned hi = f2bf(v); const float r1 = v - bflo(hi); const unsigned lo = f2bf(r1); const float r2 = r1 - bflo(lo); const unsigned lo2 = f2bf(r2);
            bf16_t* ob = o + ((size_t)(layer * 32 + s) * 9 + nt) * 512 + ln * 8 + e;
            ob[0] = (bf16_t)hi; ob[3 * 512] = (bf16_t)lo; ob[6 * 512] = (bf16_t)lo2; }
    }
}

__device__ __forceinline__ void phase_r1(const Fr& F, const Args& a) {
    unsigned char* ws = a.ws; const float* x = a.in[I_X];
    bf16_t* XN = (bf16_t*)(ws + WS_S5); bf16_t* XR = (bf16_t*)(ws + WS_S0); bf16_t* XK = (bf16_t*)(ws + WS_S1); bf16_t* XV = (bf16_t*)(ws + WS_S2);
    f32x4 gn[4], mr[4], mk[4], mv[4];
#pragma unroll
    for (int j = 0; j < 4; ++j) { const int c = 256 * j + 4 * F.lane; gn[j] = *(const f32x4*)(a.in[I_ALN] + c); mr[j] = *(const f32x4*)(a.in[I_AMU] + 0 * 1024 + c);
        mk[j] = *(const f32x4*)(a.in[I_AMU] + 2 * 1024 + c); mv[j] = *(const f32x4*)(a.in[I_AMU] + 3 * 1024 + c); }
    for (int run = F.gw; run < NT / 32; run += F.ngw) {
        const int m0 = run * 32, b = m0 >> 11, t0 = m0 & 2047;
        f32x4 pv[4];
        if (t0 == 0) {
#pragma unroll
            for (int j = 0; j < 4; ++j) { pv[j] = (f32x4){0.f, 0.f, 0.f, 0.f}; *(u32x2*)(XN + (size_t)(b * 2049) * 1024 + 256 * j + 4 * F.lane) = (u32x2){0u, 0u}; }
        } else {
            const f32x4* xr = (const f32x4*)(x + (size_t)(m0 - 1) * 1024) + F.lane; float s = 0.f;
#pragma unroll
            for (int j = 0; j < 4; ++j) { pv[j] = xr[64 * j]; s += (pv[j].x * pv[j].x + pv[j].y * pv[j].y) + (pv[j].z * pv[j].z + pv[j].w * pv[j].w); }
            const float rstd = 1.f / sqrtf(wave_sum(s) * (1.f / 1024.f) + 1e-6f);
#pragma unroll
            for (int j = 0; j < 4; ++j) pv[j] = pv[j] * rstd * gn[j];
        }
        f32x4 nx[4];
        { const f32x4* xr = (const f32x4*)(x + (size_t)m0 * 1024) + F.lane;
#pragma unroll
          for (int j = 0; j < 4; ++j) nx[j] = xr[64 * j]; }
        for (int i = 0; i < 32; ++i) {
            const int m = m0 + i;
            f32x4 v[4]; float s = 0.f;
#pragma unroll
            for (int j = 0; j < 4; ++j) v[j] = nx[j];
            if (i < 31) { const f32x4* xr = (const f32x4*)(x + (size_t)(m + 1) * 1024) + F.lane;
#pragma unroll
                for (int j = 0; j < 4; ++j) nx[j] = xr[64 * j]; }
#pragma unroll
            for (int j = 0; j < 4; ++j) s += (v[j].x * v[j].x + v[j].y * v[j].y) + (v[j].z * v[j].z + v[j].w * v[j].w);
            const float rstd = 1.f / sqrtf(wave_sum(s) * (1.f / 1024.f) + 1e-6f);
            const size_t prow = (size_t)(m + b + 1) * 1024, row = (size_t)m * 1024;
#pragma unroll
            for (int j = 0; j < 4; ++j) { const int c = 256 * j + 4 * F.lane;
                const f32x4 cur = v[j] * rstd * gn[j], xx = pv[j] - cur;
                *(u32x2*)(XN + prow + c) = (u32x2){pk2(cur.x, cur.y), pk2(cur.z, cur.w)};
                const f32x4 r_ = cur + xx * mr[j], k_ = cur + xx * mk[j], v_ = cur + xx * mv[j];
                *(u32x2*)(XR + row + c) = (u32x2){pk2(r_.x, r_.y), pk2(r_.z, r_.w)};
                *(u32x2*)(XK + row + c) = (u32x2){pk2(k_.x, k_.y), pk2(k_.z, k_.w)};
                *(u32x2*)(XV + row + c) = (u32x2){pk2(v_.x, v_.y), pk2(v_.z, v_.w)};
                pv[j] = cur; }
        }
    }
}

typedef float f32x16 __attribute__((ext_vector_type(16)));
__device__ __forceinline__ bf16x8 pack8f(float a0, float a1, float a2, float a3, float a4, float a5, float a6, float a7) {
    u32x4 w; w.x = cvtpk(a0, a1); w.y = cvtpk(a2, a3); w.z = cvtpk(a4, a5); w.w = cvtpk(a6, a7); return __builtin_bit_cast(bf16x8, w); }
__device__ __forceinline__ bf16x8 packacc(const f32x16& v, int s2) { return pack8f(v[8 * s2], v[8 * s2 + 1], v[8 * s2 + 2], v[8 * s2 + 3], v[8 * s2 + 4], v[8 * s2 + 5], v[8 * s2 + 6], v[8 * s2 + 7]); }
__device__ __forceinline__ int swap23(int w) { return (w & ~12) | ((w & 4) << 1) | ((w & 8) >> 1); }
constexpr int SC_AT = 0, SC_RT = 4096, SC_BJ = 8192, SC_KJ = 12288, SC_VI = 16384, SC_BT = 20480, SC_KT = 24576, SC_TT = 20480, SC_AAKT = 22528, SC_ABRT = 24576, SC_AKRT = 26624,
              SC_GL = 28672, SC_SS = 28928, SC_SLOT = 29184, SC_YB = 4 * SC_SLOT, SC_BON = SC_YB + 32768;
template <int HALF, int BIT>
__device__ __forceinline__ void reduce32_stage(float (&v)[32], int lane) {
    const bool up = (lane & BIT) != 0; const int addr = (lane ^ BIT) << 2;
#pragma unroll
    for (int i = 0; i < HALF; ++i) { const float keep = up ? v[i + HALF] : v[i], send = up ? v[i] : v[i + HALF];
        v[i] = keep + __int_as_float(__builtin_amdgcn_ds_bpermute(addr, __float_as_int(send))); }
}
__device__ __forceinline__ float reduce32(float (&v)[32], int lane) {
#pragma unroll
    for (int i = 0; i < 16; ++i) { const auto r = __builtin_amdgcn_permlane32_swap(__float_as_uint(v[i]), __float_as_uint(v[i + 16]), false, false); v[i] = __uint_as_float(r[0]) + __uint_as_float(r[1]); }
#pragma unroll
    for (int i = 0; i < 8; ++i) { const auto r = __builtin_amdgcn_permlane16_swap(__float_as_uint(v[i]), __float_as_uint(v[i + 8]), false, false); v[i] = __uint_as_float(r[0]) + __uint_as_float(r[1]); }
    { const bool up = (lane & 8) != 0;
#pragma unroll
      for (int i = 0; i < 4; ++i) { const float keep = up ? v[i + 4] : v[i], send = up ? v[i] : v[i + 4]; v[i] = keep + dppf<DPP_ROR8>(send); } }
    reduce32_stage<2, 4>(v, lane);
    { const bool up = (lane & 2) != 0; const float keep = up ? v[1] : v[0], send = up ? v[0] : v[1]; v[0] = keep + dppf<DPP_XOR2>(send); }
    return v[0] + dppf<DPP_XOR1>(v[0]);
}
#define SC_RAW(area, t) bf2f(*(const LAS bf16_t*)(slot + (area) + (t) * 128 + lane * 2))
#define SC_BARRIER() do { asm volatile("s_waitcnt lgkmcnt(0)" ::: "memory"); __builtin_amdgcn_s_barrier(); asm volatile("" ::: "memory"); } while (0)
struct ScanRaw { u32x4 v[10]; unsigned lwp[16]; };
__device__ __forceinline__ void scan_load(const Args& a, ScanRaw& R, int chain, int t0, int half, int lane) {
    unsigned char* ws = a.ws; const int tb = 16 * half;
    const unsigned char* Rb = ws + WS_S3; const unsigned char* LWb = ws + WS_S0; const unsigned char* Kb = ws + WS_S4; const unsigned char* Vb = (const unsigned char*)a.out; const unsigned char* Ab = ws + WS_S1;
    const size_t rowb = ((size_t)chain * SEQ + t0) * 128;
#pragma unroll
    for (int q = 0; q < 2; ++q) { const size_t o = rowb + (size_t)(tb + 8 * q) * 128 + lane * 16;
        R.v[5 * q + 0] = *(const u32x4*)(Ab + o); R.v[5 * q + 1] = *(const u32x4*)(Rb + o); R.v[5 * q + 2] = *(const u32x4*)(LWb + o); R.v[5 * q + 3] = *(const u32x4*)(Kb + o); R.v[5 * q + 4] = *(const u32x4*)(Vb + o); }
    if (half) {
#pragma unroll
        for (int m = 0; m < 16; ++m) R.lwp[m] = (unsigned)*(const bf16_t*)(LWb + rowb + (size_t)m * 128 + lane * 2); }
}
__device__ __forceinline__ void scan_pre(const Fr& F, const Args& a, LAS unsigned char* slot, LAS float* bon, LAS unsigned char* ysc, int chain, int t0, int half, ScanRaw& R, bool more, float kkc, float kac, float rkc) {
    unsigned char* ws = a.ws;
    int lane = F.lane; asm volatile("" : "+v"(lane));
    { unsigned so = (unsigned)(size_t)slot; asm volatile("" : "+s"(so)); slot = (LAS unsigned char*)(size_t)so; }
    const int b = chain >> 4, hd = chain & 15, ch = hd * 64 + lane, r = lane & 31, h = lane >> 5, tb = 16 * half;
    float cum = 0.f;
    if (half) {
#pragma unroll
        for (int m = 0; m < 16; ++m) cum += bflo(R.lwp[m]); }
    {
#pragma unroll
        for (int q = 0; q < 2; ++q) { const int lo2 = (tb + 8 * q) * 128 + lane * 16;
            *(LAS u32x4*)(slot + SC_AT + lo2) = R.v[5 * q + 0]; *(LAS u32x4*)(slot + SC_RT + lo2) = R.v[5 * q + 1]; *(LAS u32x4*)(slot + SC_BT + lo2) = R.v[5 * q + 2]; *(LAS u32x4*)(slot + SC_KT + lo2) = R.v[5 * q + 3]; *(LAS u32x4*)(slot + SC_BJ + lo2) = R.v[5 * q + 4]; }
        LDS_WAIT();
        if (more) scan_load(a, R, chain, t0 + 64, half, lane);
    }
    float kq[16], aq[16], rq[16];
    {
        float q[32];
#pragma unroll
        for (int tt = 0; tt < 16; ++tt) { const float k = SC_RAW(SC_KT, tb + tt), av = SC_RAW(SC_AT, tb + tt), rv = SC_RAW(SC_RT, tb + tt); kq[tt] = k; aq[tt] = av; rq[tt] = rv;
            const float kkv = k * kkc; q[tt] = kkv * kkv; q[16 + tt] = rv * (k * (1.f + (av - 1.f) * kac)) * rkc; }
        const float s1 = reduce32(q, lane); const int idx = (lane >> 1) & 31;
        if ((lane & 1) == 0) { if (idx < 16) ((LAS float*)(slot + SC_SS))[tb + idx] = s1; else bon[tb + idx - 16] = s1; }
    }
    unsigned vv[8];
#pragma unroll
    for (int m = 0; m < 8; ++m) vv[m] = (unsigned)*(const LAS bf16_t*)(slot + SC_BJ + (tb + 2 * m) * 128 + lane * 2) | ((unsigned)*(const LAS bf16_t*)(slot + SC_BJ + (tb + 2 * m + 1) * 128 + lane * 2) << 16);
    LDS_WAIT(); asm volatile("" ::: "memory");
    const int pj = (lane & 48) | swap23(lane & 15);
    const int pjc = pj >> 3, pjw = (pj & 7) * 2;
    unsigned bj[8], kj[8]; float gprev = half ? fexp_(cum) : 1.f, gl = 1.f;
    f32x4 ssv[4];
#pragma unroll
    for (int q4 = 0; q4 < 4; ++q4) ssv[q4] = *(const LAS f32x4*)(slot + SC_SS + (tb + 4 * q4) * 4);
    const bool odd = (lane & 1) != 0; const int pjwe = pjw & ~2;
#define SC_PAIR_STORE(area, x) do { const float _snd = odd ? x[0] : x[1]; const float _rcv = dppf<DPP_XOR1>(_snd); *(LAS unsigned*)(slot + (area) + ro) = cvtpk(odd ? _rcv : x[0], odd ? x[1] : _rcv); } while (0)
#pragma unroll
    for (int tp = 0; tp < 8; ++tp) { const int t0 = tb + 2 * tp;
        float atv[2], rtv[2], btv[2], ktv[2];
#pragma unroll
        for (int u = 0; u < 2; ++u) { const int tt = 2 * tp + u;
            const float k = kq[tt], av = aq[tt], rv = rq[tt], lw = SC_RAW(SC_BT, tb + tt);
            cum += lw; const float g = fexp_(cum), ginv = __builtin_amdgcn_rcpf(g);
            const float ss = ssv[tt >> 2][tt & 3];
            const float kk = k * kkc * __builtin_amdgcn_rsqf(fmaxf(ss, 1e-24f)); const float kp = k * (1.f + (av - 1.f) * kac);
            atv[u] = -kk * gprev; btv[u] = kk * av * ginv; ktv[u] = kp * ginv; rtv[u] = rv * g;
            gprev = g; gl = g; }
        bj[tp] = cvtpk(btv[0], btv[1]); kj[tp] = cvtpk(ktv[0], ktv[1]);
        const int ro = (t0 + (odd ? 1 : 0)) * 128 + ((pjc ^ ((t0 >> 1) & 7)) << 4) + pjwe;
        SC_PAIR_STORE(SC_AT, atv); SC_PAIR_STORE(SC_RT, rtv); SC_PAIR_STORE(SC_BT, btv); SC_PAIR_STORE(SC_KT, ktv);
    }
#undef SC_PAIR_STORE
    SC_BARRIER();
#pragma unroll
    for (int cc = 0; cc < 2; ++cc) { const int c = 2 * half + cc, m0 = 2 * cc; const int ro = lane * 64 + ((c ^ ((lane >> 2) & 3)) << 4);
        *(LAS u32x4*)(slot + SC_BJ + ro) = (u32x4){bj[m0], bj[m0 + 1], bj[m0 + 4], bj[m0 + 5]};
        *(LAS u32x4*)(slot + SC_KJ + ro) = (u32x4){kj[m0], kj[m0 + 1], kj[m0 + 4], kj[m0 + 5]};
        *(LAS u32x4*)(slot + SC_VI + ro) = (u32x4){vv[m0], vv[m0 + 1], vv[m0 + 4], vv[m0 + 5]}; }
    if (half) ((LAS float*)(slot + SC_GL))[lane] = gl;
    const int swz = (r >> 1) & 7;
    f32x16 D0, D1, D2;
#pragma unroll
    for (int i = 0; i < 16; ++i) { D0[i] = 0.f; D1[i] = 0.f; D2[i] = 0.f; }
    if (half == 0) {
#pragma unroll
        for (int ks = 0; ks < 4; ++ks) { const int ao = r * 128 + (((2 * ks + h) ^ swz) << 4);
            D0 = __builtin_amdgcn_mfma_f32_32x32x16_bf16(*(const LAS bf16x8*)(slot + SC_BT + ao), *(const LAS bf16x8*)(slot + SC_AT + ao), D0, 0, 0, 0); }
    } else {
#pragma unroll
        for (int ks = 0; ks < 4; ++ks) { const int ao = r * 128 + (((2 * ks + h) ^ swz) << 4);
            const bf16x8 bA = *(const LAS bf16x8*)(slot + SC_BT + ao), kA = *(const LAS bf16x8*)(slot + SC_KT + ao), aB = *(const LAS bf16x8*)(slot + SC_AT + ao), rB = *(const LAS bf16x8*)(slot + SC_RT + ao);
            D0 = __builtin_amdgcn_mfma_f32_32x32x16_bf16(kA, aB, D0, 0, 0, 0); D1 = __builtin_amdgcn_mfma_f32_32x32x16_bf16(bA, rB, D1, 0, 0, 0); D2 = __builtin_amdgcn_mfma_f32_32x32x16_bf16(kA, rB, D2, 0, 0, 0); }
    }
    SC_BARRIER();
    if (half == 0) {
        const int sw4 = (r >> 2) & 3; int bo[2];
#pragma unroll
        for (int s2 = 0; s2 < 2; ++s2) bo[s2] = r * 64 + (((2 * s2 + h) ^ sw4) << 4);
        const int pcol = (r & 16) | swap23(r & 15), pcc = pcol >> 3, pcw = (pcol & 7) * 2;
        f32x16 Mx, Tx;
#pragma unroll
        for (int reg = 0; reg < 16; ++reg) { const int sr = (reg & 3) + 8 * (reg >> 2) + 4 * h; const float av = (sr < r) ? D0[reg] : 0.f; Mx[reg] = av; Tx[reg] = av + ((sr == r) ? 1.f : 0.f); }
#pragma unroll
        for (int it = 0; it < 4; ++it) {
#pragma unroll
            for (int reg = 0; reg < 16; ++reg) { const int sr = (reg & 3) + 8 * (reg >> 2) + 4 * h; const int ad = sr * 64 + ((pcc ^ ((sr >> 2) & 3)) << 4) + pcw;
                *(LAS bf16_t*)(ysc + ad) = (bf16_t)f2bf(Mx[reg]); *(LAS bf16_t*)(ysc + 2048 + ad) = (bf16_t)f2bf(Tx[reg]); }
            LDS_WAIT(); asm volatile("" ::: "memory");
            bf16x8 mb[2], m2b[2];
#pragma unroll
            for (int s2 = 0; s2 < 2; ++s2) mb[s2] = packacc(Mx, s2);
            f32x16 M2;
#pragma unroll
            for (int i = 0; i < 16; ++i) M2[i] = 0.f;
#pragma unroll
            for (int s2 = 0; s2 < 2; ++s2) M2 = __builtin_amdgcn_mfma_f32_32x32x16_bf16(*(const LAS bf16x8*)(ysc + bo[s2]), mb[s2], M2, 0, 0, 0);
#pragma unroll
            for (int s2 = 0; s2 < 2; ++s2) m2b[s2] = packacc(M2, s2);
#pragma unroll
            for (int s2 = 0; s2 < 2; ++s2) Tx = __builtin_amdgcn_mfma_f32_32x32x16_bf16(*(const LAS bf16x8*)(ysc + 2048 + bo[s2]), m2b[s2], Tx, 0, 0, 0);
            Mx = M2;
            LDS_WAIT(); asm volatile("" ::: "memory");
        }
#pragma unroll
        for (int g = 0; g < 4; ++g) { const int ro = r * 64 + (((2 * (g >> 1) + h) ^ sw4) << 4) + 8 * (g & 1);
            *(LAS u32x2*)(slot + SC_TT + ro) = (u32x2){cvtpk(Tx[4 * g], Tx[4 * g + 1]), cvtpk(Tx[4 * g + 2], Tx[4 * g + 3])}; }
    } else {
#pragma unroll
        for (int reg = 0; reg < 16; ++reg) { const int sr = (reg & 3) + 8 * (reg >> 2) + 4 * h; D0[reg] = (sr < r) ? D0[reg] : 0.f; D1[reg] = (sr <= r) ? D1[reg] : 0.f; D2[reg] = (sr <= r) ? D2[reg] : 0.f; }
        const int sw4 = (r >> 2) & 3;
#pragma unroll
        for (int g = 0; g < 4; ++g) { const int ro = r * 64 + (((2 * (g >> 1) + h) ^ sw4) << 4) + 8 * (g & 1);
            *(LAS u32x2*)(slot + SC_AAKT + ro) = (u32x2){cvtpk(D0[4 * g], D0[4 * g + 1]), cvtpk(D0[4 * g + 2], D0[4 * g + 3])};
            *(LAS u32x2*)(slot + SC_ABRT + ro) = (u32x2){cvtpk(D1[4 * g], D1[4 * g + 1]), cvtpk(D1[4 * g + 2], D1[4 * g + 3])};
            *(LAS u32x2*)(slot + SC_AKRT + ro) = (u32x2){cvtpk(D2[4 * g], D2[4 * g + 1]), cvtpk(D2[4 * g + 2], D2[4 * g + 3])}; }
    }
}
__device__ __forceinline__ void scan_seq(LAS unsigned char* slot, LAS bf16_t* yb, int ib, int lane, f32x16 (&Z)[2]) {
    asm volatile("" : "+v"(lane));
    { unsigned so = (unsigned)(size_t)slot; asm volatile("" : "+s"(so)); slot = (LAS unsigned char*)(size_t)so; }
    const int r = lane & 31, h = lane >> 5, swz = (r >> 1) & 7, sw4 = (r >> 2) & 3;
    int ao[4], bo[2];
#pragma unroll
    for (int ks = 0; ks < 4; ++ks) ao[ks] = r * 128 + (((2 * ks + h) ^ swz) << 4);
#pragma unroll
    for (int s2 = 0; s2 < 2; ++s2) bo[s2] = r * 64 + (((2 * s2 + h) ^ sw4) << 4);
    bf16x8 zb[4], vB[2], xb[2], pb[2];
#pragma unroll
    for (int jb = 0; jb < 2; ++jb)
#pragma unroll
        for (int s2 = 0; s2 < 2; ++s2) zb[2 * jb + s2] = packacc(Z[jb], s2);
#pragma unroll
    for (int s2 = 0; s2 < 2; ++s2) vB[s2] = *(const LAS bf16x8*)(slot + SC_VI + ib * 2048 + bo[s2]);
    f32x16 X, P, Y;
#pragma unroll
    for (int i = 0; i < 16; ++i) { X[i] = 0.f; P[i] = 0.f; Y[i] = 0.f; }
#pragma unroll
    for (int ks = 0; ks < 4; ++ks) X = __builtin_amdgcn_mfma_f32_32x32x16_bf16(*(const LAS bf16x8*)(slot + SC_AT + ao[ks]), zb[ks], X, 0, 0, 0);
#pragma unroll
    for (int s2 = 0; s2 < 2; ++s2) X = __builtin_amdgcn_mfma_f32_32x32x16_bf16(*(const LAS bf16x8*)(slot + SC_AAKT + bo[s2]), vB[s2], X, 0, 0, 0);
#pragma unroll
    for (int s2 = 0; s2 < 2; ++s2) xb[s2] = packacc(X, s2);
#pragma unroll
    for (int s2 = 0; s2 < 2; ++s2) P = __builtin_amdgcn_mfma_f32_32x32x16_bf16(*(const LAS bf16x8*)(slot + SC_TT + bo[s2]), xb[s2], P, 0, 0, 0);
#pragma unroll
    for (int s2 = 0; s2 < 2; ++s2) pb[s2] = packacc(P, s2);
#pragma unroll
    for (int ks = 0; ks < 4; ++ks) Y = __builtin_amdgcn_mfma_f32_32x32x16_bf16(*(const LAS bf16x8*)(slot + SC_RT + ao[ks]), zb[ks], Y, 0, 0, 0);
#pragma unroll
    for (int s2 = 0; s2 < 2; ++s2) { Y = __builtin_amdgcn_mfma_f32_32x32x16_bf16(*(const LAS bf16x8*)(slot + SC_ABRT + bo[s2]), pb[s2], Y, 0, 0, 0);
        Y = __builtin_amdgcn_mfma_f32_32x32x16_bf16(*(const LAS bf16x8*)(slot + SC_AKRT + bo[s2]), vB[s2], Y, 0, 0, 0); }
#pragma unroll
    for (int jb = 0; jb < 2; ++jb) {
#pragma unroll
        for (int s2 = 0; s2 < 2; ++s2) { Z[jb] = __builtin_amdgcn_mfma_f32_32x32x16_bf16(*(const LAS bf16x8*)(slot + SC_BJ + jb * 2048 + bo[s2]), pb[s2], Z[jb], 0, 0, 0);
            Z[jb] = __builtin_amdgcn_mfma_f32_32x32x16_bf16(*(const LAS bf16x8*)(slot + SC_KJ + jb * 2048 + bo[s2]), vB[s2], Z[jb], 0, 0, 0); }
#pragma unroll
        for (int g = 0; g < 4; ++g) { const f32x4 gl4 = *(const LAS f32x4*)(slot + SC_GL + (32 * jb + 8 * g + 4 * h) * 4);
            Z[jb][4 * g] *= gl4.x; Z[jb][4 * g + 1] *= gl4.y; Z[jb][4 * g + 2] *= gl4.z; Z[jb][4 * g + 3] *= gl4.w; } }
#pragma unroll
    for (int reg = 0; reg < 16; ++reg) yb[((reg & 3) + 8 * (reg >> 2) + 4 * h) * 64 + ib * 32 + r] = (bf16_t)f2bf(Y[reg]);
}
__device__ __forceinline__ void phase_scan(const Fr& F, const Args& a) {
    unsigned char* ws = a.ws; const bf16_t* Vb = (const bf16_t*)a.out; const bf16_t* Gb = (const bf16_t*)(ws + WS_S2); bf16_t* YG = (bf16_t*)(ws + WS_S5);
    LAS bf16_t* YB = (LAS bf16_t*)(F.lds + SC_YB);
    LAS float* BON = (LAS float*)(F.lds + SC_BON);
    const int w = F.wave, lane = F.lane;
    for (int cp = blockIdx.x; cp < 256; cp += F.G) {
        f32x16 Z[2];
#pragma unroll
        for (int i = 0; i < 16; ++i) { Z[0][i] = 0.f; Z[1][i] = 0.f; }
        ScanRaw R; scan_load(a, R, 2 * cp + ((w & 3) >> 1), 32 * (w & 1), w >> 2, lane);
        const int chp = ((2 * cp + ((w & 3) >> 1)) & 15) * 64 + lane; float kkc = a.in[I_AKK][chp], kac = a.in[I_AKA][chp], rkc = a.in[I_ARK][chp];
        asm volatile("" : "+v"(kkc), "+v"(kac), "+v"(rkc));
#pragma unroll 1
        for (int bt = 0; bt <= 32; ++bt) {
            SC_BARRIER();
            if (bt < 32) { const int sl = w & 3;
                scan_pre(F, a, F.lds + sl * SC_SLOT, BON + (bt & 1) * 128 + (sl >> 1) * 64 + (sl & 1) * 32, F.lds + SC_YB + (bt & 1) * 16384 + sl * 4096, 2 * cp + (sl >> 1), 64 * bt + 32 * (sl & 1), w >> 2, R, bt < 31, kkc, kac, rkc); }
            SC_BARRIER();
            if (w >= 4) { if (bt < 32) { const int cl = (w - 4) >> 1, ib = (w - 4) & 1;
                scan_seq(F.lds + (2 * cl) * SC_SLOT, YB + (bt & 1) * 8192 + cl * 4096, ib, lane, Z);
                scan_seq(F.lds + (2 * cl + 1) * SC_SLOT, YB + (bt & 1) * 8192 + cl * 4096 + 2048, ib, lane, Z); } }
            else if (bt >= 1) {
                const int cl = w >> 1, chain = 2 * cp + cl, b = chain >> 4, hd = chain & 15, ch = hd * 64 + lane; const float lw_ = a.in[I_ALNXW][ch], lb_ = a.in[I_ALNXB][ch];
                LAS f32x2* ST = (LAS f32x2*)(F.lds + SC_BON + 1024) + w * 32;
                const int tb = 32 * (w & 1); const LAS bf16_t* yp = YB + ((bt - 1) & 1) * 8192 + cl * 4096 + tb * 64 + lane;
                const size_t go = ((size_t)chain * SEQ + 64 * (bt - 1) + tb) * 64 + lane; const bf16_t* vp = Vb + go; const bf16_t* gp = Gb + go; bf16_t* op = YG + go;
                const LAS float* bp = BON + ((bt - 1) & 1) * 128 + cl * 64 + tb;
#pragma unroll 1
                for (int hh = 0; hh < 2; ++hh) {
                    unsigned vg[16];
#pragma unroll
                    for (int tt = 0; tt < 16; ++tt) vg[tt] = (unsigned)vp[(16 * hh + tt) * 64] | ((unsigned)gp[(16 * hh + tt) * 64] << 16);
                    float yq[16];
                    {
                        float q[32];
#pragma unroll
                        for (int tt = 0; tt < 16; ++tt) { const float y = bf2f(yp[(16 * hh + tt) * 64]); yq[tt] = y; q[tt] = y; q[16 + tt] = y * y; }
                        const float s1 = reduce32(q, lane); const int idx = (lane >> 1) & 31;
                        LAS float* STf = (LAS float*)ST;
                        if ((lane & 1) == 0) STf[idx] = s1;
                    }
                    LDS_WAIT(); asm volatile("" ::: "memory");
                    f32x4 sm[4], sq[4], bv4[4];
#pragma unroll
                    for (int q4 = 0; q4 < 4; ++q4) { sm[q4] = ((const LAS f32x4*)ST)[q4]; sq[q4] = ((const LAS f32x4*)ST)[4 + q4]; bv4[q4] = *(const LAS f32x4*)(bp + 16 * hh + 4 * q4); }
#pragma unroll
                    for (int tt = 0; tt < 16; ++tt) { const int t = 16 * hh + tt; const float mean = sm[tt >> 2][tt & 3] * (1.f / 64.f); const float var = fmaxf(sq[tt >> 2][tt & 3] * (1.f / 64.f) - mean * mean, 0.f);
                        float o = (yq[tt] - mean) * __builtin_amdgcn_rsqf(var + 64e-5f) * lw_ + lb_ + bv4[tt >> 2][tt & 3] * bflo(vg[tt]);
                        o *= bfhi(vg[tt]); op[t * 64] = (bf16_t)f2bf(o); }
                    LDS_WAIT(); asm volatile("" ::: "memory");
                }
            }
        }
    }
}

template <int MODE>
__device__ __forceinline__ float load_row_hb(const Fr& F, const bf16_t* hrow, const bf16_t* Y, const int* asg, int m, float (&v)[16]) {
    int p0 = 0, p1 = 0; if (MODE == 1) { p0 = asg[m * 8 + 6]; p1 = asg[m * 8 + 7]; }
    float s = 0.f;
#pragma unroll
    for (int j = 0; j < 2; ++j) { const u32x4 hv = *(const u32x4*)(hrow + 512 * j + 8 * F.lane);
        float* o = v + 8 * j; o[0] = bflo(hv.x); o[1] = bfhi(hv.x); o[2] = bflo(hv.y); o[3] = bfhi(hv.y); o[4] = bflo(hv.z); o[5] = bfhi(hv.z); o[6] = bflo(hv.w); o[7] = bfhi(hv.w);
        if (MODE == 1) { const u32x4 y0 = *(const u32x4*)(Y + (size_t)p0 * 1024 + 512 * j + 8 * F.lane), y1 = *(const u32x4*)(Y + (size_t)p1 * 1024 + 512 * j + 8 * F.lane);
            o[0] += bflo(y0.x) + bflo(y1.x); o[1] += bfhi(y0.x) + bfhi(y1.x); o[2] += bflo(y0.y) + bflo(y1.y); o[3] += bfhi(y0.y) + bfhi(y1.y);
            o[4] += bflo(y0.z) + bflo(y1.z); o[5] += bfhi(y0.z) + bfhi(y1.z); o[6] += bflo(y0.w) + bflo(y1.w); o[7] += bfhi(y0.w) + bfhi(y1.w); }
#pragma unroll
        for (int e = 0; e < 8; ++e) s += o[e] * o[e]; }
    return 1.f / sqrtf(wave_sum(s) * (1.f / 1024.f) + 1e-6f);
}

struct RowRaw { u32x4 h[2], y0[2], y1[2]; };
__device__ __forceinline__ int y_chunk_col(int c) { const int ci = c & 31; return (c >> 5) * 256 + (((ci >> 2) & 3) * 8 + (ci >> 4) * 4 + (ci & 3)) * 8; }
__device__ __forceinline__ void row_issue(const Fr& F, const bf16_t* hrow, const bf16_t* Y, int p0, int p1, RowRaw& R) {
#pragma unroll
    for (int j = 0; j < 2; ++j) { const int yc = y_chunk_col(64 * j + F.lane);
        R.h[j] = *(const u32x4*)(hrow + 512 * j + 8 * F.lane); R.y0[j] = *(const u32x4*)(Y + (size_t)p0 * 1024 + yc); R.y1[j] = *(const u32x4*)(Y + (size_t)p1 * 1024 + yc); }
}
__device__ __forceinline__ float row_finish(const RowRaw& R, float (&v)[16], float w0, float w1) {
    float s = 0.f;
#pragma unroll
    for (int j = 0; j < 2; ++j) { const u32x4 hv = R.h[j], y0 = R.y0[j], y1 = R.y1[j]; float* o = v + 8 * j;
        o[0] = bflo(hv.x) + (w0 * bflo(y0.x) + w1 * bflo(y1.x)); o[1] = bfhi(hv.x) + (w0 * bfhi(y0.x) + w1 * bfhi(y1.x)); o[2] = bflo(hv.y) + (w0 * bflo(y0.y) + w1 * bflo(y1.y)); o[3] = bfhi(hv.y) + (w0 * bfhi(y0.y) + w1 * bfhi(y1.y));
        o[4] = bflo(hv.z) + (w0 * bflo(y0.z) + w1 * bflo(y1.z)); o[5] = bfhi(hv.z) + (w0 * bfhi(y0.z) + w1 * bfhi(y1.z)); o[6] = bflo(hv.w) + (w0 * bflo(y0.w) + w1 * bflo(y1.w)); o[7] = bfhi(hv.w) + (w0 * bfhi(y0.w) + w1 * bfhi(y1.w));
#pragma unroll
        for (int e = 0; e < 8; ++e) s += o[e] * o[e]; }
    return 1.f / sqrtf(wave_sum(s) * (1.f / 1024.f) + 1e-6f);
}
constexpr int RB = 4;
#define ROWS_ISSUE(Hbase) int p0[RB], p1[RB]; float rw0[RB], rw1[RB]; RowRaw R[RB]; \
        _Pragma("unroll") for (int r = 0; r < RB; ++r) { const int mr = m + r * F.ngw; p0[r] = 0; p1[r] = 0; rw0[r] = 0.f; rw1[r] = 0.f; if (mr < NT) { const u32x4 _as = *(const u32x4*)(asg + mr * 8 + 4); \
            const unsigned _wx = _as.x, _wy = _as.y; rw0[r] = __uint_as_float(_wx); rw1[r] = __uint_as_float(_wy); p0[r] = (int)_as.z; p1[r] = (int)_as.w; } } \
        _Pragma("unroll") for (int r = 0; r < RB; ++r) { const int mr = m + r * F.ngw; if (mr < NT) row_issue(F, (Hbase) + (size_t)mr * 1024, Y, p0[r], p1[r], R[r]); }
__device__ __forceinline__ void phase_m1(const Fr& F, const Args& a, int layer) {
    unsigned char* ws = a.ws; const bf16_t* h = (const bf16_t*)(ws + WS_H); float* RS = (float*)(ws + WS_RSTD);
    int* asg = (int*)(ws + WS_ASG);
    const bf16_t* wfb = (const bf16_t*)(ws + WS_RFRAG) + (size_t)layer * 32 * 9 * 512;
    unsigned* cnt = (unsigned*)(ws + WS_CTL) + CW_CNT + layer * 32 * 64;
    LAS float* Lg = (LAS float*)F.lds + F.wave * 1600;
    LAS float* Lr = Lg + 1536;
    for (int task = F.gw; task < NT / 32; task += F.ngw) {
        const int m0 = task * 32;
        f32x4 acc[2][3];
#pragma unroll
        for (int rb = 0; rb < 2; ++rb)
#pragma unroll
            for (int nt = 0; nt < 3; ++nt) acc[rb][nt] = (f32x4){0.f, 0.f, 0.f, 0.f};
        const int i = F.lane & 15, q = F.lane >> 4; const bf16_t* hr = h + (size_t)(m0 + i) * 1024 + 8 * q;
        float ss0 = 0.f, ss1 = 0.f;
#pragma unroll 4
        for (int s = 0; s < 32; ++s) {
            const bf16x8 a0 = *(const bf16x8*)(hr + 32 * s), a1 = *(const bf16x8*)(hr + 16 * 1024 + 32 * s);
            const bf16_t* wp = wfb + (size_t)s * 9 * 512 + F.lane * 8;
#pragma unroll
            for (int tn = 0; tn < 9; ++tn) { const bf16x8 b = *(const bf16x8*)(wp + tn * 512);
                acc[0][tn % 3] = __builtin_amdgcn_mfma_f32_16x16x32_bf16(a0, b, acc[0][tn % 3], 0, 0, 0); acc[1][tn % 3] = __builtin_amdgcn_mfma_f32_16x16x32_bf16(a1, b, acc[1][tn % 3], 0, 0, 0); }
            const u32x4 u0 = __builtin_bit_cast(u32x4, a0), u1 = __builtin_bit_cast(u32x4, a1);
#pragma unroll
            for (int e = 0; e < 4; ++e) { const float x0 = bflo(u0[e]), y0 = bfhi(u0[e]), x1 = bflo(u1[e]), y1 = bfhi(u1[e]); ss0 += x0 * x0 + y0 * y0; ss1 += x1 * x1 + y1 * y1; }
        }
        {
            auto r16 = __builtin_amdgcn_permlane16_swap(__float_as_uint(ss0), __float_as_uint(ss0), false, false); ss0 = __uint_as_float(r16[0]) + __uint_as_float(r16[1]);
            auto r32 = __builtin_amdgcn_permlane32_swap(__float_as_uint(ss0), __float_as_uint(ss0), false, false); ss0 = __uint_as_float(r32[0]) + __uint_as_float(r32[1]);
            r16 = __builtin_amdgcn_permlane16_swap(__float_as_uint(ss1), __float_as_uint(ss1), false, false); ss1 = __uint_as_float(r16[0]) + __uint_as_float(r16[1]);
            r32 = __builtin_amdgcn_permlane32_swap(__float_as_uint(ss1), __float_as_uint(ss1), false, false); ss1 = __uint_as_float(r32[0]) + __uint_as_float(r32[1]);
            const float rs0 = 1.f / sqrtf(ss0 * (1.f / 1024.f) + 1e-6f), rs1 = 1.f / sqrtf(ss1 * (1.f / 1024.f) + 1e-6f);
            if (F.lane < 16) { RS[m0 + i] = rs0; RS[m0 + 16 + i] = rs1; Lr[i] = rs0; Lr[16 + i] = rs1; }
        }
        LDS_WAIT(); asm volatile("" ::: "memory");
#pragma unroll
        for (int rb = 0; rb < 2; ++rb) { const f32x4 rs = *(const LAS f32x4*)(Lr + 16 * rb + 4 * q);
#pragma unroll
            for (int nt = 0; nt < 3; ++nt)
#pragma unroll
                for (int rg = 0; rg < 4; ++rg) Lg[(16 * rb + 4 * q + rg) * 48 + 16 * nt + i] = acc[rb][nt][rg] * rs[rg]; }
        LDS_WAIT(); asm volatile("" ::: "memory");
        if (F.lane < 32) {
            const int m = m0 + F.lane; const LAS float* lg = Lg + F.lane * 48;
            float gl[4]; float gmax = -3.0e38f; int grp = 0;
#pragma unroll
            for (int j = 0; j < 4; ++j) { gl[j] = lg[j] + a.in[I_MBG][layer * 4 + j]; if (gl[j] > gmax) { gmax = gl[j]; grp = j; } }
            float gs = 0.f;
#pragma unroll
            for (int j = 0; j < 4; ++j) gs += __expf(gl[j] - gmax);
            const float grp_w = 1.f / gs;
            float v1 = -3.0e38f, v2 = -3.0e38f; int i1 = 0, i2 = 0;
            for (int j = 0; j < 8; ++j) { const float e = lg[4 + grp * 8 + j] + a.in[I_MBE][layer * 32 + grp * 8 + j];
                if (e > v1) { v2 = v1; i2 = i1; v1 = e; i1 = j; } else if (e > v2) { v2 = e; i2 = j; } }
            const float r2 = __expf(v2 - v1); const float w1 = grp_w / (1.f + r2), w2 = grp_w * r2 / (1.f + r2);
            const int e1 = grp * 8 + i1, e2 = grp * 8 + i2;
            const unsigned s1 = __hip_atomic_fetch_add(cnt + e1 * 64, 1u, __ATOMIC_RELAXED, __HIP_MEMORY_SCOPE_AGENT);
            const unsigned s2 = __hip_atomic_fetch_add(cnt + e2 * 64, 1u, __ATOMIC_RELAXED, __HIP_MEMORY_SCOPE_AGENT);
            int* r = asg + (size_t)m * 8; r[0] = e1; r[1] = e2; r[2] = (int)s1; r[3] = (int)s2; r[4] = __builtin_bit_cast(int, w1); r[5] = __builtin_bit_cast(int, w2);
        }
        LDS_WAIT(); asm volatile("" ::: "memory");
    }
}

__device__ __forceinline__ void phase_m2(const Fr& F, const Args& a, int layer) {
    unsigned char* ws = a.ws;
    int* asg = (int*)(ws + WS_ASG); float* roww = (float*)(ws + WS_ROWW);
    int* texp = (int*)(ws + WS_TEXP);
    unsigned* cnt = (unsigned*)(ws + WS_CTL) + CW_CNT + layer * 32 * 64;
    LAS int* sb = (LAS int*)F.lds;
    if (F.tid < 32) sb[64 + F.tid] = (int)__hip_atomic_load(cnt + F.tid * 64, __ATOMIC_RELAXED, __HIP_MEMORY_SCOPE_AGENT);
    __syncthreads();
    if (F.tid == 0) { int acc = 0; for (int e = 0; e < 32; ++e) { sb[e] = acc; acc += (sb[64 + e] + 255) & ~255; } sb[32] = acc; }
    __syncthreads();
    if (blockIdx.x == 0) {
        const int ntiles = sb[32] >> 8;
        for (int t = F.tid; t < ntiles; t += 512) { int e = 0; for (int j = 1; j < 32; ++j) if ((t << 8) >= sb[j]) e = j; texp[t] = e; }
        if (F.tid == 0) texp[1023] = ntiles;
        if (F.tid < 8) { int n = 0; for (int q = 0; q < 4; ++q) { const int e = F.tid + 8 * q; for (int t = sb[e] >> 8; t < (sb[e + 1] >> 8); ++t) texp[2048 + F.tid * 640 + n++] = t | (e << 16); } texp[1008 + F.tid] = n; }
    }
    int* ridx = (int*)(ws + WS_RIDX); float* rowrs = (float*)(ws + WS_ROWRS); const float* RS = (const float*)(ws + WS_RSTD);
    for (int as = blockIdx.x * 512 + F.tid; as < NT * 2; as += F.G * 512) {
        const int m = as >> 1, k = as & 1; const int e = asg[m * 8 + k], slot = asg[m * 8 + 2 + k]; const int p = sb[e] + slot;
        ridx[p] = m; rowrs[p] = RS[m]; roww[p] = __builtin_bit_cast(float, asg[m * 8 + 4 + k]); asg[m * 8 + 6 + k] = p; }
    for (int idx = blockIdx.x * 512 + F.tid; idx < 32 * 256; idx += F.G * 512) {
        const int e = idx >> 8, r = idx & 255; const int p = sb[e] + sb[64 + e] + r;
        if (p < sb[e + 1]) { ridx[p] = 0; rowrs[p] = 0.f; roww[p] = 0.f; } }
}

__device__ __forceinline__ void phase_n1(const Fr& F, const Args& a) {
    unsigned char* ws = a.ws; bf16_t* H = (bf16_t*)(ws + WS_H); const bf16_t* Y = (const bf16_t*)(ws + WS_S1); const int* asg = (const int*)(ws + WS_ASG); float* RS = (float*)(ws + WS_RSTD);
    for (int m = F.gw; m < NT; m += RB * F.ngw) {
        ROWS_ISSUE(H)
#pragma unroll
        for (int r = 0; r < RB; ++r) { const int mr = m + r * F.ngw; if (mr < NT) {
            float v[16]; bf16_t* hrow = H + (size_t)mr * 1024; const float rstd = row_finish(R[r], v, rw0[r], rw1[r]);
#pragma unroll
            for (int j = 0; j < 2; ++j) *(u32x4*)(hrow + 512 * j + 8 * F.lane) = (u32x4){pk2(v[8 * j], v[8 * j + 1]), pk2(v[8 * j + 2], v[8 * j + 3]), pk2(v[8 * j + 4], v[8 * j + 5]), pk2(v[8 * j + 6], v[8 * j + 7])};
            if (F.lane == 0) RS[mr] = rstd; } }
    }
}
__device__ __forceinline__ void phase_final(const Fr& F, const Args& a) {
    unsigned char* ws = a.ws; const bf16_t* H = (const bf16_t*)(ws + WS_H); const bf16_t* Y = (const bf16_t*)(ws + WS_S1); const int* asg = (const int*)(ws + WS_ASG); const float* gain = a.in[I_FLN];
    for (int m = F.gw; m < NT; m += RB * F.ngw) {
        ROWS_ISSUE(H)
#pragma unroll
        for (int r = 0; r < RB; ++r) { const int mr = m + r * F.ngw; if (mr < NT) {
            float v[16]; const float rstd = row_finish(R[r], v, rw0[r], rw1[r]); float* orow = a.out + (size_t)mr * 1024;
#pragma unroll
            for (int j = 0; j < 2; ++j) { const int c = 512 * j + 8 * F.lane; const f32x4 g0 = *(const f32x4*)(gain + c), g1 = *(const f32x4*)(gain + c + 4);
                *(f32x4*)(orow + c) = (f32x4){v[8 * j] * rstd * g0.x, v[8 * j + 1] * rstd * g0.y, v[8 * j + 2] * rstd * g0.z, v[8 * j + 3] * rstd * g0.w};
                *(f32x4*)(orow + c + 4) = (f32x4){v[8 * j + 4] * rstd * g1.x, v[8 * j + 5] * rstd * g1.y, v[8 * j + 6] * rstd * g1.z, v[8 * j + 7] * rstd * g1.w}; } } }
    }
}

__device__ __forceinline__ void phase_cmp_gather(const Fr& F, const Args& a) {
    unsigned char* ws = a.ws; const bf16_t* KV = (const bf16_t*)(ws + WS_KV); bf16_t* AC = (bf16_t*)(ws + WS_ACMP);
    for (int r = F.gw; r < 2 * 16384; r += F.ngw) {
        const int grp = r >> 14, rr = r & 16383, bg = rr >> 7, n = rr & 127, b = bg >> 2, g = bg & 3;
        const float* pe = a.in[grp ? I_PEV : I_PEK] + (size_t)g * 32 * 64;
        bf16_t* dst = AC + (size_t)r * 2048;
        for (int l2 = 0; l2 < 16; ++l2) { const int l = 2 * l2 + (F.lane >> 5), d = 2 * (F.lane & 31);
            unsigned o = 0u;
            if (n < 127) { const unsigned kv = *(const unsigned*)(KV + (size_t)(b * SEQ + 16 * n + l) * 1536 + (grp * 4 + g) * 64 + d);
                o = pk2(bflo(kv) + pe[l * 64 + d], bfhi(kv) + pe[l * 64 + d + 1]); }
            *(unsigned*)(dst + l * 64 + d) = o; }
    }
}
__device__ __forceinline__ int perm16pos(int w) { return w < 4 ? w : (w < 8 ? w + 4 : (w < 12 ? w - 4 : w)); }
__device__ __forceinline__ void phase_cmp2(const Fr& F, const Args& a, int task0, int tstep, int tend) {
    unsigned char* ws = a.ws; const bf16_t* HC = (const bf16_t*)(ws + WS_HC); bf16_t* KCB = (bf16_t*)(ws + WS_KCB); bf16_t* VCT = (bf16_t*)(ws + WS_VCT); const bf16_t* WF = (const bf16_t*)(ws + WS_W2F);
    const int i = F.lane & 15, q = F.lane >> 4;
    for (int task = task0; task < tend; task += tstep) {
        const int r0 = task * 16, grp = r0 >> 14, rr = r0 & 16383, bg = rr >> 7, n0 = rr & 127;
        f32x4 acc[4];
#pragma unroll
        for (int nb = 0; nb < 4; ++nb) acc[nb] = (f32x4){0.f, 0.f, 0.f, 0.f};
        const bf16_t* hr = HC + (size_t)(r0 + i) * 256 + 8 * q; const bf16_t* wp = WF + (size_t)grp * 8 * 8 * 512 + F.lane * 8;
#pragma unroll
        for (int sk = 0; sk < 8; ++sk) { const bf16x8 av = *(const bf16x8*)(hr + 32 * sk);
#pragma unroll
            for (int tn = 0; tn < 8; ++tn) acc[tn & 3] = __builtin_amdgcn_mfma_f32_16x16x32_bf16(av, *(const bf16x8*)(wp + (sk * 8 + tn) * 512), acc[tn & 3], 0, 0, 0); }
#pragma unroll
        for (int nb = 0; nb < 4; ++nb) { const int col = 16 * nb + i; f32x4 v = acc[nb];
#pragma unroll
            for (int rg = 0; rg < 4; ++rg) if (n0 + 4 * q + rg == 127) v[rg] = 0.f;
            if (grp == 0) {
#pragma unroll
                for (int rg = 0; rg < 4; ++rg) KCB[((size_t)bg * 128 + n0 + 4 * q + rg) * 64 + col] = (bf16_t)f2bf(v[rg]); }
            else *(u32x2*)(VCT + ((size_t)bg * 64 + col) * 128 + n0 + perm16pos(4 * q)) = (u32x2){cvtpk(v[0], v[1]), cvtpk(v[2], v[3])}; }
    }
}
__device__ __forceinline__ void phase_vt(const Fr& F, const Args& a, int gw, int ngw) {
    unsigned char* ws = a.ws; const bf16_t* KV = (const bf16_t*)(ws + WS_KV); bf16_t* VT = (bf16_t*)a.out;
    LAS unsigned* T2 = (LAS unsigned*)(F.lds) + F.wave * 2080;
    for (int task = gw; task < 8192; task += ngw) {
        const int tile = task & 31, g = (task >> 5) & 3, pg = (task >> 7) & 1, b = task >> 8;
        const u32x4* src = (const u32x4*)(KV + (size_t)(b * SEQ + 64 * tile + F.lane) * 1536 + ((pg ? 5 : 3) * 4 + g) * 64);
#pragma unroll
        for (int i = 0; i < 8; ++i) { const u32x4 v = src[i]; T2[(4 * i + 0) * 65 + F.lane] = v.x; T2[(4 * i + 1) * 65 + F.lane] = v.y; T2[(4 * i + 2) * 65 + F.lane] = v.z; T2[(4 * i + 3) * 65 + F.lane] = v.w; }
        LDS_WAIT(); asm volatile("" ::: "memory");
        const int d = F.lane, dp = d >> 1; const bool hi = d & 1;
        u32x4* dst = (u32x4*)(VT + ((size_t)((b * 2 + pg) * 4 + g) * 64 + d) * 2048 + 64 * tile);
#pragma unroll
        for (int G = 0; G < 4; ++G) {
            unsigned e[16];
#pragma unroll
            for (int p = 0; p < 16; ++p) { const int key = 16 * G + ((p < 4) ? p : (p < 8) ? p + 4 : (p < 12) ? p - 4 : p); const unsigned u = T2[dp * 65 + key]; e[p] = hi ? (u >> 16) : (u & 0xffffu); }
            dst[2 * G] = (u32x4){e[0] | (e[1] << 16), e[2] | (e[3] << 16), e[4] | (e[5] << 16), e[6] | (e[7] << 16)};
            dst[2 * G + 1] = (u32x4){e[8] | (e[9] << 16), e[10] | (e[11] << 16), e[12] | (e[13] << 16), e[14] | (e[15] << 16)};
        }
        LDS_WAIT(); asm volatile("" ::: "memory");
    }
}
__device__ __forceinline__ void dma16(const void* g, LAS void* l) { __builtin_amdgcn_global_load_lds((const unsigned*)g, (LAS unsigned*)l, 16, 0, 0); }
#define ATT_NEG (-__builtin_inff())
__device__ __forceinline__ unsigned xor32u(unsigned x) { const auto r = __builtin_amdgcn_permlane32_swap(x, x, false, false); return (threadIdx.x & 32) ? r[0] : r[1]; }
__device__ __forceinline__ float xor32(float x) { return __uint_as_float(xor32u(__float_as_uint(x))); }
template <int KM>
__device__ __forceinline__ void att_fix(f32x16 (&S)[2], int dbase, unsigned maxd, bool colsel, const LAS float* dBl) {
#pragma unroll
    for (int blk = 0; blk < 2; ++blk) {
        float bv[16];
#pragma unroll
        for (int rr = 0; rr < 16; ++rr) { const int koff = 32 * blk + (rr & 3) + 8 * (rr >> 2); const unsigned di = min((unsigned)(dbase - KM * koff), 128u); bv[rr] = dBl[di]; }
#pragma unroll
        for (int rr = 0; rr < 16; ++rr) asm volatile("" : "+v"(bv[rr]));
#pragma unroll
        for (int rr = 0; rr < 16; ++rr) { const int koff = 32 * blk + (rr & 3) + 8 * (rr >> 2); const int dist = dbase - KM * koff;
            const bool ok = ((unsigned)dist < maxd) && colsel; S[blk][rr] = ok ? S[blk][rr] + bv[rr] : ATT_NEG; } }
}
template <int KM>
__device__ __forceinline__ void att_fixcb(f32x16& S, int dbase, const LAS float* dBl) {
    float bv[16];
#pragma unroll
    for (int rr = 0; rr < 16; ++rr) { const int koff = (rr & 3) + 8 * (rr >> 2); const unsigned di = min((unsigned)(dbase - KM * koff), 128u); bv[rr] = dBl[di]; }
#pragma unroll
    for (int rr = 0; rr < 16; ++rr) asm volatile("" : "+v"(bv[rr]));
#pragma unroll
    for (int rr = 0; rr < 16; ++rr) { const int koff = (rr & 3) + 8 * (rr >> 2); const int dist = dbase - KM * koff; S[rr] = (dist >= 0) ? S[rr] + bv[rr] : ATT_NEG; }
}
__device__ __forceinline__ void att_fix1(f32x16 (&S)[2], int dbase, unsigned maxd, const LAS float* bp) {
#pragma unroll
    for (int blk = 0; blk < 2; ++blk) {
        f32x4 bv[4];
#pragma unroll
        for (int q = 0; q < 4; ++q) bv[q] = *(const LAS f32x4*)(bp + 56 - 32 * blk - 8 * q);
#pragma unroll
        for (int q = 0; q < 4; ++q) asm volatile("" : "+v"(bv[q]));
#pragma unroll
        for (int rr = 0; rr < 16; ++rr) { const int koff = 32 * blk + (rr & 3) + 8 * (rr >> 2); const int dist = dbase - koff;
            S[blk][rr] = ((unsigned)dist < maxd) ? S[blk][rr] + bv[rr >> 2][3 - (rr & 3)] : ATT_NEG; } }
}
__device__ __forceinline__ void att_scores(LAS unsigned char* ktile, const int (&aoff)[4], const bf16x8 (&qf)[4], f32x16 (&S)[2]) {
#pragma unroll
    for (int blk = 0; blk < 2; ++blk)
#pragma unroll
        for (int i = 0; i < 16; ++i) S[blk][i] = 0.f;
    bf16x8 kf[2][4];
#pragma unroll
    for (int s = 0; s < 4; ++s)
#pragma unroll
        for (int blk = 0; blk < 2; ++blk) kf[blk][s] = *(const LAS bf16x8*)(ktile + blk * 4096 + aoff[s]);
#pragma unroll
    for (int s = 0; s < 4; ++s) {
        S[0] = __builtin_amdgcn_mfma_f32_32x32x16_bf16(kf[0][s], qf[s], S[0], 0, 0, 0); S[1] = __builtin_amdgcn_mfma_f32_32x32x16_bf16(kf[1][s], qf[s], S[1], 0, 0, 0);
        __builtin_amdgcn_sched_barrier(0); }
}
__device__ __forceinline__ void att_scores_init(LAS unsigned char* ktile, const int (&aoff)[4], const bf16x8 (&qf)[4], f32x16 (&S)[2], const LAS float* ip) {
#pragma unroll
    for (int blk = 0; blk < 2; ++blk)
#pragma unroll
        for (int q = 0; q < 4; ++q) { const f32x4 v = *(const LAS f32x4*)(ip + 32 * blk + 8 * q); S[blk][4 * q] = v.x; S[blk][4 * q + 1] = v.y; S[blk][4 * q + 2] = v.z; S[blk][4 * q + 3] = v.w; }
    bf16x8 kf[2][4];
#pragma unroll
    for (int s = 0; s < 4; ++s)
#pragma unroll
        for (int blk = 0; blk < 2; ++blk) kf[blk][s] = *(const LAS bf16x8*)(ktile + blk * 4096 + aoff[s]);
#pragma unroll
    for (int s = 0; s < 4; ++s) {
        S[0] = __builtin_amdgcn_mfma_f32_32x32x16_bf16(kf[0][s], qf[s], S[0], 0, 0, 0); S[1] = __builtin_amdgcn_mfma_f32_32x32x16_bf16(kf[1][s], qf[s], S[1], 0, 0, 0);
        __builtin_amdgcn_sched_barrier(0); }
}
__device__ __forceinline__ void att_pv(LAS unsigned char* vtile, const int (&aoff)[4], const f32x16 (&P)[2], f32x16 (&O)[2]) {
    bf16x8 pb[2][2];
#pragma unroll
    for (int blk = 0; blk < 2; ++blk)
#pragma unroll
        for (int s2 = 0; s2 < 2; ++s2) pb[blk][s2] = pack8f(P[blk][8 * s2], P[blk][8 * s2 + 1], P[blk][8 * s2 + 2], P[blk][8 * s2 + 3], P[blk][8 * s2 + 4], P[blk][8 * s2 + 5], P[blk][8 * s2 + 6], P[blk][8 * s2 + 7]);
#pragma unroll
    for (int dt = 0; dt < 2; ++dt)
#pragma unroll
        for (int blk = 0; blk < 2; ++blk)
#pragma unroll
            for (int s2 = 0; s2 < 2; ++s2) { const bf16x8 A = *(const LAS bf16x8*)(vtile + dt * 4096 + aoff[2 * blk + s2]); O[dt] = __builtin_amdgcn_mfma_f32_32x32x16_bf16(A, pb[blk][s2], O[dt], 0, 0, 0); }
}
#define ATT_LHI 1.8446744e19f
#define ATT_TBL_NEG (4 * 2832)
#define ATT_TBL_ZERO (4 * 2832 + 64)
__device__ __forceinline__ float att_colmax(const f32x16 (&S)[2]) {
    float mx = S[0][0];
#pragma unroll
    for (int blk = 0; blk < 2; ++blk)
#pragma unroll
        for (int rr = 0; rr < 16; ++rr) mx = fmaxf(mx, S[blk][rr]);
    return fmaxf(mx, xor32(mx));
}
__device__ __forceinline__ void att_tile(LAS unsigned char* tile, const int (&aoff)[4], const bf16x8 (&qf)[4], f32x16 (&O)[2], float& m, float& l, bool& pending, bool& shifted,
                                         int fixmode, int dbase, bool colsel, const LAS float* dBl, const LAS float* tblbase) {
    f32x16 S[2];
    const LAS float* ip = colsel ? (fixmode == 2 ? dBl - dbase : tblbase + ATT_TBL_ZERO) : tblbase + ATT_TBL_NEG;
    if (fixmode == 0) att_scores(tile, aoff, qf, S); else att_scores_init(tile, aoff, qf, S, ip);
    if (shifted) { S[0] = S[0] - m; S[1] = S[1] - m; }
    if (pending) {
        const float mxc = att_colmax(S); const float dl = (mxc > -1e29f && fabsf(mxc) > 32.f) ? mxc : 0.f;
        if (__any(dl != 0.f)) { m += dl; S[0] = S[0] - dl; S[1] = S[1] - dl; shifted = true; }
        pending = false;
    }
    float ln = l;
#pragma unroll
    for (int blk = 0; blk < 2; ++blk)
#pragma unroll
        for (int rr = 0; rr < 16; ++rr) { const float p = __builtin_amdgcn_exp2f(S[blk][rr]); S[blk][rr] = p; ln += p; }
    if (__any(ln > ATT_LHI)) {
        if (fixmode == 0) att_scores(tile, aoff, qf, S); else att_scores_init(tile, aoff, qf, S, ip);
        if (shifted) { S[0] = S[0] - m; S[1] = S[1] - m; }
        const float mxc = att_colmax(S), lnc = fmaxf(ln, xor32(ln));
        const float dl = (lnc > ATT_LHI) ? fmaxf(mxc, 32.f) : 0.f, corr = __builtin_amdgcn_exp2f(-dl);
        m += dl; l *= corr; O[0] = O[0] * corr; O[1] = O[1] * corr; S[0] = S[0] - dl; S[1] = S[1] - dl; shifted = true;
        ln = l;
#pragma unroll
        for (int blk = 0; blk < 2; ++blk)
#pragma unroll
            for (int rr = 0; rr < 16; ++rr) { const float p = __builtin_amdgcn_exp2f(S[blk][rr]); S[blk][rr] = p; ln += p; }
    }
    l = ln;
    att_pv(tile + 8192, aoff, S, O);
}
__device__ __forceinline__ void phase_attn(const Fr& F, const Args& a) {
    unsigned char* ws = a.ws;
    const bf16_t* QB = (const bf16_t*)(ws + WS_Q); const unsigned char* KV = ws + WS_KV; const unsigned char* VT = (const unsigned char*)a.out; const float* GT = (const float*)(ws + WS_GATES);
    const unsigned char* KCB = ws + WS_KCB; const unsigned char* VCT = ws + WS_VCT; bf16_t* OB = (bf16_t*)(ws + WS_OATT);
    LAS unsigned char* RING = F.lds; LAS unsigned char* CMPA = F.lds + 65536; LAS float* dB = (LAS float*)(F.lds + 98304);
    const int w = F.wave, lane = F.lane, r = lane & 31, h = lane >> 5, hh = lane & 3, tl = r >> 2, swz = (r >> 1) & 7;
    int aoff[4];
#pragma unroll
    for (int s = 0; s < 4; ++s) aoff[s] = r * 128 + (((2 * s + h) ^ swz) * 16);
    const int drow = 8 * w + (lane >> 3), dchunk = ((lane & 7) ^ ((drow >> 1) & 7)) * 16;
    const LAS float* dBl = dB + hh * 132;
    LAS float* DB4 = (LAS float*)(F.lds + 102400);
    const LAS float* dB4l = DB4 + hh * 2832 + (tl & 3) * 708 + (tl & 3) + 576;
    int gprev = -1;
    const bool xcdord = F.G == 256;
    if (w < 4) __builtin_amdgcn_s_setprio(1);
    for (int unit = blockIdx.x, uk = 0; xcdord ? uk < 16 : unit < 4096; unit += F.G, ++uk) {
        const int bg = xcdord ? (int)(blockIdx.x & 7) + 8 * uk : unit & 127, qt = xcdord ? ((uk & 1) ? 31 - (int)(blockIdx.x >> 3) : (int)(blockIdx.x >> 3)) : (unit >> 7) ^ ((unit >> 8) & 1);
        const int b = bg >> 2, g = bg & 3, t0 = 64 * qt;
        __syncthreads();
        if (g != gprev) for (int i = F.tid; i < 4 * 129; i += 512) { const int hq = i / 129, d = i % 129;
            dB[hq * 132 + d] = (d < 128) ? (a.in[I_RELB][BKT[d] * 16 + 4 * g + hq] - a.in[I_RELB][31 * 16 + 4 * g + hq]) * 1.44269504089f : 0.f; }
        if (g != gprev) for (int i = F.tid; i < 4 * 2832 + 128; i += 512) { const int hq = i / 2832, rem = i % 2832, cc = rem / 708, d = 576 - (rem % 708 - cc);
            float v;
            if (i >= 4 * 2832) v = (i < 4 * 2832 + 64) ? ATT_NEG : 0.f;
            else v = (d < 0 || d >= 512) ? ATT_NEG : (d < 128 ? (a.in[I_RELB][BKT[d] * 16 + 4 * g + hq] - a.in[I_RELB][31 * 16 + 4 * g + hq]) * 1.44269504089f : 0.f);
            DB4[i] = v; }
        gprev = g;
        const unsigned char* kwin = KV + ((size_t)(b * SEQ) * 1536 + (16 + g) * 64) * 2; const unsigned char* ksel = KV + ((size_t)(b * SEQ) * 1536 + (8 + g) * 64) * 2;
        const unsigned char* vsel = VT + ((size_t)((b * 2 + 0) * 4 + g) * 64) * 4096; const unsigned char* vwin = VT + ((size_t)((b * 2 + 1) * 4 + g) * 64) * 4096;
        const int nwin = min(qt, 8) + 1, ktlo = qt - nwin + 1, nst = nwin + qt + 1, ncmp = (qt >= 16) ? 2 : 1;
#define ATT_STAGE(i_, buf_) do { const int _i = (i_); const bool _isw = _i < nwin; const int _kt = _isw ? qt - _i : _i - nwin; \
            const unsigned char* _kp = (_isw ? kwin : ksel) + ((size_t)(64 * _kt + drow) * 1536) * 2 + dchunk; \
            const unsigned char* _vp = (_isw ? vwin : vsel) + (size_t)drow * 4096 + (size_t)_kt * 128 + dchunk; \
            dma16(_kp, (buf_) + w * 1024); dma16(_vp, (buf_) + 8192 + w * 1024); } while (0)
        for (int i = 0; i < ncmp; ++i) { dma16(KCB + ((size_t)(bg * 128 + 64 * i + drow) * 64) * 2 + dchunk, CMPA + i * 8192 + w * 1024);
            dma16(VCT + ((size_t)(bg * 64 + drow) * 128) * 2 + i * 128 + dchunk, CMPA + 16384 + i * 8192 + w * 1024); }
        const int tcol = t0 + 8 * w + tl; const size_t mtok = (size_t)b * SEQ + tcol; const int head = 4 * g + hh;
        bf16x8 qf[4];
#pragma unroll
        for (int s = 0; s < 4; ++s) qf[s] = *(const bf16x8*)(QB + mtok * 1024 + head * 64 + 16 * s + 8 * h);
        const float g0 = GT[mtok * 48 + head * 3 + 0], g1 = GT[mtok * 48 + head * 3 + 1], g2 = GT[mtok * 48 + head * 3 + 2];
        asm volatile("s_waitcnt vmcnt(0)" ::: "memory"); __syncthreads();
        ATT_STAGE(0, RING); ATT_STAGE(1, RING + 16384); if (nst > 2) ATT_STAGE(2, RING + 32768);
        f32x16 OUT[2], O[2];
        unsigned selmask;
        {
            f32x16 C[4];
            att_scores(CMPA, aoff, qf, *(f32x16 (*)[2])&C[0]);
            if (ncmp == 2) att_scores(CMPA + 8192, aoff, qf, *(f32x16 (*)[2])&C[2]);
            else {
#pragma unroll
                for (int i = 0; i < 16; ++i) { C[2][i] = ATT_NEG; C[3][i] = ATT_NEG; } }
#pragma unroll
            for (int cb = 0; cb < 4; ++cb) { const int tw = t0 + 8 * w, lo = tw - 31 - 16 * (32 * cb + 31), hi = tw + 7 - 31 - 512 * cb;
                if (cb < 2 * ncmp && lo < 128) {
                    if (hi < 0) {
#pragma unroll
                        for (int i = 0; i < 16; ++i) C[cb][i] = ATT_NEG; }
                    else att_fixcb<16>(C[cb], tcol - 31 - 64 * h - 512 * cb, dBl); } }
            float mx = C[0][0];
#pragma unroll
            for (int cb = 0; cb < 4; ++cb)
#pragma unroll
                for (int rr = 0; rr < 16; ++rr) mx = fmaxf(mx, C[cb][rr]);
            mx = fmaxf(mx, xor32(mx)); mx = fmaxf(mx, -1e30f);
            float ls = 0.f;
#pragma unroll
            for (int cb = 0; cb < 4; ++cb)
#pragma unroll
                for (int rr = 0; rr < 16; ++rr) { const float p = __builtin_amdgcn_exp2f(C[cb][rr] - mx); C[cb][rr] = p; ls += p; }
            ls += xor32(ls);
            const float inv = ls > 0.f ? 1.f / ls : 0.f;
#pragma unroll
            for (int cb = 0; cb < 4; ++cb) C[cb] = C[cb] * inv;
#pragma unroll
            for (int i = 0; i < 16; ++i) { OUT[0][i] = 0.f; OUT[1][i] = 0.f; }
            att_pv(CMPA + 16384, aoff, *(const f32x16 (*)[2])&C[0], OUT);
            if (ncmp == 2) att_pv(CMPA + 16384 + 8192, aoff, *(const f32x16 (*)[2])&C[2], OUT);
            OUT[0] = OUT[0] * g0; OUT[1] = OUT[1] * g0;
            if (qt <= 7) selmask = (2u << qt) - 1u;
            else {
                float imp[16], lastv[16];
#pragma unroll
                for (int cb = 0; cb < 4; ++cb)
#pragma unroll
                    for (int rq = 0; rq < 4; ++rq) { imp[4 * cb + rq] = (C[cb][4 * rq] + C[cb][4 * rq + 1]) + (C[cb][4 * rq + 2] + C[cb][4 * rq + 3]); lastv[4 * cb + rq] = C[cb][4 * rq + 3]; }
                unsigned key[16];
#pragma unroll
                for (int q = 0; q < 16; ++q) lastv[q] = xor32(lastv[q]);
#pragma unroll
                for (int q = 0; q < 16; ++q) { const float prev = (q >= 1) ? lastv[q - 1] : 0.f; float v = imp[q] + (h ? lastv[q] : prev);
                    v += dppf<DPP_XOR1>(v); v += dppf<DPP_XOR2>(v);
                    const int j = 2 * q + h; const bool cand = (j >= 1) && (j <= qt - 2);
                    key[q] = cand ? ((__builtin_bit_cast(unsigned, v) & ~31u) | (unsigned)(31 - j)) : 0u; }
                selmask = 1u | (1u << qt) | (1u << (qt - 1));
#pragma unroll 1
                for (int rnd = 0; rnd < 5; ++rnd) {
                    unsigned best = 0u;
#pragma unroll
                    for (int q = 0; q < 16; ++q) best = max(best, key[q]);
                    best = max(best, xor32u(best));
                    if (best != 0u) selmask |= 1u << (31 - (best & 31u));
#pragma unroll
                    for (int q = 0; q < 16; ++q) key[q] = (key[q] == best) ? 0u : key[q];
                }
            }
        }
        unsigned wor = selmask; wor |= (unsigned)__shfl_xor((int)wor, 4); wor |= (unsigned)__shfl_xor((int)wor, 8); wor |= (unsigned)__shfl_xor((int)wor, 16);
        wor = (unsigned)__builtin_amdgcn_readfirstlane((int)wor);
        unsigned wand = selmask; wand &= (unsigned)__shfl_xor((int)wand, 4); wand &= (unsigned)__shfl_xor((int)wand, 8); wand &= (unsigned)__shfl_xor((int)wand, 16);
        wand = (unsigned)__builtin_amdgcn_readfirstlane((int)wand);
        float m = 0.f, l = 0.f; bool pending = true, shifted = false;
        unsigned wall = 0xffffffffu; asm volatile("" : "+s"(wall));
#pragma unroll
        for (int i = 0; i < 16; ++i) { O[0][i] = 0.f; O[1][i] = 0.f; }
#define ATT_FINALIZE(gate_) do { const float _lt = l + xor32(l); const float _sc = _lt > 0.f ? (gate_) / _lt : 0.f; \
            OUT[0] = OUT[0] + O[0] * _sc; OUT[1] = OUT[1] + O[1] * _sc; m = 0.f; l = 0.f; pending = true; shifted = false; \
            _Pragma("unroll") for (int _i = 0; _i < 16; ++_i) { O[0][_i] = 0.f; O[1][_i] = 0.f; } } while (0)
#define ATT_TILE_SYNC(i_) do { const int _ahead = nst - 1 - (i_); \
            if (_ahead >= 2) asm volatile("s_waitcnt vmcnt(4) lgkmcnt(0)" ::: "memory"); else if (_ahead == 1) asm volatile("s_waitcnt vmcnt(2) lgkmcnt(0)" ::: "memory"); else asm volatile("s_waitcnt vmcnt(0) lgkmcnt(0)" ::: "memory"); \
            __builtin_amdgcn_s_barrier(); asm volatile("" ::: "memory"); \
            if ((i_) + 3 < nst) ATT_STAGE((i_) + 3, RING + (((i_) + 3) & 3) * 16384); } while (0)
#pragma unroll 1
        for (int i = 0; i < nwin; ++i) {
            ATT_TILE_SYNC(i);
            const int kt = qt - i; const int fm = (kt >= qt - 2 || kt == qt - 8) ? 2 : 0;
            if ((wall >> i) & 1u)
            att_tile(RING + (i & 3) * 16384, aoff, qf, O, m, l, pending, shifted, fm, tcol - 64 * kt - 4 * h, true, dB4l, DB4);
        }
        ATT_FINALIZE(g2);
#pragma unroll 1
        for (int i = nwin; i < nst; ++i) {
            ATT_TILE_SYNC(i);
            const int j = i - nwin;
            if ((wor >> j) & 1u) { const bool cs = (selmask >> j) & 1u; const int fm = (j >= qt - 2) ? 2 : (((wand >> j) & 1u) ? 0 : 1);
                att_tile(RING + (i & 3) * 16384, aoff, qf, O, m, l, pending, shifted, fm, tcol - 64 * j - 4 * h, cs, dB4l, DB4); }
        }
#undef ATT_TILE_SYNC
        ATT_FINALIZE(g1);
        bf16_t* orow = OB + mtok * 1024 + head * 64 + 4 * h;
#pragma unroll
        for (int dt = 0; dt < 2; ++dt)
#pragma unroll
            for (int rq = 0; rq < 4; ++rq) { u32x2 v; v.x = cvtpk(OUT[dt][4 * rq], OUT[dt][4 * rq + 1]); v.y = cvtpk(OUT[dt][4 * rq + 2], OUT[dt][4 * rq + 3]); *(u32x2*)(orow + 32 * dt + 8 * rq) = v; }
#undef ATT_STAGE
#undef ATT_FINALIZE
    }
    __builtin_amdgcn_s_setprio(0);
}
constexpr int LDS_BYTES = 155648;
constexpr int LDS_MISC = LDS_BYTES - 256;
constexpr int NPH = 21;

__global__ void __launch_bounds__(512, 2) fwd(Args a) {
    extern __shared__ __attribute__((aligned(16))) unsigned char lds_raw[];
    Fr F; F.lds = (LAS unsigned char*)lds_raw; F.tid = threadIdx.x; F.lane = F.tid & 63; F.wave = __builtin_amdgcn_readfirstlane(F.tid >> 6); F.G = gridDim.x;
    F.gw = blockIdx.x * 8 + F.wave; F.ngw = F.G * 8;
    unsigned char* ws = a.ws;
    volatile LAS unsigned* MISC = (volatile LAS unsigned*)(F.lds + LDS_MISC);
    if (F.tid < 64) MISC[F.tid] = 0u;
    __syncthreads();
    const int lo = a.ph_lo, hi = a.ph_hi;
    XcdBarrier bar; bar.bar = (unsigned*)(ws + WS_CTL) + CW_BAR; bar.x = 0; bar.st = nullptr;
    if (hi - lo > 1) bar = xcd_barrier_post((unsigned*)(ws + WS_CTL) + CW_BAR, MISC + 8);


#ifndef REPEAT_MASK
#define REPEAT_MASK 0u
#endif
#ifdef ONLY_PH
#define IN(k) ((k) == ONLY_PH && lo <= (k) && (k) < hi)
#else
#define IN(k) (lo <= (k) && (k) < hi)
#endif
#define REP(k) for (int _rep = 0; _rep < (((REPEAT_MASK >> (k)) & 1u) ? 2 : 1); ++_rep)
#define SEAM(k) do { if (IN(k) && IN((k) + 1)) xcd_barrier(bar); } while (0)
    using namespace pg8;
    const int c = (int)blockIdx.x;

    if (IN(0)) { phase_conv(F, a); if ((REPEAT_MASK >> 30) & 1u) { __syncthreads(); phase_conv(F, a); } phase_r1(F, a); if ((REPEAT_MASK >> 31) & 1u) { __syncthreads(); phase_r1(F, a); } }
    SEAM(0);
    if (IN(1)) REP(1) {
        { Gemm g{(const bf16_t*)(ws + WS_S0), (const bf16_t*)(ws + WS_WR), 1024, 1024, 0, 1 << 20, nullptr, 0}; StaticOrder S; S.init(NT, 1024, F.G, c); EpiBf16 E{(bf16_t*)(ws + WS_S3), 1024, 1.f, 1}; gemm_phase(F.lds, g, S, E);
#ifdef DUP_P1
        gemm_phase(F.lds, g, S, E);
#endif
        }
        { Gemm g{(const bf16_t*)(ws + WS_S1), (const bf16_t*)(ws + WS_WK), 1024, 1024, 0, 1 << 20, nullptr, 0}; StaticOrder S; S.init(NT, 1024, F.G, c); EpiBf16 E{(bf16_t*)(ws + WS_S4), 1024, 1.f, 1}; gemm_phase(F.lds, g, S, E); }
        { Gemm g{(const bf16_t*)(ws + WS_S2), (const bf16_t*)(ws + WS_WV), 1024, 1024, 0, 1 << 20, nullptr, 0}; StaticOrder S; S.init(NT, 1024, F.G, c); EpiBf16 E{(bf16_t*)a.out, 1024, 1.f, 1}; gemm_phase(F.lds, g, S, E); }
        { Gemm g{(const bf16_t*)(ws + WS_S5), (const bf16_t*)(ws + WS_WL1), 2048, 1024, 1, 16, nullptr, 0}; StaticOrder S; S.init(NT, 512, F.G, c); EpiLora1 E{(bf16_t*)((unsigned char*)a.out + 128 * MiB)}; gemm_phase(F.lds, g, S, E); }
    }
    SEAM(1);
    if (IN(2)) REP(2) {
        const bf16_t* T1 = (const bf16_t*)((unsigned char*)a.out + 128 * MiB);
        { int kwa = 128; asm volatile("" : "+s"(kwa));
          Gemm g{T1, (const bf16_t*)(ws + WS_W2WA), kwa, 512, 0, 1 << 20, nullptr, 0}; StaticOrder S; S.init(NT, 2048, F.G, c); EpiLora2WA E{(bf16_t*)(ws + WS_S0), (bf16_t*)(ws + WS_S1), a.in[I_AW0], a.in[I_AA0]}; gemm_phase(F.lds, g, S, E); }
        { Gemm g{T1 + 128, (const bf16_t*)(ws + WS_W2G), 256, 512, 0, 1 << 20, nullptr, 0}; StaticOrder S; S.init(NT, 1024, F.G, c); EpiBf16 E{(bf16_t*)(ws + WS_S2), 1024, 1.f, 1}; gemm_phase(F.lds, g, S, E); }
    }
    SEAM(2);
    if (IN(3)) REP(3) phase_scan(F, a);
    SEAM(3);
    if (IN(4)) REP(4) { Gemm g{(const bf16_t*)(ws + WS_S5), (const bf16_t*)(ws + WS_WO), 1024, 64, 0, 1 << 20, nullptr, 1}; StaticOrder S; S.init(NT, 1024, F.G, c); EpiResX E{a.in[I_X], (bf16_t*)(ws + WS_H)}; gemm_phase(F.lds, g, S, E);
#ifdef DUP_PH4
        gemm_phase(F.lds, g, S, E);
#endif
    }
    SEAM(4);
#define MOE_PHASES(layer, pb) \
    if (IN(pb)) phase_m1(F, a, layer); \
    SEAM(pb); \
    if (IN((pb) + 1)) phase_m2(F, a, layer); \
    SEAM((pb) + 1); \
    if (IN((pb) + 2)) REP((pb) + 2) { const int* texp = (const int*)(ws + WS_TEXP); Gemm g{(const bf16_t*)(ws + WS_H), (const bf16_t*)(ws + WS_BT1) + (size_t)(layer) * 32 * 1024 * 1024, 1024, 1024, 0, 1 << 20, (const int*)(ws + WS_RIDX), 0}; \
        MoeOrder S; S.init(texp, F.G, c); EpiMoe1 E{(bf16_t*)(ws + WS_S4), (const float*)(ws + WS_ROWRS)}; gemm_phase<EpiMoe1, MoeOrder, true>(F.lds, g, S, E); } \
    SEAM((pb) + 2); \
    if (IN((pb) + 3)) REP((pb) + 3) { const int* texp = (const int*)(ws + WS_TEXP); Gemm g{(const bf16_t*)(ws + WS_S4), (const bf16_t*)(ws + WS_BT2) + (size_t)(layer) * 32 * 1024 * 512, 512, 512, 0, 1 << 20, nullptr, 0}; \
        MoeOrder S; S.init(texp, F.G, c); EpiMoe2 E{(bf16_t*)(ws + WS_S1), (const float*)(ws + WS_ROWW)}; gemm_phase(F.lds, g, S, E); } \
    SEAM((pb) + 3);

    MOE_PHASES(0, 5)
    if (IN(9)) phase_n1(F, a);
    SEAM(9);
    if (IN(10)) REP(10) { Gemm g{(const bf16_t*)(ws + WS_H), (const bf16_t*)(ws + WS_WKVQG), 1024, 1024, 0, 1 << 20, nullptr, 0}; StaticOrder S; S.init(NT, 2816, F.G, c);
        EpiKvqg E{(bf16_t*)(ws + WS_KV), (bf16_t*)(ws + WS_Q), (float*)(ws + WS_GATES), (const float*)(ws + WS_RSTD)}; gemm_phase(F.lds, g, S, E); }
    SEAM(10);
    if (IN(11)) { if (F.G <= 128) phase_vt(F, a, F.gw, F.ngw); }
    if (F.G <= 128) SEAM(11);
    if (IN(12)) { Gemm g{(const bf16_t*)(ws + WS_KV), (const bf16_t*)(ws + WS_WC1), 2048, 64, 0, 1 << 20, (const int*)(ws + WS_CIDX), 2}; CmpOrder S{F.G, c}; EpiCmp E{(bf16_t*)(ws + WS_HC), (const float*)(ws + WS_PEBP)}; gemm_phase<EpiCmp, CmpOrder, true>(F.lds, g, S, E);
        if (F.G > 128 && c >= 128) phase_vt(F, a, (c - 128) * 8 + F.wave, (F.G - 128) * 8);
        if (F.G > 128 && c < 128) { __builtin_amdgcn_fence(__ATOMIC_ACQUIRE, "agent"); phase_cmp2(F, a, c * 16 + F.wave, 8, c * 16 + 16); } }
    if (F.G <= 128) SEAM(12);
    if (IN(13) && F.G <= 128) phase_cmp2(F, a, F.gw, F.ngw, 2048);
    SEAM(13);
    if (IN(14)) REP(14) phase_attn(F, a);
    SEAM(14);
    if (IN(15)) { Gemm g{(const bf16_t*)(ws + WS_OATT), (const bf16_t*)(ws + WS_WOB), 1024, 1024, 0, 1 << 20, nullptr, 0}; StaticOrder S; S.init(NT, 1024, F.G, c); EpiResH E{(bf16_t*)(ws + WS_H)}; gemm_phase(F.lds, g, S, E); }
    SEAM(15);
    MOE_PHASES(1, 16)
    if (IN(20)) phase_final(F, a);
#undef IN
#undef SEAM
}

extern "C" void kernel_launch(void* const* d_in, const int* in_sizes, int n_in, void* d_out, int out_size, void* d_ws, size_t ws_size, hipStream_t stream) {
    static int grid = 0;
    if (grid == 0) {
        if (n_in != 41 || out_size != NT * DM || ws_size < WS_NEED) { fprintf(stderr, "kernel_launch: unexpected problem (n_in %d, out %d, ws %zu); nothing launched\n", n_in, out_size, ws_size); grid = -1; return; }
        int dev = 0, cus = 0, per_cu = 0;
        if (hipGetDevice(&dev) != hipSuccess || hipDeviceGetAttribute(&cus, hipDeviceAttributeMultiprocessorCount, dev) != hipSuccess) { grid = -1; return; }
        if (hipFuncSetAttribute((const void*)fwd, hipFuncAttributeMaxDynamicSharedMemorySize, LDS_BYTES) != hipSuccess) { fprintf(stderr, "kernel_launch: hipFuncSetAttribute failed\n"); grid = -1; return; }
        if (hipOccupancyMaxActiveBlocksPerMultiprocessor(&per_cu, (const void*)fwd, 512, LDS_BYTES) != hipSuccess || per_cu < 1)
            fprintf(stderr, "kernel_launch: occupancy query reports %d workgroups per CU\n", per_cu);
        (void)hipGetLastError();
        grid = cus;
    }
    if (grid < 0) return;
    (void)hipMemsetAsync((char*)d_ws + WS_CTL, 0, CTL_BYTES, stream);
    Args a{};
    for (int i = 0; i < 41; ++i) a.in[i] = (const float*)d_in[i];
    a.out = (float*)d_out; a.ws = (unsigned char*)d_ws;
#if N_LAUNCH_MODE == 1
    a.ph_lo = 0; a.ph_hi = NPH;
    hipLaunchKernelGGL(fwd, dim3(grid), dim3(512), LDS_BYTES, stream, a);
#else
    for (int p = 0; p < NPH; ++p) { a.ph_lo = p; a.ph_hi = p + 1; hipLaunchKernelGGL(fwd, dim3(grid), dim3(512), LDS_BYTES, stream, a); }
#endif
}
```

```cpp
#include <hip/hip_runtime.h>
#include <cstdio>
#include <cstdint>

#define GAS __attribute__((address_space(1)))
#define LAS __attribute__((address_space(3)))
typedef unsigned short bf16_t;
typedef short bf16x8 __attribute__((ext_vector_type(8)));
typedef float f32x4 __attribute__((ext_vector_type(4)));
typedef float f32x2 __attribute__((ext_vector_type(2)));
typedef unsigned u32x4 __attribute__((ext_vector_type(4)));
typedef unsigned u32x2 __attribute__((ext_vector_type(2)));

#ifndef N_LAUNCH_MODE
#define N_LAUNCH_MODE 1
#endif

constexpr int NT = 65536, DM = 1024, SEQ = 2048, NB = 32;
constexpr int P_MAX = 139264;
constexpr size_t MiB = 1u << 20;
constexpr size_t WS_CTL = 0, CTL_BYTES = 1 * MiB;
constexpr size_t WS_RFRAG = 1 * MiB;
constexpr size_t WS_W2F = 3 * MiB;
constexpr size_t WS_CIDX = 3 * MiB + 256 * 1024;
constexpr size_t WS_PEBP = 3 * MiB + 512 * 1024;
constexpr size_t WS_TEXP = 2 * MiB;
constexpr size_t WS_WR = 8 * MiB, WS_WK = 10 * MiB, WS_WV = 12 * MiB, WS_WO = 14 * MiB;
constexpr size_t WS_WL1 = 16 * MiB;
constexpr size_t WS_W2WA = 18 * MiB;
constexpr size_t WS_W2G = 19 * MiB;
constexpr size_t WS_WKVQG = 20 * MiB;
constexpr size_t WS_WOB = 26 * MiB;
constexpr size_t WS_WC1 = 28 * MiB;
constexpr size_t WS_BT1 = 32 * MiB;
constexpr size_t WS_BT2 = 160 * MiB;
constexpr size_t WS_S0 = 224 * MiB, WS_S1 = 352 * MiB, WS_S2 = 480 * MiB, WS_S3 = 608 * MiB, WS_S4 = 736 * MiB, WS_S5 = 864 * MiB;
constexpr size_t WS_GATES = 993 * MiB;
constexpr size_t WS_ASG = 1014 * MiB;
constexpr size_t WS_ROWW = 1016 * MiB;
constexpr size_t WS_RIDX = 1017 * MiB;
constexpr size_t WS_RSTD = 1018 * MiB;
constexpr size_t WS_ROWRS = 1019 * MiB;
constexpr size_t WS_H = WS_S0;
constexpr size_t WS_NEED = 1024 * MiB;
constexpr size_t WS_KV = 352 * MiB, WS_Q = 544 * MiB, WS_ACMP = 672 * MiB, WS_HC = 800 * MiB, WS_OATT = 816 * MiB;
constexpr size_t WS_KCB = 1006 * MiB, WS_VCT = 1008 * MiB;
constexpr int CW_BAR = 4096;
constexpr int CW_CNT = 16384;

typedef __bf16 bf16x2n __attribute__((ext_vector_type(2)));
__device__ __forceinline__ unsigned cvtpk(float lo, float hi) { const f32x2 v = {lo, hi}; return __builtin_bit_cast(unsigned, __builtin_convertvector(v, bf16x2n)); }
__device__ __forceinline__ unsigned f2bf(float f) { return cvtpk(f, f) & 0xffffu; }
__device__ __forceinline__ unsigned pk2(float lo, float hi) { return cvtpk(lo, hi); }
__device__ __forceinline__ float bflo(unsigned u) { return __builtin_bit_cast(float, u << 16); }
__device__ __forceinline__ float bfhi(unsigned u) { return __builtin_bit_cast(float, u & 0xffff0000u); }
__device__ __forceinline__ float bf2f(bf16_t b) { return __builtin_bit_cast(float, ((unsigned)b) << 16); }
template <int CTRL> __device__ __forceinline__ float dppf(float v) { return __int_as_float(__builtin_amdgcn_update_dpp(0, __float_as_int(v), CTRL, 0xf, 0xf, true)); }
#define DPP_XOR1 0xB1
#define DPP_XOR2 0x4E
#define DPP_HALF_MIRROR 0x141
#define DPP_MIRROR 0x140
#define DPP_ROR8 0x128
__device__ __forceinline__ float wave_sum(float v) {
    v += dppf<DPP_XOR1>(v); v += dppf<DPP_XOR2>(v); v += dppf<DPP_HALF_MIRROR>(v); v += dppf<DPP_MIRROR>(v);
    { const auto r = __builtin_amdgcn_permlane16_swap(__float_as_uint(v), __float_as_uint(v), false, false); v = __uint_as_float(r[0]) + __uint_as_float(r[1]); }
    { const auto r = __builtin_amdgcn_permlane32_swap(__float_as_uint(v), __float_as_uint(v), false, false); v = __uint_as_float(r[0]) + __uint_as_float(r[1]); }
    return v;
}
__device__ __forceinline__ float fexp_(float x) { return __builtin_amdgcn_exp2f(x * 1.44269504089f); }
__device__ __forceinline__ float sigmoidf_(float x) { return __builtin_amdgcn_rcpf(1.f + fexp_(-x)); }
__device__ __forceinline__ float tanhf_(float x) { return 1.f - 2.f * __builtin_amdgcn_rcpf(1.f + fexp_(2.f * x)); }
__device__ __forceinline__ float gelu_tanh_(float x) { return 0.5f * x * (1.f + tanhf_(0.7978845608f * (x + 0.044715f * x * x * x))); }
#define LDS_WAIT() asm volatile("s_waitcnt lgkmcnt(0)" ::: "memory")

__device__ const unsigned char BKT[129] = {0, 1, 2, 3, 4, 5, 6, 7, 8, 9, 10, 11, 12, 13, 14, 15, 16, 16, 16, 17, 17, 18, 18, 18, 19, 19, 19, 20, 20, 20, 20, 21, 21, 21, 21, 22, 22, 22, 22, 22, 23, 23, 23, 23, 23, 23, 24, 24, 24, 24, 24, 24, 25, 25, 25, 25, 25, 25, 25, 26, 26, 26, 26, 26, 26, 26, 26, 27, 27, 27, 27, 27, 27, 27, 27, 27, 27, 28, 28, 28, 28, 28, 28, 28, 28, 28, 28, 29, 29, 29, 29, 29, 29, 29, 29, 29, 29, 29, 29, 30, 30, 30, 30, 30, 30, 30, 30, 30, 30, 30, 30, 30, 30, 31, 31, 31, 31, 31, 31, 31, 31, 31, 31, 31, 31, 31, 31, 31, 31};

#define XB_TMO      128
#define XB_XCNT(j)  (256  + 64 * (j))
#define XB_XSUB(j)  (1280 + 64 * (j))
#define XB_XGEN(j)  (2304 + 64 * (j))
#define XB_TOP      3328
#define XB_TOPGEN   3392
#define XCD_BAR_WORDS 3456
#define XB_SPIN_CAP (1u << 22)
__device__ __forceinline__ unsigned xb_ld(unsigned* p)              { return __hip_atomic_load(p, __ATOMIC_RELAXED, __HIP_MEMORY_SCOPE_AGENT); }
__device__ __forceinline__ unsigned xb_add(unsigned* p, unsigned v) { return __hip_atomic_fetch_add(p, v, __ATOMIC_RELAXED, __HIP_MEMORY_SCOPE_AGENT); }
__device__ __forceinline__ unsigned xb_xcc_id() { return (unsigned)__builtin_amdgcn_s_getreg((3 << 11) | 20) & 0xFu; }
#define XB_SPIN(cond, bar) do { unsigned _sp = 0; while (cond) { __builtin_amdgcn_s_sleep(1); \
    if ((++_sp & 255u) == 0u) { if (xb_ld(&(bar)[XB_TMO])) break; if (_sp > XB_SPIN_CAP) { atomicAdd(&(bar)[XB_TMO], 1u); break; } } } } while (0)
struct XcdBarrier { unsigned* bar; unsigned x; volatile LAS unsigned* st; };
__device__ __forceinline__ XcdBarrier xcd_barrier_post(unsigned* bar, volatile LAS unsigned* st) {
    XcdBarrier b; b.bar = bar; b.x = xb_xcc_id(); b.st = st;
    if (threadIdx.x == 0) (void)xb_add(&bar[XB_XCNT(b.x)], 1u);
    return b;
}
__device__ __forceinline__ void xcd_barrier_complete(unsigned* bar, unsigned x, unsigned& nloc, unsigned& nx) {
    const unsigned G = gridDim.x * gridDim.y * gridDim.z;
    unsigned sum, cnt, mine, sp = 0u;
    for (;;) {
        sum = 0u; cnt = 0u; mine = 0u;
#pragma unroll
        for (unsigned j = 0; j < 16; ++j) { const unsigned c = xb_ld(&bar[XB_XCNT(j)]); sum += c; cnt += (c > 0u) ? 1u : 0u; mine = (j == x) ? c : mine; }
        if (sum == G) break;
        __builtin_amdgcn_s_sleep(1);
        if ((++sp & 255u) == 0u) { if (xb_ld(&bar[XB_TMO])) break; if (sp > XB_SPIN_CAP) { atomicAdd(&bar[XB_TMO], 1u); break; } }
    }
    nloc = mine > 0u ? mine : 1u; nx = cnt > 0u ? cnt : 1u;
}
__device__ __forceinline__ void xcd_barrier(const XcdBarrier& b) {
    asm volatile("s_waitcnt vmcnt(0)" ::: "memory");
    __syncthreads();
    if (threadIdx.x == 0) {
        unsigned* bar = b.bar;
        __builtin_amdgcn_s_waitcnt(0);
        unsigned nloc = b.st[0], nx = b.st[1];
        if (nloc == 0u) { xcd_barrier_complete(bar, b.x, nloc, nx); b.st[0] = nloc; b.st[1] = nx; }
        const unsigned old = xb_add(&bar[XB_XSUB(b.x)], 1u);
        const unsigned gen = old / nloc;
        if (old + 1u == (gen + 1u) * nloc) {
            __builtin_amdgcn_fence(__ATOMIC_RELEASE, "agent");
            asm volatile("s_waitcnt vmcnt(0)" ::: "memory");
            const unsigned og = xb_add(&bar[XB_TOP], 1u);
            const unsigned tg = og / nx;
            if (og + 1u == (tg + 1u) * nx) xb_add(&bar[XB_TOPGEN], 1u);
            else XB_SPIN(xb_ld(&bar[XB_TOPGEN]) == tg, bar);
            __builtin_amdgcn_fence(__ATOMIC_ACQUIRE, "agent");
            xb_add(&bar[XB_XGEN(b.x)], 1u);
            asm volatile("s_waitcnt vmcnt(0)" ::: "memory");
        } else {
            XB_SPIN(xb_ld(&bar[XB_XGEN(b.x)]) == gen, bar);
            __builtin_amdgcn_fence(__ATOMIC_ACQUIRE, "agent");
            asm volatile("s_waitcnt vmcnt(0)" ::: "memory");
        }
    }
    __syncthreads();
}

namespace pg8 {
constexpr int BM = 256, BK = 64, HALF = 128, HTB = HALF * BK * 2, STAGE_BYTES = 8 * HTB, NXCD = 8, WGM = 8;
__host__ __device__ __forceinline__ int lds_byte(int r, int c) { const int st = (r >> 4) * 2 + (c >> 5), rr = r & 15, cc = c & 31, ob = rr * 64 + cc * 2; return st * 1024 + (ob ^ (((ob >> 9) & 1) << 5)); }
__host__ __device__ __forceinline__ void stage_rc(int b, int& R, int& C) { const int st = b / 1024, sb = b % 1024, swz = sb ^ (((sb >> 9) & 1) << 5); R = (st >> 1) * 16 + swz / 64; C = (st & 1) * 32 + (swz % 64) / 2; }
__host__ __device__ __forceinline__ int perm32(int rho) { const int n = rho >> 4, i = rho & 15; return 8 * (i >> 2) + 4 * n + (i & 3); }
struct Unit { int pm, pn; };
struct Gemm { const bf16_t* A; const bf16_t* Bt; int K, lda, apad, kwrap; const int* gidx; int ahm; };
struct StaticOrder {
    int nM, nN, nwg, G, c;
    __device__ void init(int M, int N, int G_, int c_) { nM = M / BM; nN = N / BM; nwg = nM * nN; G = G_; c = c_; }
    __device__ bool next(int i, Unit& u) const {
        const long L = (long)i * G + c; if (L >= nwg) return false;
        int wgid = (int)L; { const int q = nwg / NXCD, r = nwg % NXCD, xcd = wgid % NXCD, off = wgid / NXCD; wgid = (xcd < r ? xcd * (q + 1) : r * (q + 1) + (xcd - r) * q) + off; }
        const int nig = WGM * nN, gid = wgid / nig, fm = gid * WGM, gsz = (nM - fm) < WGM ? (nM - fm) : WGM;
        u.pm = fm + ((wgid % nig) % gsz); u.pn = (wgid % nig) / gsz; return true;
    }
};
struct MoeOrder {
    const int* xl; int nunits, ncu, cu; mutable int pre;
    __device__ __forceinline__ void init(const int* texp, int G_, int c_) { const int x = c_ & 7; cu = c_ >> 3; ncu = G_ >> 3; xl = texp + 2048 + x * 640; nunits = texp[1008 + x] * 4; pre = (cu < nunits) ? xl[cu >> 2] : 0; }
    __device__ __forceinline__ bool next(int i, Unit& u) const {
        const int L = i * ncu + cu; if (L >= nunits) return false;
        const int ent = pre; u.pm = ent & 0xffff; u.pn = (ent >> 16) * 4 + (L & 3);
        const int L2 = L + ncu; pre = (L2 < nunits) ? xl[L2 >> 2] : 0; return true;
    }
};
struct CmpOrder {
    int G, c;
    __device__ bool next(int i, Unit& u) const { const long L = (long)i * G + c; if (L >= 128) return false; u.pm = (int)L; u.pn = (int)(L >> 6); return true; }
};

template <class Epi, class Sched, bool GATHER = false, bool ALIGN_EPI = true, bool SP2 = true>
__device__ __forceinline__ void gemm_phase(LAS unsigned char* lds, const Gemm g, const Sched& S, const Epi& E) {
    const int tid = threadIdx.x, wid = __builtin_amdgcn_readfirstlane(tid >> 6), lane = tid & 63, wr = wid >> 2, wc = wid & 3, fr = lane & 15, fq = lane >> 4;
    const int K = g.K, nt = K / BK, lda = g.lda, kwrap = g.kwrap;
    unsigned voffA[2], voffB[2];
#pragma unroll
    for (int i = 0; i < 2; ++i) { int R, C; stage_rc(tid * 16 + i * 8192, R, C); const int Rb = Epi::PERM ? ((R & ~31) + perm32(R & 31)) : R;
        voffA[i] = (unsigned)(R * lda + C) * 2u; voffB[i] = (unsigned)(Rb * K + C) * 2u; }
    const long kstep = (long)(BK * 2); const long kstepA = g.ahm == 2 ? 3072l : g.ahm ? (long)SEQ * 128 : kstep;
    const long hstepA = (long)HALF * lda * 2, hstepB = (long)HALF * K * 2;
    const long tstepB = 2 * hstepB;
    const unsigned ldsw = (unsigned)wid * 1024u;
    const int aoff = lds_byte(wr * 64 + fr, fq * 8), boff = lds_byte(wc * 32 + fr, fq * 8);
#define PG8_KOFFA(t) (((t) < kwrap) ? (long)(t) * kstepA : (long)((t) - kwrap) * kstepA - (long)lda * 2)
#define PG8_ATILE(pm) (g.ahm ? (const char*)g.A + ((long)((pm) >> 3) * (K / 64) * SEQ + (long)((pm) & 7) * 256) * 128 : (const char*)g.A + ((long)(pm) * 256 + (g.apad ? (((pm) >> 3) + 1) : 0)) * (long)lda * 2)
#define PG8_SA(b, h) (((b) * 2 + (h)) * HTB)
#define PG8_SB(b, h) ((4 + (b) * 2 + (h)) * HTB)
#define PG8_STAGE(bufoff, gbase, voff) do { _Pragma("unroll") for (int _i = 0; _i < 2; ++_i) \
        __builtin_amdgcn_global_load_lds((const unsigned*)((const char*)(gbase) + (voff)[_i]), (LAS unsigned*)(lds + (bufoff) + ldsw + _i * 8192), 16, 0, 0); } while (0)
#define PG8_STAGE_A(bufoff, nx, h, ko) do { if constexpr (GATHER) { _Pragma("unroll") for (int _i = 0; _i < 2; ++_i) \
            __builtin_amdgcn_global_load_lds((const unsigned*)((const char*)g.A + (ko) + ((nx) ? gon[h][_i] : goc[h][_i])), (LAS unsigned*)(lds + (bufoff) + ldsw + _i * 8192), 16, 0, 0); } \
        else PG8_STAGE(bufoff, ((nx) ? nA : cA) + (h) * hstepA + (ko), voffA); } while (0)
#define PG8_GIDX(dst, pm_) do { if constexpr (GATHER) { _Pragma("unroll") for (int _h = 0; _h < 2; ++_h) _Pragma("unroll") for (int _i = 0; _i < 2; ++_i) \
            dst[_h][_i] = (unsigned)g.gidx[(pm_) * 256 + _h * 128 + (int)(voffA[_i] / (unsigned)(lda * 2))] * (unsigned)(lda * 2) + voffA[_i] % (unsigned)(lda * 2); } } while (0)
#define PG8_LDA(dst, b, h) do { _Pragma("unroll") for (int m = 0; m < 4; ++m) _Pragma("unroll") for (int k = 0; k < 2; ++k) dst[m][k] = *(const LAS bf16x8*)(lds + PG8_SA(b, h) + aoff + m * 2048 + k * 1024); } while (0)
#define PG8_LDB(dst, b, h) do { _Pragma("unroll") for (int n = 0; n < 2; ++n) _Pragma("unroll") for (int k = 0; k < 2; ++k) dst[n][k] = *(const LAS bf16x8*)(lds + PG8_SB(b, h) + boff + n * 2048 + k * 1024); } while (0)
#define PG8_MMA(ai, bj, At, Bt) do { __builtin_amdgcn_s_setprio(1); _Pragma("unroll") for (int m = 0; m < 4; ++m) _Pragma("unroll") for (int n = 0; n < 2; ++n) _Pragma("unroll") for (int k = 0; k < 2; ++k) \
        acc[ai][bj][m][n] = __builtin_amdgcn_mfma_f32_16x16x32_bf16(Bt[n][k], At[m][k], acc[ai][bj][m][n], 0, 0, 0); __builtin_amdgcn_s_setprio(0); } while (0)
#define PG8_WAIT_V(n) asm volatile("s_waitcnt vmcnt(" #n ")" ::: "memory")
#define PG8_WAIT_L(n) asm volatile("s_waitcnt lgkmcnt(" #n ")" ::: "memory")
#define PG8_BAR __builtin_amdgcn_s_barrier()
#define PG8_SCHED __builtin_amdgcn_sched_barrier(0)
    Unit cur, nxt; int ui = 0;
    if (!S.next(0, cur)) return;
    f32x4 acc[2][2][4][2];
#pragma unroll
    for (int a = 0; a < 2; ++a)
#pragma unroll
        for (int b = 0; b < 2; ++b)
#pragma unroll
            for (int m = 0; m < 4; ++m)
#pragma unroll
                for (int n = 0; n < 2; ++n) acc[a][b][m][n] = (f32x4){0.f, 0.f, 0.f, 0.f};
    bf16x8 At[4][2], B0[2][2], B1[2][2];
    const char* cA = PG8_ATILE(cur.pm); const char* cB = (const char*)g.Bt + (long)cur.pn * tstepB; const char* nA = cA;
    unsigned goc[2][2], gon[2][2];
#pragma unroll
    for (int _h = 0; _h < 2; ++_h)
#pragma unroll
        for (int _i = 0; _i < 2; ++_i) { goc[_h][_i] = 0u; gon[_h][_i] = 0u; }
    PG8_GIDX(goc, cur.pm);
    if constexpr (SP2) {
        PG8_STAGE(PG8_SB(0, 0), cB, voffB); PG8_STAGE(PG8_SB(0, 1), cB + hstepB, voffB); PG8_STAGE_A(PG8_SA(0, 0), false, 0, 0); PG8_STAGE_A(PG8_SA(0, 1), false, 1, 0);
        if (wr == 1) PG8_BAR;
        PG8_WAIT_V(2); PG8_BAR;
        PG8_STAGE(PG8_SB(1, 0), cB + kstep, voffB); PG8_STAGE_A(PG8_SA(1, 0), false, 0, kstepA); PG8_STAGE(PG8_SB(1, 1), cB + hstepB + kstep, voffB);
        PG8_WAIT_V(6); PG8_BAR;
    } else {
        PG8_STAGE(PG8_SB(0, 0), cB, voffB); PG8_STAGE_A(PG8_SA(0, 0), false, 0, 0); PG8_STAGE(PG8_SB(0, 1), cB + hstepB, voffB); PG8_STAGE_A(PG8_SA(0, 1), false, 1, 0);
        if (wr == 1) PG8_BAR;
        PG8_WAIT_V(4); PG8_BAR;
        PG8_STAGE(PG8_SB(1, 0), cB + kstep, voffB); PG8_STAGE_A(PG8_SA(1, 0), false, 0, kstepA); PG8_STAGE(PG8_SB(1, 1), cB + hstepB + kstep, voffB);
        PG8_WAIT_V(6); PG8_BAR;
    }
    for (;;) {
        const bool has_next = S.next(ui + 1, nxt);
        nA = has_next ? PG8_ATILE(nxt.pm) : cA; const char* nB = has_next ? (const char*)g.Bt + (long)nxt.pn * tstepB : cB;
        if constexpr (GATHER) { if (has_next) PG8_GIDX(gon, nxt.pm); else {
#pragma unroll
            for (int _h = 0; _h < 2; ++_h)
#pragma unroll
                for (int _i = 0; _i < 2; ++_i) gon[_h][_i] = goc[_h][_i]; } }
#pragma unroll 1
        for (int t = 0; t < nt; t += 2) {
            const bool last = (t == nt - 2);
            const long k1 = PG8_KOFFA(t + 1), k2 = last ? 0 : PG8_KOFFA(t + 2), k3 = last ? kstepA : PG8_KOFFA(t + 3);
            const char* b2 = last ? nB : cB + (long)(t + 2) * kstep; const char* b3 = b2 + kstep;
            if constexpr (SP2) {
            PG8_LDB(B0, 0, 0); PG8_LDB(B1, 0, 1); PG8_SCHED; PG8_LDA(At, 0, 0); PG8_STAGE_A(PG8_SA(1, 1), false, 1, k1);
            PG8_WAIT_V(8); PG8_WAIT_L(0); PG8_BAR; PG8_MMA(0, 0, At, B0); PG8_MMA(0, 1, At, B1); PG8_BAR; PG8_SCHED;
            PG8_LDA(At, 0, 1); PG8_STAGE(PG8_SB(0, 0), b2, voffB); PG8_STAGE(PG8_SB(0, 1), b2 + hstepB, voffB); PG8_STAGE_A(PG8_SA(0, 0), last, 0, k2);
            PG8_WAIT_V(8); PG8_WAIT_L(0); PG8_BAR; PG8_MMA(1, 0, At, B0); PG8_MMA(1, 1, At, B1); PG8_BAR; PG8_SCHED;
            PG8_LDB(B0, 1, 0); PG8_LDB(B1, 1, 1); PG8_SCHED; PG8_LDA(At, 1, 0); PG8_STAGE_A(PG8_SA(0, 1), last, 1, k2);
            PG8_WAIT_V(8); PG8_WAIT_L(0); PG8_BAR; PG8_MMA(0, 0, At, B0); PG8_MMA(0, 1, At, B1); PG8_BAR; PG8_SCHED;
            PG8_LDA(At, 1, 1); PG8_STAGE(PG8_SB(1, 0), b3, voffB); PG8_STAGE(PG8_SB(1, 1), b3 + hstepB, voffB); PG8_STAGE_A(PG8_SA(1, 0), last, 0, k3);
            PG8_WAIT_V(8); PG8_WAIT_L(0); PG8_BAR; PG8_MMA(1, 0, At, B0); PG8_MMA(1, 1, At, B1); PG8_BAR; PG8_SCHED;
            } else {
            PG8_LDB(B0, 0, 0); PG8_SCHED; PG8_LDA(At, 0, 0); PG8_STAGE_A(PG8_SA(1, 1), false, 1, k1);
            PG8_WAIT_L(8); PG8_BAR; PG8_WAIT_L(0); PG8_MMA(0, 0, At, B0); PG8_BAR; PG8_SCHED;
            PG8_LDB(B1, 0, 1); PG8_STAGE(PG8_SB(0, 0), b2, voffB);
            PG8_BAR; PG8_WAIT_L(0); PG8_MMA(0, 1, At, B1); PG8_BAR;
            PG8_LDA(At, 0, 1); PG8_STAGE_A(PG8_SA(0, 0), last, 0, k2);
            PG8_BAR; PG8_WAIT_L(0); PG8_MMA(1, 0, At, B0); PG8_BAR; PG8_SCHED;
            PG8_STAGE(PG8_SB(0, 1), b2 + hstepB, voffB);
            PG8_WAIT_V(6); PG8_BAR; PG8_MMA(1, 1, At, B1); PG8_BAR;
            PG8_LDB(B0, 1, 0); PG8_SCHED; PG8_LDA(At, 1, 0); PG8_STAGE_A(PG8_SA(0, 1), last, 1, k2);
            PG8_WAIT_L(8); PG8_BAR; PG8_WAIT_L(0); PG8_MMA(0, 0, At, B0); PG8_BAR; PG8_SCHED;
            PG8_LDB(B1, 1, 1); PG8_STAGE(PG8_SB(1, 0), b3, voffB);
            PG8_BAR; PG8_WAIT_L(0); PG8_MMA(0, 1, At, B1); PG8_BAR;
            PG8_LDA(At, 1, 1); PG8_STAGE_A(PG8_SA(1, 0), last, 0, k3);
            PG8_BAR; PG8_WAIT_L(0); PG8_MMA(1, 0, At, B0); PG8_BAR; PG8_SCHED;
            PG8_STAGE(PG8_SB(1, 1), b3 + hstepB, voffB);
            PG8_WAIT_V(6); PG8_BAR; PG8_MMA(1, 1, At, B1); PG8_BAR;
            }
        }
        if constexpr (ALIGN_EPI) { if (wr == 0) PG8_BAR; }
        E(acc, cur, wr, wc, fr, fq);
        if (!has_next) break;
#pragma unroll
        for (int a = 0; a < 2; ++a)
#pragma unroll
            for (int b = 0; b < 2; ++b)
#pragma unroll
                for (int m = 0; m < 4; ++m)
#pragma unroll
                    for (int n = 0; n < 2; ++n) acc[a][b][m][n] = (f32x4){0.f, 0.f, 0.f, 0.f};
        cur = nxt; cA = nA; cB = nB; ++ui;
        if constexpr (GATHER) {
#pragma unroll
            for (int _h = 0; _h < 2; ++_h)
#pragma unroll
                for (int _i = 0; _i < 2; ++_i) goc[_h][_i] = gon[_h][_i]; }
        if constexpr (ALIGN_EPI) { if (wr == 1) PG8_BAR; }
    }
    PG8_WAIT_V(0);
    if constexpr (!ALIGN_EPI) { if (wr == 0) PG8_BAR; }
    PG8_BAR;
#undef PG8_STAGE_A
#undef PG8_GIDX
#undef PG8_KOFFA
#undef PG8_ATILE
#undef PG8_SA
#undef PG8_SB
#undef PG8_STAGE
#undef PG8_LDA
#undef PG8_LDB
#undef PG8_MMA
#undef PG8_WAIT_V
#undef PG8_WAIT_L
#undef PG8_BAR
#undef PG8_SCHED
}

#define EPI_LOOP_ROWS for (int ai = 0; ai < 2; ++ai) _Pragma("unroll") for (int m = 0; m < 4; ++m)
__device__ __forceinline__ u32x4 pack8(const f32x4 v0, const f32x4 v1) { u32x4 w; w.x = pk2(v0[0], v0[1]); w.y = pk2(v0[2], v0[3]); w.z = pk2(v1[0], v1[1]); w.w = pk2(v1[2], v1[3]); return w; }

__device__ __forceinline__ size_t hm_off(int row, int col) { return ((size_t)((row >> 11) * 16 + (col >> 6)) * SEQ + (row & 2047)) * 64 + (col & 63); }
struct EpiBf16 {
    static constexpr bool PERM = true;
    bf16_t* O; int ldc; float scale; int hm;
    __device__ __forceinline__ void operator()(const f32x4 (&acc)[2][2][4][2], const Unit& u, int wr, int wc, int fr, int fq) const {
        const int row0 = u.pm * BM + wr * 64 + fr, col0 = u.pn * BM + wc * 32 + 8 * fq;
#pragma unroll
        EPI_LOOP_ROWS { const int row = row0 + ai * HALF + m * 16;
#pragma unroll
            for (int bj = 0; bj < 2; ++bj) { bf16_t* p = hm ? O + hm_off(row, col0 + bj * HALF) : O + (size_t)row * ldc + col0 + bj * HALF;
                *(u32x4*)p = pack8(acc[ai][bj][m][0] * scale, acc[ai][bj][m][1] * scale); } }
    }
};
struct EpiLora1 {
    static constexpr bool PERM = true;
    bf16_t* O;
    __device__ __forceinline__ void operator()(const f32x4 (&acc)[2][2][4][2], const Unit& u, int wr, int wc, int fr, int fq) const {
        const int row0 = u.pm * BM + wr * 64 + fr, col0 = u.pn * BM + wc * 32 + 8 * fq;
#pragma unroll
        EPI_LOOP_ROWS { bf16_t* rowp = O + (size_t)(row0 + ai * HALF + m * 16) * 512 + col0;
#pragma unroll
            for (int bj = 0; bj < 2; ++bj) { const int c = col0 + bj * HALF; f32x4 v0 = acc[ai][bj][m][0], v1 = acc[ai][bj][m][1];
                if (c < 64) {
#pragma unroll
                    for (int j = 0; j < 4; ++j) { v0[j] = tanhf_(v0[j]); v1[j] = tanhf_(v1[j]); }
                } else if (c < 128) {
                } else if (c < 288) {
#pragma unroll
                    for (int j = 0; j < 4; ++j) { v0[j] = sigmoidf_(v0[j]); v1[j] = sigmoidf_(v1[j]); }
                } else { v0 = (f32x4){0.f, 0.f, 0.f, 0.f}; v1 = v0; }
                *(u32x4*)(rowp + bj * HALF) = pack8(v0, v1); } }
    }
};
struct EpiLora2WA {
    static constexpr bool PERM = true;
    bf16_t* LW; bf16_t* AA; const float* w0; const float* a0;
    __device__ __forceinline__ void operator()(const f32x4 (&acc)[2][2][4][2], const Unit& u, int wr, int wc, int fr, int fq) const {
        const int row0 = u.pm * BM + wr * 64 + fr; const bool isw = u.pn < 4; const int col0 = (u.pn & 3) * BM + wc * 32 + 8 * fq;
        bf16_t* O = isw ? LW : AA; const float* bias = isw ? w0 : a0; const float mul = isw ? -0.60653065971f : 1.0f;
#pragma unroll
        for (int bj = 0; bj < 2; ++bj) { const f32x4 b0 = *(const f32x4*)(bias + col0 + bj * HALF), b1 = *(const f32x4*)(bias + col0 + bj * HALF + 4);
#pragma unroll
            EPI_LOOP_ROWS { bf16_t* rowp = O + hm_off(row0 + ai * HALF + m * 16, col0 + bj * HALF); f32x4 v0 = acc[ai][bj][m][0] + b0, v1 = acc[ai][bj][m][1] + b1;
#pragma unroll
                for (int j = 0; j < 4; ++j) { v0[j] = mul * sigmoidf_(v0[j]); v1[j] = mul * sigmoidf_(v1[j]); }
                *(u32x4*)rowp = pack8(v0, v1); } }
    }
};
struct EpiResX {
    static constexpr bool PERM = true;
    const float* x; bf16_t* h;
    __device__ __forceinline__ void operator()(const f32x4 (&acc)[2][2][4][2], const Unit& u, int wr, int wc, int fr, int fq) const {
        const int row0 = u.pm * BM + wr * 64 + fr, col0 = u.pn * BM + wc * 32 + 8 * fq;
#pragma unroll
        for (int ai = 0; ai < 2; ++ai) {
            f32x4 xb[4][2][2];
#pragma unroll
            for (int m = 0; m < 4; ++m)
#pragma unroll
                for (int bj = 0; bj < 2; ++bj) { const float* p = x + (size_t)(row0 + ai * HALF + m * 16) * 1024 + col0 + bj * HALF; xb[m][bj][0] = *(const f32x4*)p; xb[m][bj][1] = *(const f32x4*)(p + 4); }
#pragma unroll
            for (int m = 0; m < 4; ++m) { const size_t off = (size_t)(row0 + ai * HALF + m * 16) * 1024 + col0;
#pragma unroll
                for (int bj = 0; bj < 2; ++bj) *(u32x4*)(h + off + bj * HALF) = pack8(acc[ai][bj][m][0] + xb[m][bj][0], acc[ai][bj][m][1] + xb[m][bj][1]); } }
    }
};
struct EpiResH {
    static constexpr bool PERM = true;
    bf16_t* h;
    __device__ __forceinline__ void operator()(const f32x4 (&acc)[2][2][4][2], const Unit& u, int wr, int wc, int fr, int fq) const {
        const int row0 = u.pm * BM + wr * 64 + fr, col0 = u.pn * BM + wc * 32 + 8 * fq;
        u32x4 hb[2][4][2];
#pragma unroll
        EPI_LOOP_ROWS { const size_t off = (size_t)(row0 + ai * HALF + m * 16) * 1024 + col0;
#pragma unroll
            for (int bj = 0; bj < 2; ++bj) hb[ai][m][bj] = *(const u32x4*)(h + off + bj * HALF); }
#pragma unroll
        EPI_LOOP_ROWS { const size_t off = (size_t)(row0 + ai * HALF + m * 16) * 1024 + col0;
#pragma unroll
            for (int bj = 0; bj < 2; ++bj) { const u32x4 b = hb[ai][m][bj];
                const f32x4 b0 = {bflo(b.x), bfhi(b.x), bflo(b.y), bfhi(b.y)}, b1 = {bflo(b.z), bfhi(b.z), bflo(b.w), bfhi(b.w)};
                *(u32x4*)(h + off + bj * HALF) = pack8(acc[ai][bj][m][0] + b0, acc[ai][bj][m][1] + b1); } }
    }
};
struct EpiKvqg {
    static constexpr bool PERM = true;
    bf16_t* KV; bf16_t* Q; float* GT; const float* rs;
    __device__ __forceinline__ void operator()(const f32x4 (&acc)[2][2][4][2], const Unit& u, int wr, int wc, int fr, int fq) const {
        const int row0 = u.pm * BM + wr * 64 + fr;
        float rsv[2][4];
#pragma unroll
        EPI_LOOP_ROWS rsv[ai][m] = rs[row0 + ai * HALF + m * 16];
        if (u.pn < 10) {
            const bool iskv = u.pn < 6; bf16_t* O = iskv ? KV : Q; const int ldc = iskv ? 1536 : 1024; const float sc = iskv ? 1.0f : 0.18033688011f;
            const int col0 = (iskv ? u.pn : u.pn - 6) * BM + wc * 32 + 8 * fq;
#pragma unroll
            EPI_LOOP_ROWS { const int row = row0 + ai * HALF + m * 16; const float scr_ = sc * rsv[ai][m]; bf16_t* rowp = O + (size_t)row * ldc + col0;
#pragma unroll
                for (int bj = 0; bj < 2; ++bj) *(u32x4*)(rowp + bj * HALF) = pack8(acc[ai][bj][m][0] * scr_, acc[ai][bj][m][1] * scr_); }
        } else {
            const int c0 = wc * 32 + 8 * fq;
            if (c0 < 48) {
#pragma unroll
                EPI_LOOP_ROWS { const int row = row0 + ai * HALF + m * 16; const float rr_ = rsv[ai][m]; float* rowp = GT + (size_t)row * 48 + c0; f32x4 v0 = acc[ai][0][m][0] * rr_, v1 = acc[ai][0][m][1] * rr_;
#pragma unroll
                    for (int j = 0; j < 4; ++j) { v0[j] = sigmoidf_(v0[j]); v1[j] = sigmoidf_(v1[j]); }
                    *(f32x4*)(rowp) = v0; *(f32x4*)(rowp + 4) = v1; }
            }
        }
    }
};
struct EpiMoe1 {
    static constexpr bool PERM = true;
    bf16_t* H; const float* rs;
    __device__ __forceinline__ void operator()(const f32x4 (&acc)[2][2][4][2], const Unit& u, int wr, int wc, int fr, int fq) const {
        const int row0 = u.pm * BM + wr * 64 + fr, col0 = (u.pn & 3) * 128 + wc * 32 + 8 * fq;
        float rsv[2][4];
#pragma unroll
        EPI_LOOP_ROWS rsv[ai][m] = rs[row0 + ai * HALF + m * 16];
#pragma unroll
        EPI_LOOP_ROWS { const int row = row0 + ai * HALF + m * 16; const float r_ = rsv[ai][m]; bf16_t* rowp = H + (size_t)row * 512 + col0; f32x4 v0, v1;
#pragma unroll
            for (int j = 0; j < 4; ++j) { const float g0 = acc[ai][0][m][0][j] * r_, g1 = acc[ai][0][m][1][j] * r_; v0[j] = g0 * sigmoidf_(g0) * (acc[ai][1][m][0][j] * r_); v1[j] = g1 * sigmoidf_(g1) * (acc[ai][1][m][1][j] * r_); }
            *(u32x4*)(rowp) = pack8(v0, v1); }
    }
};
struct EpiMoe2 {
    static constexpr bool PERM = true;
    bf16_t* Y; const float* roww;
    __device__ __forceinline__ void operator()(const f32x4 (&acc)[2][2][4][2], const Unit& u, int wr, int wc, int fr, int fq) const {
        const bool up = (fr & 8) != 0;
        const int rowb = u.pm * BM + wr * 64 + (fr & 7), colp = (u.pn & 3) * BM + wc * 64 + 8 * fq;
#pragma unroll
        EPI_LOOP_ROWS { const u32x4 a0 = pack8(acc[ai][0][m][0], acc[ai][0][m][1]), a1 = pack8(acc[ai][1][m][0], acc[ai][1][m][1]); u32x4 x1;
            x1.x = (unsigned)__builtin_amdgcn_update_dpp(0, (int)a1.x, 0x128, 0xf, 0xf, true); x1.y = (unsigned)__builtin_amdgcn_update_dpp(0, (int)a1.y, 0x128, 0xf, 0xf, true);
            x1.z = (unsigned)__builtin_amdgcn_update_dpp(0, (int)a1.z, 0x128, 0xf, 0xf, true); x1.w = (unsigned)__builtin_amdgcn_update_dpp(0, (int)a1.w, 0x128, 0xf, 0xf, true);
            bf16_t* r0p = Y + (size_t)(rowb + ai * HALF + m * 16) * 1024 + colp;
            *(u32x4*)(r0p + (up ? 32 : 0)) = up ? x1 : a0;
            *(u32x4*)(r0p + 8 * 1024 + (up ? 0 : 32)) = up ? a0 : x1; }
    }
};
struct EpiCmp {
    static constexpr bool PERM = true;
    bf16_t* O; const float* pb;
    __device__ __forceinline__ void operator()(const f32x4 (&acc)[2][2][4][2], const Unit& u, int wr, int wc, int fr, int fq) const {
        const int row0 = u.pm * BM + wr * 64 + fr, col0 = wc * 32 + 8 * fq;
        f32x4 bias[2][2][2];
#pragma unroll
        for (int ai = 0; ai < 2; ++ai)
#pragma unroll
            for (int bj = 0; bj < 2; ++bj)
#pragma unroll
                for (int hf = 0; hf < 2; ++hf) { const float* p = pb + (size_t)((u.pm >> 6) * 4 + ((2 * u.pm + ai) & 3)) * 256 + col0 + bj * HALF + 4 * hf;
                    bias[ai][bj][hf] = (*(const f32x4*)p + *(const f32x4*)(p + 2048)) + (*(const f32x4*)(p + 4096) + *(const f32x4*)(p + 6144)); }
#pragma unroll
        EPI_LOOP_ROWS { bf16_t* rowp = O + (size_t)(row0 + ai * HALF + m * 16) * 256 + col0;
#pragma unroll
            for (int bj = 0; bj < 2; ++bj) { f32x4 v0 = acc[ai][bj][m][0] + bias[ai][bj][0], v1 = acc[ai][bj][m][1] + bias[ai][bj][1];
#pragma unroll
                for (int j = 0; j < 4; ++j) { v0[j] = gelu_tanh_(v0[j]); v1[j] = gelu_tanh_(v1[j]); }
                *(u32x4*)(rowp + bj * HALF) = pack8(v0, v1); } }
    }
};
}

struct Args { const float* in[41]; float* out; unsigned char* ws; int ph_lo, ph_hi; };
enum { I_X = 0, I_ALN, I_AMU, I_AWR, I_AWK, I_AWV, I_AWO, I_AW0, I_AW1, I_AW2, I_AA0, I_AA1, I_AA2, I_AG1, I_AG2, I_AKK, I_AKA, I_ARK, I_ALNXW, I_ALNXB,
       I_KVLN, I_KVW, I_PEK, I_PEV, I_CKW1, I_CKW2, I_CVW1, I_CVW2, I_RELB, I_BLN, I_BWQG, I_BWO, I_MLN, I_MWG, I_MBG, I_MWE, I_MBE, I_MW1, I_MW3, I_MW2, I_FLN };

struct Fr { LAS unsigned char* lds; int tid, lane, wave, G, gw, ngw; };

__device__ __forceinline__ void tr_item(const float* W, int N, int Klim, int Nlim, int k0, int n0, bf16_t* out, long orow0, int ldo, int kout0,
                                        const float* sc, int scmode, LAS float* scr, int lane) {
    f32x4 ld[8];
#pragma unroll
    for (int i = 0; i < 8; ++i) { const int kk = 8 * i + (lane >> 3), k = k0 + kk, n = n0 + 4 * (lane & 7);
        ld[i] = (k < Klim && n < Nlim) ? *(const f32x4*)(W + (size_t)k * N + n) : (f32x4){0.f, 0.f, 0.f, 0.f}; }
#pragma unroll
    for (int i = 0; i < 8; ++i) { const int kk = 8 * i + (lane >> 3), k = k0 + kk; f32x4 v = ld[i];
        if (scmode && k < Klim) { const float sv = sc[k]; v = v * (scmode == 1 ? sv : 1.f - sv); }
        LAS float* d = scr + kk * 33 + 4 * (lane & 7); d[0] = v.x; d[1] = v.y; d[2] = v.z; d[3] = v.w; }
    LDS_WAIT(); asm volatile("" ::: "memory");
    const int c = lane & 7;
#pragma unroll
    for (int j = 0; j < 4; ++j) { const int n = (lane >> 3) + 8 * j; const LAS float* s = scr + (8 * c) * 33 + n;
        u32x4 o; o.x = pk2(s[0 * 33], s[1 * 33]); o.y = pk2(s[2 * 33], s[3 * 33]); o.z = pk2(s[4 * 33], s[5 * 33]); o.w = pk2(s[6 * 33], s[7 * 33]);
        *(u32x4*)(out + (size_t)(orow0 + n) * ldo + kout0 + 8 * c) = o; }
    LDS_WAIT(); asm volatile("" ::: "memory");
}
__device__ __forceinline__ void conv_mat(const Fr& F, const float* W, int K, int N, bf16_t* out, long orow0, int ldo, int kout0, const float* sc, int scmode, LAS float* scr) {
    const int nkb = (K + 63) / 64, nnb = (N + 31) / 32, nit = nkb * nnb;
    for (int it = F.gw; it < nit; it += F.ngw) { const int kb = it / nnb, nb = it % nnb;
        tr_item(W, N, K, N, kb * 64, nb * 32, out, orow0 + nb * 32, ldo, kout0 + kb * 64, sc, scmode, scr, F.lane); }
}
__device__ __forceinline__ void zero_rect(const Fr& F, bf16_t* out, int rows, int cols8, int ldo) {
    const long tot = (long)rows * cols8;
    for (long i = (long)F.gw * 64 + F.lane; i < tot; i += (long)F.ngw * 64) { const long r = i / cols8, c = i % cols8; *(u32x4*)(out + r * ldo + c * 8) = (u32x4){0u, 0u, 0u, 0u}; }
}
__device__ __forceinline__ bf16x8 pack8c(const float (&v)[8]) { u32x4 w; w.x = cvtpk(v[0], v[1]); w.y = cvtpk(v[2], v[3]); w.z = cvtpk(v[4], v[5]); w.w = cvtpk(v[6], v[7]); return __builtin_bit_cast(bf16x8, w); }
__device__ __forceinline__ void phase_conv(const Fr& F, const Args& a) {
    unsigned char* ws = a.ws;
    LAS float* scr = (LAS float*)(F.lds + F.wave * 8704);
    const float* mu = a.in[I_AMU];
    conv_mat(F, a.in[I_AWR], 1024, 1024, (bf16_t*)(ws + WS_WR), 0, 1024, 0, nullptr, 0, scr);
    conv_mat(F, a.in[I_AWK], 1024, 1024, (bf16_t*)(ws + WS_WK), 0, 1024, 0, nullptr, 0, scr);
    conv_mat(F, a.in[I_AWV], 1024, 1024, (bf16_t*)(ws + WS_WV), 0, 1024, 0, nullptr, 0, scr);
    conv_mat(F, a.in[I_AWO], 1024, 1024, (bf16_t*)(ws + WS_WO), 0, 1024, 0, nullptr, 0, scr);
    {
        bf16_t* o = (bf16_t*)(ws + WS_WL1);
        conv_mat(F, a.in[I_AW1], 1024, 64, o, 0, 2048, 0, mu + 1 * 1024, 2, scr);    conv_mat(F, a.in[I_AW1], 1024, 64, o, 0, 2048, 1024, mu + 1 * 1024, 1, scr);
        conv_mat(F, a.in[I_AA1], 1024, 64, o, 64, 2048, 0, mu + 4 * 1024, 2, scr);   conv_mat(F, a.in[I_AA1], 1024, 64, o, 64, 2048, 1024, mu + 4 * 1024, 1, scr);
        conv_mat(F, a.in[I_AG1], 1024, 160, o, 128, 2048, 0, mu + 5 * 1024, 2, scr); conv_mat(F, a.in[I_AG1], 1024, 160, o, 128, 2048, 1024, mu + 5 * 1024, 1, scr);
        zero_rect(F, o + (size_t)288 * 2048, 224, 256, 2048);
    }
    {
        bf16_t* o = (bf16_t*)(ws + WS_W2WA);
        conv_mat(F, a.in[I_AW2], 64, 1024, o, 0, 128, 0, nullptr, 0, scr);
        zero_rect(F, o + 64, 1024, 8, 128);
        conv_mat(F, a.in[I_AA2], 64, 1024, o, 1024, 128, 64, nullptr, 0, scr);
        zero_rect(F, o + (size_t)1024 * 128, 1024, 8, 128);
    }
    {
        bf16_t* o = (bf16_t*)(ws + WS_W2G);
        conv_mat(F, a.in[I_AG2], 160, 1024, o, 0, 256, 0, nullptr, 0, scr);
        zero_rect(F, o + 192, 1024, 8, 256);
    }
    {
        bf16_t* o = (bf16_t*)(ws + WS_WKVQG);
        conv_mat(F, a.in[I_KVW], 1024, 1536, o, 0, 1024, 0, a.in[I_KVLN], 1, scr);
        conv_mat(F, a.in[I_BWQG], 1024, 1072, o, 1536, 1024, 0, a.in[I_BLN], 1, scr);
        zero_rect(F, o + (size_t)2624 * 1024, 192, 128, 1024);
    }
    conv_mat(F, a.in[I_BWO], 1024, 1024, (bf16_t*)(ws + WS_WOB), 0, 1024, 0, nullptr, 0, scr);
    conv_mat(F, a.in[I_CKW1], 2048, 256, (bf16_t*)(ws + WS_WC1), 0, 2048, 0, nullptr, 0, scr);
    conv_mat(F, a.in[I_CVW1], 2048, 256, (bf16_t*)(ws + WS_WC1) + (size_t)256 * 2048, 0, 2048, 0, nullptr, 0, scr);
    {
        bf16_t* o1 = (bf16_t*)(ws + WS_BT1); bf16_t* o2 = (bf16_t*)(ws + WS_BT2);
        for (int it = F.gw; it < 64 * 256; it += F.ngw) { const int mat = it >> 8, r = it & 255, kb = r >> 4, nb = r & 15, n0 = nb * 32;
            const long orow = (long)mat * 1024 + (n0 >> 7) * 256 + (n0 & 127);
            const float* gm = a.in[I_MLN] + (mat >> 5) * 1024;
            tr_item(a.in[I_MW1] + (size_t)mat * 1024 * 512, 512, 1024, 512, kb * 64, n0, o1, orow, 1024, kb * 64, gm, 1, scr, F.lane);
            tr_item(a.in[I_MW3] + (size_t)mat * 1024 * 512, 512, 1024, 512, kb * 64, n0, o1, orow + 128, 1024, kb * 64, gm, 1, scr, F.lane); }
        for (int it = F.gw; it < 64 * 256; it += F.ngw) { const int mat = it >> 8, r = it & 255, kb = r >> 5, nb = r & 31;
            tr_item(a.in[I_MW2] + (size_t)mat * 512 * 1024, 1024, 512, 1024, kb * 64, nb * 32, o2, (long)mat * 1024 + nb * 32, 512, kb * 64, nullptr, 0, scr, F.lane); }
    }
    {
        int* ci = (int*)(ws + WS_CIDX);
        for (int r = F.gw * 64 + F.lane; r < 2 * 16384; r += F.ngw * 64) { const int grp = r >> 14, rr = r & 16383, bg = rr >> 7, n = rr & 127; ci[r] = ((bg >> 2) * SEQ + 16 * n) * 24 + grp * 4 + (bg & 3); }
        if (F.wave == 0 && blockIdx.x < 128) { const int id = blockIdx.x, grp = id >> 6, nb = (id >> 2) & 15, kq = id & 3, i = F.lane & 15, q = F.lane >> 4;
            const float* pe = a.in[grp ? I_PEV : I_PEK] + (size_t)(i & 3) * 2048 + kq * 512 + 8 * q; const float* w = a.in[grp ? I_CVW1 : I_CKW1] + (size_t)(kq * 512 + 8 * q) * 256 + 16 * nb + i;
            f32x4 acc = (f32x4){0.f, 0.f, 0.f, 0.f};
#pragma unroll 2
            for (int sk = 0; sk < 16; ++sk) { const f32x4 p0 = *(const f32x4*)(pe + 32 * sk), p1 = *(const f32x4*)(pe + 32 * sk + 4);
                float wv[8];
#pragma unroll
                for (int e = 0; e < 8; ++e) wv[e] = w[(size_t)(32 * sk + e) * 256];
                const float pv[8] = {p0.x, p0.y, p0.z, p0.w, p1.x, p1.y, p1.z, p1.w}; float pl[8];
#pragma unroll
                for (int e = 0; e < 8; ++e) pl[e] = pv[e] - bflo(f2bf(pv[e]));
                const bf16x8 ah = pack8c(pv), al = pack8c(pl), bw = pack8c(wv);
                acc = __builtin_amdgcn_mfma_f32_16x16x32_bf16(ah, bw, acc, 0, 0, 0); acc = __builtin_amdgcn_mfma_f32_16x16x32_bf16(al, bw, acc, 0, 0, 0); }
            if (F.lane < 16) { float* pb = (float*)(ws + WS_PEBP) + ((size_t)(kq * 2 + grp) * 4) * 256 + 16 * nb + i;
#pragma unroll
                for (int rg = 0; rg < 4; ++rg) pb[rg * 256] = acc[rg]; }
        }
    }
    {
        bf16_t* o = (bf16_t*)(ws + WS_W2F);
        for (int i = F.gw * 64 + F.lane; i < 2 * 16384; i += F.ngw * 64) { const int e = i & 7, ln = (i >> 3) & 63, nb = (i >> 9) & 3, sk = (i >> 11) & 7, grp = i >> 14;
            const int k = 32 * sk + 8 * (ln >> 4) + e, n = 16 * nb + (ln & 15); const float v = a.in[grp ? I_CVW2 : I_CKW2][k * 64 + n];
            const unsigned hi = f2bf(v), lo = f2bf(v - bflo(hi));
            bf16_t* ob = o + ((size_t)((grp * 8 + sk) * 2) * 4 + nb) * 512 + ln * 8 + e; ob[0] = (bf16_t)hi; ob[4 * 512] = (bf16_t)lo; }
    }
    {
        bf16_t* o = (bf16_t*)(ws + WS_RFRAG);
        for (int i = F.gw * 64 + F.lane; i < 2 * 49152; i += F.ngw * 64) { const int layer = i / 49152, r = i % 49152, e = r & 7, ln = (r >> 3) & 63, nt = (r >> 9) % 3, s = r / 1536;
            const int k = 32 * s + 8 * (ln >> 4) + e, n = 16 * nt + (ln & 15);
            float v = 0.f; if (n < 4) v = a.in[I_MWG][((size_t)layer * 1024 + k) * 4 + n]; else if (n < 36) v = a.in[I_MWE][((size_t)layer * 1024 + k) * 32 + (n - 4)];
            v *= a.in[I_MLN][layer * 1024 + k];
            const unsigned hi = f2bf(v); const float r1 = v - bflo(hi); const unsigned lo = f2bf(r1); const float r2 = r1 - bflo(lo); const unsigned lo2 = f2bf(r2);
            bf16_t* ob = o + ((size_t)(layer * 32 + s) * 9 + nt) * 512 + ln * 8 + e;
            ob[0] = (bf16_t)hi; ob[3 * 512] = (bf16_t)lo; ob[6 * 512] = (bf16_t)lo2; }
    }
}

__device__ __forceinline__ void phase_r1(const Fr& F, const Args& a) {
    unsigned char* ws = a.ws; const float* x = a.in[I_X];
    bf16_t* XN = (bf16_t*)(ws + WS_S5); bf16_t* XR = (bf16_t*)(ws + WS_S0); bf16_t* XK = (bf16_t*)(ws + WS_S1); bf16_t* XV = (bf16_t*)(ws + WS_S2);
    f32x4 gn[4], mr[4], mk[4], mv[4];
#pragma unroll
    for (int j = 0; j < 4; ++j) { const int c = 256 * j + 4 * F.lane; gn[j] = *(const f32x4*)(a.in[I_ALN] + c); mr[j] = *(const f32x4*)(a.in[I_AMU] + 0 * 1024 + c);
        mk[j] = *(const f32x4*)(a.in[I_AMU] + 2 * 1024 + c); mv[j] = *(const f32x4*)(a.in[I_AMU] + 3 * 1024 + c); }
    for (int run = F.gw; run < NT / 32; run += F.ngw) {
        const int m0 = run * 32, b = m0 >> 11, t0 = m0 & 2047;
        f32x4 pv[4];
        if (t0 == 0) {
#pragma unroll
            for (int j = 0; j < 4; ++j) { pv[j] = (f32x4){0.f, 0.f, 0.f, 0.f}; *(u32x2*)(XN + (size_t)(b * 2049) * 1024 + 256 * j + 4 * F.lane) = (u32x2){0u, 0u}; }
        } else {
            const f32x4* xr = (const f32x4*)(x + (size_t)(m0 - 1) * 1024) + F.lane; float s = 0.f;
#pragma unroll
            for (int j = 0; j < 4; ++j) { pv[j] = xr[64 * j]; s += (pv[j].x * pv[j].x + pv[j].y * pv[j].y) + (pv[j].z * pv[j].z + pv[j].w * pv[j].w); }
            const float rstd = 1.f / sqrtf(wave_sum(s) * (1.f / 1024.f) + 1e-6f);
#pragma unroll
            for (int j = 0; j < 4; ++j) pv[j] = pv[j] * rstd * gn[j];
        }
        f32x4 nx[4];
        { const f32x4* xr = (const f32x4*)(x + (size_t)m0 * 1024) + F.lane;
#pragma unroll
          for (int j = 0; j < 4; ++j) nx[j] = xr[64 * j]; }
        for (int i = 0; i < 32; ++i) {
            const int m = m0 + i;
            f32x4 v[4]; float s = 0.f;
#pragma unroll
            for (int j = 0; j < 4; ++j) v[j] = nx[j];
            if (i < 31) { const f32x4* xr = (const f32x4*)(x + (size_t)(m + 1) * 1024) + F.lane;
#pragma unroll
                for (int j = 0; j < 4; ++j) nx[j] = xr[64 * j]; }
#pragma unroll
            for (int j = 0; j < 4; ++j) s += (v[j].x * v[j].x + v[j].y * v[j].y) + (v[j].z * v[j].z + v[j].w * v[j].w);
            const float rstd = 1.f / sqrtf(wave_sum(s) * (1.f / 1024.f) + 1e-6f);
            const size_t prow = (size_t)(m + b + 1) * 1024, row = (size_t)m * 1024;
#pragma unroll
            for (int j = 0; j < 4; ++j) { const int c = 256 * j + 4 * F.lane;
                const f32x4 cur = v[j] * rstd * gn[j], xx = pv[j] - cur;
                *(u32x2*)(XN + prow + c) = (u32x2){pk2(cur.x, cur.y), pk2(cur.z, cur.w)};
                const f32x4 r_ = cur + xx * mr[j], k_ = cur + xx * mk[j], v_ = cur + xx * mv[j];
                *(u32x2*)(XR + row + c) = (u32x2){pk2(r_.x, r_.y), pk2(r_.z, r_.w)};
                *(u32x2*)(XK + row + c) = (u32x2){pk2(k_.x, k_.y), pk2(k_.z, k_.w)};
                *(u32x2*)(XV + row + c) = (u32x2){pk2(v_.x, v_.y), pk2(v_.z, v_.w)};
                pv[j] = cur; }
        }
    }
}

typedef float f32x16 __attribute__((ext_vector_type(16)));
__device__ __forceinline__ bf16x8 pack8f(float a0, float a1, float a2, float a3, float a4, float a5, float a6, float a7) {
    u32x4 w; w.x = cvtpk(a0, a1); w.y = cvtpk(a2, a3); w.z = cvtpk(a4, a5); w.w = cvtpk(a6, a7); return __builtin_bit_cast(bf16x8, w); }
__device__ __forceinline__ bf16x8 packacc(const f32x16& v, int s2) { return pack8f(v[8 * s2], v[8 * s2 + 1], v[8 * s2 + 2], v[8 * s2 + 3], v[8 * s2 + 4], v[8 * s2 + 5], v[8 * s2 + 6], v[8 * s2 + 7]); }
__device__ __forceinline__ int swap23(int w) { return (w & ~12) | ((w & 4) << 1) | ((w & 8) >> 1); }
constexpr int SC_AT = 0, SC_RT = 4096, SC_BJ = 8192, SC_KJ = 12288, SC_VI = 16384, SC_BT = 20480, SC_KT = 24576, SC_TT = 20480, SC_AAKT = 22528, SC_ABRT = 24576, SC_AKRT = 26624,
              SC_GL = 28672, SC_SS = 28928, SC_SLOT = 29184, SC_YB = 4 * SC_SLOT, SC_BON = SC_YB + 32768;
template <int HALF, int BIT>
__device__ __forceinline__ void reduce32_stage(float (&v)[32], int lane) {
    const bool up = (lane & BIT) != 0; const int addr = (lane ^ BIT) << 2;
#pragma unroll
    for (int i = 0; i < HALF; ++i) { const float keep = up ? v[i + HALF] : v[i], send = up ? v[i] : v[i + HALF];
        v[i] = keep + __int_as_float(__builtin_amdgcn_ds_bpermute(addr, __float_as_int(send))); }
}
__device__ __forceinline__ float reduce32(float (&v)[32], int lane) {
#pragma unroll
    for (int i = 0; i < 16; ++i) { const auto r = __builtin_amdgcn_permlane32_swap(__float_as_uint(v[i]), __float_as_uint(v[i + 16]), false, false); v[i] = __uint_as_float(r[0]) + __uint_as_float(r[1]); }
#pragma unroll
    for (int i = 0; i < 8; ++i) { const auto r = __builtin_amdgcn_permlane16_swap(__float_as_uint(v[i]), __float_as_uint(v[i + 8]), false, false); v[i] = __uint_as_float(r[0]) + __uint_as_float(r[1]); }
    { const bool up = (lane & 8) != 0;
#pragma unroll
      for (int i = 0; i < 4; ++i) { const float keep = up ? v[i + 4] : v[i], send = up ? v[i] : v[i + 4]; v[i] = keep + dppf<DPP_ROR8>(send); } }
    reduce32_stage<2, 4>(v, lane);
    { const bool up = (lane & 2) != 0; const float keep = up ? v[1] : v[0], send = up ? v[0] : v[1]; v[0] = keep + dppf<DPP_XOR2>(send); }
    return v[0] + dppf<DPP_XOR1>(v[0]);
}
#define SC_RAW(area, t) bf2f(*(const LAS bf16_t*)(slot + (area) + (t) * 128 + lane * 2))
#define SC_BARRIER() do { asm volatile("s_waitcnt lgkmcnt(0)" ::: "memory"); __builtin_amdgcn_s_barrier(); asm volatile("" ::: "memory"); } while (0)
struct ScanRaw { u32x4 v[10]; unsigned lwp[16]; };
__device__ __forceinline__ void scan_load(const Args& a, ScanRaw& R, int chain, int t0, int half, int lane) {
    unsigned char* ws = a.ws; const int tb = 16 * half;
    const unsigned char* Rb = ws + WS_S3; const unsigned char* LWb = ws + WS_S0; const unsigned char* Kb = ws + WS_S4; const unsigned char* Vb = (const unsigned char*)a.out; const unsigned char* Ab = ws + WS_S1;
    const size_t rowb = ((size_t)chain * SEQ + t0) * 128;
#pragma unroll
    for (int q = 0; q < 2; ++q) { const size_t o = rowb + (size_t)(tb + 8 * q) * 128 + lane * 16;
        R.v[5 * q + 0] = *(const u32x4*)(Ab + o); R.v[5 * q + 1] = *(const u32x4*)(Rb + o); R.v[5 * q + 2] = *(const u32x4*)(LWb + o); R.v[5 * q + 3] = *(const u32x4*)(Kb + o); R.v[5 * q + 4] = *(const u32x4*)(Vb + o); }
    if (half) {
#pragma unroll
        for (int m = 0; m < 16; ++m) R.lwp[m] = (unsigned)*(const bf16_t*)(LWb + rowb + (size_t)m * 128 + lane * 2); }
}
__device__ __forceinline__ void scan_pre(const Fr& F, const Args& a, LAS unsigned char* slot, LAS float* bon, LAS unsigned char* ysc, int chain, int t0, int half, ScanRaw& R, bool more, float kkc, float kac, float rkc) {
    unsigned char* ws = a.ws;
    int lane = F.lane; asm volatile("" : "+v"(lane));
    { unsigned so = (unsigned)(size_t)slot; asm volatile("" : "+s"(so)); slot = (LAS unsigned char*)(size_t)so; }
    const int b = chain >> 4, hd = chain & 15, ch = hd * 64 + lane, r = lane & 31, h = lane >> 5, tb = 16 * half;
    float cum = 0.f;
    if (half) {
#pragma unroll
        for (int m = 0; m < 16; ++m) cum += bflo(R.lwp[m]); }
    {
#pragma unroll
        for (int q = 0; q < 2; ++q) { const int lo2 = (tb + 8 * q) * 128 + lane * 16;
            *(LAS u32x4*)(slot + SC_AT + lo2) = R.v[5 * q + 0]; *(LAS u32x4*)(slot + SC_RT + lo2) = R.v[5 * q + 1]; *(LAS u32x4*)(slot + SC_BT + lo2) = R.v[5 * q + 2]; *(LAS u32x4*)(slot + SC_KT + lo2) = R.v[5 * q + 3]; *(LAS u32x4*)(slot + SC_BJ + lo2) = R.v[5 * q + 4]; }
        LDS_WAIT();
        if (more) scan_load(a, R, chain, t0 + 64, half, lane);
    }
    float kq[16], aq[16], rq[16];
    {
        float q[32];
#pragma unroll
        for (int tt = 0; tt < 16; ++tt) { const float k = SC_RAW(SC_KT, tb + tt), av = SC_RAW(SC_AT, tb + tt), rv = SC_RAW(SC_RT, tb + tt); kq[tt] = k; aq[tt] = av; rq[tt] = rv;
            const float kkv = k * kkc; q[tt] = kkv * kkv; q[16 + tt] = rv * (k * (1.f + (av - 1.f) * kac)) * rkc; }
        const float s1 = reduce32(q, lane); const int idx = (lane >> 1) & 31;
        if ((lane & 1) == 0) { if (idx < 16) ((LAS float*)(slot + SC_SS))[tb + idx] = s1; else bon[tb + idx - 16] = s1; }
    }
    unsigned vv[8];
#pragma unroll
    for (int m = 0; m < 8; ++m) vv[m] = (unsigned)*(const LAS bf16_t*)(slot + SC_BJ + (tb + 2 * m) * 128 + lane * 2) | ((unsigned)*(const LAS bf16_t*)(slot + SC_BJ + (tb + 2 * m + 1) * 128 + lane * 2) << 16);
    LDS_WAIT(); asm volatile("" ::: "memory");
    const int pj = (lane & 48) | swap23(lane & 15);
    const int pjc = pj >> 3, pjw = (pj & 7) * 2;
    unsigned bj[8], kj[8]; float gprev = half ? fexp_(cum) : 1.f, gl = 1.f;
    f32x4 ssv[4];
#pragma unroll
    for (int q4 = 0; q4 < 4; ++q4) ssv[q4] = *(const LAS f32x4*)(slot + SC_SS + (tb + 4 * q4) * 4);
    const bool odd = (lane & 1) != 0; const int pjwe = pjw & ~2;
#define SC_PAIR_STORE(area, x) do { const float _snd = odd ? x[0] : x[1]; const float _rcv = dppf<DPP_XOR1>(_snd); *(LAS unsigned*)(slot + (area) + ro) = cvtpk(odd ? _rcv : x[0], odd ? x[1] : _rcv); } while (0)
#pragma unroll
    for (int tp = 0; tp < 8; ++tp) { const int t0 = tb + 2 * tp;
        float atv[2], rtv[2], btv[2], ktv[2];
#pragma unroll
        for (int u = 0; u < 2; ++u) { const int tt = 2 * tp + u;
            const float k = kq[tt], av = aq[tt], rv = rq[tt], lw = SC_RAW(SC_BT, tb + tt);
            cum += lw; const float g = fexp_(cum), ginv = __builtin_amdgcn_rcpf(g);
            const float ss = ssv[tt >> 2][tt & 3];
            const float kk = k * kkc * __builtin_amdgcn_rsqf(fmaxf(ss, 1e-24f)); const float kp = k * (1.f + (av - 1.f) * kac);
            atv[u] = -kk * gprev; btv[u] = kk * av * ginv; ktv[u] = kp * ginv; rtv[u] = rv * g;
            gprev = g; gl = g; }
        bj[tp] = cvtpk(btv[0], btv[1]); kj[tp] = cvtpk(ktv[0], ktv[1]);
        const int ro = (t0 + (odd ? 1 : 0)) * 128 + ((pjc ^ ((t0 >> 1) & 7)) << 4) + pjwe;
        SC_PAIR_STORE(SC_AT, atv); SC_PAIR_STORE(SC_RT, rtv); SC_PAIR_STORE(SC_BT, btv); SC_PAIR_STORE(SC_KT, ktv);
    }
#undef SC_PAIR_STORE
    SC_BARRIER();
#pragma unroll
    for (int cc = 0; cc < 2; ++cc) { const int c = 2 * half + cc, m0 = 2 * cc; const int ro = lane * 64 + ((c ^ ((lane >> 2) & 3)) << 4);
        *(LAS u32x4*)(slot + SC_BJ + ro) = (u32x4){bj[m0], bj[m0 + 1], bj[m0 + 4], bj[m0 + 5]};
        *(LAS u32x4*)(slot + SC_KJ + ro) = (u32x4){kj[m0], kj[m0 + 1], kj[m0 + 4], kj[m0 + 5]};
        *(LAS u32x4*)(slot + SC_VI + ro) = (u32x4){vv[m0], vv[m0 + 1], vv[m0 + 4], vv[m0 + 5]}; }
    if (half) ((LAS float*)(slot + SC_GL))[lane] = gl;
    const int swz = (r >> 1) & 7;
    f32x16 D0, D1, D2;
#pragma unroll
    for (int i = 0; i < 16; ++i) { D0[i] = 0.f; D1[i] = 0.f; D2[i] = 0.f; }
    if (half == 0) {
#pragma unroll
        for (int ks = 0; ks < 4; ++ks) { const int ao = r * 128 + (((2 * ks + h) ^ swz) << 4);
            D0 = __builtin_amdgcn_mfma_f32_32x32x16_bf16(*(const LAS bf16x8*)(slot + SC_BT + ao), *(const LAS bf16x8*)(slot + SC_AT + ao), D0, 0, 0, 0); }
    } else {
#pragma unroll
        for (int ks = 0; ks < 4; ++ks) { const int ao = r * 128 + (((2 * ks + h) ^ swz) << 4);
            const bf16x8 bA = *(const LAS bf16x8*)(slot + SC_BT + ao), kA = *(const LAS bf16x8*)(slot + SC_KT + ao), aB = *(const LAS bf16x8*)(slot + SC_AT + ao), rB = *(const LAS bf16x8*)(slot + SC_RT + ao);
            D0 = __builtin_amdgcn_mfma_f32_32x32x16_bf16(kA, aB, D0, 0, 0, 0); D1 = __builtin_amdgcn_mfma_f32_32x32x16_bf16(bA, rB, D1, 0, 0, 0); D2 = __builtin_amdgcn_mfma_f32_32x32x16_bf16(kA, rB, D2, 0, 0, 0); }
    }
    SC_BARRIER();
    if (half == 0) {
        const int sw4 = (r >> 2) & 3; int bo[2];
#pragma unroll
        for (int s2 = 0; s2 < 2; ++s2) bo[s2] = r * 64 + (((2 * s2 + h) ^ sw4) << 4);
        const int pcol = (r & 16) | swap23(r & 15), pcc = pcol >> 3, pcw = (pcol & 7) * 2;
        f32x16 Mx, Tx;
#pragma unroll
        for (int reg = 0; reg < 16; ++reg) { const int sr = (reg & 3) + 8 * (reg >> 2) + 4 * h; const float av = (sr < r) ? D0[reg] : 0.f; Mx[reg] = av; Tx[reg] = av + ((sr == r) ? 1.f : 0.f); }
#pragma unroll
        for (int it = 0; it < 4; ++it) {
#pragma unroll
            for (int reg = 0; reg < 16; ++reg) { const int sr = (reg & 3) + 8 * (reg >> 2) + 4 * h; const int ad = sr * 64 + ((pcc ^ ((sr >> 2) & 3)) << 4) + pcw;
                *(LAS bf16_t*)(ysc + ad) = (bf16_t)f2bf(Mx[reg]); *(LAS bf16_t*)(ysc + 2048 + ad) = (bf16_t)f2bf(Tx[reg]); }
            LDS_WAIT(); asm volatile("" ::: "memory");
            bf16x8 mb[2], m2b[2];
#pragma unroll
            for (int s2 = 0; s2 < 2; ++s2) mb[s2] = packacc(Mx, s2);
            f32x16 M2;
#pragma unroll
            for (int i = 0; i < 16; ++i) M2[i] = 0.f;
#pragma unroll
            for (int s2 = 0; s2 < 2; ++s2) M2 = __builtin_amdgcn_mfma_f32_32x32x16_bf16(*(const LAS bf16x8*)(ysc + bo[s2]), mb[s2], M2, 0, 0, 0);
#pragma unroll
            for (int s2 = 0; s2 < 2; ++s2) m2b[s2] = packacc(M2, s2);
#pragma unroll
            for (int s2 = 0; s2 < 2; ++s2) Tx = __builtin_amdgcn_mfma_f32_32x32x16_bf16(*(const LAS bf16x8*)(ysc + 2048 + bo[s2]), m2b[s2], Tx, 0, 0, 0);
            Mx = M2;
            LDS_WAIT(); asm volatile("" ::: "memory");
        }
#pragma unroll
        for (int g = 0; g < 4; ++g) { const int ro = r * 64 + (((2 * (g >> 1) + h) ^ sw4) << 4) + 8 * (g & 1);
            *(LAS u32x2*)(slot + SC_TT + ro) = (u32x2){cvtpk(Tx[4 * g], Tx[4 * g + 1]), cvtpk(Tx[4 * g + 2], Tx[4 * g + 3])}; }
    } else {
#pragma unroll
        for (int reg = 0; reg < 16; ++reg) { const int sr = (reg & 3) + 8 * (reg >> 2) + 4 * h; D0[reg] = (sr < r) ? D0[reg] : 0.f; D1[reg] = (sr <= r) ? D1[reg] : 0.f; D2[reg] = (sr <= r) ? D2[reg] : 0.f; }
        const int sw4 = (r >> 2) & 3;
#pragma unroll
        for (int g = 0; g < 4; ++g) { const int ro = r * 64 + (((2 * (g >> 1) + h) ^ sw4) << 4) + 8 * (g & 1);
            *(LAS u32x2*)(slot + SC_AAKT + ro) = (u32x2){cvtpk(D0[4 * g], D0[4 * g + 1]), cvtpk(D0[4 * g + 2], D0[4 * g + 3])};
            *(LAS u32x2*)(slot + SC_ABRT + ro) = (u32x2){cvtpk(D1[4 * g], D1[4 * g + 1]), cvtpk(D1[4 * g + 2], D1[4 * g + 3])};
            *(LAS u32x2*)(slot + SC_AKRT + ro) = (u32x2){cvtpk(D2[4 * g], D2[4 * g + 1]), cvtpk(D2[4 * g + 2], D2[4 * g + 3])}; }
    }
}
__device__ __forceinline__ void scan_seq(LAS unsigned char* slot, LAS bf16_t* yb, int ib, int lane, f32x16 (&Z)[2]) {
    asm volatile("" : "+v"(lane));
    { unsigned so = (unsigned)(size_t)slot; asm volatile("" : "+s"(so)); slot = (LAS unsigned char*)(size_t)so; }
    const int r = lane & 31, h = lane >> 5, swz = (r >> 1) & 7, sw4 = (r >> 2) & 3;
    int ao[4], bo[2];
#pragma unroll
    for (int ks = 0; ks < 4; ++ks) ao[ks] = r * 128 + (((2 * ks + h) ^ swz) << 4);
#pragma unroll
    for (int s2 = 0; s2 < 2; ++s2) bo[s2] = r * 64 + (((2 * s2 + h) ^ sw4) << 4);
    bf16x8 zb[4], vB[2], xb[2], pb[2];
#pragma unroll
    for (int jb = 0; jb < 2; ++jb)
#pragma unroll
        for (int s2 = 0; s2 < 2; ++s2) zb[2 * jb + s2] = packacc(Z[jb], s2);
#pragma unroll
    for (int s2 = 0; s2 < 2; ++s2) vB[s2] = *(const LAS bf16x8*)(slot + SC_VI + ib * 2048 + bo[s2]);
    f32x16 X, P, Y;
#pragma unroll
    for (int i = 0; i < 16; ++i) { X[i] = 0.f; P[i] = 0.f; Y[i] = 0.f; }
#pragma unroll
    for (int ks = 0; ks < 4; ++ks) X = __builtin_amdgcn_mfma_f32_32x32x16_bf16(*(const LAS bf16x8*)(slot + SC_AT + ao[ks]), zb[ks], X, 0, 0, 0);
#pragma unroll
    for (int s2 = 0; s2 < 2; ++s2) X = __builtin_amdgcn_mfma_f32_32x32x16_bf16(*(const LAS bf16x8*)(slot + SC_AAKT + bo[s2]), vB[s2], X, 0, 0, 0);
#pragma unroll
    for (int s2 = 0; s2 < 2; ++s2) xb[s2] = packacc(X, s2);
#pragma unroll
    for (int s2 = 0; s2 < 2; ++s2) P = __builtin_amdgcn_mfma_f32_32x32x16_bf16(*(const LAS bf16x8*)(slot + SC_TT + bo[s2]), xb[s2], P, 0, 0, 0);
#pragma unroll
    for (int s2 = 0; s2 < 2; ++s2) pb[s2] = packacc(P, s2);
#pragma unroll
    for (int ks = 0; ks < 4; ++ks) Y = __builtin_amdgcn_mfma_f32_32x32x16_bf16(*(const LAS bf16x8*)(slot + SC_RT + ao[ks]), zb[ks], Y, 0, 0, 0);
#pragma unroll
    for (int s2 = 0; s2 < 2; ++s2) { Y = __builtin_amdgcn_mfma_f32_32x32x16_bf16(*(const LAS bf16x8*)(slot + SC_ABRT + bo[s2]), pb[s2], Y, 0, 0, 0);
        Y = __builtin_amdgcn_mfma_f32_32x32x16_bf16(*(const LAS bf16x8*)(slot + SC_AKRT + bo[s2]), vB[s2], Y, 0, 0, 0); }
#pragma unroll
    for (int jb = 0; jb < 2; ++jb) {
#pragma unroll
        for (int s2 = 0; s2 < 2; ++s2) { Z[jb] = __builtin_amdgcn_mfma_f32_32x32x16_bf16(*(const LAS bf16x8*)(slot + SC_BJ + jb * 2048 + bo[s2]), pb[s2], Z[jb], 0, 0, 0);
            Z[jb] = __builtin_amdgcn_mfma_f32_32x32x16_bf16(*(const LAS bf16x8*)(slot + SC_KJ + jb * 2048 + bo[s2]), vB[s2], Z[jb], 0, 0, 0); }
#pragma unroll
        for (int g = 0; g < 4; ++g) { const f32x4 gl4 = *(const LAS f32x4*)(slot + SC_GL + (32 * jb + 8 * g + 4 * h) * 4);
            Z[jb][4 * g] *= gl4.x; Z[jb][4 * g + 1] *= gl4.y; Z[jb][4 * g + 2] *= gl4.z; Z[jb][4 * g + 3] *= gl4.w; } }
#pragma unroll
    for (int reg = 0; reg < 16; ++reg) yb[((reg & 3) + 8 * (reg >> 2) + 4 * h) * 64 + ib * 32 + r] = (bf16_t)f2bf(Y[reg]);
}
__device__ __forceinline__ void phase_scan(const Fr& F, const Args& a) {
    unsigned char* ws = a.ws; const bf16_t* Vb = (const bf16_t*)a.out; const bf16_t* Gb = (const bf16_t*)(ws + WS_S2); bf16_t* YG = (bf16_t*)(ws + WS_S5);
    LAS bf16_t* YB = (LAS bf16_t*)(F.lds + SC_YB);
    LAS float* BON = (LAS float*)(F.lds + SC_BON);
    const int w = F.wave, lane = F.lane;
    for (int cp = blockIdx.x; cp < 256; cp += F.G) {
        f32x16 Z[2];
#pragma unroll
        for (int i = 0; i < 16; ++i) { Z[0][i] = 0.f; Z[1][i] = 0.f; }
        ScanRaw R; scan_load(a, R, 2 * cp + ((w & 3) >> 1), 32 * (w & 1), w >> 2, lane);
        const int chp = ((2 * cp + ((w & 3) >> 1)) & 15) * 64 + lane; float kkc = a.in[I_AKK][chp], kac = a.in[I_AKA][chp], rkc = a.in[I_ARK][chp];
        asm volatile("" : "+v"(kkc), "+v"(kac), "+v"(rkc));
#pragma unroll 1
        for (int bt = 0; bt <= 32; ++bt) {
            SC_BARRIER();
            if (bt < 32) { const int sl = w & 3;
                scan_pre(F, a, F.lds + sl * SC_SLOT, BON + (bt & 1) * 128 + (sl >> 1) * 64 + (sl & 1) * 32, F.lds + SC_YB + (bt & 1) * 16384 + sl * 4096, 2 * cp + (sl >> 1), 64 * bt + 32 * (sl & 1), w >> 2, R, bt < 31, kkc, kac, rkc); }
            SC_BARRIER();
            if (w >= 4) { if (bt < 32) { const int cl = (w - 4) >> 1, ib = (w - 4) & 1;
                scan_seq(F.lds + (2 * cl) * SC_SLOT, YB + (bt & 1) * 8192 + cl * 4096, ib, lane, Z);
                scan_seq(F.lds + (2 * cl + 1) * SC_SLOT, YB + (bt & 1) * 8192 + cl * 4096 + 2048, ib, lane, Z); } }
            else if (bt >= 1) {
                const int cl = w >> 1, chain = 2 * cp + cl, b = chain >> 4, hd = chain & 15, ch = hd * 64 + lane; const float lw_ = a.in[I_ALNXW][ch], lb_ = a.in[I_ALNXB][ch];
                LAS f32x2* ST = (LAS f32x2*)(F.lds + SC_BON + 1024) + w * 32;
                const int tb = 32 * (w & 1); const LAS bf16_t* yp = YB + ((bt - 1) & 1) * 8192 + cl * 4096 + tb * 64 + lane;
                const size_t go = ((size_t)chain * SEQ + 64 * (bt - 1) + tb) * 64 + lane; const bf16_t* vp = Vb + go; const bf16_t* gp = Gb + go; bf16_t* op = YG + go;
                const LAS float* bp = BON + ((bt - 1) & 1) * 128 + cl * 64 + tb;
#pragma unroll 1
                for (int hh = 0; hh < 2; ++hh) {
                    unsigned vg[16];
#pragma unroll
                    for (int tt = 0; tt < 16; ++tt) vg[tt] = (unsigned)vp[(16 * hh + tt) * 64] | ((unsigned)gp[(16 * hh + tt) * 64] << 16);
                    float yq[16];
                    {
                        float q[32];
#pragma unroll
                        for (int tt = 0; tt < 16; ++tt) { const float y = bf2f(yp[(16 * hh + tt) * 64]); yq[tt] = y; q[tt] = y; q[16 + tt] = y * y; }
                        const float s1 = reduce32(q, lane); const int idx = (lane >> 1) & 31;
                        LAS float* STf = (LAS float*)ST;
                        if ((lane & 1) == 0) STf[idx] = s1;
                    }
                    LDS_WAIT(); asm volatile("" ::: "memory");
                    f32x4 sm[4], sq[4], bv4[4];
#pragma unroll
                    for (int q4 = 0; q4 < 4; ++q4) { sm[q4] = ((const LAS f32x4*)ST)[q4]; sq[q4] = ((const LAS f32x4*)ST)[4 + q4]; bv4[q4] = *(const LAS f32x4*)(bp + 16 * hh + 4 * q4); }
#pragma unroll
                    for (int tt = 0; tt < 16; ++tt) { const int t = 16 * hh + tt; const float mean = sm[tt >> 2][tt & 3] * (1.f / 64.f); const float var = fmaxf(sq[tt >> 2][tt & 3] * (1.f / 64.f) - mean * mean, 0.f);
                        float o = (yq[tt] - mean) * __builtin_amdgcn_rsqf(var + 64e-5f) * lw_ + lb_ + bv4[tt >> 2][tt & 3] * bflo(vg[tt]);
                        o *= bfhi(vg[tt]); op[t * 64] = (bf16_t)f2bf(o); }
                    LDS_WAIT(); asm volatile("" ::: "memory");
                }
            }
        }
    }
}

template <int MODE>
__device__ __forceinline__ float load_row_hb(const Fr& F, const bf16_t* hrow, const bf16_t* Y, const int* asg, int m, float (&v)[16]) {
    int p0 = 0, p1 = 0; if (MODE == 1) { p0 = asg[m * 8 + 6]; p1 = asg[m * 8 + 7]; }
    float s = 0.f;
#pragma unroll
    for (int j = 0; j < 2; ++j) { const u32x4 hv = *(const u32x4*)(hrow + 512 * j + 8 * F.lane);
        float* o = v + 8 * j; o[0] = bflo(hv.x); o[1] = bfhi(hv.x); o[2] = bflo(hv.y); o[3] = bfhi(hv.y); o[4] = bflo(hv.z); o[5] = bfhi(hv.z); o[6] = bflo(hv.w); o[7] = bfhi(hv.w);
        if (MODE == 1) { const u32x4 y0 = *(const u32x4*)(Y + (size_t)p0 * 1024 + 512 * j + 8 * F.lane), y1 = *(const u32x4*)(Y + (size_t)p1 * 1024 + 512 * j + 8 * F.lane);
            o[0] += bflo(y0.x) + bflo(y1.x); o[1] += bfhi(y0.x) + bfhi(y1.x); o[2] += bflo(y0.y) + bflo(y1.y); o[3] += bfhi(y0.y) + bfhi(y1.y);
            o[4] += bflo(y0.z) + bflo(y1.z); o[5] += bfhi(y0.z) + bfhi(y1.z); o[6] += bflo(y0.w) + bflo(y1.w); o[7] += bfhi(y0.w) + bfhi(y1.w); }
#pragma unroll
        for (int e = 0; e < 8; ++e) s += o[e] * o[e]; }
    return 1.f / sqrtf(wave_sum(s) * (1.f / 1024.f) + 1e-6f);
}

struct RowRaw { u32x4 h[2], y0[2], y1[2]; };
__device__ __forceinline__ int y_chunk_col(int c) { const int ci = c & 31; return (c >> 5) * 256 + (((ci >> 2) & 3) * 8 + (ci >> 4) * 4 + (ci & 3)) * 8; }
__device__ __forceinline__ void row_issue(const Fr& F, const bf16_t* hrow, const bf16_t* Y, int p0, int p1, RowRaw& R) {
#pragma unroll
    for (int j = 0; j < 2; ++j) { const int yc = y_chunk_col(64 * j + F.lane);
        R.h[j] = *(const u32x4*)(hrow + 512 * j + 8 * F.lane); R.y0[j] = *(const u32x4*)(Y + (size_t)p0 * 1024 + yc); R.y1[j] = *(const u32x4*)(Y + (size_t)p1 * 1024 + yc); }
}
__device__ __forceinline__ float row_finish(const RowRaw& R, float (&v)[16], float w0, float w1) {
    float s = 0.f;
#pragma unroll
    for (int j = 0; j < 2; ++j) { const u32x4 hv = R.h[j], y0 = R.y0[j], y1 = R.y1[j]; float* o = v + 8 * j;
        o[0] = bflo(hv.x) + (w0 * bflo(y0.x) + w1 * bflo(y1.x)); o[1] = bfhi(hv.x) + (w0 * bfhi(y0.x) + w1 * bfhi(y1.x)); o[2] = bflo(hv.y) + (w0 * bflo(y0.y) + w1 * bflo(y1.y)); o[3] = bfhi(hv.y) + (w0 * bfhi(y0.y) + w1 * bfhi(y1.y));
        o[4] = bflo(hv.z) + (w0 * bflo(y0.z) + w1 * bflo(y1.z)); o[5] = bfhi(hv.z) + (w0 * bfhi(y0.z) + w1 * bfhi(y1.z)); o[6] = bflo(hv.w) + (w0 * bflo(y0.w) + w1 * bflo(y1.w)); o[7] = bfhi(hv.w) + (w0 * bfhi(y0.w) + w1 * bfhi(y1.w));
#pragma unroll
        for (int e = 0; e < 8; ++e) s += o[e] * o[e]; }
    return 1.f / sqrtf(wave_sum(s) * (1.f / 1024.f) + 1e-6f);
}
constexpr int RB = 4;
#define ROWS_ISSUE(Hbase) int p0[RB], p1[RB]; float rw0[RB], rw1[RB]; RowRaw R[RB]; \
        _Pragma("unroll") for (int r = 0; r < RB; ++r) { const int mr = m + r * F.ngw; p0[r] = 0; p1[r] = 0; rw0[r] = 0.f; rw1[r] = 0.f; if (mr < NT) { const u32x4 _as = *(const u32x4*)(asg + mr * 8 + 4); \
            const unsigned _wx = _as.x, _wy = _as.y; rw0[r] = __uint_as_float(_wx); rw1[r] = __uint_as_float(_wy); p0[r] = (int)_as.z; p1[r] = (int)_as.w; } } \
        _Pragma("unroll") for (int r = 0; r < RB; ++r) { const int mr = m + r * F.ngw; if (mr < NT) row_issue(F, (Hbase) + (size_t)mr * 1024, Y, p0[r], p1[r], R[r]); }
__device__ __forceinline__ void phase_m1(const Fr& F, const Args& a, int layer) {
    unsigned char* ws = a.ws; const bf16_t* h = (const bf16_t*)(ws + WS_H); float* RS = (float*)(ws + WS_RSTD);
    int* asg = (int*)(ws + WS_ASG);
    const bf16_t* wfb = (const bf16_t*)(ws + WS_RFRAG) + (size_t)layer * 32 * 9 * 512;
    unsigned* cnt = (unsigned*)(ws + WS_CTL) + CW_CNT + layer * 32 * 64;
    LAS float* Lg = (LAS float*)F.lds + F.wave * 1600;
    LAS float* Lr = Lg + 1536;
    for (int task = F.gw; task < NT / 32; task += F.ngw) {
        const int m0 = task * 32;
        f32x4 acc[2][3];
#pragma unroll
        for (int rb = 0; rb < 2; ++rb)
#pragma unroll
            for (int nt = 0; nt < 3; ++nt) acc[rb][nt] = (f32x4){0.f, 0.f, 0.f, 0.f};
        const int i = F.lane & 15, q = F.lane >> 4; const bf16_t* hr = h + (size_t)(m0 + i) * 1024 + 8 * q;
        float ss0 = 0.f, ss1 = 0.f;
#pragma unroll 4
        for (int s = 0; s < 32; ++s) {
            const bf16x8 a0 = *(const bf16x8*)(hr + 32 * s), a1 = *(const bf16x8*)(hr + 16 * 1024 + 32 * s);
            const bf16_t* wp = wfb + (size_t)s * 9 * 512 + F.lane * 8;
#pragma unroll
            for (int tn = 0; tn < 9; ++tn) { const bf16x8 b = *(const bf16x8*)(wp + tn * 512);
                acc[0][tn % 3] = __builtin_amdgcn_mfma_f32_16x16x32_bf16(a0, b, acc[0][tn % 3], 0, 0, 0); acc[1][tn % 3] = __builtin_amdgcn_mfma_f32_16x16x32_bf16(a1, b, acc[1][tn % 3], 0, 0, 0); }
            const u32x4 u0 = __builtin_bit_cast(u32x4, a0), u1 = __builtin_bit_cast(u32x4, a1);
#pragma unroll
            for (int e = 0; e < 4; ++e) { const float x0 = bflo(u0[e]), y0 = bfhi(u0[e]), x1 = bflo(u1[e]), y1 = bfhi(u1[e]); ss0 += x0 * x0 + y0 * y0; ss1 += x1 * x1 + y1 * y1; }
        }
        {
            auto r16 = __builtin_amdgcn_permlane16_swap(__float_as_uint(ss0), __float_as_uint(ss0), false, false); ss0 = __uint_as_float(r16[0]) + __uint_as_float(r16[1]);
            auto r32 = __builtin_amdgcn_permlane32_swap(__float_as_uint(ss0), __float_as_uint(ss0), false, false); ss0 = __uint_as_float(r32[0]) + __uint_as_float(r32[1]);
            r16 = __builtin_amdgcn_permlane16_swap(__float_as_uint(ss1), __float_as_uint(ss1), false, false); ss1 = __uint_as_float(r16[0]) + __uint_as_float(r16[1]);
            r32 = __builtin_amdgcn_permlane32_swap(__float_as_uint(ss1), __float_as_uint(ss1), false, false); ss1 = __uint_as_float(r32[0]) + __uint_as_float(r32[1]);
            const float rs0 = 1.f / sqrtf(ss0 * (1.f / 1024.f) + 1e-6f), rs1 = 1.f / sqrtf(ss1 * (1.f / 1024.f) + 1e-6f);
            if (F.lane < 16) { RS[m0 + i] = rs0; RS[m0 + 16 + i] = rs1; Lr[i] = rs0; Lr[16 + i] = rs1; }
        }
        LDS_WAIT(); asm volatile("" ::: "memory");
#pragma unroll
        for (int rb = 0; rb < 2; ++rb) { const f32x4 rs = *(const LAS f32x4*)(Lr + 16 * rb + 4 * q);
#pragma unroll
            for (int nt = 0; nt < 3; ++nt)
#pragma unroll
                for (int rg = 0; rg < 4; ++rg) Lg[(16 * rb + 4 * q + rg) * 48 + 16 * nt + i] = acc[rb][nt][rg] * rs[rg]; }
        LDS_WAIT(); asm volatile("" ::: "memory");
        if (F.lane < 32) {
            const int m = m0 + F.lane; const LAS float* lg = Lg + F.lane * 48;
            float gl[4]; float gmax = -3.0e38f; int grp = 0;
#pragma unroll
            for (int j = 0; j < 4; ++j) { gl[j] = lg[j] + a.in[I_MBG][layer * 4 + j]; if (gl[j] > gmax) { gmax = gl[j]; grp = j; } }
            float gs = 0.f;
#pragma unroll
            for (int j = 0; j < 4; ++j) gs += __expf(gl[j] - gmax);
            const float grp_w = 1.f / gs;
            float v1 = -3.0e38f, v2 = -3.0e38f; int i1 = 0, i2 = 0;
            for (int j = 0; j < 8; ++j) { const float e = lg[4 + grp * 8 + j] + a.in[I_MBE][layer * 32 + grp * 8 + j];
                if (e > v1) { v2 = v1; i2 = i1; v1 = e; i1 = j; } else if (e > v2) { v2 = e; i2 = j; } }
            const float r2 = __expf(v2 - v1); const float w1 = grp_w / (1.f + r2), w2 = grp_w * r2 / (1.f + r2);
            const int e1 = grp * 8 + i1, e2 = grp * 8 + i2;
            const unsigned s1 = __hip_atomic_fetch_add(cnt + e1 * 64, 1u, __ATOMIC_RELAXED, __HIP_MEMORY_SCOPE_AGENT);
            const unsigned s2 = __hip_atomic_fetch_add(cnt + e2 * 64, 1u, __ATOMIC_RELAXED, __HIP_MEMORY_SCOPE_AGENT);
            int* r = asg + (size_t)m * 8; r[0] = e1; r[1] = e2; r[2] = (int)s1; r[3] = (int)s2; r[4] = __builtin_bit_cast(int, w1); r[5] = __builtin_bit_cast(int, w2);
        }
        LDS_WAIT(); asm volatile("" ::: "memory");
    }
}

__device__ __forceinline__ void phase_m2(const Fr& F, const Args& a, int layer) {
    unsigned char* ws = a.ws;
    int* asg = (int*)(ws + WS_ASG); float* roww = (float*)(ws + WS_ROWW);
    int* texp = (int*)(ws + WS_TEXP);
    unsigned* cnt = (unsigned*)(ws + WS_CTL) + CW_CNT + layer * 32 * 64;
    LAS int* sb = (LAS int*)F.lds;
    if (F.tid < 32) sb[64 + F.tid] = (int)__hip_atomic_load(cnt + F.tid * 64, __ATOMIC_RELAXED, __HIP_MEMORY_SCOPE_AGENT);
    __syncthreads();
    if (F.tid == 0) { int acc = 0; for (int e = 0; e < 32; ++e) { sb[e] = acc; acc += (sb[64 + e] + 255) & ~255; } sb[32] = acc; }
    __syncthreads();
    if (blockIdx.x == 0) {
        const int ntiles = sb[32] >> 8;
        for (int t = F.tid; t < ntiles; t += 512) { int e = 0; for (int j = 1; j < 32; ++j) if ((t << 8) >= sb[j]) e = j; texp[t] = e; }
        if (F.tid == 0) texp[1023] = ntiles;
        if (F.tid < 8) { int n = 0; for (int q = 0; q < 4; ++q) { const int e = F.tid + 8 * q; for (int t = sb[e] >> 8; t < (sb[e + 1] >> 8); ++t) texp[2048 + F.tid * 640 + n++] = t | (e << 16); } texp[1008 + F.tid] = n; }
    }
    int* ridx = (int*)(ws + WS_RIDX); float* rowrs = (float*)(ws + WS_ROWRS); const float* RS = (const float*)(ws + WS_RSTD);
    for (int as = blockIdx.x * 512 + F.tid; as < NT * 2; as += F.G * 512) {
        const int m = as >> 1, k = as & 1; const int e = asg[m * 8 + k], slot = asg[m * 8 + 2 + k]; const int p = sb[e] + slot;
        ridx[p] = m; rowrs[p] = RS[m]; roww[p] = __builtin_bit_cast(float, asg[m * 8 + 4 + k]); asg[m * 8 + 6 + k] = p; }
    for (int idx = blockIdx.x * 512 + F.tid; idx < 32 * 256; idx += F.G * 512) {
        const int e = idx >> 8, r = idx & 255; const int p = sb[e] + sb[64 + e] + r;
        if (p < sb[e + 1]) { ridx[p] = 0; rowrs[p] = 0.f; roww[p] = 0.f; } }
}

__device__ __forceinline__ void phase_n1(const Fr& F, const Args& a) {
    unsigned char* ws = a.ws; bf16_t* H = (bf16_t*)(ws + WS_H); const bf16_t* Y = (const bf16_t*)(ws + WS_S1); const int* asg = (const int*)(ws + WS_ASG); float* RS = (float*)(ws + WS_RSTD);
    for (int m = F.gw; m < NT; m += RB * F.ngw) {
        ROWS_ISSUE(H)
#pragma unroll
        for (int r = 0; r < RB; ++r) { const int mr = m + r * F.ngw; if (mr < NT) {
            float v[16]; bf16_t* hrow = H + (size_t)mr * 1024; const float rstd = row_finish(R[r], v, rw0[r], rw1[r]);
#pragma unroll
            for (int j = 0; j < 2; ++j) *(u32x4*)(hrow + 512 * j + 8 * F.lane) = (u32x4){pk2(v[8 * j], v[8 * j + 1]), pk2(v[8 * j + 2], v[8 * j + 3]), pk2(v[8 * j + 4], v[8 * j + 5]), pk2(v[8 * j + 6], v[8 * j + 7])};
            if (F.lane == 0) RS[mr] = rstd; } }
    }
}
__device__ __forceinline__ void phase_final(const Fr& F, const Args& a) {
    unsigned char* ws = a.ws; const bf16_t* H = (const bf16_t*)(ws + WS_H); const bf16_t* Y = (const bf16_t*)(ws + WS_S1); const int* asg = (const int*)(ws + WS_ASG); const float* gain = a.in[I_FLN];
    for (int m = F.gw; m < NT; m += RB * F.ngw) {
        ROWS_ISSUE(H)
#pragma unroll
        for (int r = 0; r < RB; ++r) { const int mr = m + r * F.ngw; if (mr < NT) {
            float v[16]; const float rstd = row_finish(R[r], v, rw0[r], rw1[r]); float* orow = a.out + (size_t)mr * 1024;
#pragma unroll
            for (int j = 0; j < 2; ++j) { const int c = 512 * j + 8 * F.lane; const f32x4 g0 = *(const f32x4*)(gain + c), g1 = *(const f32x4*)(gain + c + 4);
                *(f32x4*)(orow + c) = (f32x4){v[8 * j] * rstd * g0.x, v[8 * j + 1] * rstd * g0.y, v[8 * j + 2] * rstd * g0.z, v[8 * j + 3] * rstd * g0.w};
                *(f32x4*)(orow + c + 4) = (f32x4){v[8 * j + 4] * rstd * g1.x, v[8 * j + 5] * rstd * g1.y, v[8 * j + 6] * rstd * g1.z, v[8 * j + 7] * rstd * g1.w}; } } }
    }
}

__device__ __forceinline__ void phase_cmp_gather(const Fr& F, const Args& a) {
    unsigned char* ws = a.ws; const bf16_t* KV = (const bf16_t*)(ws + WS_KV); bf16_t* AC = (bf16_t*)(ws + WS_ACMP);
    for (int r = F.gw; r < 2 * 16384; r += F.ngw) {
        const int grp = r >> 14, rr = r & 16383, bg = rr >> 7, n = rr & 127, b = bg >> 2, g = bg & 3;
        const float* pe = a.in[grp ? I_PEV : I_PEK] + (size_t)g * 32 * 64;
        bf16_t* dst = AC + (size_t)r * 2048;
        for (int l2 = 0; l2 < 16; ++l2) { const int l = 2 * l2 + (F.lane >> 5), d = 2 * (F.lane & 31);
            unsigned o = 0u;
            if (n < 127) { const unsigned kv = *(const unsigned*)(KV + (size_t)(b * SEQ + 16 * n + l) * 1536 + (grp * 4 + g) * 64 + d);
                o = pk2(bflo(kv) + pe[l * 64 + d], bfhi(kv) + pe[l * 64 + d + 1]); }
            *(unsigned*)(dst + l * 64 + d) = o; }
    }
}
__device__ __forceinline__ int perm16pos(int w) { return w < 4 ? w : (w < 8 ? w + 4 : (w < 12 ? w - 4 : w)); }
__device__ __forceinline__ void phase_cmp2(const Fr& F, const Args& a, int task0, int tstep, int tend) {
    unsigned char* ws = a.ws; const bf16_t* HC = (const bf16_t*)(ws + WS_HC); bf16_t* KCB = (bf16_t*)(ws + WS_KCB); bf16_t* VCT = (bf16_t*)(ws + WS_VCT); const bf16_t* WF = (const bf16_t*)(ws + WS_W2F);
    const int i = F.lane & 15, q = F.lane >> 4;
    for (int task = task0; task < tend; task += tstep) {
        const int r0 = task * 16, grp = r0 >> 14, rr = r0 & 16383, bg = rr >> 7, n0 = rr & 127;
        f32x4 acc[4];
#pragma unroll
        for (int nb = 0; nb < 4; ++nb) acc[nb] = (f32x4){0.f, 0.f, 0.f, 0.f};
        const bf16_t* hr = HC + (size_t)(r0 + i) * 256 + 8 * q; const bf16_t* wp = WF + (size_t)grp * 8 * 8 * 512 + F.lane * 8;
#pragma unroll
        for (int sk = 0; sk < 8; ++sk) { const bf16x8 av = *(const bf16x8*)(hr + 32 * sk);
#pragma unroll
            for (int tn = 0; tn < 8; ++tn) acc[tn & 3] = __builtin_amdgcn_mfma_f32_16x16x32_bf16(av, *(const bf16x8*)(wp + (sk * 8 + tn) * 512), acc[tn & 3], 0, 0, 0); }
#pragma unroll
        for (int nb = 0; nb < 4; ++nb) { const int col = 16 * nb + i; f32x4 v = acc[nb];
#pragma unroll
            for (int rg = 0; rg < 4; ++rg) if (n0 + 4 * q + rg == 127) v[rg] = 0.f;
            if (grp == 0) {
#pragma unroll
                for (int rg = 0; rg < 4; ++rg) KCB[((size_t)bg * 128 + n0 + 4 * q + rg) * 64 + col] = (bf16_t)f2bf(v[rg]); }
            else *(u32x2*)(VCT + ((size_t)bg * 64 + col) * 128 + n0 + perm16pos(4 * q)) = (u32x2){cvtpk(v[0], v[1]), cvtpk(v[2], v[3])}; }
    }
}
__device__ __forceinline__ void phase_vt(const Fr& F, const Args& a, int gw, int ngw) {
    unsigned char* ws = a.ws; const bf16_t* KV = (const bf16_t*)(ws + WS_KV); bf16_t* VT = (bf16_t*)a.out;
    LAS unsigned* T2 = (LAS unsigned*)(F.lds) + F.wave * 2080;
    for (int task = gw; task < 8192; task += ngw) {
        const int tile = task & 31, g = (task >> 5) & 3, pg = (task >> 7) & 1, b = task >> 8;
        const u32x4* src = (const u32x4*)(KV + (size_t)(b * SEQ + 64 * tile + F.lane) * 1536 + ((pg ? 5 : 3) * 4 + g) * 64);
#pragma unroll
        for (int i = 0; i < 8; ++i) { const u32x4 v = src[i]; T2[(4 * i + 0) * 65 + F.lane] = v.x; T2[(4 * i + 1) * 65 + F.lane] = v.y; T2[(4 * i + 2) * 65 + F.lane] = v.z; T2[(4 * i + 3) * 65 + F.lane] = v.w; }
        LDS_WAIT(); asm volatile("" ::: "memory");
        const int d = F.lane, dp = d >> 1; const bool hi = d & 1;
        u32x4* dst = (u32x4*)(VT + ((size_t)((b * 2 + pg) * 4 + g) * 64 + d) * 2048 + 64 * tile);
#pragma unroll
        for (int G = 0; G < 4; ++G) {
            unsigned e[16];
#pragma unroll
            for (int p = 0; p < 16; ++p) { const int key = 16 * G + ((p < 4) ? p : (p < 8) ? p + 4 : (p < 12) ? p - 4 : p); const unsigned u = T2[dp * 65 + key]; e[p] = hi ? (u >> 16) : (u & 0xffffu); }
            dst[2 * G] = (u32x4){e[0] | (e[1] << 16), e[2] | (e[3] << 16), e[4] | (e[5] << 16), e[6] | (e[7] << 16)};
            dst[2 * G + 1] = (u32x4){e[8] | (e[9] << 16), e[10] | (e[11] << 16), e[12] | (e[13] << 16), e[14] | (e[15] << 16)};
        }
        LDS_WAIT(); asm volatile("" ::: "memory");
    }
}
__device__ __forceinline__ void dma16(const void* g, LAS void* l) { __builtin_amdgcn_global_load_lds((const unsigned*)g, (LAS unsigned*)l, 16, 0, 0); }
#define ATT_NEG (-__builtin_inff())
__device__ __forceinline__ unsigned xor32u(unsigned x) { const auto r = __builtin_amdgcn_permlane32_swap(x, x, false, false); return (threadIdx.x & 32) ? r[0] : r[1]; }
__device__ __forceinline__ float xor32(float x) { return __uint_as_float(xor32u(__float_as_uint(x))); }
template <int KM>
__device__ __forceinline__ void att_fix(f32x16 (&S)[2], int dbase, unsigned maxd, bool colsel, const LAS float* dBl) {
#pragma unroll
    for (int blk = 0; blk < 2; ++blk) {
        float bv[16];
#pragma unroll
        for (int rr = 0; rr < 16; ++rr) { const int koff = 32 * blk + (rr & 3) + 8 * (rr >> 2); const unsigned di = min((unsigned)(dbase - KM * koff), 128u); bv[rr] = dBl[di]; }
#pragma unroll
        for (int rr = 0; rr < 16; ++rr) asm volatile("" : "+v"(bv[rr]));
#pragma unroll
        for (int rr = 0; rr < 16; ++rr) { const int koff = 32 * blk + (rr & 3) + 8 * (rr >> 2); const int dist = dbase - KM * koff;
            const bool ok = ((unsigned)dist < maxd) && colsel; S[blk][rr] = ok ? S[blk][rr] + bv[rr] : ATT_NEG; } }
}
template <int KM>
__device__ __forceinline__ void att_fixcb(f32x16& S, int dbase, const LAS float* dBl) {
    float bv[16];
#pragma unroll
    for (int rr = 0; rr < 16; ++rr) { const int koff = (rr & 3) + 8 * (rr >> 2); const unsigned di = min((unsigned)(dbase - KM * koff), 128u); bv[rr] = dBl[di]; }
#pragma unroll
    for (int rr = 0; rr < 16; ++rr) asm volatile("" : "+v"(bv[rr]));
#pragma unroll
    for (int rr = 0; rr < 16; ++rr) { const int koff = (rr & 3) + 8 * (rr >> 2); const int dist = dbase - KM * koff; S[rr] = (dist >= 0) ? S[rr] + bv[rr] : ATT_NEG; }
}
__device__ __forceinline__ void att_fix1(f32x16 (&S)[2], int dbase, unsigned maxd, const LAS float* bp) {
#pragma unroll
    for (int blk = 0; blk < 2; ++blk) {
        f32x4 bv[4];
#pragma unroll
        for (int q = 0; q < 4; ++q) bv[q] = *(const LAS f32x4*)(bp + 56 - 32 * blk - 8 * q);
#pragma unroll
        for (int q = 0; q < 4; ++q) asm volatile("" : "+v"(bv[q]));
#pragma unroll
        for (int rr = 0; rr < 16; ++rr) { const int koff = 32 * blk + (rr & 3) + 8 * (rr >> 2); const int dist = dbase - koff;
            S[blk][rr] = ((unsigned)dist < maxd) ? S[blk][rr] + bv[rr >> 2][3 - (rr & 3)] : ATT_NEG; } }
}
__device__ __forceinline__ void att_scores(LAS unsigned char* ktile, const int (&aoff)[4], const bf16x8 (&qf)[4], f32x16 (&S)[2]) {
#pragma unroll
    for (int blk = 0; blk < 2; ++blk)
#pragma unroll
        for (int i = 0; i < 16; ++i) S[blk][i] = 0.f;
    bf16x8 kf[2][4];
#pragma unroll
    for (int s = 0; s < 4; ++s)
#pragma unroll
        for (int blk = 0; blk < 2; ++blk) kf[blk][s] = *(const LAS bf16x8*)(ktile + blk * 4096 + aoff[s]);
#pragma unroll
    for (int s = 0; s < 4; ++s) {
        S[0] = __builtin_amdgcn_mfma_f32_32x32x16_bf16(kf[0][s], qf[s], S[0], 0, 0, 0); S[1] = __builtin_amdgcn_mfma_f32_32x32x16_bf16(kf[1][s], qf[s], S[1], 0, 0, 0);
        __builtin_amdgcn_sched_barrier(0); }
}
__device__ __forceinline__ void att_scores_init(LAS unsigned char* ktile, const int (&aoff)[4], const bf16x8 (&qf)[4], f32x16 (&S)[2], const LAS float* ip) {
#pragma unroll
    for (int blk = 0; blk < 2; ++blk)
#pragma unroll
        for (int q = 0; q < 4; ++q) { const f32x4 v = *(const LAS f32x4*)(ip + 32 * blk + 8 * q); S[blk][4 * q] = v.x; S[blk][4 * q + 1] = v.y; S[blk][4 * q + 2] = v.z; S[blk][4 * q + 3] = v.w; }
    bf16x8 kf[2][4];
#pragma unroll
    for (int s = 0; s < 4; ++s)
#pragma unroll
        for (int blk = 0; blk < 2; ++blk) kf[blk][s] = *(const LAS bf16x8*)(ktile + blk * 4096 + aoff[s]);
#pragma unroll
    for (int s = 0; s < 4; ++s) {
        S[0] = __builtin_amdgcn_mfma_f32_32x32x16_bf16(kf[0][s], qf[s], S[0], 0, 0, 0); S[1] = __builtin_amdgcn_mfma_f32_32x32x16_bf16(kf[1][s], qf[s], S[1], 0, 0, 0);
        __builtin_amdgcn_sched_barrier(0); }
}
__device__ __forceinline__ void att_pv(LAS unsigned char* vtile, const int (&aoff)[4], const f32x16 (&P)[2], f32x16 (&O)[2]) {
    bf16x8 pb[2][2];
#pragma unroll
    for (int blk = 0; blk < 2; ++blk)
#pragma unroll
        for (int s2 = 0; s2 < 2; ++s2) pb[blk][s2] = pack8f(P[blk][8 * s2], P[blk][8 * s2 + 1], P[blk][8 * s2 + 2], P[blk][8 * s2 + 3], P[blk][8 * s2 + 4], P[blk][8 * s2 + 5], P[blk][8 * s2 + 6], P[blk][8 * s2 + 7]);
#pragma unroll
    for (int dt = 0; dt < 2; ++dt)
#pragma unroll
        for (int blk = 0; blk < 2; ++blk)
#pragma unroll
            for (int s2 = 0; s2 < 2; ++s2) { const bf16x8 A = *(const LAS bf16x8*)(vtile + dt * 4096 + aoff[2 * blk + s2]); O[dt] = __builtin_amdgcn_mfma_f32_32x32x16_bf16(A, pb[blk][s2], O[dt], 0, 0, 0); }
}
#define ATT_LHI 1.8446744e19f
#define ATT_TBL_NEG (4 * 2832)
#define ATT_TBL_ZERO (4 * 2832 + 64)
__device__ __forceinline__ float att_colmax(const f32x16 (&S)[2]) {
    float mx = S[0][0];
#pragma unroll
    for (int blk = 0; blk < 2; ++blk)
#pragma unroll
        for (int rr = 0; rr < 16; ++rr) mx = fmaxf(mx, S[blk][rr]);
    return fmaxf(mx, xor32(mx));
}
__device__ __forceinline__ void att_tile(LAS unsigned char* tile, const int (&aoff)[4], const bf16x8 (&qf)[4], f32x16 (&O)[2], float& m, float& l, bool& pending, bool& shifted,
                                         int fixmode, int dbase, bool colsel, const LAS float* dBl, const LAS float* tblbase) {
    f32x16 S[2];
    const LAS float* ip = colsel ? (fixmode == 2 ? dBl - dbase : tblbase + ATT_TBL_ZERO) : tblbase + ATT_TBL_NEG;
    if (fixmode == 0) att_scores(tile, aoff, qf, S); else att_scores_init(tile, aoff, qf, S, ip);
    if (shifted) { S[0] = S[0] - m; S[1] = S[1] - m; }
    if (pending) {
        const float mxc = att_colmax(S); const float dl = (mxc > -1e29f && fabsf(mxc) > 32.f) ? mxc : 0.f;
        if (__any(dl != 0.f)) { m += dl; S[0] = S[0] - dl; S[1] = S[1] - dl; shifted = true; }
        pending = false;
    }
    float ln = l;
#pragma unroll
    for (int blk = 0; blk < 2; ++blk)
#pragma unroll
        for (int rr = 0; rr < 16; ++rr) { const float p = __builtin_amdgcn_exp2f(S[blk][rr]); S[blk][rr] = p; ln += p; }
    if (__any(ln > ATT_LHI)) {
        if (fixmode == 0) att_scores(tile, aoff, qf, S); else att_scores_init(tile, aoff, qf, S, ip);
        if (shifted) { S[0] = S[0] - m; S[1] = S[1] - m; }
        const float mxc = att_colmax(S), lnc = fmaxf(ln, xor32(ln));
        const float dl = (lnc > ATT_LHI) ? fmaxf(mxc, 32.f) : 0.f, corr = __builtin_amdgcn_exp2f(-dl);
        m += dl; l *= corr; O[0] = O[0] * corr; O[1] = O[1] * corr; S[0] = S[0] - dl; S[1] = S[1] - dl; shifted = true;
        ln = l;
#pragma unroll
        for (int blk = 0; blk < 2; ++blk)
#pragma unroll
            for (int rr = 0; rr < 16; ++rr) { const float p = __builtin_amdgcn_exp2f(S[blk][rr]); S[blk][rr] = p; ln += p; }
    }
    l = ln;
    att_pv(tile + 8192, aoff, S, O);
}
__device__ const unsigned char ATT_QOFF[16] = {29, 2, 18, 29, 2, 8, 26, 6, 26, 13, 18, 19, 8, 13, 6, 19};
__device__ __forceinline__ void phase_attn(const Fr& F, const Args& a) {
    unsigned char* ws = a.ws;
    const bf16_t* QB = (const bf16_t*)(ws + WS_Q); const unsigned char* KV = ws + WS_KV; const unsigned char* VT = (const unsigned char*)a.out; const float* GT = (const float*)(ws + WS_GATES);
    const unsigned char* KCB = ws + WS_KCB; const unsigned char* VCT = ws + WS_VCT; bf16_t* OB = (bf16_t*)(ws + WS_OATT);
    LAS unsigned char* RING = F.lds; LAS unsigned char* CMPA = F.lds + 65536; LAS float* dB = (LAS float*)(F.lds + 98304);
    const int w = F.wave, lane = F.lane, r = lane & 31, h = lane >> 5, hh = lane & 3, tl = r >> 2, swz = (r >> 1) & 7;
    int aoff[4];
#pragma unroll
    for (int s = 0; s < 4; ++s) aoff[s] = r * 128 + (((2 * s + h) ^ swz) * 16);
    const int drow = 8 * w + (lane >> 3), dchunk = ((lane & 7) ^ ((drow >> 1) & 7)) * 16;
    const LAS float* dBl = dB + hh * 132;
    LAS float* DB4 = (LAS float*)(F.lds + 102400);
    const LAS float* dB4l = DB4 + hh * 2832 + (tl & 3) * 708 + (tl & 3) + 576;
    int gprev = -1;
    const bool xcdord = F.G == 256;
    for (int unit = blockIdx.x, uk = 0; xcdord ? uk < 16 : unit < 4096; unit += F.G, ++uk) {
        const int qrot = (int)((blockIdx.x >> 3) + ATT_QOFF[uk & 15]) & 31;
        const int bg = xcdord ? (int)(blockIdx.x & 7) + 8 * uk : unit & 127, qt = xcdord ? (((42232u >> (uk & 15)) & 1u) ? 31 - qrot : qrot) : (unit >> 7) ^ ((unit >> 8) & 1);
        const int b = bg >> 2, g = bg & 3, t0 = 64 * qt;
        __syncthreads();
        if (g != gprev) for (int i = F.tid; i < 4 * 129; i += 512) { const int hq = i / 129, d = i % 129;
            dB[hq * 132 + d] = (d < 128) ? (a.in[I_RELB][BKT[d] * 16 + 4 * g + hq] - a.in[I_RELB][31 * 16 + 4 * g + hq]) * 1.44269504089f : 0.f; }
        if (g != gprev) for (int i = F.tid; i < 4 * 2832 + 128; i += 512) { const int hq = i / 2832, rem = i % 2832, cc = rem / 708, d = 576 - (rem % 708 - cc);
            float v;
            if (i >= 4 * 2832) v = (i < 4 * 2832 + 64) ? ATT_NEG : 0.f;
            else v = (d < 0 || d >= 512) ? ATT_NEG : (d < 128 ? (a.in[I_RELB][BKT[d] * 16 + 4 * g + hq] - a.in[I_RELB][31 * 16 + 4 * g + hq]) * 1.44269504089f : 0.f);
            DB4[i] = v; }
        gprev = g;
        const unsigned char* kwin = KV + ((size_t)(b * SEQ) * 1536 + (16 + g) * 64) * 2; const unsigned char* ksel = KV + ((size_t)(b * SEQ) * 1536 + (8 + g) * 64) * 2;
        const unsigned char* vsel = VT + ((size_t)((b * 2 + 0) * 4 + g) * 64) * 4096; const unsigned char* vwin = VT + ((size_t)((b * 2 + 1) * 4 + g) * 64) * 4096;
        const int nwin = min(qt, 8) + 1, ktlo = qt - nwin + 1, nst = nwin + qt + 1, ncmp = (qt >= 16) ? 2 : 1;
#define ATT_STAGE(i_, buf_) do { const int _i = (i_); const bool _isw = _i < nwin; const int _kt = _isw ? qt - _i : _i - nwin; \
            const unsigned char* _kp = (_isw ? kwin : ksel) + ((size_t)(64 * _kt + drow) * 1536) * 2 + dchunk; \
            const unsigned char* _vp = (_isw ? vwin : vsel) + (size_t)drow * 4096 + (size_t)_kt * 128 + dchunk; \
            dma16(_kp, (buf_) + w * 1024); dma16(_vp, (buf_) + 8192 + w * 1024); } while (0)
        for (int i = 0; i < ncmp; ++i) { dma16(KCB + ((size_t)(bg * 128 + 64 * i + drow) * 64) * 2 + dchunk, CMPA + i * 8192 + w * 1024);
            dma16(VCT + ((size_t)(bg * 64 + drow) * 128) * 2 + i * 128 + dchunk, CMPA + 16384 + i * 8192 + w * 1024); }
        const int tcol = t0 + 8 * w + tl; const size_t mtok = (size_t)b * SEQ + tcol; const int head = 4 * g + hh;
        bf16x8 qf[4];
#pragma unroll
        for (int s = 0; s < 4; ++s) qf[s] = *(const bf16x8*)(QB + mtok * 1024 + head * 64 + 16 * s + 8 * h);
        const float g0 = GT[mtok * 48 + head * 3 + 0], g1 = GT[mtok * 48 + head * 3 + 1], g2 = GT[mtok * 48 + head * 3 + 2];
        asm volatile("s_waitcnt vmcnt(0)" ::: "memory"); __syncthreads();
        ATT_STAGE(0, RING); ATT_STAGE(1, RING + 16384); if (nst > 2) ATT_STAGE(2, RING + 32768);
        f32x16 OUT[2], O[2];
        unsigned selmask;
        {
            f32x16 C[4];
            att_scores(CMPA, aoff, qf, *(f32x16 (*)[2])&C[0]);
            if (ncmp == 2) att_scores(CMPA + 8192, aoff, qf, *(f32x16 (*)[2])&C[2]);
            else {
#pragma unroll
                for (int i = 0; i < 16; ++i) { C[2][i] = ATT_NEG; C[3][i] = ATT_NEG; } }
#pragma unroll
            for (int cb = 0; cb < 4; ++cb) { const int tw = t0 + 8 * w, lo = tw - 31 - 16 * (32 * cb + 31), hi = tw + 7 - 31 - 512 * cb;
                if (cb < 2 * ncmp && lo < 128) {
                    if (hi < 0) {
#pragma unroll
                        for (int i = 0; i < 16; ++i) C[cb][i] = ATT_NEG; }
                    else att_fixcb<16>(C[cb], tcol - 31 - 64 * h - 512 * cb, dBl); } }
            float mx = C[0][0];
#pragma unroll
            for (int cb = 0; cb < 4; ++cb)
#pragma unroll
                for (int rr = 0; rr < 16; ++rr) mx = fmaxf(mx, C[cb][rr]);
            mx = fmaxf(mx, xor32(mx)); mx = fmaxf(mx, -1e30f);
            float ls = 0.f;
#pragma unroll
            for (int cb = 0; cb < 4; ++cb)
#pragma unroll
                for (int rr = 0; rr < 16; ++rr) { const float p = __builtin_amdgcn_exp2f(C[cb][rr] - mx); C[cb][rr] = p; ls += p; }
            ls += xor32(ls);
            const float inv = ls > 0.f ? 1.f / ls : 0.f;
#pragma unroll
            for (int cb = 0; cb < 4; ++cb) C[cb] = C[cb] * inv;
#pragma unroll
            for (int i = 0; i < 16; ++i) { OUT[0][i] = 0.f; OUT[1][i] = 0.f; }
            att_pv(CMPA + 16384, aoff, *(const f32x16 (*)[2])&C[0], OUT);
            if (ncmp == 2) att_pv(CMPA + 16384 + 8192, aoff, *(const f32x16 (*)[2])&C[2], OUT);
            OUT[0] = OUT[0] * g0; OUT[1] = OUT[1] * g0;
            if (qt <= 7) selmask = (2u << qt) - 1u;
            else {
                float imp[16], lastv[16];
#pragma unroll
                for (int cb = 0; cb < 4; ++cb)
#pragma unroll
                    for (int rq = 0; rq < 4; ++rq) { imp[4 * cb + rq] = (C[cb][4 * rq] + C[cb][4 * rq + 1]) + (C[cb][4 * rq + 2] + C[cb][4 * rq + 3]); lastv[4 * cb + rq] = C[cb][4 * rq + 3]; }
                unsigned key[16];
#pragma unroll
                for (int q = 0; q < 16; ++q) lastv[q] = xor32(lastv[q]);
#pragma unroll
                for (int q = 0; q < 16; ++q) { const float prev = (q >= 1) ? lastv[q - 1] : 0.f; float v = imp[q] + (h ? lastv[q] : prev);
                    v += dppf<DPP_XOR1>(v); v += dppf<DPP_XOR2>(v);
                    const int j = 2 * q + h; const bool cand = (j >= 1) && (j <= qt - 2);
                    key[q] = cand ? ((__builtin_bit_cast(unsigned, v) & ~31u) | (unsigned)(31 - j)) : 0u; }
                selmask = 1u | (1u << qt) | (1u << (qt - 1));
#pragma unroll 1
                for (int rnd = 0; rnd < 5; ++rnd) {
                    unsigned best = 0u;
#pragma unroll
                    for (int q = 0; q < 16; ++q) best = max(best, key[q]);
                    best = max(best, xor32u(best));
                    if (best != 0u) selmask |= 1u << (31 - (best & 31u));
#pragma unroll
                    for (int q = 0; q < 16; ++q) key[q] = (key[q] == best) ? 0u : key[q];
                }
            }
        }
        unsigned wor = selmask; wor |= (unsigned)__shfl_xor((int)wor, 4); wor |= (unsigned)__shfl_xor((int)wor, 8); wor |= (unsigned)__shfl_xor((int)wor, 16);
        wor = (unsigned)__builtin_amdgcn_readfirstlane((int)wor);
        unsigned wand = selmask; wand &= (unsigned)__shfl_xor((int)wand, 4); wand &= (unsigned)__shfl_xor((int)wand, 8); wand &= (unsigned)__shfl_xor((int)wand, 16);
        wand = (unsigned)__builtin_amdgcn_readfirstlane((int)wand);
        float m = 0.f, l = 0.f; bool pending = true, shifted = false;
        unsigned wall = 0xffffffffu; asm volatile("" : "+s"(wall));
#pragma unroll
        for (int i = 0; i < 16; ++i) { O[0][i] = 0.f; O[1][i] = 0.f; }
#define ATT_FINALIZE(gate_) do { const float _lt = l + xor32(l); const float _sc = _lt > 0.f ? (gate_) / _lt : 0.f; \
            OUT[0] = OUT[0] + O[0] * _sc; OUT[1] = OUT[1] + O[1] * _sc; m = 0.f; l = 0.f; pending = true; shifted = false; \
            _Pragma("unroll") for (int _i = 0; _i < 16; ++_i) { O[0][_i] = 0.f; O[1][_i] = 0.f; } } while (0)
#define ATT_TILE_SYNC(i_) do { const int _ahead = nst - 1 - (i_); \
            if (_ahead >= 2) asm volatile("s_waitcnt vmcnt(4) lgkmcnt(0)" ::: "memory"); else if (_ahead == 1) asm volatile("s_waitcnt vmcnt(2) lgkmcnt(0)" ::: "memory"); else asm volatile("s_waitcnt vmcnt(0) lgkmcnt(0)" ::: "memory"); \
            __builtin_amdgcn_s_barrier(); asm volatile("" ::: "memory"); \
            if ((i_) + 3 < nst) ATT_STAGE((i_) + 3, RING + (((i_) + 3) & 3) * 16384); } while (0)
#pragma unroll 1
        for (int i = 0; i < nwin; ++i) {
            ATT_TILE_SYNC(i);
            const int kt = qt - i; const int fm = (kt >= qt - 2 || kt == qt - 8) ? 2 : 0;
            if ((wall >> i) & 1u)
            att_tile(RING + (i & 3) * 16384, aoff, qf, O, m, l, pending, shifted, fm, tcol - 64 * kt - 4 * h, true, dB4l, DB4);
        }
        ATT_FINALIZE(g2);
#pragma unroll 1
        for (int i = nwin; i < nst; ++i) {
            ATT_TILE_SYNC(i);
            const int j = i - nwin;
            if ((wor >> j) & 1u) { const bool cs = (selmask >> j) & 1u; const int fm = (j >= qt - 2) ? 2 : (((wand >> j) & 1u) ? 0 : 1);
                att_tile(RING + (i & 3) * 16384, aoff, qf, O, m, l, pending, shifted, fm, tcol - 64 * j - 4 * h, cs, dB4l, DB4); }
        }
#undef ATT_TILE_SYNC
        ATT_FINALIZE(g1);
        bf16_t* orow = OB + mtok * 1024 + head * 64 + 4 * h;
#pragma unroll
        for (int dt = 0; dt < 2; ++dt)
#pragma unroll
            for (int rq = 0; rq < 4; ++rq) { u32x2 v; v.x = cvtpk(OUT[dt][4 * rq], OUT[dt][4 * rq + 1]); v.y = cvtpk(OUT[dt][4 * rq + 2], OUT[dt][4 * rq + 3]); *(u32x2*)(orow + 32 * dt + 8 * rq) = v; }
#undef ATT_STAGE
#undef ATT_FINALIZE
    }
}
constexpr int LDS_BYTES = 155648;
constexpr int LDS_MISC = LDS_BYTES - 256;
constexpr int NPH = 21;

__global__ void __launch_bounds__(512, 2) fwd(Args a) {
    extern __shared__ __attribute__((aligned(16))) unsigned char lds_raw[];
    Fr F; F.lds = (LAS unsigned char*)lds_raw; F.tid = threadIdx.x; F.lane = F.tid & 63; F.wave = __builtin_amdgcn_readfirstlane(F.tid >> 6); F.G = gridDim.x;
    F.gw = blockIdx.x * 8 + F.wave; F.ngw = F.G * 8;
    unsigned char* ws = a.ws;
    volatile LAS unsigned* MISC = (volatile LAS unsigned*)(F.lds + LDS_MISC);
    if (F.tid < 64) MISC[F.tid] = 0u;
    __syncthreads();
    const int lo = a.ph_lo, hi = a.ph_hi;
    XcdBarrier bar; bar.bar = (unsigned*)(ws + WS_CTL) + CW_BAR; bar.x = 0; bar.st = nullptr;
    if (hi - lo > 1) bar = xcd_barrier_post((unsigned*)(ws + WS_CTL) + CW_BAR, MISC + 8);


#ifndef REPEAT_MASK
#define REPEAT_MASK 0u
#endif
#ifdef ONLY_PH
#define IN(k) ((k) == ONLY_PH && lo <= (k) && (k) < hi)
#else
#define IN(k) (lo <= (k) && (k) < hi)
#endif
#define REP(k) for (int _rep = 0; _rep < (((REPEAT_MASK >> (k)) & 1u) ? 2 : 1); ++_rep)
#define SEAM(k) do { if (IN(k) && IN((k) + 1)) xcd_barrier(bar); } while (0)
    using namespace pg8;
    const int c = (int)blockIdx.x;

    if (IN(0)) { phase_conv(F, a); if ((REPEAT_MASK >> 30) & 1u) { __syncthreads(); phase_conv(F, a); } phase_r1(F, a); if ((REPEAT_MASK >> 31) & 1u) { __syncthreads(); phase_r1(F, a); } }
    SEAM(0);
    if (IN(1)) REP(1) {
        { Gemm g{(const bf16_t*)(ws + WS_S0), (const bf16_t*)(ws + WS_WR), 1024, 1024, 0, 1 << 20, nullptr, 0}; StaticOrder S; S.init(NT, 1024, F.G, c); EpiBf16 E{(bf16_t*)(ws + WS_S3), 1024, 1.f, 1}; gemm_phase(F.lds, g, S, E);
#ifdef DUP_P1
        gemm_phase(F.lds, g, S, E);
#endif
        }
        { Gemm g{(const bf16_t*)(ws + WS_S1), (const bf16_t*)(ws + WS_WK), 1024, 1024, 0, 1 << 20, nullptr, 0}; StaticOrder S; S.init(NT, 1024, F.G, c); EpiBf16 E{(bf16_t*)(ws + WS_S4), 1024, 1.f, 1}; gemm_phase(F.lds, g, S, E); }
        { Gemm g{(const bf16_t*)(ws + WS_S2), (const bf16_t*)(ws + WS_WV), 1024, 1024, 0, 1 << 20, nullptr, 0}; StaticOrder S; S.init(NT, 1024, F.G, c); EpiBf16 E{(bf16_t*)a.out, 1024, 1.f, 1}; gemm_phase(F.lds, g, S, E); }
        { Gemm g{(const bf16_t*)(ws + WS_S5), (const bf16_t*)(ws + WS_WL1), 2048, 1024, 1, 16, nullptr, 0}; StaticOrder S; S.init(NT, 512, F.G, c); EpiLora1 E{(bf16_t*)((unsigned char*)a.out + 128 * MiB)}; gemm_phase(F.lds, g, S, E); }
    }
    SEAM(1);
    if (IN(2)) REP(2) {
        const bf16_t* T1 = (const bf16_t*)((unsigned char*)a.out + 128 * MiB);
        { int kwa = 128; asm volatile("" : "+s"(kwa));
          Gemm g{T1, (const bf16_t*)(ws + WS_W2WA), kwa, 512, 0, 1 << 20, nullptr, 0}; StaticOrder S; S.init(NT, 2048, F.G, c); EpiLora2WA E{(bf16_t*)(ws + WS_S0), (bf16_t*)(ws + WS_S1), a.in[I_AW0], a.in[I_AA0]}; gemm_phase(F.lds, g, S, E); }
        { Gemm g{T1 + 128, (const bf16_t*)(ws + WS_W2G), 256, 512, 0, 1 << 20, nullptr, 0}; StaticOrder S; S.init(NT, 1024, F.G, c); EpiBf16 E{(bf16_t*)(ws + WS_S2), 1024, 1.f, 1}; gemm_phase(F.lds, g, S, E); }
    }
    SEAM(2);
    if (IN(3)) REP(3) phase_scan(F, a);
    SEAM(3);
    if (IN(4)) REP(4) { Gemm g{(const bf16_t*)(ws + WS_S5), (const bf16_t*)(ws + WS_WO), 1024, 64, 0, 1 << 20, nullptr, 1}; StaticOrder S; S.init(NT, 1024, F.G, c); EpiResX E{a.in[I_X], (bf16_t*)(ws + WS_H)}; gemm_phase(F.lds, g, S, E);
#ifdef DUP_PH4
        gemm_phase(F.lds, g, S, E);
#endif
    }
    SEAM(4);
#define MOE_PHASES(layer, pb) \
    if (IN(pb)) phase_m1(F, a, layer); \
    SEAM(pb); \
    if (IN((pb) + 1)) phase_m2(F, a, layer); \
    SEAM((pb) + 1); \
    if (IN((pb) + 2)) REP((pb) + 2) { const int* texp = (const int*)(ws + WS_TEXP); Gemm g{(const bf16_t*)(ws + WS_H), (const bf16_t*)(ws + WS_BT1) + (size_t)(layer) * 32 * 1024 * 1024, 1024, 1024, 0, 1 << 20, (const int*)(ws + WS_RIDX), 0}; \
        MoeOrder S; S.init(texp, F.G, c); EpiMoe1 E{(bf16_t*)(ws + WS_S4), (const float*)(ws + WS_ROWRS)}; gemm_phase<EpiMoe1, MoeOrder, true>(F.lds, g, S, E); } \
    SEAM((pb) + 2); \
    if (IN((pb) + 3)) REP((pb) + 3) { const int* texp = (const int*)(ws + WS_TEXP); Gemm g{(const bf16_t*)(ws + WS_S4), (const bf16_t*)(ws + WS_BT2) + (size_t)(layer) * 32 * 1024 * 512, 512, 512, 0, 1 << 20, nullptr, 0}; \
        MoeOrder S; S.init(texp, F.G, c); EpiMoe2 E{(bf16_t*)(ws + WS_S1), (const float*)(ws + WS_ROWW)}; gemm_phase(F.lds, g, S, E); } \
    SEAM((pb) + 3);

    MOE_PHASES(0, 5)
    if (IN(9)) phase_n1(F, a);
    SEAM(9);
    if (IN(10)) REP(10) { Gemm g{(const bf16_t*)(ws + WS_H), (const bf16_t*)(ws + WS_WKVQG), 1024, 1024, 0, 1 << 20, nullptr, 0}; StaticOrder S; S.init(NT, 2816, F.G, c);
        EpiKvqg E{(bf16_t*)(ws + WS_KV), (bf16_t*)(ws + WS_Q), (float*)(ws + WS_GATES), (const float*)(ws + WS_RSTD)}; gemm_phase(F.lds, g, S, E); }
    SEAM(10);
    if (IN(11)) { if (F.G <= 128) phase_vt(F, a, F.gw, F.ngw); }
    if (F.G <= 128) SEAM(11);
    if (IN(12)) { Gemm g{(const bf16_t*)(ws + WS_KV), (const bf16_t*)(ws + WS_WC1), 2048, 64, 0, 1 << 20, (const int*)(ws + WS_CIDX), 2}; CmpOrder S{F.G, c}; EpiCmp E{(bf16_t*)(ws + WS_HC), (const float*)(ws + WS_PEBP)}; gemm_phase<EpiCmp, CmpOrder, true>(F.lds, g, S, E);
        if (F.G > 128 && c >= 128) phase_vt(F, a, (c - 128) * 8 + F.wave, (F.G - 128) * 8);
        if (F.G > 128 && c < 128) { __builtin_amdgcn_fence(__ATOMIC_ACQUIRE, "agent"); phase_cmp2(F, a, c * 16 + F.wave, 8, c * 16 + 16); } }
    if (F.G <= 128) SEAM(12);
    if (IN(13) && F.G <= 128) phase_cmp2(F, a, F.gw, F.ngw, 2048);
    SEAM(13);
    if (IN(14)) REP(14) phase_attn(F, a);
    SEAM(14);
    if (IN(15)) { Gemm g{(const bf16_t*)(ws + WS_OATT), (const bf16_t*)(ws + WS_WOB), 1024, 1024, 0, 1 << 20, nullptr, 0}; StaticOrder S; S.init(NT, 1024, F.G, c); EpiResH E{(bf16_t*)(ws + WS_H)}; gemm_phase(F.lds, g, S, E); }
    SEAM(15);
    MOE_PHASES(1, 16)
    if (IN(20)) phase_final(F, a);
#undef IN
#undef SEAM
}

extern "C" void kernel_launch(void* const* d_in, const int* in_sizes, int n_in, void* d_out, int out_size, void* d_ws, size_t ws_size, hipStream_t stream) {
    static int grid = 0;
    if (grid == 0) {
        if (n_in != 41 || out_size != NT * DM || ws_size < WS_NEED) { fprintf(stderr, "kernel_launch: unexpected problem (n_in %d, out %d, ws %zu); nothing launched\n", n_in, out_size, ws_size); grid = -1; return; }
        int dev = 0, cus = 0, per_cu = 0;
        if (hipGetDevice(&dev) != hipSuccess || hipDeviceGetAttribute(&cus, hipDeviceAttributeMultiprocessorCount, dev) != hipSuccess) { grid = -1; return; }
        if (hipFuncSetAttribute((const void*)fwd, hipFuncAttributeMaxDynamicSharedMemorySize, LDS_BYTES) != hipSuccess) { fprintf(stderr, "kernel_launch: hipFuncSetAttribute failed\n"); grid = -1; return; }
        if (hipOccupancyMaxActiveBlocksPerMultiprocessor(&per_cu, (const void*)fwd, 512, LDS_BYTES) != hipSuccess || per_cu < 1)
            fprintf(stderr, "kernel_launch: occupancy query reports %d workgroups per CU\n", per_cu);
        (void)hipGetLastError();
        grid = cus;
    }
    if (grid < 0) return;
    (void)hipMemsetAsync((char*)d_ws + WS_CTL, 0, CTL_BYTES, stream);
    Args a{};
    for (int i = 0; i < 41; ++i) a.in[i] = (const float*)d_in[i];
    a.out = (float*)d_out; a.ws = (unsigned char*)d_ws;
#if N_LAUNCH_MODE == 1
    a.ph_lo = 0; a.ph_hi = NPH;
    hipLaunchKernelGGL(fwd, dim3(grid), dim3(512), LDS_BYTES, stream, a);
#else
    for (int p = 0; p < NPH; ++p) { a.ph_lo = p; a.ph_hi = p + 1; hipLaunchKernelGGL(fwd, dim3(grid), dim3(512), LDS_BYTES, stream, a); }
#endif
}
```

```cpp
#include <hip/hip_runtime.h>
#include <cstdio>
#include <cstdint>

#define GAS __attribute__((address_space(1)))
#define LAS __attribute__((address_space(3)))
typedef unsigned short bf16_t;
typedef short bf16x8 __attribute__((ext_vector_type(8)));
typedef float f32x4 __attribute__((ext_vector_type(4)));
typedef float f32x2 __attribute__((ext_vector_type(2)));
typedef unsigned u32x4 __attribute__((ext_vector_type(4)));
typedef unsigned u32x2 __attribute__((ext_vector_type(2)));

#ifndef N_LAUNCH_MODE
#define N_LAUNCH_MODE 1
#endif

constexpr int NT = 65536, DM = 1024, SEQ = 2048, NB = 32;
constexpr int P_MAX = 139264;
constexpr size_t MiB = 1u << 20;
constexpr size_t WS_CTL = 0, CTL_BYTES = 1 * MiB;
constexpr size_t WS_RFRAG = 1 * MiB;
constexpr size_t WS_W2F = 3 * MiB;
constexpr size_t WS_CIDX = 3 * MiB + 256 * 1024;
constexpr size_t WS_PEBP = 3 * MiB + 512 * 1024;
constexpr size_t WS_TEXP = 2 * MiB;
constexpr size_t WS_WR = 8 * MiB, WS_WK = 10 * MiB, WS_WV = 12 * MiB, WS_WO = 14 * MiB;
constexpr size_t WS_WL1 = 16 * MiB;
constexpr size_t WS_W2WA = 18 * MiB;
constexpr size_t WS_W2G = 19 * MiB;
constexpr size_t WS_WKVQG = 20 * MiB;
constexpr size_t WS_WOB = 26 * MiB;
constexpr size_t WS_WC1 = 28 * MiB;
constexpr size_t WS_BT1 = 32 * MiB;
constexpr size_t WS_BT2 = 160 * MiB;
constexpr size_t WS_S0 = 224 * MiB, WS_S1 = 352 * MiB, WS_S2 = 480 * MiB, WS_S3 = 608 * MiB, WS_S4 = 736 * MiB, WS_S5 = 864 * MiB;
constexpr size_t WS_GATES = 993 * MiB;
constexpr size_t WS_ASG = 1014 * MiB;
constexpr size_t WS_ROWW = 1016 * MiB;
constexpr size_t WS_RIDX = 1017 * MiB;
constexpr size_t WS_RSTD = 1018 * MiB;
constexpr size_t WS_ROWRS = 1019 * MiB;
constexpr size_t WS_H = WS_S0;
constexpr size_t WS_NEED = 1024 * MiB;
constexpr size_t WS_KV = 352 * MiB, WS_Q = 544 * MiB, WS_ACMP = 672 * MiB, WS_HC = 800 * MiB, WS_OATT = 816 * MiB;
constexpr size_t WS_KCB = 1006 * MiB, WS_VCT = 1008 * MiB;
constexpr int CW_BAR = 4096;
constexpr int CW_CNT = 16384;

typedef __bf16 bf16x2n __attribute__((ext_vector_type(2)));
__device__ __forceinline__ unsigned cvtpk(float lo, float hi) { const f32x2 v = {lo, hi}; return __builtin_bit_cast(unsigned, __builtin_convertvector(v, bf16x2n)); }
__device__ __forceinline__ unsigned f2bf(float f) { return cvtpk(f, f) & 0xffffu; }
__device__ __forceinline__ unsigned pk2(float lo, float hi) { return cvtpk(lo, hi); }
__device__ __forceinline__ float bflo(unsigned u) { return __builtin_bit_cast(float, u << 16); }
__device__ __forceinline__ float bfhi(unsigned u) { return __builtin_bit_cast(float, u & 0xffff0000u); }
__device__ __forceinline__ float bf2f(bf16_t b) { return __builtin_bit_cast(float, ((unsigned)b) << 16); }
template <int CTRL> __device__ __forceinline__ float dppf(float v) { return __int_as_float(__builtin_amdgcn_update_dpp(0, __float_as_int(v), CTRL, 0xf, 0xf, true)); }
#define DPP_XOR1 0xB1
#define DPP_XOR2 0x4E
#define DPP_HALF_MIRROR 0x141
#define DPP_MIRROR 0x140
#define DPP_ROR8 0x128
__device__ __forceinline__ float wave_sum(float v) {
    v += dppf<DPP_XOR1>(v); v += dppf<DPP_XOR2>(v); v += dppf<DPP_HALF_MIRROR>(v); v += dppf<DPP_MIRROR>(v);
    { const auto r = __builtin_amdgcn_permlane16_swap(__float_as_uint(v), __float_as_uint(v), false, false); v = __uint_as_float(r[0]) + __uint_as_float(r[1]); }
    { const auto r = __builtin_amdgcn_permlane32_swap(__float_as_uint(v), __float_as_uint(v), false, false); v = __uint_as_float(r[0]) + __uint_as_float(r[1]); }
    return v;
}
__device__ __forceinline__ float fexp_(float x) { return __builtin_amdgcn_exp2f(x * 1.44269504089f); }
__device__ __forceinline__ float sigmoidf_(float x) { return __builtin_amdgcn_rcpf(1.f + fexp_(-x)); }
__device__ __forceinline__ float tanhf_(float x) { return 1.f - 2.f * __builtin_amdgcn_rcpf(1.f + fexp_(2.f * x)); }
__device__ __forceinline__ float gelu_tanh_(float x) { return 0.5f * x * (1.f + tanhf_(0.7978845608f * (x + 0.044715f * x * x * x))); }
#define LDS_WAIT() asm volatile("s_waitcnt lgkmcnt(0)" ::: "memory")

__device__ const unsigned char BKT[129] = {0, 1, 2, 3, 4, 5, 6, 7, 8, 9, 10, 11, 12, 13, 14, 15, 16, 16, 16, 17, 17, 18, 18, 18, 19, 19, 19, 20, 20, 20, 20, 21, 21, 21, 21, 22, 22, 22, 22, 22, 23, 23, 23, 23, 23, 23, 24, 24, 24, 24, 24, 24, 25, 25, 25, 25, 25, 25, 25, 26, 26, 26, 26, 26, 26, 26, 26, 27, 27, 27, 27, 27, 27, 27, 27, 27, 27, 28, 28, 28, 28, 28, 28, 28, 28, 28, 28, 29, 29, 29, 29, 29, 29, 29, 29, 29, 29, 29, 29, 30, 30, 30, 30, 30, 30, 30, 30, 30, 30, 30, 30, 30, 30, 31, 31, 31, 31, 31, 31, 31, 31, 31, 31, 31, 31, 31, 31, 31, 31};

#define XB_TMO      128
#define XB_XCNT(j)  (256  + 64 * (j))
#define XB_XSUB(j)  (1280 + 64 * (j))
#define XB_XGEN(j)  (2304 + 64 * (j))
#define XB_TOP      3328
#define XB_TOPGEN   3392
#define XCD_BAR_WORDS 3456
#define XB_SPIN_CAP (1u << 22)
__device__ __forceinline__ unsigned xb_ld(unsigned* p)              { return __hip_atomic_load(p, __ATOMIC_RELAXED, __HIP_MEMORY_SCOPE_AGENT); }
__device__ __forceinline__ unsigned xb_add(unsigned* p, unsigned v) { return __hip_atomic_fetch_add(p, v, __ATOMIC_RELAXED, __HIP_MEMORY_SCOPE_AGENT); }
__device__ __forceinline__ unsigned xb_xcc_id() { return (unsigned)__builtin_amdgcn_s_getreg((3 << 11) | 20) & 0xFu; }
#define XB_SPIN(cond, bar) do { unsigned _sp = 0; while (cond) { __builtin_amdgcn_s_sleep(1); \
    if ((++_sp & 255u) == 0u) { if (xb_ld(&(bar)[XB_TMO])) break; if (_sp > XB_SPIN_CAP) { atomicAdd(&(bar)[XB_TMO], 1u); break; } } } } while (0)
struct XcdBarrier { unsigned* bar; unsigned x; volatile LAS unsigned* st; };
__device__ __forceinline__ XcdBarrier xcd_barrier_post(unsigned* bar, volatile LAS unsigned* st) {
    XcdBarrier b; b.bar = bar; b.x = xb_xcc_id(); b.st = st;
    if (threadIdx.x == 0) (void)xb_add(&bar[XB_XCNT(b.x)], 1u);
    return b;
}
__device__ __forceinline__ void xcd_barrier_complete(unsigned* bar, unsigned x, unsigned& nloc, unsigned& nx) {
    const unsigned G = gridDim.x * gridDim.y * gridDim.z;
    unsigned sum, cnt, mine, sp = 0u;
    for (;;) {
        sum = 0u; cnt = 0u; mine = 0u;
#pragma unroll
        for (unsigned j = 0; j < 16; ++j) { const unsigned c = xb_ld(&bar[XB_XCNT(j)]); sum += c; cnt += (c > 0u) ? 1u : 0u; mine = (j == x) ? c : mine; }
        if (sum == G) break;
        __builtin_amdgcn_s_sleep(1);
        if ((++sp & 255u) == 0u) { if (xb_ld(&bar[XB_TMO])) break; if (sp > XB_SPIN_CAP) { atomicAdd(&bar[XB_TMO], 1u); break; } }
    }
    nloc = mine > 0u ? mine : 1u; nx = cnt > 0u ? cnt : 1u;
}
__device__ __forceinline__ void xcd_barrier(const XcdBarrier& b) {
    asm volatile("s_waitcnt vmcnt(0)" ::: "memory");
    __syncthreads();
    if (threadIdx.x == 0) {
        unsigned* bar = b.bar;
        __builtin_amdgcn_s_waitcnt(0);
        unsigned nloc = b.st[0], nx = b.st[1];
        if (nloc == 0u) { xcd_barrier_complete(bar, b.x, nloc, nx); b.st[0] = nloc; b.st[1] = nx; }
        const unsigned old = xb_add(&bar[XB_XSUB(b.x)], 1u);
        const unsigned gen = old / nloc;
        if (old + 1u == (gen + 1u) * nloc) {
            __builtin_amdgcn_fence(__ATOMIC_RELEASE, "agent");
            asm volatile("s_waitcnt vmcnt(0)" ::: "memory");
            const unsigned og = xb_add(&bar[XB_TOP], 1u);
            const unsigned tg = og / nx;
            if (og + 1u == (tg + 1u) * nx) xb_add(&bar[XB_TOPGEN], 1u);
            else XB_SPIN(xb_ld(&bar[XB_TOPGEN]) == tg, bar);
            __builtin_amdgcn_fence(__ATOMIC_ACQUIRE, "agent");
            xb_add(&bar[XB_XGEN(b.x)], 1u);
            asm volatile("s_waitcnt vmcnt(0)" ::: "memory");
        } else {
            XB_SPIN(xb_ld(&bar[XB_XGEN(b.x)]) == gen, bar);
            __builtin_amdgcn_fence(__ATOMIC_ACQUIRE, "agent");
            asm volatile("s_waitcnt vmcnt(0)" ::: "memory");
        }
    }
    __syncthreads();
}

namespace pg8 {
constexpr int BM = 256, BK = 64, HALF = 128, HTB = HALF * BK * 2, STAGE_BYTES = 8 * HTB, NXCD = 8, WGM = 8;
__host__ __device__ __forceinline__ int lds_byte(int r, int c) { const int st = (r >> 4) * 2 + (c >> 5), rr = r & 15, cc = c & 31, ob = rr * 64 + cc * 2; return st * 1024 + (ob ^ (((ob >> 9) & 1) << 5)); }
__host__ __device__ __forceinline__ void stage_rc(int b, int& R, int& C) { const int st = b / 1024, sb = b % 1024, swz = sb ^ (((sb >> 9) & 1) << 5); R = (st >> 1) * 16 + swz / 64; C = (st & 1) * 32 + (swz % 64) / 2; }
__host__ __device__ __forceinline__ int perm32(int rho) { const int n = rho >> 4, i = rho & 15; return 8 * (i >> 2) + 4 * n + (i & 3); }
struct Unit { int pm, pn; };
struct Gemm { const bf16_t* A; const bf16_t* Bt; int K, lda, apad, kwrap; const int* gidx; int ahm; };
struct StaticOrder {
    int nM, nN, nwg, G, c;
    __device__ void init(int M, int N, int G_, int c_) { nM = M / BM; nN = N / BM; nwg = nM * nN; G = G_; c = c_; }
    __device__ bool next(int i, Unit& u) const {
        const long L = (long)i * G + c; if (L >= nwg) return false;
        int wgid = (int)L; { const int q = nwg / NXCD, r = nwg % NXCD, xcd = wgid % NXCD, off = wgid / NXCD; wgid = (xcd < r ? xcd * (q + 1) : r * (q + 1) + (xcd - r) * q) + off; }
        const int nig = WGM * nN, gid = wgid / nig, fm = gid * WGM, gsz = (nM - fm) < WGM ? (nM - fm) : WGM;
        u.pm = fm + ((wgid % nig) % gsz); u.pn = (wgid % nig) / gsz; return true;
    }
};
struct MoeOrder {
    const int* xl; int nunits, ncu, cu; mutable int pre;
    __device__ __forceinline__ void init(const int* texp, int G_, int c_) { const int x = c_ & 7; cu = c_ >> 3; ncu = G_ >> 3; xl = texp + 2048 + x * 640; nunits = texp[1008 + x] * 4; pre = (cu < nunits) ? xl[cu >> 2] : 0; }
    __device__ __forceinline__ bool next(int i, Unit& u) const {
        const int L = i * ncu + cu; if (L >= nunits) return false;
        const int ent = pre; u.pm = ent & 0xffff; u.pn = (ent >> 16) * 4 + (L & 3);
        const int L2 = L + ncu; pre = (L2 < nunits) ? xl[L2 >> 2] : 0; return true;
    }
};
struct CmpOrder {
    int G, c;
    __device__ bool next(int i, Unit& u) const { const long L = (long)i * G + c; if (L >= 128) return false; u.pm = (int)L; u.pn = (int)(L >> 6); return true; }
};

template <class Epi, class Sched, bool GATHER = false, bool ALIGN_EPI = true, bool SP2 = true>
__device__ __forceinline__ void gemm_phase(LAS unsigned char* lds, const Gemm g, const Sched& S, const Epi& E) {
    const int tid = threadIdx.x, wid = __builtin_amdgcn_readfirstlane(tid >> 6), lane = tid & 63, wr = wid >> 2, wc = wid & 3, fr = lane & 15, fq = lane >> 4;
    const int K = g.K, nt = K / BK, lda = g.lda, kwrap = g.kwrap;
    unsigned voffA[2], voffB[2];
#pragma unroll
    for (int i = 0; i < 2; ++i) { int R, C; stage_rc(tid * 16 + i * 8192, R, C); const int Rb = Epi::PERM ? ((R & ~31) + perm32(R & 31)) : R;
        voffA[i] = (unsigned)(R * lda + C) * 2u; voffB[i] = (unsigned)(Rb * K + C) * 2u; }
    const long kstep = (long)(BK * 2); const long kstepA = g.ahm == 2 ? 3072l : g.ahm ? (long)SEQ * 128 : kstep;
    const long hstepA = (long)HALF * lda * 2, hstepB = (long)HALF * K * 2;
    const long tstepB = 2 * hstepB;
    const unsigned ldsw = (unsigned)wid * 1024u;
    const int aoff = lds_byte(wr * 64 + fr, fq * 8), boff = lds_byte(wc * 32 + fr, fq * 8);
#define PG8_KOFFA(t) (((t) < kwrap) ? (long)(t) * kstepA : (long)((t) - kwrap) * kstepA - (long)lda * 2)
#define PG8_ATILE(pm) (g.ahm ? (const char*)g.A + ((long)((pm) >> 3) * (K / 64) * SEQ + (long)((pm) & 7) * 256) * 128 : (const char*)g.A + ((long)(pm) * 256 + (g.apad ? (((pm) >> 3) + 1) : 0)) * (long)lda * 2)
#define PG8_SA(b, h) (((b) * 2 + (h)) * HTB)
#define PG8_SB(b, h) ((4 + (b) * 2 + (h)) * HTB)
#define PG8_STAGE(bufoff, gbase, voff) do { _Pragma("unroll") for (int _i = 0; _i < 2; ++_i) \
        __builtin_amdgcn_global_load_lds((const unsigned*)((const char*)(gbase) + (voff)[_i]), (LAS unsigned*)(lds + (bufoff) + ldsw + _i * 8192), 16, 0, 0); } while (0)
#define PG8_STAGE_A(bufoff, nx, h, ko) do { if constexpr (GATHER) { _Pragma("unroll") for (int _i = 0; _i < 2; ++_i) \
            __builtin_amdgcn_global_load_lds((const unsigned*)((const char*)g.A + (ko) + ((nx) ? gon[h][_i] : goc[h][_i])), (LAS unsigned*)(lds + (bufoff) + ldsw + _i * 8192), 16, 0, 0); } \
        else PG8_STAGE(bufoff, ((nx) ? nA : cA) + (h) * hstepA + (ko), voffA); } while (0)
#define PG8_GIDX(dst, pm_) do { if constexpr (GATHER) { _Pragma("unroll") for (int _h = 0; _h < 2; ++_h) _Pragma("unroll") for (int _i = 0; _i < 2; ++_i) \
            dst[_h][_i] = (unsigned)g.gidx[(pm_) * 256 + _h * 128 + (int)(voffA[_i] / (unsigned)(lda * 2))] * (unsigned)(lda * 2) + voffA[_i] % (unsigned)(lda * 2); } } while (0)
#define PG8_LDA(dst, b, h) do { _Pragma("unroll") for (int m = 0; m < 4; ++m) _Pragma("unroll") for (int k = 0; k < 2; ++k) dst[m][k] = *(const LAS bf16x8*)(lds + PG8_SA(b, h) + aoff + m * 2048 + k * 1024); } while (0)
#define PG8_LDB(dst, b, h) do { _Pragma("unroll") for (int n = 0; n < 2; ++n) _Pragma("unroll") for (int k = 0; k < 2; ++k) dst[n][k] = *(const LAS bf16x8*)(lds + PG8_SB(b, h) + boff + n * 2048 + k * 1024); } while (0)
#define PG8_MMA(ai, bj, At, Bt) do { __builtin_amdgcn_s_setprio(1); _Pragma("unroll") for (int m = 0; m < 4; ++m) _Pragma("unroll") for (int n = 0; n < 2; ++n) _Pragma("unroll") for (int k = 0; k < 2; ++k) \
        acc[ai][bj][m][n] = __builtin_amdgcn_mfma_f32_16x16x32_bf16(Bt[n][k], At[m][k], acc[ai][bj][m][n], 0, 0, 0); __builtin_amdgcn_s_setprio(0); } while (0)
#define PG8_WAIT_V(n) asm volatile("s_waitcnt vmcnt(" #n ")" ::: "memory")
#define PG8_WAIT_L(n) asm volatile("s_waitcnt lgkmcnt(" #n ")" ::: "memory")
#define PG8_BAR __builtin_amdgcn_s_barrier()
#define PG8_SCHED __builtin_amdgcn_sched_barrier(0)
    Unit cur, nxt; int ui = 0;
    if (!S.next(0, cur)) return;
    f32x4 acc[2][2][4][2];
#pragma unroll
    for (int a = 0; a < 2; ++a)
#pragma unroll
        for (int b = 0; b < 2; ++b)
#pragma unroll
            for (int m = 0; m < 4; ++m)
#pragma unroll
                for (int n = 0; n < 2; ++n) acc[a][b][m][n] = (f32x4){0.f, 0.f, 0.f, 0.f};
    bf16x8 At[4][2], B0[2][2], B1[2][2];
    const char* cA = PG8_ATILE(cur.pm); const char* cB = (const char*)g.Bt + (long)cur.pn * tstepB; const char* nA = cA;
    unsigned goc[2][2], gon[2][2];
#pragma unroll
    for (int _h = 0; _h < 2; ++_h)
#pragma unroll
        for (int _i = 0; _i < 2; ++_i) { goc[_h][_i] = 0u; gon[_h][_i] = 0u; }
    PG8_GIDX(goc, cur.pm);
    if constexpr (SP2) {
        PG8_STAGE(PG8_SB(0, 0), cB, voffB); PG8_STAGE(PG8_SB(0, 1), cB + hstepB, voffB); PG8_STAGE_A(PG8_SA(0, 0), false, 0, 0); PG8_STAGE_A(PG8_SA(0, 1), false, 1, 0);
        if (wr == 1) PG8_BAR;
        PG8_WAIT_V(2); PG8_BAR;
        PG8_STAGE(PG8_SB(1, 0), cB + kstep, voffB); PG8_STAGE_A(PG8_SA(1, 0), false, 0, kstepA); PG8_STAGE(PG8_SB(1, 1), cB + hstepB + kstep, voffB);
        PG8_WAIT_V(6); PG8_BAR;
    } else {
        PG8_STAGE(PG8_SB(0, 0), cB, voffB); PG8_STAGE_A(PG8_SA(0, 0), false, 0, 0); PG8_STAGE(PG8_SB(0, 1), cB + hstepB, voffB); PG8_STAGE_A(PG8_SA(0, 1), false, 1, 0);
        if (wr == 1) PG8_BAR;
        PG8_WAIT_V(4); PG8_BAR;
        PG8_STAGE(PG8_SB(1, 0), cB + kstep, voffB); PG8_STAGE_A(PG8_SA(1, 0), false, 0, kstepA); PG8_STAGE(PG8_SB(1, 1), cB + hstepB + kstep, voffB);
        PG8_WAIT_V(6); PG8_BAR;
    }
    for (;;) {
        const bool has_next = S.next(ui + 1, nxt);
        nA = has_next ? PG8_ATILE(nxt.pm) : cA; const char* nB = has_next ? (const char*)g.Bt + (long)nxt.pn * tstepB : cB;
        if constexpr (GATHER) { if (has_next) PG8_GIDX(gon, nxt.pm); else {
#pragma unroll
            for (int _h = 0; _h < 2; ++_h)
#pragma unroll
                for (int _i = 0; _i < 2; ++_i) gon[_h][_i] = goc[_h][_i]; } }
#pragma unroll 1
        for (int t = 0; t < nt; t += 2) {
            const bool last = (t == nt - 2);
            const long k1 = PG8_KOFFA(t + 1), k2 = last ? 0 : PG8_KOFFA(t + 2), k3 = last ? kstepA : PG8_KOFFA(t + 3);
            const char* b2 = last ? nB : cB + (long)(t + 2) * kstep; const char* b3 = b2 + kstep;
            if constexpr (SP2) {
            PG8_LDB(B0, 0, 0); PG8_LDB(B1, 0, 1); PG8_SCHED; PG8_LDA(At, 0, 0); PG8_STAGE_A(PG8_SA(1, 1), false, 1, k1);
            PG8_WAIT_V(8); PG8_WAIT_L(0); PG8_BAR; PG8_MMA(0, 0, At, B0); PG8_MMA(0, 1, At, B1); PG8_BAR; PG8_SCHED;
            PG8_LDA(At, 0, 1); PG8_STAGE(PG8_SB(0, 0), b2, voffB); PG8_STAGE(PG8_SB(0, 1), b2 + hstepB, voffB); PG8_STAGE_A(PG8_SA(0, 0), last, 0, k2);
            PG8_WAIT_V(8); PG8_WAIT_L(0); PG8_BAR; PG8_MMA(1, 0, At, B0); PG8_MMA(1, 1, At, B1); PG8_BAR; PG8_SCHED;
            PG8_LDB(B0, 1, 0); PG8_LDB(B1, 1, 1); PG8_SCHED; PG8_LDA(At, 1, 0); PG8_STAGE_A(PG8_SA(0, 1), last, 1, k2);
            PG8_WAIT_V(8); PG8_WAIT_L(0); PG8_BAR; PG8_MMA(0, 0, At, B0); PG8_MMA(0, 1, At, B1); PG8_BAR; PG8_SCHED;
            PG8_LDA(At, 1, 1); PG8_STAGE(PG8_SB(1, 0), b3, voffB); PG8_STAGE(PG8_SB(1, 1), b3 + hstepB, voffB); PG8_STAGE_A(PG8_SA(1, 0), last, 0, k3);
            PG8_WAIT_V(8); PG8_WAIT_L(0); PG8_BAR; PG8_MMA(1, 0, At, B0); PG8_MMA(1, 1, At, B1); PG8_BAR; PG8_SCHED;
            } else {
            PG8_LDB(B0, 0, 0); PG8_SCHED; PG8_LDA(At, 0, 0); PG8_STAGE_A(PG8_SA(1, 1), false, 1, k1);
            PG8_WAIT_L(8); PG8_BAR; PG8_WAIT_L(0); PG8_MMA(0, 0, At, B0); PG8_BAR; PG8_SCHED;
            PG8_LDB(B1, 0, 1); PG8_STAGE(PG8_SB(0, 0), b2, voffB);
            PG8_BAR; PG8_WAIT_L(0); PG8_MMA(0, 1, At, B1); PG8_BAR;
            PG8_LDA(At, 0, 1); PG8_STAGE_A(PG8_SA(0, 0), last, 0, k2);
            PG8_BAR; PG8_WAIT_L(0); PG8_MMA(1, 0, At, B0); PG8_BAR; PG8_SCHED;
            PG8_STAGE(PG8_SB(0, 1), b2 + hstepB, voffB);
            PG8_WAIT_V(6); PG8_BAR; PG8_MMA(1, 1, At, B1); PG8_BAR;
            PG8_LDB(B0, 1, 0); PG8_SCHED; PG8_LDA(At, 1, 0); PG8_STAGE_A(PG8_SA(0, 1), last, 1, k2);
            PG8_WAIT_L(8); PG8_BAR; PG8_WAIT_L(0); PG8_MMA(0, 0, At, B0); PG8_BAR; PG8_SCHED;
            PG8_LDB(B1, 1, 1); PG8_STAGE(PG8_SB(1, 0), b3, voffB);
            PG8_BAR; PG8_WAIT_L(0); PG8_MMA(0, 1, At, B1); PG8_BAR;
            PG8_LDA(At, 1, 1); PG8_STAGE_A(PG8_SA(1, 0), last, 0, k3);
            PG8_BAR; PG8_WAIT_L(0); PG8_MMA(1, 0, At, B0); PG8_BAR; PG8_SCHED;
            PG8_STAGE(PG8_SB(1, 1), b3 + hstepB, voffB);
            PG8_WAIT_V(6); PG8_BAR; PG8_MMA(1, 1, At, B1); PG8_BAR;
            }
        }
        if constexpr (ALIGN_EPI) { if (wr == 0) PG8_BAR; }
        E(acc, cur, wr, wc, fr, fq);
        if (!has_next) break;
#pragma unroll
        for (int a = 0; a < 2; ++a)
#pragma unroll
            for (int b = 0; b < 2; ++b)
#pragma unroll
                for (int m = 0; m < 4; ++m)
#pragma unroll
                    for (int n = 0; n < 2; ++n) acc[a][b][m][n] = (f32x4){0.f, 0.f, 0.f, 0.f};
        cur = nxt; cA = nA; cB = nB; ++ui;
        if constexpr (GATHER) {
#pragma unroll
            for (int _h = 0; _h < 2; ++_h)
#pragma unroll
                for (int _i = 0; _i < 2; ++_i) goc[_h][_i] = gon[_h][_i]; }
        if constexpr (ALIGN_EPI) { if (wr == 1) PG8_BAR; }
    }
    PG8_WAIT_V(0);
    if constexpr (!ALIGN_EPI) { if (wr == 0) PG8_BAR; }
    PG8_BAR;
#undef PG8_STAGE_A
#undef PG8_GIDX
#undef PG8_KOFFA
#undef PG8_ATILE
#undef PG8_SA
#undef PG8_SB
#undef PG8_STAGE
#undef PG8_LDA
#undef PG8_LDB
#undef PG8_MMA
#undef PG8_WAIT_V
#undef PG8_WAIT_L
#undef PG8_BAR
#undef PG8_SCHED
}

#define EPI_LOOP_ROWS for (int ai = 0; ai < 2; ++ai) _Pragma("unroll") for (int m = 0; m < 4; ++m)
__device__ __forceinline__ u32x4 pack8(const f32x4 v0, const f32x4 v1) { u32x4 w; w.x = pk2(v0[0], v0[1]); w.y = pk2(v0[2], v0[3]); w.z = pk2(v1[0], v1[1]); w.w = pk2(v1[2], v1[3]); return w; }

__device__ __forceinline__ size_t hm_off(int row, int col) { return ((size_t)((row >> 11) * 16 + (col >> 6)) * SEQ + (row & 2047)) * 64 + (col & 63); }
struct EpiBf16 {
    static constexpr bool PERM = true;
    bf16_t* O; int ldc; float scale; int hm;
    __device__ __forceinline__ void operator()(const f32x4 (&acc)[2][2][4][2], const Unit& u, int wr, int wc, int fr, int fq) const {
        const int row0 = u.pm * BM + wr * 64 + fr, col0 = u.pn * BM + wc * 32 + 8 * fq;
#pragma unroll
        EPI_LOOP_ROWS { const int row = row0 + ai * HALF + m * 16;
#pragma unroll
            for (int bj = 0; bj < 2; ++bj) { bf16_t* p = hm ? O + hm_off(row, col0 + bj * HALF) : O + (size_t)row * ldc + col0 + bj * HALF;
                *(u32x4*)p = pack8(acc[ai][bj][m][0] * scale, acc[ai][bj][m][1] * scale); } }
    }
};
struct EpiLora1 {
    static constexpr bool PERM = true;
    bf16_t* O;
    __device__ __forceinline__ void operator()(const f32x4 (&acc)[2][2][4][2], const Unit& u, int wr, int wc, int fr, int fq) const {
        const int row0 = u.pm * BM + wr * 64 + fr, col0 = u.pn * BM + wc * 32 + 8 * fq;
#pragma unroll
        EPI_LOOP_ROWS { bf16_t* rowp = O + (size_t)(row0 + ai * HALF + m * 16) * 512 + col0;
#pragma unroll
            for (int bj = 0; bj < 2; ++bj) { const int c = col0 + bj * HALF; f32x4 v0 = acc[ai][bj][m][0], v1 = acc[ai][bj][m][1];
                if (c < 64) {
#pragma unroll
                    for (int j = 0; j < 4; ++j) { v0[j] = tanhf_(v0[j]); v1[j] = tanhf_(v1[j]); }
                } else if (c < 128) {
                } else if (c < 288) {
#pragma unroll
                    for (int j = 0; j < 4; ++j) { v0[j] = sigmoidf_(v0[j]); v1[j] = sigmoidf_(v1[j]); }
                } else { v0 = (f32x4){0.f, 0.f, 0.f, 0.f}; v1 = v0; }
                *(u32x4*)(rowp + bj * HALF) = pack8(v0, v1); } }
    }
};
struct EpiLora2WA {
    static constexpr bool PERM = true;
    bf16_t* LW; bf16_t* AA; const float* w0; const float* a0;
    __device__ __forceinline__ void operator()(const f32x4 (&acc)[2][2][4][2], const Unit& u, int wr, int wc, int fr, int fq) const {
        const int row0 = u.pm * BM + wr * 64 + fr; const bool isw = u.pn < 4; const int col0 = (u.pn & 3) * BM + wc * 32 + 8 * fq;
        bf16_t* O = isw ? LW : AA; const float* bias = isw ? w0 : a0; const float mul = isw ? -0.60653065971f : 1.0f;
#pragma unroll
        for (int bj = 0; bj < 2; ++bj) { const f32x4 b0 = *(const f32x4*)(bias + col0 + bj * HALF), b1 = *(const f32x4*)(bias + col0 + bj * HALF + 4);
#pragma unroll
            EPI_LOOP_ROWS { bf16_t* rowp = O + hm_off(row0 + ai * HALF + m * 16, col0 + bj * HALF); f32x4 v0 = acc[ai][bj][m][0] + b0, v1 = acc[ai][bj][m][1] + b1;
#pragma unroll
                for (int j = 0; j < 4; ++j) { v0[j] = mul * sigmoidf_(v0[j]); v1[j] = mul * sigmoidf_(v1[j]); }
                *(u32x4*)rowp = pack8(v0, v1); } }
    }
};
struct EpiResX {
    static constexpr bool PERM = true;
    const float* x; bf16_t* h;
    __device__ __forceinline__ void operator()(const f32x4 (&acc)[2][2][4][2], const Unit& u, int wr, int wc, int fr, int fq) const {
        const int row0 = u.pm * BM + wr * 64 + fr, col0 = u.pn * BM + wc * 32 + 8 * fq;
#pragma unroll
        for (int ai = 0; ai < 2; ++ai) {
            f32x4 xb[4][2][2];
#pragma unroll
            for (int m = 0; m < 4; ++m)
#pragma unroll
                for (int bj = 0; bj < 2; ++bj) { const float* p = x + (size_t)(row0 + ai * HALF + m * 16) * 1024 + col0 + bj * HALF; xb[m][bj][0] = *(const f32x4*)p; xb[m][bj][1] = *(const f32x4*)(p + 4); }
#pragma unroll
            for (int m = 0; m < 4; ++m) { const size_t off = (size_t)(row0 + ai * HALF + m * 16) * 1024 + col0;
#pragma unroll
                for (int bj = 0; bj < 2; ++bj) *(u32x4*)(h + off + bj * HALF) = pack8(acc[ai][bj][m][0] + xb[m][bj][0], acc[ai][bj][m][1] + xb[m][bj][1]); } }
    }
};
struct EpiResH {
    static constexpr bool PERM = true;
    bf16_t* h;
    __device__ __forceinline__ void operator()(const f32x4 (&acc)[2][2][4][2], const Unit& u, int wr, int wc, int fr, int fq) const {
        const int row0 = u.pm * BM + wr * 64 + fr, col0 = u.pn * BM + wc * 32 + 8 * fq;
        u32x4 hb[2][4][2];
#pragma unroll
        EPI_LOOP_ROWS { const size_t off = (size_t)(row0 + ai * HALF + m * 16) * 1024 + col0;
#pragma unroll
            for (int bj = 0; bj < 2; ++bj) hb[ai][m][bj] = *(const u32x4*)(h + off + bj * HALF); }
#pragma unroll
        EPI_LOOP_ROWS { const size_t off = (size_t)(row0 + ai * HALF + m * 16) * 1024 + col0;
#pragma unroll
            for (int bj = 0; bj < 2; ++bj) { const u32x4 b = hb[ai][m][bj];
                const f32x4 b0 = {bflo(b.x), bfhi(b.x), bflo(b.y), bfhi(b.y)}, b1 = {bflo(b.z), bfhi(b.z), bflo(b.w), bfhi(b.w)};
                *(u32x4*)(h + off + bj * HALF) = pack8(acc[ai][bj][m][0] + b0, acc[ai][bj][m][1] + b1); } }
    }
};
struct EpiKvqg {
    static constexpr bool PERM = true;
    bf16_t* KV; bf16_t* Q; float* GT; const float* rs;
    __device__ __forceinline__ void operator()(const f32x4 (&acc)[2][2][4][2], const Unit& u, int wr, int wc, int fr, int fq) const {
        const int row0 = u.pm * BM + wr * 64 + fr;
        float rsv[2][4];
#pragma unroll
        EPI_LOOP_ROWS rsv[ai][m] = rs[row0 + ai * HALF + m * 16];
        if (u.pn < 10) {
            const bool iskv = u.pn < 6; bf16_t* O = iskv ? KV : Q; const int ldc = iskv ? 1536 : 1024; const float sc = iskv ? 1.0f : 0.18033688011f;
            const int col0 = (iskv ? u.pn : u.pn - 6) * BM + wc * 32 + 8 * fq;
#pragma unroll
            EPI_LOOP_ROWS { const int row = row0 + ai * HALF + m * 16; const float scr_ = sc * rsv[ai][m]; bf16_t* rowp = O + (size_t)row * ldc + col0;
#pragma unroll
                for (int bj = 0; bj < 2; ++bj) *(u32x4*)(rowp + bj * HALF) = pack8(acc[ai][bj][m][0] * scr_, acc[ai][bj][m][1] * scr_); }
        } else {
            const int c0 = wc * 32 + 8 * fq;
            if (c0 < 48) {
#pragma unroll
                EPI_LOOP_ROWS { const int row = row0 + ai * HALF + m * 16; const float rr_ = rsv[ai][m]; float* rowp = GT + (size_t)row * 48 + c0; f32x4 v0 = acc[ai][0][m][0] * rr_, v1 = acc[ai][0][m][1] * rr_;
#pragma unroll
                    for (int j = 0; j < 4; ++j) { v0[j] = sigmoidf_(v0[j]); v1[j] = sigmoidf_(v1[j]); }
                    *(f32x4*)(rowp) = v0; *(f32x4*)(rowp + 4) = v1; }
            }
        }
    }
};
struct EpiMoe1 {
    static constexpr bool PERM = true;
    bf16_t* H; const float* rs;
    __device__ __forceinline__ void operator()(const f32x4 (&acc)[2][2][4][2], const Unit& u, int wr, int wc, int fr, int fq) const {
        const int row0 = u.pm * BM + wr * 64 + fr, col0 = (u.pn & 3) * 128 + wc * 32 + 8 * fq;
        float rsv[2][4];
#pragma unroll
        EPI_LOOP_ROWS rsv[ai][m] = rs[row0 + ai * HALF + m * 16];
#pragma unroll
        EPI_LOOP_ROWS { const int row = row0 + ai * HALF + m * 16; const float r_ = rsv[ai][m]; bf16_t* rowp = H + (size_t)row * 512 + col0; f32x4 v0, v1;
#pragma unroll
            for (int j = 0; j < 4; ++j) { const float g0 = acc[ai][0][m][0][j] * r_, g1 = acc[ai][0][m][1][j] * r_; v0[j] = g0 * sigmoidf_(g0) * (acc[ai][1][m][0][j] * r_); v1[j] = g1 * sigmoidf_(g1) * (acc[ai][1][m][1][j] * r_); }
            *(u32x4*)(rowp) = pack8(v0, v1); }
    }
};
struct EpiMoe2 {
    static constexpr bool PERM = true;
    bf16_t* Y; const float* roww;
    __device__ __forceinline__ void operator()(const f32x4 (&acc)[2][2][4][2], const Unit& u, int wr, int wc, int fr, int fq) const {
        const bool up = (fr & 8) != 0;
        const int rowb = u.pm * BM + wr * 64 + (fr & 7), colp = (u.pn & 3) * BM + wc * 64 + 8 * fq;
#pragma unroll
        EPI_LOOP_ROWS { const u32x4 a0 = pack8(acc[ai][0][m][0], acc[ai][0][m][1]), a1 = pack8(acc[ai][1][m][0], acc[ai][1][m][1]); u32x4 x1;
            x1.x = (unsigned)__builtin_amdgcn_update_dpp(0, (int)a1.x, 0x128, 0xf, 0xf, true); x1.y = (unsigned)__builtin_amdgcn_update_dpp(0, (int)a1.y, 0x128, 0xf, 0xf, true);
            x1.z = (unsigned)__builtin_amdgcn_update_dpp(0, (int)a1.z, 0x128, 0xf, 0xf, true); x1.w = (unsigned)__builtin_amdgcn_update_dpp(0, (int)a1.w, 0x128, 0xf, 0xf, true);
            bf16_t* r0p = Y + (size_t)(rowb + ai * HALF + m * 16) * 1024 + colp;
            *(u32x4*)(r0p + (up ? 32 : 0)) = up ? x1 : a0;
            *(u32x4*)(r0p + 8 * 1024 + (up ? 0 : 32)) = up ? a0 : x1; }
    }
};
struct EpiCmp {
    static constexpr bool PERM = true;
    bf16_t* O; const float* pb;
    __device__ __forceinline__ void operator()(const f32x4 (&acc)[2][2][4][2], const Unit& u, int wr, int wc, int fr, int fq) const {
        const int row0 = u.pm * BM + wr * 64 + fr, col0 = wc * 32 + 8 * fq;
        f32x4 bias[2][2][2];
#pragma unroll
        for (int ai = 0; ai < 2; ++ai)
#pragma unroll
            for (int bj = 0; bj < 2; ++bj)
#pragma unroll
                for (int hf = 0; hf < 2; ++hf) { const float* p = pb + (size_t)((u.pm >> 6) * 4 + ((2 * u.pm + ai) & 3)) * 256 + col0 + bj * HALF + 4 * hf;
                    bias[ai][bj][hf] = (*(const f32x4*)p + *(const f32x4*)(p + 2048)) + (*(const f32x4*)(p + 4096) + *(const f32x4*)(p + 6144)); }
#pragma unroll
        EPI_LOOP_ROWS { bf16_t* rowp = O + (size_t)(row0 + ai * HALF + m * 16) * 256 + col0;
#pragma unroll
            for (int bj = 0; bj < 2; ++bj) { f32x4 v0 = acc[ai][bj][m][0] + bias[ai][bj][0], v1 = acc[ai][bj][m][1] + bias[ai][bj][1];
#pragma unroll
                for (int j = 0; j < 4; ++j) { v0[j] = gelu_tanh_(v0[j]); v1[j] = gelu_tanh_(v1[j]); }
                *(u32x4*)(rowp + bj * HALF) = pack8(v0, v1); } }
    }
};
}

struct Args { const float* in[41]; float* out; unsigned char* ws; int ph_lo, ph_hi; };
enum { I_X = 0, I_ALN, I_AMU, I_AWR, I_AWK, I_AWV, I_AWO, I_AW0, I_AW1, I_AW2, I_AA0, I_AA1, I_AA2, I_AG1, I_AG2, I_AKK, I_AKA, I_ARK, I_ALNXW, I_ALNXB,
       I_KVLN, I_KVW, I_PEK, I_PEV, I_CKW1, I_CKW2, I_CVW1, I_CVW2, I_RELB, I_BLN, I_BWQG, I_BWO, I_MLN, I_MWG, I_MBG, I_MWE, I_MBE, I_MW1, I_MW3, I_MW2, I_FLN };

struct Fr { LAS unsigned char* lds; int tid, lane, wave, G, gw, ngw; };

__device__ __forceinline__ void tr_item(const float* W, int N, int Klim, int Nlim, int k0, int n0, bf16_t* out, long orow0, int ldo, int kout0,
                                        const float* sc, int scmode, LAS float* scr, int lane) {
    f32x4 ld[8];
#pragma unroll
    for (int i = 0; i < 8; ++i) { const int kk = 8 * i + (lane >> 3), k = k0 + kk, n = n0 + 4 * (lane & 7);
        ld[i] = (k < Klim && n < Nlim) ? *(const f32x4*)(W + (size_t)k * N + n) : (f32x4){0.f, 0.f, 0.f, 0.f}; }
#pragma unroll
    for (int i = 0; i < 8; ++i) { const int kk = 8 * i + (lane >> 3), k = k0 + kk; f32x4 v = ld[i];
        if (scmode && k < Klim) { const float sv = sc[k]; v = v * (scmode == 1 ? sv : 1.f - sv); }
        LAS float* d = scr + kk * 33 + 4 * (lane & 7); d[0] = v.x; d[1] = v.y; d[2] = v.z; d[3] = v.w; }
    LDS_WAIT(); asm volatile("" ::: "memory");
    const int c = lane & 7;
#pragma unroll
    for (int j = 0; j < 4; ++j) { const int n = (lane >> 3) + 8 * j; const LAS float* s = scr + (8 * c) * 33 + n;
        u32x4 o; o.x = pk2(s[0 * 33], s[1 * 33]); o.y = pk2(s[2 * 33], s[3 * 33]); o.z = pk2(s[4 * 33], s[5 * 33]); o.w = pk2(s[6 * 33], s[7 * 33]);
        *(u32x4*)(out + (size_t)(orow0 + n) * ldo + kout0 + 8 * c) = o; }
    LDS_WAIT(); asm volatile("" ::: "memory");
}
__device__ __forceinline__ void conv_mat(const Fr& F, const float* W, int K, int N, bf16_t* out, long orow0, int ldo, int kout0, const float* sc, int scmode, LAS float* scr) {
    const int nkb = (K + 63) / 64, nnb = (N + 31) / 32, nit = nkb * nnb;
    const int off = (int)((((size_t)(out + orow0 * (long)ldo + kout0)) >> 12) % (unsigned)F.ngw);
    for (int it = (F.gw + F.ngw - off) % F.ngw; it < nit; it += F.ngw) { const int kb = it / nnb, nb = it % nnb;
        tr_item(W, N, K, N, kb * 64, nb * 32, out, orow0 + nb * 32, ldo, kout0 + kb * 64, sc, scmode, scr, F.lane); }
}
__device__ __forceinline__ void zero_rect(const Fr& F, bf16_t* out, int rows, int cols8, int ldo) {
    const long tot = (long)rows * cols8;
    for (long i = (long)F.gw * 64 + F.lane; i < tot; i += (long)F.ngw * 64) { const long r = i / cols8, c = i % cols8; *(u32x4*)(out + r * ldo + c * 8) = (u32x4){0u, 0u, 0u, 0u}; }
}
__device__ __forceinline__ bf16x8 pack8c(const float (&v)[8]) { u32x4 w; w.x = cvtpk(v[0], v[1]); w.y = cvtpk(v[2], v[3]); w.z = cvtpk(v[4], v[5]); w.w = cvtpk(v[6], v[7]); return __builtin_bit_cast(bf16x8, w); }
__device__ __forceinline__ void phase_conv(const Fr& F, const Args& a) {
    unsigned char* ws = a.ws;
    LAS float* scr = (LAS float*)(F.lds + F.wave * 8704);
    const float* mu = a.in[I_AMU];
    conv_mat(F, a.in[I_AWR], 1024, 1024, (bf16_t*)(ws + WS_WR), 0, 1024, 0, nullptr, 0, scr);
    conv_mat(F, a.in[I_AWK], 1024, 1024, (bf16_t*)(ws + WS_WK), 0, 1024, 0, nullptr, 0, scr);
    conv_mat(F, a.in[I_AWV], 1024, 1024, (bf16_t*)(ws + WS_WV), 0, 1024, 0, nullptr, 0, scr);
    conv_mat(F, a.in[I_AWO], 1024, 1024, (bf16_t*)(ws + WS_WO), 0, 1024, 0, nullptr, 0, scr);
    {
        bf16_t* o = (bf16_t*)(ws + WS_WL1);
        conv_mat(F, a.in[I_AW1], 1024, 64, o, 0, 2048, 0, mu + 1 * 1024, 2, scr);    conv_mat(F, a.in[I_AW1], 1024, 64, o, 0, 2048, 1024, mu + 1 * 1024, 1, scr);
        conv_mat(F, a.in[I_AA1], 1024, 64, o, 64, 2048, 0, mu + 4 * 1024, 2, scr);   conv_mat(F, a.in[I_AA1], 1024, 64, o, 64, 2048, 1024, mu + 4 * 1024, 1, scr);
        conv_mat(F, a.in[I_AG1], 1024, 160, o, 128, 2048, 0, mu + 5 * 1024, 2, scr); conv_mat(F, a.in[I_AG1], 1024, 160, o, 128, 2048, 1024, mu + 5 * 1024, 1, scr);
        zero_rect(F, o + (size_t)288 * 2048, 224, 256, 2048);
    }
    {
        bf16_t* o = (bf16_t*)(ws + WS_W2WA);
        conv_mat(F, a.in[I_AW2], 64, 1024, o, 0, 128, 0, nullptr, 0, scr);
        zero_rect(F, o + 64, 1024, 8, 128);
        conv_mat(F, a.in[I_AA2], 64, 1024, o, 1024, 128, 64, nullptr, 0, scr);
        zero_rect(F, o + (size_t)1024 * 128, 1024, 8, 128);
    }
    {
        bf16_t* o = (bf16_t*)(ws + WS_W2G);
        conv_mat(F, a.in[I_AG2], 160, 1024, o, 0, 256, 0, nullptr, 0, scr);
        zero_rect(F, o + 192, 1024, 8, 256);
    }
    {
        bf16_t* o = (bf16_t*)(ws + WS_WKVQG);
        conv_mat(F, a.in[I_KVW], 1024, 1536, o, 0, 1024, 0, a.in[I_KVLN], 1, scr);
        conv_mat(F, a.in[I_BWQG], 1024, 1072, o, 1536, 1024, 0, a.in[I_BLN], 1, scr);
        zero_rect(F, o + (size_t)2624 * 1024, 192, 128, 1024);
    }
    conv_mat(F, a.in[I_BWO], 1024, 1024, (bf16_t*)(ws + WS_WOB), 0, 1024, 0, nullptr, 0, scr);
    conv_mat(F, a.in[I_CKW1], 2048, 256, (bf16_t*)(ws + WS_WC1), 0, 2048, 0, nullptr, 0, scr);
    conv_mat(F, a.in[I_CVW1], 2048, 256, (bf16_t*)(ws + WS_WC1) + (size_t)256 * 2048, 0, 2048, 0, nullptr, 0, scr);
    {
        bf16_t* o1 = (bf16_t*)(ws + WS_BT1); bf16_t* o2 = (bf16_t*)(ws + WS_BT2);
        for (int it = F.gw; it < 64 * 256; it += F.ngw) { const int mat = it >> 8, r = it & 255, kb = r >> 4, nb = r & 15, n0 = nb * 32;
            const long orow = (long)mat * 1024 + (n0 >> 7) * 256 + (n0 & 127);
            const float* gm = a.in[I_MLN] + (mat >> 5) * 1024;
            tr_item(a.in[I_MW1] + (size_t)mat * 1024 * 512, 512, 1024, 512, kb * 64, n0, o1, orow, 1024, kb * 64, gm, 1, scr, F.lane);
            tr_item(a.in[I_MW3] + (size_t)mat * 1024 * 512, 512, 1024, 512, kb * 64, n0, o1, orow + 128, 1024, kb * 64, gm, 1, scr, F.lane); }
        for (int it = F.gw; it < 64 * 256; it += F.ngw) { const int mat = it >> 8, r = it & 255, kb = r >> 5, nb = r & 31;
            tr_item(a.in[I_MW2] + (size_t)mat * 512 * 1024, 1024, 512, 1024, kb * 64, nb * 32, o2, (long)mat * 1024 + nb * 32, 512, kb * 64, nullptr, 0, scr, F.lane); }
    }
    {
        int* ci = (int*)(ws + WS_CIDX);
        for (int r = F.gw * 64 + F.lane; r < 2 * 16384; r += F.ngw * 64) { const int grp = r >> 14, rr = r & 16383, bg = rr >> 7, n = rr & 127; ci[r] = ((bg >> 2) * SEQ + 16 * n) * 24 + grp * 4 + (bg & 3); }
        if (F.wave == 0 && blockIdx.x < 128) { const int id = blockIdx.x, grp = id >> 6, nb = (id >> 2) & 15, kq = id & 3, i = F.lane & 15, q = F.lane >> 4;
            const float* pe = a.in[grp ? I_PEV : I_PEK] + (size_t)(i & 3) * 2048 + kq * 512 + 8 * q; const float* w = a.in[grp ? I_CVW1 : I_CKW1] + (size_t)(kq * 512 + 8 * q) * 256 + 16 * nb + i;
            f32x4 acc = (f32x4){0.f, 0.f, 0.f, 0.f};
#pragma unroll 2
            for (int sk = 0; sk < 16; ++sk) { const f32x4 p0 = *(const f32x4*)(pe + 32 * sk), p1 = *(const f32x4*)(pe + 32 * sk + 4);
                float wv[8];
#pragma unroll
                for (int e = 0; e < 8; ++e) wv[e] = w[(size_t)(32 * sk + e) * 256];
                const float pv[8] = {p0.x, p0.y, p0.z, p0.w, p1.x, p1.y, p1.z, p1.w}; float pl[8];
#pragma unroll
                for (int e = 0; e < 8; ++e) pl[e] = pv[e] - bflo(f2bf(pv[e]));
                const bf16x8 ah = pack8c(pv), al = pack8c(pl), bw = pack8c(wv);
                acc = __builtin_amdgcn_mfma_f32_16x16x32_bf16(ah, bw, acc, 0, 0, 0); acc = __builtin_amdgcn_mfma_f32_16x16x32_bf16(al, bw, acc, 0, 0, 0); }
            if (F.lane < 16) { float* pb = (float*)(ws + WS_PEBP) + ((size_t)(kq * 2 + grp) * 4) * 256 + 16 * nb + i;
#pragma unroll
                for (int rg = 0; rg < 4; ++rg) pb[rg * 256] = acc[rg]; }
        }
    }
    {
        bf16_t* o = (bf16_t*)(ws + WS_W2F);
        for (int i = F.gw * 64 + F.lane; i < 2 * 16384; i += F.ngw * 64) { const int e = i & 7, ln = (i >> 3) & 63, nb = (i >> 9) & 3, sk = (i >> 11) & 7, grp = i >> 14;
            const int k = 32 * sk + 8 * (ln >> 4) + e, n = 16 * nb + (ln & 15); const float v = a.in[grp ? I_CVW2 : I_CKW2][k * 64 + n];
            const unsigned hi = f2bf(v), lo = f2bf(v - bflo(hi));
            bf16_t* ob = o + ((size_t)((grp * 8 + sk) * 2) * 4 + nb) * 512 + ln * 8 + e; ob[0] = (bf16_t)hi; ob[4 * 512] = (bf16_t)lo; }
    }
    {
        bf16_t* o = (bf16_t*)(ws + WS_RFRAG);
        for (int i = F.gw * 64 + F.lane; i < 2 * 49152; i += F.ngw * 64) { const int layer = i / 49152, r = i % 49152, e = r & 7, ln = (r >> 3) & 63, nt = (r >> 9) % 3, s = r / 1536;
            const int k = 32 * s + 8 * (ln >> 4) + e, n = 16 * nt + (ln & 15);
            float v = 0.f; if (n < 4) v = a.in[I_MWG][((size_t)layer * 1024 + k) * 4 + n]; else if (n < 36) v = a.in[I_MWE][((size_t)layer * 1024 + k) * 32 + (n - 4)];
            v *= a.in[I_MLN][layer * 1024 + k];
            const unsigned hi = f2bf(v); const float r1 = v - bflo(hi); const unsigned lo = f2bf(r1); const float r2 = r1 - bflo(lo); const unsigned lo2 = f2bf(r2);
            bf16_t* ob = o + ((size_t)(layer * 32 + s) * 9 + nt) * 512 + ln * 8 + e;
            ob[0] = (bf16_t)hi; ob[3 * 512] = (bf16_t)lo; ob[6 * 512] = (bf16_t)lo2; }
    }
}

__device__ __forceinline__ void phase_r1(const Fr& F, const Args& a) {
    unsigned char* ws = a.ws; const float* x = a.in[I_X];
    bf16_t* XN = (bf16_t*)(ws + WS_S5); bf16_t* XR = (bf16_t*)(ws + WS_S0); bf16_t* XK = (bf16_t*)(ws + WS_S1); bf16_t* XV = (bf16_t*)(ws + WS_S2);
    f32x4 gn[4], mr[4], mk[4], mv[4];
#pragma unroll
    for (int j = 0; j < 4; ++j) { const int c = 256 * j + 4 * F.lane; gn[j] = *(const f32x4*)(a.in[I_ALN] + c); mr[j] = *(const f32x4*)(a.in[I_AMU] + 0 * 1024 + c);
        mk[j] = *(const f32x4*)(a.in[I_AMU] + 2 * 1024 + c); mv[j] = *(const f32x4*)(a.in[I_AMU] + 3 * 1024 + c); }
    for (int run = F.gw; run < NT / 32; run += F.ngw) {
        const int m0 = run * 32, b = m0 >> 11, t0 = m0 & 2047;
        f32x4 pv[4];
        if (t0 == 0) {
#pragma unroll
            for (int j = 0; j < 4; ++j) { pv[j] = (f32x4){0.f, 0.f, 0.f, 0.f}; *(u32x2*)(XN + (size_t)(b * 2049) * 1024 + 256 * j + 4 * F.lane) = (u32x2){0u, 0u}; }
        } else {
            const f32x4* xr = (const f32x4*)(x + (size_t)(m0 - 1) * 1024) + F.lane; float s = 0.f;
#pragma unroll
            for (int j = 0; j < 4; ++j) { pv[j] = xr[64 * j]; s += (pv[j].x * pv[j].x + pv[j].y * pv[j].y) + (pv[j].z * pv[j].z + pv[j].w * pv[j].w); }
            const float rstd = 1.f / sqrtf(wave_sum(s) * (1.f / 1024.f) + 1e-6f);
#pragma unroll
            for (int j = 0; j < 4; ++j) pv[j] = pv[j] * rstd * gn[j];
        }
        f32x4 nx[4];
        { const f32x4* xr = (const f32x4*)(x + (size_t)m0 * 1024) + F.lane;
#pragma unroll
          for (int j = 0; j < 4; ++j) nx[j] = xr[64 * j]; }
        for (int i = 0; i < 32; ++i) {
            const int m = m0 + i;
            f32x4 v[4]; float s = 0.f;
#pragma unroll
            for (int j = 0; j < 4; ++j) v[j] = nx[j];
            if (i < 31) { const f32x4* xr = (const f32x4*)(x + (size_t)(m + 1) * 1024) + F.lane;
#pragma unroll
                for (int j = 0; j < 4; ++j) nx[j] = xr[64 * j]; }
#pragma unroll
            for (int j = 0; j < 4; ++j) s += (v[j].x * v[j].x + v[j].y * v[j].y) + (v[j].z * v[j].z + v[j].w * v[j].w);
            const float rstd = 1.f / sqrtf(wave_sum(s) * (1.f / 1024.f) + 1e-6f);
            const size_t prow = (size_t)(m + b + 1) * 1024, row = (size_t)m * 1024;
#pragma unroll
            for (int j = 0; j < 4; ++j) { const int c = 256 * j + 4 * F.lane;
                const f32x4 cur = v[j] * rstd * gn[j], xx = pv[j] - cur;
                *(u32x2*)(XN + prow + c) = (u32x2){pk2(cur.x, cur.y), pk2(cur.z, cur.w)};
                const f32x4 r_ = cur + xx * mr[j], k_ = cur + xx * mk[j], v_ = cur + xx * mv[j];
                *(u32x2*)(XR + row + c) = (u32x2){pk2(r_.x, r_.y), pk2(r_.z, r_.w)};
                *(u32x2*)(XK + row + c) = (u32x2){pk2(k_.x, k_.y), pk2(k_.z, k_.w)};
                *(u32x2*)(XV + row + c) = (u32x2){pk2(v_.x, v_.y), pk2(v_.z, v_.w)};
                pv[j] = cur; }
        }
    }
}

typedef float f32x16 __attribute__((ext_vector_type(16)));
__device__ __forceinline__ bf16x8 pack8f(float a0, float a1, float a2, float a3, float a4, float a5, float a6, float a7) {
    u32x4 w; w.x = cvtpk(a0, a1); w.y = cvtpk(a2, a3); w.z = cvtpk(a4, a5); w.w = cvtpk(a6, a7); return __builtin_bit_cast(bf16x8, w); }
__device__ __forceinline__ bf16x8 packacc(const f32x16& v, int s2) { return pack8f(v[8 * s2], v[8 * s2 + 1], v[8 * s2 + 2], v[8 * s2 + 3], v[8 * s2 + 4], v[8 * s2 + 5], v[8 * s2 + 6], v[8 * s2 + 7]); }
__device__ __forceinline__ int swap23(int w) { return (w & ~12) | ((w & 4) << 1) | ((w & 8) >> 1); }
constexpr int SC_AT = 0, SC_RT = 4096, SC_BJ = 8192, SC_KJ = 12288, SC_VI = 16384, SC_BT = 20480, SC_KT = 24576, SC_TT = 20480, SC_AAKT = 22528, SC_ABRT = 24576, SC_AKRT = 26624,
              SC_GL = 28672, SC_SS = 28928, SC_SLOT = 29184, SC_YB = 4 * SC_SLOT, SC_BON = SC_YB + 32768;
template <int HALF, int BIT>
__device__ __forceinline__ void reduce32_stage(float (&v)[32], int lane) {
    const bool up = (lane & BIT) != 0; const int addr = (lane ^ BIT) << 2;
#pragma unroll
    for (int i = 0; i < HALF; ++i) { const float keep = up ? v[i + HALF] : v[i], send = up ? v[i] : v[i + HALF];
        v[i] = keep + __int_as_float(__builtin_amdgcn_ds_bpermute(addr, __float_as_int(send))); }
}
__device__ __forceinline__ float reduce32(float (&v)[32], int lane) {
#pragma unroll
    for (int i = 0; i < 16; ++i) { const auto r = __builtin_amdgcn_permlane32_swap(__float_as_uint(v[i]), __float_as_uint(v[i + 16]), false, false); v[i] = __uint_as_float(r[0]) + __uint_as_float(r[1]); }
#pragma unroll
    for (int i = 0; i < 8; ++i) { const auto r = __builtin_amdgcn_permlane16_swap(__float_as_uint(v[i]), __float_as_uint(v[i + 8]), false, false); v[i] = __uint_as_float(r[0]) + __uint_as_float(r[1]); }
    { const bool up = (lane & 8) != 0;
#pragma unroll
      for (int i = 0; i < 4; ++i) { const float keep = up ? v[i + 4] : v[i], send = up ? v[i] : v[i + 4]; v[i] = keep + dppf<DPP_ROR8>(send); } }
    reduce32_stage<2, 4>(v, lane);
    { const bool up = (lane & 2) != 0; const float keep = up ? v[1] : v[0], send = up ? v[0] : v[1]; v[0] = keep + dppf<DPP_XOR2>(send); }
    return v[0] + dppf<DPP_XOR1>(v[0]);
}
#define SC_RAW(area, t) bf2f(*(const LAS bf16_t*)(slot + (area) + (t) * 128 + lane * 2))
#define SC_BARRIER() do { asm volatile("s_waitcnt lgkmcnt(0)" ::: "memory"); __builtin_amdgcn_s_barrier(); asm volatile("" ::: "memory"); } while (0)
struct ScanRaw { u32x4 v[10]; unsigned lwp[16]; };
__device__ __forceinline__ void scan_load(const Args& a, ScanRaw& R, int chain, int t0, int half, int lane) {
    unsigned char* ws = a.ws; const int tb = 16 * half;
    const unsigned char* Rb = ws + WS_S3; const unsigned char* LWb = ws + WS_S0; const unsigned char* Kb = ws + WS_S4; const unsigned char* Vb = (const unsigned char*)a.out; const unsigned char* Ab = ws + WS_S1;
    const size_t rowb = ((size_t)chain * SEQ + t0) * 128;
#pragma unroll
    for (int q = 0; q < 2; ++q) { const size_t o = rowb + (size_t)(tb + 8 * q) * 128 + lane * 16;
        R.v[5 * q + 0] = *(const u32x4*)(Ab + o); R.v[5 * q + 1] = *(const u32x4*)(Rb + o); R.v[5 * q + 2] = *(const u32x4*)(LWb + o); R.v[5 * q + 3] = *(const u32x4*)(Kb + o); R.v[5 * q + 4] = *(const u32x4*)(Vb + o); }
    if (half) {
#pragma unroll
        for (int m = 0; m < 16; ++m) R.lwp[m] = (unsigned)*(const bf16_t*)(LWb + rowb + (size_t)m * 128 + lane * 2); }
}
__device__ __forceinline__ void scan_pre(const Fr& F, const Args& a, LAS unsigned char* slot, LAS float* bon, LAS unsigned char* ysc, int chain, int t0, int half, ScanRaw& R, bool more, float kkc, float kac, float rkc) {
    unsigned char* ws = a.ws;
    int lane = F.lane; asm volatile("" : "+v"(lane));
    { unsigned so = (unsigned)(size_t)slot; asm volatile("" : "+s"(so)); slot = (LAS unsigned char*)(size_t)so; }
    const int b = chain >> 4, hd = chain & 15, ch = hd * 64 + lane, r = lane & 31, h = lane >> 5, tb = 16 * half;
    float cum = 0.f;
    if (half) {
#pragma unroll
        for (int m = 0; m < 16; ++m) cum += bflo(R.lwp[m]); }
    {
#pragma unroll
        for (int q = 0; q < 2; ++q) { const int lo2 = (tb + 8 * q) * 128 + lane * 16;
            *(LAS u32x4*)(slot + SC_AT + lo2) = R.v[5 * q + 0]; *(LAS u32x4*)(slot + SC_RT + lo2) = R.v[5 * q + 1]; *(LAS u32x4*)(slot + SC_BT + lo2) = R.v[5 * q + 2]; *(LAS u32x4*)(slot + SC_KT + lo2) = R.v[5 * q + 3]; *(LAS u32x4*)(slot + SC_BJ + lo2) = R.v[5 * q + 4]; }
        LDS_WAIT();
        if (more) scan_load(a, R, chain, t0 + 64, half, lane);
    }
    float kq[16], aq[16], rq[16];
    {
        float q[32];
#pragma unroll
        for (int tt = 0; tt < 16; ++tt) { const float k = SC_RAW(SC_KT, tb + tt), av = SC_RAW(SC_AT, tb + tt), rv = SC_RAW(SC_RT, tb + tt); kq[tt] = k; aq[tt] = av; rq[tt] = rv;
            const float kkv = k * kkc; q[tt] = kkv * kkv; q[16 + tt] = rv * (k * (1.f + (av - 1.f) * kac)) * rkc; }
        const float s1 = reduce32(q, lane); const int idx = (lane >> 1) & 31;
        if ((lane & 1) == 0) { if (idx < 16) ((LAS float*)(slot + SC_SS))[tb + idx] = s1; else bon[tb + idx - 16] = s1; }
    }
    unsigned vv[8];
#pragma unroll
    for (int m = 0; m < 8; ++m) vv[m] = (unsigned)*(const LAS bf16_t*)(slot + SC_BJ + (tb + 2 * m) * 128 + lane * 2) | ((unsigned)*(const LAS bf16_t*)(slot + SC_BJ + (tb + 2 * m + 1) * 128 + lane * 2) << 16);
    LDS_WAIT(); asm volatile("" ::: "memory");
    const int pj = (lane & 48) | swap23(lane & 15);
    const int pjc = pj >> 3, pjw = (pj & 7) * 2;
    unsigned bj[8], kj[8]; float gprev = half ? fexp_(cum) : 1.f, gl = 1.f;
    f32x4 ssv[4];
#pragma unroll
    for (int q4 = 0; q4 < 4; ++q4) ssv[q4] = *(const LAS f32x4*)(slot + SC_SS + (tb + 4 * q4) * 4);
    const bool odd = (lane & 1) != 0; const int pjwe = pjw & ~2;
#define SC_PAIR_STORE(area, x) do { const float _snd = odd ? x[0] : x[1]; const float _rcv = dppf<DPP_XOR1>(_snd); *(LAS unsigned*)(slot + (area) + ro) = cvtpk(odd ? _rcv : x[0], odd ? x[1] : _rcv); } while (0)
#pragma unroll
    for (int tp = 0; tp < 8; ++tp) { const int t0 = tb + 2 * tp;
        float atv[2], rtv[2], btv[2], ktv[2];
#pragma unroll
        for (int u = 0; u < 2; ++u) { const int tt = 2 * tp + u;
            const float k = kq[tt], av = aq[tt], rv = rq[tt], lw = SC_RAW(SC_BT, tb + tt);
            cum += lw; const float g = fexp_(cum), ginv = __builtin_amdgcn_rcpf(g);
            const float ss = ssv[tt >> 2][tt & 3];
            const float kk = k * kkc * __builtin_amdgcn_rsqf(fmaxf(ss, 1e-24f)); const float kp = k * (1.f + (av - 1.f) * kac);
            atv[u] = -kk * gprev; btv[u] = kk * av * ginv; ktv[u] = kp * ginv; rtv[u] = rv * g;
            gprev = g; gl = g; }
        bj[tp] = cvtpk(btv[0], btv[1]); kj[tp] = cvtpk(ktv[0], ktv[1]);
        const int ro = (t0 + (odd ? 1 : 0)) * 128 + ((pjc ^ ((t0 >> 1) & 7)) << 4) + pjwe;
        SC_PAIR_STORE(SC_AT, atv); SC_PAIR_STORE(SC_RT, rtv); SC_PAIR_STORE(SC_BT, btv); SC_PAIR_STORE(SC_KT, ktv);
    }
#undef SC_PAIR_STORE
    SC_BARRIER();
#pragma unroll
    for (int cc = 0; cc < 2; ++cc) { const int c = 2 * half + cc, m0 = 2 * cc; const int ro = lane * 64 + ((c ^ ((lane >> 2) & 3)) << 4);
        *(LAS u32x4*)(slot + SC_BJ + ro) = (u32x4){bj[m0], bj[m0 + 1], bj[m0 + 4], bj[m0 + 5]};
        *(LAS u32x4*)(slot + SC_KJ + ro) = (u32x4){kj[m0], kj[m0 + 1], kj[m0 + 4], kj[m0 + 5]};
        *(LAS u32x4*)(slot + SC_VI + ro) = (u32x4){vv[m0], vv[m0 + 1], vv[m0 + 4], vv[m0 + 5]}; }
    if (half) ((LAS float*)(slot + SC_GL))[lane] = gl;
    const int swz = (r >> 1) & 7;
    f32x16 D0, D1, D2;
#pragma unroll
    for (int i = 0; i < 16; ++i) { D0[i] = 0.f; D1[i] = 0.f; D2[i] = 0.f; }
    if (half == 0) {
#pragma unroll
        for (int ks = 0; ks < 4; ++ks) { const int ao = r * 128 + (((2 * ks + h) ^ swz) << 4);
            D0 = __builtin_amdgcn_mfma_f32_32x32x16_bf16(*(const LAS bf16x8*)(slot + SC_BT + ao), *(const LAS bf16x8*)(slot + SC_AT + ao), D0, 0, 0, 0); }
    } else {
#pragma unroll
        for (int ks = 0; ks < 4; ++ks) { const int ao = r * 128 + (((2 * ks + h) ^ swz) << 4);
            const bf16x8 bA = *(const LAS bf16x8*)(slot + SC_BT + ao), kA = *(const LAS bf16x8*)(slot + SC_KT + ao), aB = *(const LAS bf16x8*)(slot + SC_AT + ao), rB = *(const LAS bf16x8*)(slot + SC_RT + ao);
            D0 = __builtin_amdgcn_mfma_f32_32x32x16_bf16(kA, aB, D0, 0, 0, 0); D1 = __builtin_amdgcn_mfma_f32_32x32x16_bf16(bA, rB, D1, 0, 0, 0); D2 = __builtin_amdgcn_mfma_f32_32x32x16_bf16(kA, rB, D2, 0, 0, 0); }
    }
    SC_BARRIER();
    if (half == 0) {
        const int sw4 = (r >> 2) & 3; int bo[2];
#pragma unroll
        for (int s2 = 0; s2 < 2; ++s2) bo[s2] = r * 64 + (((2 * s2 + h) ^ sw4) << 4);
        const int pcol = (r & 16) | swap23(r & 15), pcc = pcol >> 3, pcw = (pcol & 7) * 2;
        f32x16 Mx, Tx;
#pragma unroll
        for (int reg = 0; reg < 16; ++reg) { const int sr = (reg & 3) + 8 * (reg >> 2) + 4 * h; const float av = (sr < r) ? D0[reg] : 0.f; Mx[reg] = av; Tx[reg] = av + ((sr == r) ? 1.f : 0.f); }
#pragma unroll
        for (int it = 0; it < 4; ++it) {
#pragma unroll
            for (int reg = 0; reg < 16; ++reg) { const int sr = (reg & 3) + 8 * (reg >> 2) + 4 * h; const int ad = sr * 64 + ((pcc ^ ((sr >> 2) & 3)) << 4) + pcw;
                *(LAS bf16_t*)(ysc + ad) = (bf16_t)f2bf(Mx[reg]); *(LAS bf16_t*)(ysc + 2048 + ad) = (bf16_t)f2bf(Tx[reg]); }
            LDS_WAIT(); asm volatile("" ::: "memory");
            bf16x8 mb[2], m2b[2];
#pragma unroll
            for (int s2 = 0; s2 < 2; ++s2) mb[s2] = packacc(Mx, s2);
            f32x16 M2;
#pragma unroll
            for (int i = 0; i < 16; ++i) M2[i] = 0.f;
#pragma unroll
            for (int s2 = 0; s2 < 2; ++s2) M2 = __builtin_amdgcn_mfma_f32_32x32x16_bf16(*(const LAS bf16x8*)(ysc + bo[s2]), mb[s2], M2, 0, 0, 0);
#pragma unroll
            for (int s2 = 0; s2 < 2; ++s2) m2b[s2] = packacc(M2, s2);
#pragma unroll
            for (int s2 = 0; s2 < 2; ++s2) Tx = __builtin_amdgcn_mfma_f32_32x32x16_bf16(*(const LAS bf16x8*)(ysc + 2048 + bo[s2]), m2b[s2], Tx, 0, 0, 0);
            Mx = M2;
            LDS_WAIT(); asm volatile("" ::: "memory");
        }
#pragma unroll
        for (int g = 0; g < 4; ++g) { const int ro = r * 64 + (((2 * (g >> 1) + h) ^ sw4) << 4) + 8 * (g & 1);
            *(LAS u32x2*)(slot + SC_TT + ro) = (u32x2){cvtpk(Tx[4 * g], Tx[4 * g + 1]), cvtpk(Tx[4 * g + 2], Tx[4 * g + 3])}; }
    } else {
#pragma unroll
        for (int reg = 0; reg < 16; ++reg) { const int sr = (reg & 3) + 8 * (reg >> 2) + 4 * h; D0[reg] = (sr < r) ? D0[reg] : 0.f; D1[reg] = (sr <= r) ? D1[reg] : 0.f; D2[reg] = (sr <= r) ? D2[reg] : 0.f; }
        const int sw4 = (r >> 2) & 3;
#pragma unroll
        for (int g = 0; g < 4; ++g) { const int ro = r * 64 + (((2 * (g >> 1) + h) ^ sw4) << 4) + 8 * (g & 1);
            *(LAS u32x2*)(slot + SC_AAKT + ro) = (u32x2){cvtpk(D0[4 * g], D0[4 * g + 1]), cvtpk(D0[4 * g + 2], D0[4 * g + 3])};
            *(LAS u32x2*)(slot + SC_ABRT + ro) = (u32x2){cvtpk(D1[4 * g], D1[4 * g + 1]), cvtpk(D1[4 * g + 2], D1[4 * g + 3])};
            *(LAS u32x2*)(slot + SC_AKRT + ro) = (u32x2){cvtpk(D2[4 * g], D2[4 * g + 1]), cvtpk(D2[4 * g + 2], D2[4 * g + 3])}; }
    }
}
__device__ __forceinline__ void scan_seq(LAS unsigned char* slot, LAS bf16_t* yb, int ib, int lane, f32x16 (&Z)[2]) {
    asm volatile("" : "+v"(lane));
    { unsigned so = (unsigned)(size_t)slot; asm volatile("" : "+s"(so)); slot = (LAS unsigned char*)(size_t)so; }
    const int r = lane & 31, h = lane >> 5, swz = (r >> 1) & 7, sw4 = (r >> 2) & 3;
    int ao[4], bo[2];
#pragma unroll
    for (int ks = 0; ks < 4; ++ks) ao[ks] = r * 128 + (((2 * ks + h) ^ swz) << 4);
#pragma unroll
    for (int s2 = 0; s2 < 2; ++s2) bo[s2] = r * 64 + (((2 * s2 + h) ^ sw4) << 4);
    bf16x8 zb[4], vB[2], xb[2], pb[2];
#pragma unroll
    for (int jb = 0; jb < 2; ++jb)
#pragma unroll
        for (int s2 = 0; s2 < 2; ++s2) zb[2 * jb + s2] = packacc(Z[jb], s2);
#pragma unroll
    for (int s2 = 0; s2 < 2; ++s2) vB[s2] = *(const LAS bf16x8*)(slot + SC_VI + ib * 2048 + bo[s2]);
    f32x16 X, P, Y;
#pragma unroll
    for (int i = 0; i < 16; ++i) { X[i] = 0.f; P[i] = 0.f; Y[i] = 0.f; }
#pragma unroll
    for (int ks = 0; ks < 4; ++ks) X = __builtin_amdgcn_mfma_f32_32x32x16_bf16(*(const LAS bf16x8*)(slot + SC_AT + ao[ks]), zb[ks], X, 0, 0, 0);
#pragma unroll
    for (int s2 = 0; s2 < 2; ++s2) X = __builtin_amdgcn_mfma_f32_32x32x16_bf16(*(const LAS bf16x8*)(slot + SC_AAKT + bo[s2]), vB[s2], X, 0, 0, 0);
#pragma unroll
    for (int s2 = 0; s2 < 2; ++s2) xb[s2] = packacc(X, s2);
#pragma unroll
    for (int s2 = 0; s2 < 2; ++s2) P = __builtin_amdgcn_mfma_f32_32x32x16_bf16(*(const LAS bf16x8*)(slot + SC_TT + bo[s2]), xb[s2], P, 0, 0, 0);
#pragma unroll
    for (int s2 = 0; s2 < 2; ++s2) pb[s2] = packacc(P, s2);
#pragma unroll
    for (int ks = 0; ks < 4; ++ks) Y = __builtin_amdgcn_mfma_f32_32x32x16_bf16(*(const LAS bf16x8*)(slot + SC_RT + ao[ks]), zb[ks], Y, 0, 0, 0);
#pragma unroll
    for (int s2 = 0; s2 < 2; ++s2) { Y = __builtin_amdgcn_mfma_f32_32x32x16_bf16(*(const LAS bf16x8*)(slot + SC_ABRT + bo[s2]), pb[s2], Y, 0, 0, 0);
        Y = __builtin_amdgcn_mfma_f32_32x32x16_bf16(*(const LAS bf16x8*)(slot + SC_AKRT + bo[s2]), vB[s2], Y, 0, 0, 0); }
#pragma unroll
    for (int jb = 0; jb < 2; ++jb) {
#pragma unroll
        for (int s2 = 0; s2 < 2; ++s2) { Z[jb] = __builtin_amdgcn_mfma_f32_32x32x16_bf16(*(const LAS bf16x8*)(slot + SC_BJ + jb * 2048 + bo[s2]), pb[s2], Z[jb], 0, 0, 0);
            Z[jb] = __builtin_amdgcn_mfma_f32_32x32x16_bf16(*(const LAS bf16x8*)(slot + SC_KJ + jb * 2048 + bo[s2]), vB[s2], Z[jb], 0, 0, 0); }
#pragma unroll
        for (int g = 0; g < 4; ++g) { const f32x4 gl4 = *(const LAS f32x4*)(slot + SC_GL + (32 * jb + 8 * g + 4 * h) * 4);
            Z[jb][4 * g] *= gl4.x; Z[jb][4 * g + 1] *= gl4.y; Z[jb][4 * g + 2] *= gl4.z; Z[jb][4 * g + 3] *= gl4.w; } }
#pragma unroll
    for (int reg = 0; reg < 16; ++reg) yb[((reg & 3) + 8 * (reg >> 2) + 4 * h) * 64 + ib * 32 + r] = (bf16_t)f2bf(Y[reg]);
}
__device__ __forceinline__ void phase_scan(const Fr& F, const Args& a) {
    unsigned char* ws = a.ws; const bf16_t* Vb = (const bf16_t*)a.out; const bf16_t* Gb = (const bf16_t*)(ws + WS_S2); bf16_t* YG = (bf16_t*)(ws + WS_S5);
    LAS bf16_t* YB = (LAS bf16_t*)(F.lds + SC_YB);
    LAS float* BON = (LAS float*)(F.lds + SC_BON);
    const int w = F.wave, lane = F.lane;
    for (int cp = blockIdx.x; cp < 256; cp += F.G) {
        f32x16 Z[2];
#pragma unroll
        for (int i = 0; i < 16; ++i) { Z[0][i] = 0.f; Z[1][i] = 0.f; }
        ScanRaw R; scan_load(a, R, 2 * cp + ((w & 3) >> 1), 32 * (w & 1), w >> 2, lane);
        const int chp = ((2 * cp + ((w & 3) >> 1)) & 15) * 64 + lane; float kkc = a.in[I_AKK][chp], kac = a.in[I_AKA][chp], rkc = a.in[I_ARK][chp];
        asm volatile("" : "+v"(kkc), "+v"(kac), "+v"(rkc));
#pragma unroll 1
        for (int bt = 0; bt <= 32; ++bt) {
            SC_BARRIER();
            if (bt < 32) { const int sl = w & 3;
                scan_pre(F, a, F.lds + sl * SC_SLOT, BON + (bt & 1) * 128 + (sl >> 1) * 64 + (sl & 1) * 32, F.lds + SC_YB + (bt & 1) * 16384 + sl * 4096, 2 * cp + (sl >> 1), 64 * bt + 32 * (sl & 1), w >> 2, R, bt < 31, kkc, kac, rkc); }
            SC_BARRIER();
            if (w >= 4) { if (bt < 32) { const int cl = (w - 4) >> 1, ib = (w - 4) & 1;
                scan_seq(F.lds + (2 * cl) * SC_SLOT, YB + (bt & 1) * 8192 + cl * 4096, ib, lane, Z);
                scan_seq(F.lds + (2 * cl + 1) * SC_SLOT, YB + (bt & 1) * 8192 + cl * 4096 + 2048, ib, lane, Z); } }
            else if (bt >= 1) {
                const int cl = w >> 1, chain = 2 * cp + cl, b = chain >> 4, hd = chain & 15, ch = hd * 64 + lane; const float lw_ = a.in[I_ALNXW][ch], lb_ = a.in[I_ALNXB][ch];
                LAS f32x2* ST = (LAS f32x2*)(F.lds + SC_BON + 1024) + w * 32;
                const int tb = 32 * (w & 1); const LAS bf16_t* yp = YB + ((bt - 1) & 1) * 8192 + cl * 4096 + tb * 64 + lane;
                const size_t go = ((size_t)chain * SEQ + 64 * (bt - 1) + tb) * 64 + lane; const bf16_t* vp = Vb + go; const bf16_t* gp = Gb + go; bf16_t* op = YG + go;
                const LAS float* bp = BON + ((bt - 1) & 1) * 128 + cl * 64 + tb;
#pragma unroll 1
                for (int hh = 0; hh < 2; ++hh) {
                    unsigned vg[16];
#pragma unroll
                    for (int tt = 0; tt < 16; ++tt) vg[tt] = (unsigned)vp[(16 * hh + tt) * 64] | ((unsigned)gp[(16 * hh + tt) * 64] << 16);
                    float yq[16];
                    {
                        float q[32];
#pragma unroll
                        for (int tt = 0; tt < 16; ++tt) { const float y = bf2f(yp[(16 * hh + tt) * 64]); yq[tt] = y; q[tt] = y; q[16 + tt] = y * y; }
                        const float s1 = reduce32(q, lane); const int idx = (lane >> 1) & 31;
                        LAS float* STf = (LAS float*)ST;
                        if ((lane & 1) == 0) STf[idx] = s1;
                    }
                    LDS_WAIT(); asm volatile("" ::: "memory");
                    f32x4 sm[4], sq[4], bv4[4];
#pragma unroll
                    for (int q4 = 0; q4 < 4; ++q4) { sm[q4] = ((const LAS f32x4*)ST)[q4]; sq[q4] = ((const LAS f32x4*)ST)[4 + q4]; bv4[q4] = *(const LAS f32x4*)(bp + 16 * hh + 4 * q4); }
#pragma unroll
                    for (int tt = 0; tt < 16; ++tt) { const int t = 16 * hh + tt; const float mean = sm[tt >> 2][tt & 3] * (1.f / 64.f); const float var = fmaxf(sq[tt >> 2][tt & 3] * (1.f / 64.f) - mean * mean, 0.f);
                        float o = (yq[tt] - mean) * __builtin_amdgcn_rsqf(var + 64e-5f) * lw_ + lb_ + bv4[tt >> 2][tt & 3] * bflo(vg[tt]);
                        o *= bfhi(vg[tt]); op[t * 64] = (bf16_t)f2bf(o); }
                    LDS_WAIT(); asm volatile("" ::: "memory");
                }
            }
        }
    }
}

template <int MODE>
__device__ __forceinline__ float load_row_hb(const Fr& F, const bf16_t* hrow, const bf16_t* Y, const int* asg, int m, float (&v)[16]) {
    int p0 = 0, p1 = 0; if (MODE == 1) { p0 = asg[m * 8 + 6]; p1 = asg[m * 8 + 7]; }
    float s = 0.f;
#pragma unroll
    for (int j = 0; j < 2; ++j) { const u32x4 hv = *(const u32x4*)(hrow + 512 * j + 8 * F.lane);
        float* o = v + 8 * j; o[0] = bflo(hv.x); o[1] = bfhi(hv.x); o[2] = bflo(hv.y); o[3] = bfhi(hv.y); o[4] = bflo(hv.z); o[5] = bfhi(hv.z); o[6] = bflo(hv.w); o[7] = bfhi(hv.w);
        if (MODE == 1) { const u32x4 y0 = *(const u32x4*)(Y + (size_t)p0 * 1024 + 512 * j + 8 * F.lane), y1 = *(const u32x4*)(Y + (size_t)p1 * 1024 + 512 * j + 8 * F.lane);
            o[0] += bflo(y0.x) + bflo(y1.x); o[1] += bfhi(y0.x) + bfhi(y1.x); o[2] += bflo(y0.y) + bflo(y1.y); o[3] += bfhi(y0.y) + bfhi(y1.y);
            o[4] += bflo(y0.z) + bflo(y1.z); o[5] += bfhi(y0.z) + bfhi(y1.z); o[6] += bflo(y0.w) + bflo(y1.w); o[7] += bfhi(y0.w) + bfhi(y1.w); }
#pragma unroll
        for (int e = 0; e < 8; ++e) s += o[e] * o[e]; }
    return 1.f / sqrtf(wave_sum(s) * (1.f / 1024.f) + 1e-6f);
}

struct RowRaw { u32x4 h[2], y0[2], y1[2]; };
__device__ __forceinline__ int y_chunk_col(int c) { const int ci = c & 31; return (c >> 5) * 256 + (((ci >> 2) & 3) * 8 + (ci >> 4) * 4 + (ci & 3)) * 8; }
__device__ __forceinline__ void row_issue(const Fr& F, const bf16_t* hrow, const bf16_t* Y, int p0, int p1, RowRaw& R) {
#pragma unroll
    for (int j = 0; j < 2; ++j) { const int yc = y_chunk_col(64 * j + F.lane);
        R.h[j] = *(const u32x4*)(hrow + 512 * j + 8 * F.lane); R.y0[j] = *(const u32x4*)(Y + (size_t)p0 * 1024 + yc); R.y1[j] = *(const u32x4*)(Y + (size_t)p1 * 1024 + yc); }
}
__device__ __forceinline__ float row_finish(const RowRaw& R, float (&v)[16], float w0, float w1) {
    float s = 0.f;
#pragma unroll
    for (int j = 0; j < 2; ++j) { const u32x4 hv = R.h[j], y0 = R.y0[j], y1 = R.y1[j]; float* o = v + 8 * j;
        o[0] = bflo(hv.x) + (w0 * bflo(y0.x) + w1 * bflo(y1.x)); o[1] = bfhi(hv.x) + (w0 * bfhi(y0.x) + w1 * bfhi(y1.x)); o[2] = bflo(hv.y) + (w0 * bflo(y0.y) + w1 * bflo(y1.y)); o[3] = bfhi(hv.y) + (w0 * bfhi(y0.y) + w1 * bfhi(y1.y));
        o[4] = bflo(hv.z) + (w0 * bflo(y0.z) + w1 * bflo(y1.z)); o[5] = bfhi(hv.z) + (w0 * bfhi(y0.z) + w1 * bfhi(y1.z)); o[6] = bflo(hv.w) + (w0 * bflo(y0.w) + w1 * bflo(y1.w)); o[7] = bfhi(hv.w) + (w0 * bfhi(y0.w) + w1 * bfhi(y1.w));
#pragma unroll
        for (int e = 0; e < 8; ++e) s += o[e] * o[e]; }
    return 1.f / sqrtf(wave_sum(s) * (1.f / 1024.f) + 1e-6f);
}
constexpr int RB = 4;
#define ROWS_ISSUE(Hbase) int p0[RB], p1[RB]; float rw0[RB], rw1[RB]; RowRaw R[RB]; \
        _Pragma("unroll") for (int r = 0; r < RB; ++r) { const int mr = m + r * F.ngw; p0[r] = 0; p1[r] = 0; rw0[r] = 0.f; rw1[r] = 0.f; if (mr < NT) { const u32x4 _as = *(const u32x4*)(asg + mr * 8 + 4); \
            const unsigned _wx = _as.x, _wy = _as.y; rw0[r] = __uint_as_float(_wx); rw1[r] = __uint_as_float(_wy); p0[r] = (int)_as.z; p1[r] = (int)_as.w; } } \
        _Pragma("unroll") for (int r = 0; r < RB; ++r) { const int mr = m + r * F.ngw; if (mr < NT) row_issue(F, (Hbase) + (size_t)mr * 1024, Y, p0[r], p1[r], R[r]); }
__device__ __forceinline__ void phase_m1(const Fr& F, const Args& a, int layer) {
    unsigned char* ws = a.ws; const bf16_t* h = (const bf16_t*)(ws + WS_H); float* RS = (float*)(ws + WS_RSTD);
    int* asg = (int*)(ws + WS_ASG);
    const bf16_t* wfb = (const bf16_t*)(ws + WS_RFRAG) + (size_t)layer * 32 * 9 * 512;
    unsigned* cnt = (unsigned*)(ws + WS_CTL) + CW_CNT + layer * 32 * 64;
    LAS float* Lg = (LAS float*)F.lds + F.wave * 1600;
    LAS float* Lr = Lg + 1536;
    for (int task = F.gw; task < NT / 32; task += F.ngw) {
        const int m0 = task * 32;
        f32x4 acc[2][3];
#pragma unroll
        for (int rb = 0; rb < 2; ++rb)
#pragma unroll
            for (int nt = 0; nt < 3; ++nt) acc[rb][nt] = (f32x4){0.f, 0.f, 0.f, 0.f};
        const int i = F.lane & 15, q = F.lane >> 4; const bf16_t* hr = h + (size_t)(m0 + i) * 1024 + 8 * q;
        float ss0 = 0.f, ss1 = 0.f;
#pragma unroll 4
        for (int s = 0; s < 32; ++s) {
            const bf16x8 a0 = *(const bf16x8*)(hr + 32 * s), a1 = *(const bf16x8*)(hr + 16 * 1024 + 32 * s);
            const bf16_t* wp = wfb + (size_t)s * 9 * 512 + F.lane * 8;
#pragma unroll
            for (int tn = 0; tn < 9; ++tn) { const bf16x8 b = *(const bf16x8*)(wp + tn * 512);
                acc[0][tn % 3] = __builtin_amdgcn_mfma_f32_16x16x32_bf16(a0, b, acc[0][tn % 3], 0, 0, 0); acc[1][tn % 3] = __builtin_amdgcn_mfma_f32_16x16x32_bf16(a1, b, acc[1][tn % 3], 0, 0, 0); }
            const u32x4 u0 = __builtin_bit_cast(u32x4, a0), u1 = __builtin_bit_cast(u32x4, a1);
#pragma unroll
            for (int e = 0; e < 4; ++e) { const float x0 = bflo(u0[e]), y0 = bfhi(u0[e]), x1 = bflo(u1[e]), y1 = bfhi(u1[e]); ss0 += x0 * x0 + y0 * y0; ss1 += x1 * x1 + y1 * y1; }
        }
        {
            auto r16 = __builtin_amdgcn_permlane16_swap(__float_as_uint(ss0), __float_as_uint(ss0), false, false); ss0 = __uint_as_float(r16[0]) + __uint_as_float(r16[1]);
            auto r32 = __builtin_amdgcn_permlane32_swap(__float_as_uint(ss0), __float_as_uint(ss0), false, false); ss0 = __uint_as_float(r32[0]) + __uint_as_float(r32[1]);
            r16 = __builtin_amdgcn_permlane16_swap(__float_as_uint(ss1), __float_as_uint(ss1), false, false); ss1 = __uint_as_float(r16[0]) + __uint_as_float(r16[1]);
            r32 = __builtin_amdgcn_permlane32_swap(__float_as_uint(ss1), __float_as_uint(ss1), false, false); ss1 = __uint_as_float(r32[0]) + __uint_as_float(r32[1]);
            const float rs0 = 1.f / sqrtf(ss0 * (1.f / 1024.f) + 1e-6f), rs1 = 1.f / sqrtf(ss1 * (1.f / 1024.f) + 1e-6f);
            if (F.lane < 16) { RS[m0 + i] = rs0; RS[m0 + 16 + i] = rs1; Lr[i] = rs0; Lr[16 + i] = rs1; }
        }
        LDS_WAIT(); asm volatile("" ::: "memory");
#pragma unroll
        for (int rb = 0; rb < 2; ++rb) { const f32x4 rs = *(const LAS f32x4*)(Lr + 16 * rb + 4 * q);
#pragma unroll
            for (int nt = 0; nt < 3; ++nt)
#pragma unroll
                for (int rg = 0; rg < 4; ++rg) Lg[(16 * rb + 4 * q + rg) * 48 + 16 * nt + i] = acc[rb][nt][rg] * rs[rg]; }
        LDS_WAIT(); asm volatile("" ::: "memory");
        if (F.lane < 32) {
            const int m = m0 + F.lane; const LAS float* lg = Lg + F.lane * 48;
            float gl[4]; float gmax = -3.0e38f; int grp = 0;
#pragma unroll
            for (int j = 0; j < 4; ++j) { gl[j] = lg[j] + a.in[I_MBG][layer * 4 + j]; if (gl[j] > gmax) { gmax = gl[j]; grp = j; } }
            float gs = 0.f;
#pragma unroll
            for (int j = 0; j < 4; ++j) gs += __expf(gl[j] - gmax);
            const float grp_w = 1.f / gs;
            float v1 = -3.0e38f, v2 = -3.0e38f; int i1 = 0, i2 = 0;
            for (int j = 0; j < 8; ++j) { const float e = lg[4 + grp * 8 + j] + a.in[I_MBE][layer * 32 + grp * 8 + j];
                if (e > v1) { v2 = v1; i2 = i1; v1 = e; i1 = j; } else if (e > v2) { v2 = e; i2 = j; } }
            const float r2 = __expf(v2 - v1); const float w1 = grp_w / (1.f + r2), w2 = grp_w * r2 / (1.f + r2);
            const int e1 = grp * 8 + i1, e2 = grp * 8 + i2;
            const unsigned s1 = __hip_atomic_fetch_add(cnt + e1 * 64, 1u, __ATOMIC_RELAXED, __HIP_MEMORY_SCOPE_AGENT);
            const unsigned s2 = __hip_atomic_fetch_add(cnt + e2 * 64, 1u, __ATOMIC_RELAXED, __HIP_MEMORY_SCOPE_AGENT);
            int* r = asg + (size_t)m * 8; r[0] = e1; r[1] = e2; r[2] = (int)s1; r[3] = (int)s2; r[4] = __builtin_bit_cast(int, w1); r[5] = __builtin_bit_cast(int, w2);
        }
        LDS_WAIT(); asm volatile("" ::: "memory");
    }
}

__device__ __forceinline__ void phase_m2(const Fr& F, const Args& a, int layer) {
    unsigned char* ws = a.ws;
    int* asg = (int*)(ws + WS_ASG); float* roww = (float*)(ws + WS_ROWW);
    int* texp = (int*)(ws + WS_TEXP);
    unsigned* cnt = (unsigned*)(ws + WS_CTL) + CW_CNT + layer * 32 * 64;
    LAS int* sb = (LAS int*)F.lds;
    if (F.tid < 32) sb[64 + F.tid] = (int)__hip_atomic_load(cnt + F.tid * 64, __ATOMIC_RELAXED, __HIP_MEMORY_SCOPE_AGENT);
    __syncthreads();
    if (F.tid == 0) { int acc = 0; for (int e = 0; e < 32; ++e) { sb[e] = acc; acc += (sb[64 + e] + 255) & ~255; } sb[32] = acc; }
    __syncthreads();
    if (blockIdx.x == 0) {
        const int ntiles = sb[32] >> 8;
        for (int t = F.tid; t < ntiles; t += 512) { int e = 0; for (int j = 1; j < 32; ++j) if ((t << 8) >= sb[j]) e = j; texp[t] = e; }
        if (F.tid == 0) texp[1023] = ntiles;
        if (F.tid < 8) { int n = 0; for (int q = 0; q < 4; ++q) { const int e = F.tid + 8 * q; for (int t = sb[e] >> 8; t < (sb[e + 1] >> 8); ++t) texp[2048 + F.tid * 640 + n++] = t | (e << 16); } texp[1008 + F.tid] = n; }
    }
    int* ridx = (int*)(ws + WS_RIDX); float* rowrs = (float*)(ws + WS_ROWRS); const float* RS = (const float*)(ws + WS_RSTD);
    for (int as = blockIdx.x * 512 + F.tid; as < NT * 2; as += F.G * 512) {
        const int m = as >> 1, k = as & 1; const int e = asg[m * 8 + k], slot = asg[m * 8 + 2 + k]; const int p = sb[e] + slot;
        ridx[p] = m; rowrs[p] = RS[m]; roww[p] = __builtin_bit_cast(float, asg[m * 8 + 4 + k]); asg[m * 8 + 6 + k] = p; }
    for (int idx = blockIdx.x * 512 + F.tid; idx < 32 * 256; idx += F.G * 512) {
        const int e = idx >> 8, r = idx & 255; const int p = sb[e] + sb[64 + e] + r;
        if (p < sb[e + 1]) { ridx[p] = 0; rowrs[p] = 0.f; roww[p] = 0.f; } }
}

__device__ __forceinline__ void phase_n1(const Fr& F, const Args& a) {
    unsigned char* ws = a.ws; bf16_t* H = (bf16_t*)(ws + WS_H); const bf16_t* Y = (const bf16_t*)(ws + WS_S1); const int* asg = (const int*)(ws + WS_ASG); float* RS = (float*)(ws + WS_RSTD);
    for (int m = F.gw; m < NT; m += RB * F.ngw) {
        ROWS_ISSUE(H)
#pragma unroll
        for (int r = 0; r < RB; ++r) { const int mr = m + r * F.ngw; if (mr < NT) {
            float v[16]; bf16_t* hrow = H + (size_t)mr * 1024; const float rstd = row_finish(R[r], v, rw0[r], rw1[r]);
#pragma unroll
            for (int j = 0; j < 2; ++j) *(u32x4*)(hrow + 512 * j + 8 * F.lane) = (u32x4){pk2(v[8 * j], v[8 * j + 1]), pk2(v[8 * j + 2], v[8 * j + 3]), pk2(v[8 * j + 4], v[8 * j + 5]), pk2(v[8 * j + 6], v[8 * j + 7])};
            if (F.lane == 0) RS[mr] = rstd; } }
    }
}
__device__ __forceinline__ void phase_final(const Fr& F, const Args& a) {
    unsigned char* ws = a.ws; const bf16_t* H = (const bf16_t*)(ws + WS_H); const bf16_t* Y = (const bf16_t*)(ws + WS_S1); const int* asg = (const int*)(ws + WS_ASG); const float* gain = a.in[I_FLN];
    for (int m = F.gw; m < NT; m += RB * F.ngw) {
        ROWS_ISSUE(H)
#pragma unroll
        for (int r = 0; r < RB; ++r) { const int mr = m + r * F.ngw; if (mr < NT) {
            float v[16]; const float rstd = row_finish(R[r], v, rw0[r], rw1[r]); float* orow = a.out + (size_t)mr * 1024;
#pragma unroll
            for (int j = 0; j < 2; ++j) { const int c = 512 * j + 8 * F.lane; const f32x4 g0 = *(const f32x4*)(gain + c), g1 = *(const f32x4*)(gain + c + 4);
                *(f32x4*)(orow + c) = (f32x4){v[8 * j] * rstd * g0.x, v[8 * j + 1] * rstd * g0.y, v[8 * j + 2] * rstd * g0.z, v[8 * j + 3] * rstd * g0.w};
                *(f32x4*)(orow + c + 4) = (f32x4){v[8 * j + 4] * rstd * g1.x, v[8 * j + 5] * rstd * g1.y, v[8 * j + 6] * rstd * g1.z, v[8 * j + 7] * rstd * g1.w}; } } }
    }
}

__device__ __forceinline__ void phase_cmp_gather(const Fr& F, const Args& a) {
    unsigned char* ws = a.ws; const bf16_t* KV = (const bf16_t*)(ws + WS_KV); bf16_t* AC = (bf16_t*)(ws + WS_ACMP);
    for (int r = F.gw; r < 2 * 16384; r += F.ngw) {
        const int grp = r >> 14, rr = r & 16383, bg = rr >> 7, n = rr & 127, b = bg >> 2, g = bg & 3;
        const float* pe = a.in[grp ? I_PEV : I_PEK] + (size_t)g * 32 * 64;
        bf16_t* dst = AC + (size_t)r * 2048;
        for (int l2 = 0; l2 < 16; ++l2) { const int l = 2 * l2 + (F.lane >> 5), d = 2 * (F.lane & 31);
            unsigned o = 0u;
            if (n < 127) { const unsigned kv = *(const unsigned*)(KV + (size_t)(b * SEQ + 16 * n + l) * 1536 + (grp * 4 + g) * 64 + d);
                o = pk2(bflo(kv) + pe[l * 64 + d], bfhi(kv) + pe[l * 64 + d + 1]); }
            *(unsigned*)(dst + l * 64 + d) = o; }
    }
}
__device__ __forceinline__ int perm16pos(int w) { return w < 4 ? w : (w < 8 ? w + 4 : (w < 12 ? w - 4 : w)); }
__device__ __forceinline__ void phase_cmp2(const Fr& F, const Args& a, int task0, int tstep, int tend) {
    unsigned char* ws = a.ws; const bf16_t* HC = (const bf16_t*)(ws + WS_HC); bf16_t* KCB = (bf16_t*)(ws + WS_KCB); bf16_t* VCT = (bf16_t*)(ws + WS_VCT); const bf16_t* WF = (const bf16_t*)(ws + WS_W2F);
    const int i = F.lane & 15, q = F.lane >> 4;
    for (int task = task0; task < tend; task += tstep) {
        const int r0 = task * 16, grp = r0 >> 14, rr = r0 & 16383, bg = rr >> 7, n0 = rr & 127;
        f32x4 acc[4];
#pragma unroll
        for (int nb = 0; nb < 4; ++nb) acc[nb] = (f32x4){0.f, 0.f, 0.f, 0.f};
        const bf16_t* hr = HC + (size_t)(r0 + i) * 256 + 8 * q; const bf16_t* wp = WF + (size_t)grp * 8 * 8 * 512 + F.lane * 8;
#pragma unroll
        for (int sk = 0; sk < 8; ++sk) { const bf16x8 av = *(const bf16x8*)(hr + 32 * sk);
#pragma unroll
            for (int tn = 0; tn < 8; ++tn) acc[tn & 3] = __builtin_amdgcn_mfma_f32_16x16x32_bf16(av, *(const bf16x8*)(wp + (sk * 8 + tn) * 512), acc[tn & 3], 0, 0, 0); }
#pragma unroll
        for (int nb = 0; nb < 4; ++nb) { const int col = 16 * nb + i; f32x4 v = acc[nb];
#pragma unroll
            for (int rg = 0; rg < 4; ++rg) if (n0 + 4 * q + rg == 127) v[rg] = 0.f;
            if (grp == 0) {
#pragma unroll
                for (int rg = 0; rg < 4; ++rg) KCB[((size_t)bg * 128 + n0 + 4 * q + rg) * 64 + col] = (bf16_t)f2bf(v[rg]); }
            else *(u32x2*)(VCT + ((size_t)bg * 64 + col) * 128 + n0 + perm16pos(4 * q)) = (u32x2){cvtpk(v[0], v[1]), cvtpk(v[2], v[3])}; }
    }
}
__device__ __forceinline__ void phase_vt(const Fr& F, const Args& a, int gw, int ngw) {
    unsigned char* ws = a.ws; const bf16_t* KV = (const bf16_t*)(ws + WS_KV); bf16_t* VT = (bf16_t*)a.out;
    LAS unsigned* T2 = (LAS unsigned*)(F.lds) + F.wave * 2080;
    for (int task = gw; task < 8192; task += ngw) {
        const int tile = task & 31, g = (task >> 5) & 3, pg = (task >> 7) & 1, b = task >> 8;
        const u32x4* src = (const u32x4*)(KV + (size_t)(b * SEQ + 64 * tile + F.lane) * 1536 + ((pg ? 5 : 3) * 4 + g) * 64);
#pragma unroll
        for (int i = 0; i < 8; ++i) { const u32x4 v = src[i]; T2[(4 * i + 0) * 65 + F.lane] = v.x; T2[(4 * i + 1) * 65 + F.lane] = v.y; T2[(4 * i + 2) * 65 + F.lane] = v.z; T2[(4 * i + 3) * 65 + F.lane] = v.w; }
        LDS_WAIT(); asm volatile("" ::: "memory");
        const int d = F.lane, dp = d >> 1; const bool hi = d & 1;
        u32x4* dst = (u32x4*)(VT + ((size_t)((b * 2 + pg) * 4 + g) * 64 + d) * 2048 + 64 * tile);
#pragma unroll
        for (int G = 0; G < 4; ++G) {
            unsigned e[16];
#pragma unroll
            for (int p = 0; p < 16; ++p) { const int key = 16 * G + ((p < 4) ? p : (p < 8) ? p + 4 : (p < 12) ? p - 4 : p); const unsigned u = T2[dp * 65 + key]; e[p] = hi ? (u >> 16) : (u & 0xffffu); }
            dst[2 * G] = (u32x4){e[0] | (e[1] << 16), e[2] | (e[3] << 16), e[4] | (e[5] << 16), e[6] | (e[7] << 16)};
            dst[2 * G + 1] = (u32x4){e[8] | (e[9] << 16), e[10] | (e[11] << 16), e[12] | (e[13] << 16), e[14] | (e[15] << 16)};
        }
        LDS_WAIT(); asm volatile("" ::: "memory");
    }
}
__device__ __forceinline__ void dma16(const void* g, LAS void* l) { __builtin_amdgcn_global_load_lds((const unsigned*)g, (LAS unsigned*)l, 16, 0, 0); }
#define ATT_NEG (-__builtin_inff())
__device__ __forceinline__ unsigned xor32u(unsigned x) { const auto r = __builtin_amdgcn_permlane32_swap(x, x, false, false); return (threadIdx.x & 32) ? r[0] : r[1]; }
__device__ __forceinline__ float xor32(float x) { return __uint_as_float(xor32u(__float_as_uint(x))); }
template <int KM>
__device__ __forceinline__ void att_fix(f32x16 (&S)[2], int dbase, unsigned maxd, bool colsel, const LAS float* dBl) {
#pragma unroll
    for (int blk = 0; blk < 2; ++blk) {
        float bv[16];
#pragma unroll
        for (int rr = 0; rr < 16; ++rr) { const int koff = 32 * blk + (rr & 3) + 8 * (rr >> 2); const unsigned di = min((unsigned)(dbase - KM * koff), 128u); bv[rr] = dBl[di]; }
#pragma unroll
        for (int rr = 0; rr < 16; ++rr) asm volatile("" : "+v"(bv[rr]));
#pragma unroll
        for (int rr = 0; rr < 16; ++rr) { const int koff = 32 * blk + (rr & 3) + 8 * (rr >> 2); const int dist = dbase - KM * koff;
            const bool ok = ((unsigned)dist < maxd) && colsel; S[blk][rr] = ok ? S[blk][rr] + bv[rr] : ATT_NEG; } }
}
template <int KM>
__device__ __forceinline__ void att_fixcb(f32x16& S, int dbase, const LAS float* dBl) {
    float bv[16];
#pragma unroll
    for (int rr = 0; rr < 16; ++rr) { const int koff = (rr & 3) + 8 * (rr >> 2); const unsigned di = min((unsigned)(dbase - KM * koff), 128u); bv[rr] = dBl[di]; }
#pragma unroll
    for (int rr = 0; rr < 16; ++rr) asm volatile("" : "+v"(bv[rr]));
#pragma unroll
    for (int rr = 0; rr < 16; ++rr) { const int koff = (rr & 3) + 8 * (rr >> 2); const int dist = dbase - KM * koff; S[rr] = (dist >= 0) ? S[rr] + bv[rr] : ATT_NEG; }
}
__device__ __forceinline__ void att_fix1(f32x16 (&S)[2], int dbase, unsigned maxd, const LAS float* bp) {
#pragma unroll
    for (int blk = 0; blk < 2; ++blk) {
        f32x4 bv[4];
#pragma unroll
        for (int q = 0; q < 4; ++q) bv[q] = *(const LAS f32x4*)(bp + 56 - 32 * blk - 8 * q);
#pragma unroll
        for (int q = 0; q < 4; ++q) asm volatile("" : "+v"(bv[q]));
#pragma unroll
        for (int rr = 0; rr < 16; ++rr) { const int koff = 32 * blk + (rr & 3) + 8 * (rr >> 2); const int dist = dbase - koff;
            S[blk][rr] = ((unsigned)dist < maxd) ? S[blk][rr] + bv[rr >> 2][3 - (rr & 3)] : ATT_NEG; } }
}
__device__ __forceinline__ void att_scores(LAS unsigned char* ktile, const int (&aoff)[4], const bf16x8 (&qf)[4], f32x16 (&S)[2]) {
#pragma unroll
    for (int blk = 0; blk < 2; ++blk)
#pragma unroll
        for (int i = 0; i < 16; ++i) S[blk][i] = 0.f;
    bf16x8 kf[2][4];
#pragma unroll
    for (int s = 0; s < 4; ++s)
#pragma unroll
        for (int blk = 0; blk < 2; ++blk) kf[blk][s] = *(const LAS bf16x8*)(ktile + blk * 4096 + aoff[s]);
#pragma unroll
    for (int s = 0; s < 4; ++s) {
        S[0] = __builtin_amdgcn_mfma_f32_32x32x16_bf16(kf[0][s], qf[s], S[0], 0, 0, 0); S[1] = __builtin_amdgcn_mfma_f32_32x32x16_bf16(kf[1][s], qf[s], S[1], 0, 0, 0);
        __builtin_amdgcn_sched_barrier(0); }
}
__device__ __forceinline__ void att_scores_init(LAS unsigned char* ktile, const int (&aoff)[4], const bf16x8 (&qf)[4], f32x16 (&S)[2], const LAS float* ip) {
#pragma unroll
    for (int blk = 0; blk < 2; ++blk)
#pragma unroll
        for (int q = 0; q < 4; ++q) { const f32x4 v = *(const LAS f32x4*)(ip + 32 * blk + 8 * q); S[blk][4 * q] = v.x; S[blk][4 * q + 1] = v.y; S[blk][4 * q + 2] = v.z; S[blk][4 * q + 3] = v.w; }
    bf16x8 kf[2][4];
#pragma unroll
    for (int s = 0; s < 4; ++s)
#pragma unroll
        for (int blk = 0; blk < 2; ++blk) kf[blk][s] = *(const LAS bf16x8*)(ktile + blk * 4096 + aoff[s]);
#pragma unroll
    for (int s = 0; s < 4; ++s) {
        S[0] = __builtin_amdgcn_mfma_f32_32x32x16_bf16(kf[0][s], qf[s], S[0], 0, 0, 0); S[1] = __builtin_amdgcn_mfma_f32_32x32x16_bf16(kf[1][s], qf[s], S[1], 0, 0, 0);
        __builtin_amdgcn_sched_barrier(0); }
}
__device__ __forceinline__ void att_pv(LAS unsigned char* vtile, const int (&aoff)[4], const f32x16 (&P)[2], f32x16 (&O)[2]) {
    bf16x8 pb[2][2];
#pragma unroll
    for (int blk = 0; blk < 2; ++blk)
#pragma unroll
        for (int s2 = 0; s2 < 2; ++s2) pb[blk][s2] = pack8f(P[blk][8 * s2], P[blk][8 * s2 + 1], P[blk][8 * s2 + 2], P[blk][8 * s2 + 3], P[blk][8 * s2 + 4], P[blk][8 * s2 + 5], P[blk][8 * s2 + 6], P[blk][8 * s2 + 7]);
#pragma unroll
    for (int dt = 0; dt < 2; ++dt)
#pragma unroll
        for (int blk = 0; blk < 2; ++blk)
#pragma unroll
            for (int s2 = 0; s2 < 2; ++s2) { const bf16x8 A = *(const LAS bf16x8*)(vtile + dt * 4096 + aoff[2 * blk + s2]); O[dt] = __builtin_amdgcn_mfma_f32_32x32x16_bf16(A, pb[blk][s2], O[dt], 0, 0, 0); }
}
#define ATT_LHI 1.8446744e19f
#define ATT_TBL_NEG (4 * 2832)
#define ATT_TBL_ZERO (4 * 2832 + 64)
__device__ __forceinline__ float att_colmax(const f32x16 (&S)[2]) {
    float mx = S[0][0];
#pragma unroll
    for (int blk = 0; blk < 2; ++blk)
#pragma unroll
        for (int rr = 0; rr < 16; ++rr) mx = fmaxf(mx, S[blk][rr]);
    return fmaxf(mx, xor32(mx));
}
__device__ __forceinline__ void att_tile(LAS unsigned char* tile, const int (&aoff)[4], const bf16x8 (&qf)[4], f32x16 (&O)[2], float& m, float& l, bool& pending, bool& shifted,
                                         int fixmode, int dbase, bool colsel, const LAS float* dBl, const LAS float* tblbase) {
    f32x16 S[2];
    const LAS float* ip = colsel ? (fixmode == 2 ? dBl - dbase : tblbase + ATT_TBL_ZERO) : tblbase + ATT_TBL_NEG;
    if (fixmode == 0) att_scores(tile, aoff, qf, S); else att_scores_init(tile, aoff, qf, S, ip);
    if (shifted) { S[0] = S[0] - m; S[1] = S[1] - m; }
    if (pending) {
        const float mxc = att_colmax(S); const float dl = (mxc > -1e29f && fabsf(mxc) > 32.f) ? mxc : 0.f;
        if (__any(dl != 0.f)) { m += dl; S[0] = S[0] - dl; S[1] = S[1] - dl; shifted = true; }
        pending = false;
    }
    float ln = l;
#pragma unroll
    for (int blk = 0; blk < 2; ++blk)
#pragma unroll
        for (int rr = 0; rr < 16; ++rr) { const float p = __builtin_amdgcn_exp2f(S[blk][rr]); S[blk][rr] = p; ln += p; }
    if (__any(ln > ATT_LHI)) {
        if (fixmode == 0) att_scores(tile, aoff, qf, S); else att_scores_init(tile, aoff, qf, S, ip);
        if (shifted) { S[0] = S[0] - m; S[1] = S[1] - m; }
        const float mxc = att_colmax(S), lnc = fmaxf(ln, xor32(ln));
        const float dl = (lnc > ATT_LHI) ? fmaxf(mxc, 32.f) : 0.f, corr = __builtin_amdgcn_exp2f(-dl);
        m += dl; l *= corr; O[0] = O[0] * corr; O[1] = O[1] * corr; S[0] = S[0] - dl; S[1] = S[1] - dl; shifted = true;
        ln = l;
#pragma unroll
        for (int blk = 0; blk < 2; ++blk)
#pragma unroll
            for (int rr = 0; rr < 16; ++rr) { const float p = __builtin_amdgcn_exp2f(S[blk][rr]); S[blk][rr] = p; ln += p; }
    }
    l = ln;
    att_pv(tile + 8192, aoff, S, O);
}
__device__ const unsigned char ATT_QOFF[16] = {29, 2, 18, 29, 2, 8, 26, 6, 26, 13, 18, 19, 8, 13, 6, 19};
__device__ __forceinline__ void phase_attn(const Fr& F, const Args& a) {
    unsigned char* ws = a.ws;
    const bf16_t* QB = (const bf16_t*)(ws + WS_Q); const unsigned char* KV = ws + WS_KV; const unsigned char* VT = (const unsigned char*)a.out; const float* GT = (const float*)(ws + WS_GATES);
    const unsigned char* KCB = ws + WS_KCB; const unsigned char* VCT = ws + WS_VCT; bf16_t* OB = (bf16_t*)(ws + WS_OATT);
    LAS unsigned char* RING = F.lds; LAS unsigned char* CMPA = F.lds + 65536; LAS float* dB = (LAS float*)(F.lds + 98304);
    const int w = F.wave, lane = F.lane, r = lane & 31, h = lane >> 5, hh = lane & 3, tl = r >> 2, swz = (r >> 1) & 7;
    int aoff[4];
#pragma unroll
    for (int s = 0; s < 4; ++s) aoff[s] = r * 128 + (((2 * s + h) ^ swz) * 16);
    const int drow = 8 * w + (lane >> 3), dchunk = ((lane & 7) ^ ((drow >> 1) & 7)) * 16;
    const LAS float* dBl = dB + hh * 132;
    LAS float* DB4 = (LAS float*)(F.lds + 102400);
    const LAS float* dB4l = DB4 + hh * 2832 + (tl & 3) * 708 + (tl & 3) + 576;
    int gprev = -1;
    const bool xcdord = F.G == 256;
    for (int unit = blockIdx.x, uk = 0; xcdord ? uk < 16 : unit < 4096; unit += F.G, ++uk) {
        const int qrot = (int)((blockIdx.x >> 3) + ATT_QOFF[uk & 15]) & 31;
        const int bg = xcdord ? (int)(blockIdx.x & 7) + 8 * uk : unit & 127, qt = xcdord ? (((42232u >> (uk & 15)) & 1u) ? 31 - qrot : qrot) : (unit >> 7) ^ ((unit >> 8) & 1);
        const int b = bg >> 2, g = bg & 3, t0 = 64 * qt;
        __syncthreads();
        if (g != gprev) for (int i = F.tid; i < 4 * 129; i += 512) { const int hq = i / 129, d = i % 129;
            dB[hq * 132 + d] = (d < 128) ? (a.in[I_RELB][BKT[d] * 16 + 4 * g + hq] - a.in[I_RELB][31 * 16 + 4 * g + hq]) * 1.44269504089f : 0.f; }
        if (g != gprev) for (int i = F.tid; i < 4 * 2832 + 128; i += 512) { const int hq = i / 2832, rem = i % 2832, cc = rem / 708, d = 576 - (rem % 708 - cc);
            float v;
            if (i >= 4 * 2832) v = (i < 4 * 2832 + 64) ? ATT_NEG : 0.f;
            else v = (d < 0 || d >= 512) ? ATT_NEG : (d < 128 ? (a.in[I_RELB][BKT[d] * 16 + 4 * g + hq] - a.in[I_RELB][31 * 16 + 4 * g + hq]) * 1.44269504089f : 0.f);
            DB4[i] = v; }
        gprev = g;
        const unsigned char* kwin = KV + ((size_t)(b * SEQ) * 1536 + (16 + g) * 64) * 2; const unsigned char* ksel = KV + ((size_t)(b * SEQ) * 1536 + (8 + g) * 64) * 2;
        const unsigned char* vsel = VT + ((size_t)((b * 2 + 0) * 4 + g) * 64) * 4096; const unsigned char* vwin = VT + ((size_t)((b * 2 + 1) * 4 + g) * 64) * 4096;
        const int nwin = min(qt, 8) + 1, ktlo = qt - nwin + 1, nst = nwin + qt + 1, ncmp = (qt >= 16) ? 2 : 1;
#define ATT_STAGE(i_, buf_) do { const int _i = (i_); const bool _isw = _i < nwin; const int _kt = _isw ? qt - _i : _i - nwin; \
            const unsigned char* _kp = (_isw ? kwin : ksel) + ((size_t)(64 * _kt + drow) * 1536) * 2 + dchunk; \
            const unsigned char* _vp = (_isw ? vwin : vsel) + (size_t)drow * 4096 + (size_t)_kt * 128 + dchunk; \
            dma16(_kp, (buf_) + w * 1024); dma16(_vp, (buf_) + 8192 + w * 1024); } while (0)
        for (int i = 0; i < ncmp; ++i) { dma16(KCB + ((size_t)(bg * 128 + 64 * i + drow) * 64) * 2 + dchunk, CMPA + i * 8192 + w * 1024);
            dma16(VCT + ((size_t)(bg * 64 + drow) * 128) * 2 + i * 128 + dchunk, CMPA + 16384 + i * 8192 + w * 1024); }
        const int tcol = t0 + 8 * w + tl; const size_t mtok = (size_t)b * SEQ + tcol; const int head = 4 * g + hh;
        bf16x8 qf[4];
#pragma unroll
        for (int s = 0; s < 4; ++s) qf[s] = *(const bf16x8*)(QB + mtok * 1024 + head * 64 + 16 * s + 8 * h);
        const float g0 = GT[mtok * 48 + head * 3 + 0], g1 = GT[mtok * 48 + head * 3 + 1], g2 = GT[mtok * 48 + head * 3 + 2];
        asm volatile("s_waitcnt vmcnt(0)" ::: "memory"); __syncthreads();
        ATT_STAGE(0, RING); ATT_STAGE(1, RING + 16384); if (nst > 2) ATT_STAGE(2, RING + 32768);
        f32x16 OUT[2], O[2];
        unsigned selmask;
        {
            f32x16 C[4];
            att_scores(CMPA, aoff, qf, *(f32x16 (*)[2])&C[0]);
            if (ncmp == 2) att_scores(CMPA + 8192, aoff, qf, *(f32x16 (*)[2])&C[2]);
            else {
#pragma unroll
                for (int i = 0; i < 16; ++i) { C[2][i] = ATT_NEG; C[3][i] = ATT_NEG; } }
#pragma unroll
            for (int cb = 0; cb < 4; ++cb) { const int tw = t0 + 8 * w, lo = tw - 31 - 16 * (32 * cb + 31), hi = tw + 7 - 31 - 512 * cb;
                if (cb < 2 * ncmp && lo < 128) {
                    if (hi < 0) {
#pragma unroll
                        for (int i = 0; i < 16; ++i) C[cb][i] = ATT_NEG; }
                    else att_fixcb<16>(C[cb], tcol - 31 - 64 * h - 512 * cb, dBl); } }
            float mx = C[0][0];
#pragma unroll
            for (int cb = 0; cb < 4; ++cb)
#pragma unroll
                for (int rr = 0; rr < 16; ++rr) mx = fmaxf(mx, C[cb][rr]);
            mx = fmaxf(mx, xor32(mx)); mx = fmaxf(mx, -1e30f);
            float ls = 0.f;
#pragma unroll
            for (int cb = 0; cb < 4; ++cb)
#pragma unroll
                for (int rr = 0; rr < 16; ++rr) { const float p = __builtin_amdgcn_exp2f(C[cb][rr] - mx); C[cb][rr] = p; ls += p; }
            ls += xor32(ls);
            const float inv = ls > 0.f ? 1.f / ls : 0.f;
#pragma unroll
            for (int cb = 0; cb < 4; ++cb) C[cb] = C[cb] * inv;
#pragma unroll
            for (int i = 0; i < 16; ++i) { OUT[0][i] = 0.f; OUT[1][i] = 0.f; }
            att_pv(CMPA + 16384, aoff, *(const f32x16 (*)[2])&C[0], OUT);
            if (ncmp == 2) att_pv(CMPA + 16384 + 8192, aoff, *(const f32x16 (*)[2])&C[2], OUT);
            OUT[0] = OUT[0] * g0; OUT[1] = OUT[1] * g0;
            if (qt <= 7) selmask = (2u << qt) - 1u;
            else {
                float imp[16], lastv[16];
#pragma unroll
                for (int cb = 0; cb < 4; ++cb)
#pragma unroll
                    for (int rq = 0; rq < 4; ++rq) { imp[4 * cb + rq] = (C[cb][4 * rq] + C[cb][4 * rq + 1]) + (C[cb][4 * rq + 2] + C[cb][4 * rq + 3]); lastv[4 * cb + rq] = C[cb][4 * rq + 3]; }
                unsigned key[16];
#pragma unroll
                for (int q = 0; q < 16; ++q) lastv[q] = xor32(lastv[q]);
#pragma unroll
                for (int q = 0; q < 16; ++q) { const float prev = (q >= 1) ? lastv[q - 1] : 0.f; float v = imp[q] + (h ? lastv[q] : prev);
                    v += dppf<DPP_XOR1>(v); v += dppf<DPP_XOR2>(v);
                    const int j = 2 * q + h; const bool cand = (j >= 1) && (j <= qt - 2);
                    key[q] = cand ? ((__builtin_bit_cast(unsigned, v) & ~31u) | (unsigned)(31 - j)) : 0u; }
                selmask = 1u | (1u << qt) | (1u << (qt - 1));
#pragma unroll 1
                for (int rnd = 0; rnd < 5; ++rnd) {
                    unsigned best = 0u;
#pragma unroll
                    for (int q = 0; q < 16; ++q) best = max(best, key[q]);
                    best = max(best, xor32u(best));
                    if (best != 0u) selmask |= 1u << (31 - (best & 31u));
#pragma unroll
                    for (int q = 0; q < 16; ++q) key[q] = (key[q] == best) ? 0u : key[q];
                }
            }
        }
        unsigned wor = selmask; wor |= (unsigned)__shfl_xor((int)wor, 4); wor |= (unsigned)__shfl_xor((int)wor, 8); wor |= (unsigned)__shfl_xor((int)wor, 16);
        wor = (unsigned)__builtin_amdgcn_readfirstlane((int)wor);
        unsigned wand = selmask; wand &= (unsigned)__shfl_xor((int)wand, 4); wand &= (unsigned)__shfl_xor((int)wand, 8); wand &= (unsigned)__shfl_xor((int)wand, 16);
        wand = (unsigned)__builtin_amdgcn_readfirstlane((int)wand);
        float m = 0.f, l = 0.f; bool pending = true, shifted = false;
        unsigned wall = 0xffffffffu; asm volatile("" : "+s"(wall));
#pragma unroll
        for (int i = 0; i < 16; ++i) { O[0][i] = 0.f; O[1][i] = 0.f; }
#define ATT_FINALIZE(gate_) do { const float _lt = l + xor32(l); const float _sc = _lt > 0.f ? (gate_) / _lt : 0.f; \
            OUT[0] = OUT[0] + O[0] * _sc; OUT[1] = OUT[1] + O[1] * _sc; m = 0.f; l = 0.f; pending = true; shifted = false; \
            _Pragma("unroll") for (int _i = 0; _i < 16; ++_i) { O[0][_i] = 0.f; O[1][_i] = 0.f; } } while (0)
#define ATT_TILE_SYNC(i_) do { const int _ahead = nst - 1 - (i_); \
            if (_ahead >= 2) asm volatile("s_waitcnt vmcnt(4) lgkmcnt(0)" ::: "memory"); else if (_ahead == 1) asm volatile("s_waitcnt vmcnt(2) lgkmcnt(0)" ::: "memory"); else asm volatile("s_waitcnt vmcnt(0) lgkmcnt(0)" ::: "memory"); \
            __builtin_amdgcn_s_barrier(); asm volatile("" ::: "memory"); \
            if ((i_) + 3 < nst) ATT_STAGE((i_) + 3, RING + (((i_) + 3) & 3) * 16384); } while (0)
#pragma unroll 1
        for (int i = 0; i < nwin; ++i) {
            ATT_TILE_SYNC(i);
            const int kt = qt - i; const int fm = (kt >= qt - 2 || kt == qt - 8) ? 2 : 0;
            if ((wall >> i) & 1u)
            att_tile(RING + (i & 3) * 16384, aoff, qf, O, m, l, pending, shifted, fm, tcol - 64 * kt - 4 * h, true, dB4l, DB4);
        }
        ATT_FINALIZE(g2);
#pragma unroll 1
        for (int i = nwin; i < nst; ++i) {
            ATT_TILE_SYNC(i);
            const int j = i - nwin;
            if ((wor >> j) & 1u) { const bool cs = (selmask >> j) & 1u; const int fm = (j >= qt - 2) ? 2 : (((wand >> j) & 1u) ? 0 : 1);
                att_tile(RING + (i & 3) * 16384, aoff, qf, O, m, l, pending, shifted, fm, tcol - 64 * j - 4 * h, cs, dB4l, DB4); }
        }
#undef ATT_TILE_SYNC
        ATT_FINALIZE(g1);
        bf16_t* orow = OB + mtok * 1024 + head * 64 + 4 * h;
#pragma unroll
        for (int dt = 0; dt < 2; ++dt)
#pragma unroll
            for (int rq = 0; rq < 4; ++rq) { u32x2 v; v.x = cvtpk(OUT[dt][4 * rq], OUT[dt][4 * rq + 1]); v.y = cvtpk(OUT[dt][4 * rq + 2], OUT[dt][4 * rq + 3]); *(u32x2*)(orow + 32 * dt + 8 * rq) = v; }
#undef ATT_STAGE
#undef ATT_FINALIZE
    }
}
constexpr int LDS_BYTES = 155648;
constexpr int LDS_MISC = LDS_BYTES - 256;
constexpr int NPH = 21;

__global__ void __launch_bounds__(512, 2) fwd(Args a) {
    extern __shared__ __attribute__((aligned(16))) unsigned char lds_raw[];
    Fr F; F.lds = (LAS unsigned char*)lds_raw; F.tid = threadIdx.x; F.lane = F.tid & 63; F.wave = __builtin_amdgcn_readfirstlane(F.tid >> 6); F.G = gridDim.x;
    F.gw = blockIdx.x * 8 + F.wave; F.ngw = F.G * 8;
    unsigned char* ws = a.ws;
    volatile LAS unsigned* MISC = (volatile LAS unsigned*)(F.lds + LDS_MISC);
    if (F.tid < 64) MISC[F.tid] = 0u;
    __syncthreads();
    const int lo = a.ph_lo, hi = a.ph_hi;
    XcdBarrier bar; bar.bar = (unsigned*)(ws + WS_CTL) + CW_BAR; bar.x = 0; bar.st = nullptr;
    if (hi - lo > 1) bar = xcd_barrier_post((unsigned*)(ws + WS_CTL) + CW_BAR, MISC + 8);


#ifndef REPEAT_MASK
#define REPEAT_MASK 0u
#endif
#ifdef ONLY_PH
#define IN(k) ((k) == ONLY_PH && lo <= (k) && (k) < hi)
#else
#define IN(k) (lo <= (k) && (k) < hi)
#endif
#define REP(k) for (int _rep = 0; _rep < (((REPEAT_MASK >> (k)) & 1u) ? 2 : 1); ++_rep)
#define SEAM(k) do { if (IN(k) && IN((k) + 1)) xcd_barrier(bar); } while (0)
    using namespace pg8;
    const int c = (int)blockIdx.x;

    if (IN(0)) { phase_conv(F, a); if ((REPEAT_MASK >> 30) & 1u) { __syncthreads(); phase_conv(F, a); } phase_r1(F, a); if ((REPEAT_MASK >> 31) & 1u) { __syncthreads(); phase_r1(F, a); } }
    SEAM(0);
    if (IN(1)) REP(1) {
        { Gemm g{(const bf16_t*)(ws + WS_S0), (const bf16_t*)(ws + WS_WR), 1024, 1024, 0, 1 << 20, nullptr, 0}; StaticOrder S; S.init(NT, 1024, F.G, c); EpiBf16 E{(bf16_t*)(ws + WS_S3), 1024, 1.f, 1}; gemm_phase(F.lds, g, S, E);
#ifdef DUP_P1
        gemm_phase(F.lds, g, S, E);
#endif
        }
        { Gemm g{(const bf16_t*)(ws + WS_S1), (const bf16_t*)(ws + WS_WK), 1024, 1024, 0, 1 << 20, nullptr, 0}; StaticOrder S; S.init(NT, 1024, F.G, c); EpiBf16 E{(bf16_t*)(ws + WS_S4), 1024, 1.f, 1}; gemm_phase(F.lds, g, S, E); }
        { Gemm g{(const bf16_t*)(ws + WS_S2), (const bf16_t*)(ws + WS_WV), 1024, 1024, 0, 1 << 20, nullptr, 0}; StaticOrder S; S.init(NT, 1024, F.G, c); EpiBf16 E{(bf16_t*)a.out, 1024, 1.f, 1}; gemm_phase(F.lds, g, S, E); }
        { Gemm g{(const bf16_t*)(ws + WS_S5), (const bf16_t*)(ws + WS_WL1), 2048, 1024, 1, 16, nullptr, 0}; StaticOrder S; S.init(NT, 512, F.G, c); EpiLora1 E{(bf16_t*)((unsigned char*)a.out + 128 * MiB)}; gemm_phase(F.lds, g, S, E); }
    }
    SEAM(1);
    if (IN(2)) REP(2) {
        const bf16_t* T1 = (const bf16_t*)((unsigned char*)a.out + 128 * MiB);
        { int kwa = 128; asm volatile("" : "+s"(kwa));
          Gemm g{T1, (const bf16_t*)(ws + WS_W2WA), kwa, 512, 0, 1 << 20, nullptr, 0}; StaticOrder S; S.init(NT, 2048, F.G, c); EpiLora2WA E{(bf16_t*)(ws + WS_S0), (bf16_t*)(ws + WS_S1), a.in[I_AW0], a.in[I_AA0]}; gemm_phase(F.lds, g, S, E); }
        { Gemm g{T1 + 128, (const bf16_t*)(ws + WS_W2G), 256, 512, 0, 1 << 20, nullptr, 0}; StaticOrder S; S.init(NT, 1024, F.G, c); EpiBf16 E{(bf16_t*)(ws + WS_S2), 1024, 1.f, 1}; gemm_phase(F.lds, g, S, E); }
    }
    SEAM(2);
    if (IN(3)) REP(3) phase_scan(F, a);
    SEAM(3);
    if (IN(4)) REP(4) { Gemm g{(const bf16_t*)(ws + WS_S5), (const bf16_t*)(ws + WS_WO), 1024, 64, 0, 1 << 20, nullptr, 1}; StaticOrder S; S.init(NT, 1024, F.G, c); EpiResX E{a.in[I_X], (bf16_t*)(ws + WS_H)}; gemm_phase(F.lds, g, S, E);
#ifdef DUP_PH4
        gemm_phase(F.lds, g, S, E);
#endif
    }
    SEAM(4);
#define MOE_PHASES(layer, pb) \
    if (IN(pb)) phase_m1(F, a, layer); \
    SEAM(pb); \
    if (IN((pb) + 1)) phase_m2(F, a, layer); \
    SEAM((pb) + 1); \
    if (IN((pb) + 2)) REP((pb) + 2) { const int* texp = (const int*)(ws + WS_TEXP); Gemm g{(const bf16_t*)(ws + WS_H), (const bf16_t*)(ws + WS_BT1) + (size_t)(layer) * 32 * 1024 * 1024, 1024, 1024, 0, 1 << 20, (const int*)(ws + WS_RIDX), 0}; \
        MoeOrder S; S.init(texp, F.G, c); EpiMoe1 E{(bf16_t*)(ws + WS_S4), (const float*)(ws + WS_ROWRS)}; gemm_phase<EpiMoe1, MoeOrder, true>(F.lds, g, S, E); } \
    SEAM((pb) + 2); \
    if (IN((pb) + 3)) REP((pb) + 3) { const int* texp = (const int*)(ws + WS_TEXP); Gemm g{(const bf16_t*)(ws + WS_S4), (const bf16_t*)(ws + WS_BT2) + (size_t)(layer) * 32 * 1024 * 512, 512, 512, 0, 1 << 20, nullptr, 0}; \
        MoeOrder S; S.init(texp, F.G, c); EpiMoe2 E{(bf16_t*)(ws + WS_S1), (const float*)(ws + WS_ROWW)}; gemm_phase(F.lds, g, S, E); } \
    SEAM((pb) + 3);

    MOE_PHASES(0, 5)
    if (IN(9)) phase_n1(F, a);
    SEAM(9);
    if (IN(10)) REP(10) { Gemm g{(const bf16_t*)(ws + WS_H), (const bf16_t*)(ws + WS_WKVQG), 1024, 1024, 0, 1 << 20, nullptr, 0}; StaticOrder S; S.init(NT, 2816, F.G, c);
        EpiKvqg E{(bf16_t*)(ws + WS_KV), (bf16_t*)(ws + WS_Q), (float*)(ws + WS_GATES), (const float*)(ws + WS_RSTD)}; gemm_phase(F.lds, g, S, E); }
    SEAM(10);
    if (IN(11)) { if (F.G <= 128) phase_vt(F, a, F.gw, F.ngw); }
    if (F.G <= 128) SEAM(11);
    if (IN(12)) { Gemm g{(const bf16_t*)(ws + WS_KV), (const bf16_t*)(ws + WS_WC1), 2048, 64, 0, 1 << 20, (const int*)(ws + WS_CIDX), 2}; CmpOrder S{F.G, c}; EpiCmp E{(bf16_t*)(ws + WS_HC), (const float*)(ws + WS_PEBP)}; gemm_phase<EpiCmp, CmpOrder, true>(F.lds, g, S, E);
        if (F.G > 128 && c >= 128) phase_vt(F, a, (c - 128) * 8 + F.wave, (F.G - 128) * 8);
        if (F.G > 128 && c < 128) { __builtin_amdgcn_fence(__ATOMIC_ACQUIRE, "agent"); phase_cmp2(F, a, c * 16 + F.wave, 8, c * 16 + 16); } }
    if (F.G <= 128) SEAM(12);
    if (IN(13) && F.G <= 128) phase_cmp2(F, a, F.gw, F.ngw, 2048);
    SEAM(13);
    if (IN(14)) REP(14) phase_attn(F, a);
    SEAM(14);
    if (IN(15)) { Gemm g{(const bf16_t*)(ws + WS_OATT), (const bf16_t*)(ws + WS_WOB), 1024, 1024, 0, 1 << 20, nullptr, 0}; StaticOrder S; S.init(NT, 1024, F.G, c); EpiResH E{(bf16_t*)(ws + WS_H)}; gemm_phase(F.lds, g, S, E); }
    SEAM(15);
    MOE_PHASES(1, 16)
    if (IN(20)) phase_final(F, a);
#undef IN
#undef SEAM
}

extern "C" void kernel_launch(void* const* d_in, const int* in_sizes, int n_in, void* d_out, int out_size, void* d_ws, size_t ws_size, hipStream_t stream) {
    static int grid = 0;
    if (grid == 0) {
        if (n_in != 41 || out_size != NT * DM || ws_size < WS_NEED) { fprintf(stderr, "kernel_launch: unexpected problem (n_in %d, out %d, ws %zu); nothing launched\n", n_in, out_size, ws_size); grid = -1; return; }
        int dev = 0, cus = 0, per_cu = 0;
        if (hipGetDevice(&dev) != hipSuccess || hipDeviceGetAttribute(&cus, hipDeviceAttributeMultiprocessorCount, dev) != hipSuccess) { grid = -1; return; }
        if (hipFuncSetAttribute((const void*)fwd, hipFuncAttributeMaxDynamicSharedMemorySize, LDS_BYTES) != hipSuccess) { fprintf(stderr, "kernel_launch: hipFuncSetAttribute failed\n"); grid = -1; return; }
        if (hipOccupancyMaxActiveBlocksPerMultiprocessor(&per_cu, (const void*)fwd, 512, LDS_BYTES) != hipSuccess || per_cu < 1)
            fprintf(stderr, "kernel_launch: occupancy query reports %d workgroups per CU\n", per_cu);
        (void)hipGetLastError();
        grid = cus;
    }
    if (grid < 0) return;
    (void)hipMemsetAsync((char*)d_ws + WS_CTL, 0, CTL_BYTES, stream);
    Args a{};
    for (int i = 0; i < 41; ++i) a.in[i] = (const float*)d_in[i];
    a.out = (float*)d_out; a.ws = (unsigned char*)d_ws;
#if N_LAUNCH_MODE == 1
    a.ph_lo = 0; a.ph_hi = NPH;
    hipLaunchKernelGGL(fwd, dim3(grid), dim3(512), LDS_BYTES, stream, a);
#else
    for (int p = 0; p < NPH; ++p) { a.ph_lo = p; a.ph_hi = p + 1; hipLaunchKernelGGL(fwd, dim3(grid), dim3(512), LDS_BYTES, stream, a); }
#endif
}
```

```cpp
#include <hip/hip_runtime.h>
#include <cstdio>
#include <cstdint>

#define GAS __attribute__((address_space(1)))
#define LAS __attribute__((address_space(3)))
typedef unsigned short bf16_t;
typedef short bf16x8 __attribute__((ext_vector_type(8)));
typedef float f32x4 __attribute__((ext_vector_type(4)));
typedef float f32x2 __attribute__((ext_vector_type(2)));
typedef unsigned u32x4 __attribute__((ext_vector_type(4)));
typedef unsigned u32x2 __attribute__((ext_vector_type(2)));

#ifndef N_LAUNCH_MODE
#define N_LAUNCH_MODE 1
#endif

constexpr int NT = 65536, DM = 1024, SEQ = 2048, NB = 32;
constexpr int P_MAX = 139264;
constexpr size_t MiB = 1u << 20;
constexpr size_t WS_CTL = 0, CTL_BYTES = 1 * MiB;
constexpr size_t WS_RFRAG = 1 * MiB;
constexpr size_t WS_W2F = 3 * MiB;
constexpr size_t WS_CIDX = 3 * MiB + 256 * 1024;
constexpr size_t WS_PEBP = 3 * MiB + 512 * 1024;
constexpr size_t WS_PEB = 3 * MiB + 768 * 1024;
constexpr size_t WS_TEXP = 2 * MiB;
constexpr size_t WS_WR = 8 * MiB, WS_WK = 10 * MiB, WS_WV = 12 * MiB, WS_WO = 14 * MiB;
constexpr size_t WS_WL1 = 16 * MiB;
constexpr size_t WS_W2WA = 18 * MiB;
constexpr size_t WS_W2G = 19 * MiB;
constexpr size_t WS_WKVQG = 20 * MiB;
constexpr size_t WS_WOB = 26 * MiB;
constexpr size_t WS_WC1 = 28 * MiB;
constexpr size_t WS_BT1 = 32 * MiB;
constexpr size_t WS_BT2 = 160 * MiB;
constexpr size_t WS_S0 = 224 * MiB, WS_S1 = 352 * MiB, WS_S2 = 480 * MiB, WS_S3 = 608 * MiB, WS_S4 = 736 * MiB, WS_S5 = 864 * MiB;
constexpr size_t WS_GATES = 993 * MiB;
constexpr size_t WS_ASG = 1014 * MiB;
constexpr size_t WS_ROWW = 1016 * MiB;
constexpr size_t WS_RIDX = 1017 * MiB;
constexpr size_t WS_RSTD = 1018 * MiB;
constexpr size_t WS_ROWRS = 1019 * MiB;
constexpr size_t WS_H = WS_S0;
constexpr size_t WS_NEED = 1024 * MiB;
constexpr size_t WS_KV = 352 * MiB, WS_Q = 544 * MiB, WS_ACMP = 672 * MiB, WS_HC = 800 * MiB, WS_OATT = 816 * MiB;
constexpr size_t WS_KCB = 1006 * MiB, WS_VCT = 1008 * MiB;
constexpr int CW_BAR = 4096;
constexpr int CW_CNT = 16384;

typedef __bf16 bf16x2n __attribute__((ext_vector_type(2)));
__device__ __forceinline__ unsigned cvtpk(float lo, float hi) { const f32x2 v = {lo, hi}; return __builtin_bit_cast(unsigned, __builtin_convertvector(v, bf16x2n)); }
__device__ __forceinline__ unsigned f2bf(float f) { return cvtpk(f, f) & 0xffffu; }
__device__ __forceinline__ unsigned pk2(float lo, float hi) { return cvtpk(lo, hi); }
__device__ __forceinline__ float bflo(unsigned u) { return __builtin_bit_cast(float, u << 16); }
__device__ __forceinline__ float bfhi(unsigned u) { return __builtin_bit_cast(float, u & 0xffff0000u); }
__device__ __forceinline__ float bf2f(bf16_t b) { return __builtin_bit_cast(float, ((unsigned)b) << 16); }
template <int CTRL> __device__ __forceinline__ float dppf(float v) { return __int_as_float(__builtin_amdgcn_update_dpp(0, __float_as_int(v), CTRL, 0xf, 0xf, true)); }
#define DPP_XOR1 0xB1
#define DPP_XOR2 0x4E
#define DPP_HALF_MIRROR 0x141
#define DPP_MIRROR 0x140
#define DPP_ROR8 0x128
__device__ __forceinline__ float wave_sum(float v) {
    v += dppf<DPP_XOR1>(v); v += dppf<DPP_XOR2>(v); v += dppf<DPP_HALF_MIRROR>(v); v += dppf<DPP_MIRROR>(v);
    { const auto r = __builtin_amdgcn_permlane16_swap(__float_as_uint(v), __float_as_uint(v), false, false); v = __uint_as_float(r[0]) + __uint_as_float(r[1]); }
    { const auto r = __builtin_amdgcn_permlane32_swap(__float_as_uint(v), __float_as_uint(v), false, false); v = __uint_as_float(r[0]) + __uint_as_float(r[1]); }
    return v;
}
__device__ __forceinline__ float fexp_(float x) { return __builtin_amdgcn_exp2f(x * 1.44269504089f); }
__device__ __forceinline__ float sigmoidf_(float x) { return __builtin_amdgcn_rcpf(1.f + fexp_(-x)); }
__device__ __forceinline__ float tanhf_(float x) { return 1.f - 2.f * __builtin_amdgcn_rcpf(1.f + fexp_(2.f * x)); }
__device__ __forceinline__ float gelu_tanh_(float x) { return 0.5f * x * (1.f + tanhf_(0.7978845608f * (x + 0.044715f * x * x * x))); }
#define LDS_WAIT() asm volatile("s_waitcnt lgkmcnt(0)" ::: "memory")

__device__ const unsigned char BKT[129] = {0, 1, 2, 3, 4, 5, 6, 7, 8, 9, 10, 11, 12, 13, 14, 15, 16, 16, 16, 17, 17, 18, 18, 18, 19, 19, 19, 20, 20, 20, 20, 21, 21, 21, 21, 22, 22, 22, 22, 22, 23, 23, 23, 23, 23, 23, 24, 24, 24, 24, 24, 24, 25, 25, 25, 25, 25, 25, 25, 26, 26, 26, 26, 26, 26, 26, 26, 27, 27, 27, 27, 27, 27, 27, 27, 27, 27, 28, 28, 28, 28, 28, 28, 28, 28, 28, 28, 29, 29, 29, 29, 29, 29, 29, 29, 29, 29, 29, 29, 30, 30, 30, 30, 30, 30, 30, 30, 30, 30, 30, 30, 30, 30, 31, 31, 31, 31, 31, 31, 31, 31, 31, 31, 31, 31, 31, 31, 31, 31};

#define XB_TMO      128
#define XB_XCNT(j)  (256  + 64 * (j))
#define XB_XSUB(j)  (1280 + 64 * (j))
#define XB_XGEN(j)  (2304 + 64 * (j))
#define XB_TOP      3328
#define XB_TOPGEN   3392
#define XCD_BAR_WORDS 3456
#define XB_SPIN_CAP (1u << 22)
__device__ __forceinline__ unsigned xb_ld(unsigned* p)              { return __hip_atomic_load(p, __ATOMIC_RELAXED, __HIP_MEMORY_SCOPE_AGENT); }
__device__ __forceinline__ unsigned xb_add(unsigned* p, unsigned v) { return __hip_atomic_fetch_add(p, v, __ATOMIC_RELAXED, __HIP_MEMORY_SCOPE_AGENT); }
__device__ __forceinline__ unsigned xb_xcc_id() { return (unsigned)__builtin_amdgcn_s_getreg((3 << 11) | 20) & 0xFu; }
#define XB_SPIN(cond, bar) do { unsigned _sp = 0; while (cond) { __builtin_amdgcn_s_sleep(1); \
    if ((++_sp & 255u) == 0u) { if (xb_ld(&(bar)[XB_TMO])) break; if (_sp > XB_SPIN_CAP) { atomicAdd(&(bar)[XB_TMO], 1u); break; } } } } while (0)
struct XcdBarrier { unsigned* bar; unsigned x; volatile LAS unsigned* st; };
__device__ __forceinline__ XcdBarrier xcd_barrier_post(unsigned* bar, volatile LAS unsigned* st) {
    XcdBarrier b; b.bar = bar; b.x = xb_xcc_id(); b.st = st;
    if (threadIdx.x == 0) (void)xb_add(&bar[XB_XCNT(b.x)], 1u);
    return b;
}
__device__ __forceinline__ void xcd_barrier_complete(unsigned* bar, unsigned x, unsigned& nloc, unsigned& nx) {
    const unsigned G = gridDim.x * gridDim.y * gridDim.z;
    unsigned sum, cnt, mine, sp = 0u;
    for (;;) {
        sum = 0u; cnt = 0u; mine = 0u;
#pragma unroll
        for (unsigned j = 0; j < 16; ++j) { const unsigned c = xb_ld(&bar[XB_XCNT(j)]); sum += c; cnt += (c > 0u) ? 1u : 0u; mine = (j == x) ? c : mine; }
        if (sum == G) break;
        __builtin_amdgcn_s_sleep(1);
        if ((++sp & 255u) == 0u) { if (xb_ld(&bar[XB_TMO])) break; if (sp > XB_SPIN_CAP) { atomicAdd(&bar[XB_TMO], 1u); break; } }
    }
    nloc = mine > 0u ? mine : 1u; nx = cnt > 0u ? cnt : 1u;
}
__device__ __forceinline__ void xcd_barrier(const XcdBarrier& b) {
    asm volatile("s_waitcnt vmcnt(0)" ::: "memory");
    __syncthreads();
    if (threadIdx.x == 0) {
        unsigned* bar = b.bar;
        __builtin_amdgcn_s_waitcnt(0);
        unsigned nloc = b.st[0], nx = b.st[1];
        if (nloc == 0u) { xcd_barrier_complete(bar, b.x, nloc, nx); b.st[0] = nloc; b.st[1] = nx; }
        const unsigned old = xb_add(&bar[XB_XSUB(b.x)], 1u);
        const unsigned gen = old / nloc;
        if (old + 1u == (gen + 1u) * nloc) {
            __builtin_amdgcn_fence(__ATOMIC_RELEASE, "agent");
            asm volatile("s_waitcnt vmcnt(0)" ::: "memory");
            const unsigned og = xb_add(&bar[XB_TOP], 1u);
            const unsigned tg = og / nx;
            if (og + 1u == (tg + 1u) * nx) xb_add(&bar[XB_TOPGEN], 1u);
            else XB_SPIN(xb_ld(&bar[XB_TOPGEN]) == tg, bar);
            __builtin_amdgcn_fence(__ATOMIC_ACQUIRE, "agent");
            xb_add(&bar[XB_XGEN(b.x)], 1u);
            asm volatile("s_waitcnt vmcnt(0)" ::: "memory");
        } else {
            XB_SPIN(xb_ld(&bar[XB_XGEN(b.x)]) == gen, bar);
            __builtin_amdgcn_fence(__ATOMIC_ACQUIRE, "agent");
            asm volatile("s_waitcnt vmcnt(0)" ::: "memory");
        }
    }
    __syncthreads();
}

namespace pg8 {
constexpr int BM = 256, BK = 64, HALF = 128, HTB = HALF * BK * 2, STAGE_BYTES = 8 * HTB, NXCD = 8, WGM = 8;
__host__ __device__ __forceinline__ int lds_byte(int r, int c) { const int st = (r >> 4) * 2 + (c >> 5), rr = r & 15, cc = c & 31, ob = rr * 64 + cc * 2; return st * 1024 + (ob ^ (((ob >> 9) & 1) << 5)); }
__host__ __device__ __forceinline__ void stage_rc(int b, int& R, int& C) { const int st = b / 1024, sb = b % 1024, swz = sb ^ (((sb >> 9) & 1) << 5); R = (st >> 1) * 16 + swz / 64; C = (st & 1) * 32 + (swz % 64) / 2; }
__host__ __device__ __forceinline__ int perm32(int rho) { const int n = rho >> 4, i = rho & 15; return 8 * (i >> 2) + 4 * n + (i & 3); }
struct Unit { int pm, pn; };
struct Gemm { const bf16_t* A; const bf16_t* Bt; int K, lda, apad, kwrap; const int* gidx; int ahm; };
struct StaticOrder {
    int nM, nN, nwg, G, c;
    __device__ void init(int M, int N, int G_, int c_) { nM = M / BM; nN = N / BM; nwg = nM * nN; G = G_; c = c_; }
    __device__ bool next(int i, Unit& u) const {
        const long L = (long)i * G + c; if (L >= nwg) return false;
        int wgid = (int)L; { const int q = nwg / NXCD, r = nwg % NXCD, xcd = wgid % NXCD, off = wgid / NXCD; wgid = (xcd < r ? xcd * (q + 1) : r * (q + 1) + (xcd - r) * q) + off; }
        const int nig = WGM * nN, gid = wgid / nig, fm = gid * WGM, gsz = (nM - fm) < WGM ? (nM - fm) : WGM;
        u.pm = fm + ((wgid % nig) % gsz); u.pn = (wgid % nig) / gsz; return true;
    }
};
struct MoeOrder {
    const int* xl; int nunits, ncu, cu; mutable int pre;
    __device__ __forceinline__ void init(const int* texp, int G_, int c_) { const int x = c_ & 7; cu = c_ >> 3; ncu = G_ >> 3; xl = texp + 2048 + x * 640; nunits = texp[1008 + x] * 4; pre = (cu < nunits) ? xl[cu >> 2] : 0; }
    __device__ __forceinline__ bool next(int i, Unit& u) const {
        const int L = i * ncu + cu; if (L >= nunits) return false;
        const int ent = pre; u.pm = ent & 0xffff; u.pn = (ent >> 16) * 4 + (L & 3);
        const int L2 = L + ncu; pre = (L2 < nunits) ? xl[L2 >> 2] : 0; return true;
    }
};
struct CmpOrder {
    int G, c;
    __device__ bool next(int i, Unit& u) const { const long L = (long)i * G + c; if (L >= 128) return false; u.pm = (int)L; u.pn = (int)(L >> 6); return true; }
};

template <class Epi, class Sched, bool GATHER = false, bool ALIGN_EPI = true, bool SP2 = true>
__device__ __forceinline__ void gemm_phase(LAS unsigned char* lds, const Gemm g, const Sched& S, const Epi& E) {
    const int tid = threadIdx.x, wid = __builtin_amdgcn_readfirstlane(tid >> 6), lane = tid & 63, wr = wid >> 2, wc = wid & 3, fr = lane & 15, fq = lane >> 4;
    const int K = g.K, nt = K / BK, lda = g.lda, kwrap = g.kwrap;
    unsigned voffA[2], voffB[2];
#pragma unroll
    for (int i = 0; i < 2; ++i) { int R, C; stage_rc(tid * 16 + i * 8192, R, C); const int Rb = Epi::PERM ? ((R & ~31) + perm32(R & 31)) : R;
        voffA[i] = (unsigned)(R * lda + C) * 2u; voffB[i] = (unsigned)(Rb * K + C) * 2u; }
    const long kstep = (long)(BK * 2); const long kstepA = g.ahm == 2 ? 3072l : g.ahm ? (long)SEQ * 128 : kstep;
    const long hstepA = (long)HALF * lda * 2, hstepB = (long)HALF * K * 2;
    const long tstepB = 2 * hstepB;
    const unsigned ldsw = (unsigned)wid * 1024u;
    const int aoff = lds_byte(wr * 64 + fr, fq * 8), boff = lds_byte(wc * 32 + fr, fq * 8);
#define PG8_KOFFA(t) (((t) < kwrap) ? (long)(t) * kstepA : (long)((t) - kwrap) * kstepA - (long)lda * 2)
#define PG8_ATILE(pm) (g.ahm ? (const char*)g.A + ((long)((pm) >> 3) * (K / 64) * SEQ + (long)((pm) & 7) * 256) * 128 : (const char*)g.A + ((long)(pm) * 256 + (g.apad ? (((pm) >> 3) + 1) : 0)) * (long)lda * 2)
#define PG8_SA(b, h) (((b) * 2 + (h)) * HTB)
#define PG8_SB(b, h) ((4 + (b) * 2 + (h)) * HTB)
#define PG8_STAGE(bufoff, gbase, voff) do { _Pragma("unroll") for (int _i = 0; _i < 2; ++_i) \
        __builtin_amdgcn_global_load_lds((const unsigned*)((const char*)(gbase) + (voff)[_i]), (LAS unsigned*)(lds + (bufoff) + ldsw + _i * 8192), 16, 0, 0); } while (0)
#define PG8_STAGE_A(bufoff, nx, h, ko) do { if constexpr (GATHER) { _Pragma("unroll") for (int _i = 0; _i < 2; ++_i) \
            __builtin_amdgcn_global_load_lds((const unsigned*)((const char*)g.A + (ko) + ((nx) ? gon[h][_i] : goc[h][_i])), (LAS unsigned*)(lds + (bufoff) + ldsw + _i * 8192), 16, 0, 0); } \
        else PG8_STAGE(bufoff, ((nx) ? nA : cA) + (h) * hstepA + (ko), voffA); } while (0)
#define PG8_GIDX(dst, pm_) do { if constexpr (GATHER) { _Pragma("unroll") for (int _h = 0; _h < 2; ++_h) _Pragma("unroll") for (int _i = 0; _i < 2; ++_i) \
            dst[_h][_i] = (unsigned)g.gidx[(pm_) * 256 + _h * 128 + (int)(voffA[_i] / (unsigned)(lda * 2))] * (unsigned)(lda * 2) + voffA[_i] % (unsigned)(lda * 2); } } while (0)
#define PG8_LDA(dst, b, h) do { _Pragma("unroll") for (int m = 0; m < 4; ++m) _Pragma("unroll") for (int k = 0; k < 2; ++k) dst[m][k] = *(const LAS bf16x8*)(lds + PG8_SA(b, h) + aoff + m * 2048 + k * 1024); } while (0)
#define PG8_LDB(dst, b, h) do { _Pragma("unroll") for (int n = 0; n < 2; ++n) _Pragma("unroll") for (int k = 0; k < 2; ++k) dst[n][k] = *(const LAS bf16x8*)(lds + PG8_SB(b, h) + boff + n * 2048 + k * 1024); } while (0)
#define PG8_MMA(ai, bj, At, Bt) do { __builtin_amdgcn_s_setprio(1); _Pragma("unroll") for (int m = 0; m < 4; ++m) _Pragma("unroll") for (int n = 0; n < 2; ++n) _Pragma("unroll") for (int k = 0; k < 2; ++k) \
        acc[ai][bj][m][n] = __builtin_amdgcn_mfma_f32_16x16x32_bf16(Bt[n][k], At[m][k], acc[ai][bj][m][n], 0, 0, 0); __builtin_amdgcn_s_setprio(0); } while (0)
#define PG8_WAIT_V(n) asm volatile("s_waitcnt vmcnt(" #n ")" ::: "memory")
#define PG8_WAIT_L(n) asm volatile("s_waitcnt lgkmcnt(" #n ")" ::: "memory")
#define PG8_BAR __builtin_amdgcn_s_barrier()
#define PG8_SCHED __builtin_amdgcn_sched_barrier(0)
    Unit cur, nxt; int ui = 0;
    if (!S.next(0, cur)) return;
    f32x4 acc[2][2][4][2];
#pragma unroll
    for (int a = 0; a < 2; ++a)
#pragma unroll
        for (int b = 0; b < 2; ++b)
#pragma unroll
            for (int m = 0; m < 4; ++m)
#pragma unroll
                for (int n = 0; n < 2; ++n) acc[a][b][m][n] = (f32x4){0.f, 0.f, 0.f, 0.f};
    bf16x8 At[4][2], B0[2][2], B1[2][2];
    const char* cA = PG8_ATILE(cur.pm); const char* cB = (const char*)g.Bt + (long)cur.pn * tstepB; const char* nA = cA;
    unsigned goc[2][2], gon[2][2];
#pragma unroll
    for (int _h = 0; _h < 2; ++_h)
#pragma unroll
        for (int _i = 0; _i < 2; ++_i) { goc[_h][_i] = 0u; gon[_h][_i] = 0u; }
    PG8_GIDX(goc, cur.pm);
    if constexpr (SP2) {
        PG8_STAGE(PG8_SB(0, 0), cB, voffB); PG8_STAGE(PG8_SB(0, 1), cB + hstepB, voffB); PG8_STAGE_A(PG8_SA(0, 0), false, 0, 0); PG8_STAGE_A(PG8_SA(0, 1), false, 1, 0);
        if (wr == 1) PG8_BAR;
        PG8_WAIT_V(2); PG8_BAR;
        PG8_STAGE(PG8_SB(1, 0), cB + kstep, voffB); PG8_STAGE_A(PG8_SA(1, 0), false, 0, kstepA); PG8_STAGE(PG8_SB(1, 1), cB + hstepB + kstep, voffB);
        PG8_WAIT_V(6); PG8_BAR;
    } else {
        PG8_STAGE(PG8_SB(0, 0), cB, voffB); PG8_STAGE_A(PG8_SA(0, 0), false, 0, 0); PG8_STAGE(PG8_SB(0, 1), cB + hstepB, voffB); PG8_STAGE_A(PG8_SA(0, 1), false, 1, 0);
        if (wr == 1) PG8_BAR;
        PG8_WAIT_V(4); PG8_BAR;
        PG8_STAGE(PG8_SB(1, 0), cB + kstep, voffB); PG8_STAGE_A(PG8_SA(1, 0), false, 0, kstepA); PG8_STAGE(PG8_SB(1, 1), cB + hstepB + kstep, voffB);
        PG8_WAIT_V(6); PG8_BAR;
    }
    for (;;) {
        const bool has_next = S.next(ui + 1, nxt);
        nA = has_next ? PG8_ATILE(nxt.pm) : cA; const char* nB = has_next ? (const char*)g.Bt + (long)nxt.pn * tstepB : cB;
        if constexpr (GATHER) { if (has_next) PG8_GIDX(gon, nxt.pm); else {
#pragma unroll
            for (int _h = 0; _h < 2; ++_h)
#pragma unroll
                for (int _i = 0; _i < 2; ++_i) gon[_h][_i] = goc[_h][_i]; } }
#pragma unroll 1
        for (int t = 0; t < nt; t += 2) {
            const bool last = (t == nt - 2);
            const long k1 = PG8_KOFFA(t + 1), k2 = last ? 0 : PG8_KOFFA(t + 2), k3 = last ? kstepA : PG8_KOFFA(t + 3);
            const char* b2 = last ? nB : cB + (long)(t + 2) * kstep; const char* b3 = b2 + kstep;
            if constexpr (SP2) {
            PG8_LDB(B0, 0, 0); PG8_LDB(B1, 0, 1); PG8_SCHED; PG8_LDA(At, 0, 0); PG8_STAGE_A(PG8_SA(1, 1), false, 1, k1);
            PG8_WAIT_V(8); PG8_WAIT_L(0); PG8_BAR; PG8_MMA(0, 0, At, B0); PG8_MMA(0, 1, At, B1); PG8_BAR; PG8_SCHED;
            PG8_LDA(At, 0, 1); PG8_STAGE(PG8_SB(0, 0), b2, voffB); PG8_STAGE(PG8_SB(0, 1), b2 + hstepB, voffB); PG8_STAGE_A(PG8_SA(0, 0), last, 0, k2);
            PG8_WAIT_V(8); PG8_WAIT_L(0); PG8_BAR; PG8_MMA(1, 0, At, B0); PG8_MMA(1, 1, At, B1); PG8_BAR; PG8_SCHED;
            PG8_LDB(B0, 1, 0); PG8_LDB(B1, 1, 1); PG8_SCHED; PG8_LDA(At, 1, 0); PG8_STAGE_A(PG8_SA(0, 1), last, 1, k2);
            PG8_WAIT_V(8); PG8_WAIT_L(0); PG8_BAR; PG8_MMA(0, 0, At, B0); PG8_MMA(0, 1, At, B1); PG8_BAR; PG8_SCHED;
            PG8_LDA(At, 1, 1); PG8_STAGE(PG8_SB(1, 0), b3, voffB); PG8_STAGE(PG8_SB(1, 1), b3 + hstepB, voffB); PG8_STAGE_A(PG8_SA(1, 0), last, 0, k3);
            PG8_WAIT_V(8); PG8_WAIT_L(0); PG8_BAR; PG8_MMA(1, 0, At, B0); PG8_MMA(1, 1, At, B1); PG8_BAR; PG8_SCHED;
            } else {
            PG8_LDB(B0, 0, 0); PG8_SCHED; PG8_LDA(At, 0, 0); PG8_STAGE_A(PG8_SA(1, 1), false, 1, k1);
            PG8_WAIT_L(8); PG8_BAR; PG8_WAIT_L(0); PG8_MMA(0, 0, At, B0); PG8_BAR; PG8_SCHED;
            PG8_LDB(B1, 0, 1); PG8_STAGE(PG8_SB(0, 0), b2, voffB);
            PG8_BAR; PG8_WAIT_L(0); PG8_MMA(0, 1, At, B1); PG8_BAR;
            PG8_LDA(At, 0, 1); PG8_STAGE_A(PG8_SA(0, 0), last, 0, k2);
            PG8_BAR; PG8_WAIT_L(0); PG8_MMA(1, 0, At, B0); PG8_BAR; PG8_SCHED;
            PG8_STAGE(PG8_SB(0, 1), b2 + hstepB, voffB);
            PG8_WAIT_V(6); PG8_BAR; PG8_MMA(1, 1, At, B1); PG8_BAR;
            PG8_LDB(B0, 1, 0); PG8_SCHED; PG8_LDA(At, 1, 0); PG8_STAGE_A(PG8_SA(0, 1), last, 1, k2);
            PG8_WAIT_L(8); PG8_BAR; PG8_WAIT_L(0); PG8_MMA(0, 0, At, B0); PG8_BAR; PG8_SCHED;
            PG8_LDB(B1, 1, 1); PG8_STAGE(PG8_SB(1, 0), b3, voffB);
            PG8_BAR; PG8_WAIT_L(0); PG8_MMA(0, 1, At, B1); PG8_BAR;
            PG8_LDA(At, 1, 1); PG8_STAGE_A(PG8_SA(1, 0), last, 0, k3);
            PG8_BAR; PG8_WAIT_L(0); PG8_MMA(1, 0, At, B0); PG8_BAR; PG8_SCHED;
            PG8_STAGE(PG8_SB(1, 1), b3 + hstepB, voffB);
            PG8_WAIT_V(6); PG8_BAR; PG8_MMA(1, 1, At, B1); PG8_BAR;
            }
        }
        if constexpr (ALIGN_EPI) { if (wr == 0) PG8_BAR; }
        E(acc, cur, wr, wc, fr, fq);
        if (!has_next) break;
#pragma unroll
        for (int a = 0; a < 2; ++a)
#pragma unroll
            for (int b = 0; b < 2; ++b)
#pragma unroll
                for (int m = 0; m < 4; ++m)
#pragma unroll
                    for (int n = 0; n < 2; ++n) acc[a][b][m][n] = (f32x4){0.f, 0.f, 0.f, 0.f};
        cur = nxt; cA = nA; cB = nB; ++ui;
        if constexpr (GATHER) {
#pragma unroll
            for (int _h = 0; _h < 2; ++_h)
#pragma unroll
                for (int _i = 0; _i < 2; ++_i) goc[_h][_i] = gon[_h][_i]; }
        if constexpr (ALIGN_EPI) { if (wr == 1) PG8_BAR; }
    }
    PG8_WAIT_V(0);
    if constexpr (!ALIGN_EPI) { if (wr == 0) PG8_BAR; }
    PG8_BAR;
#undef PG8_STAGE_A
#undef PG8_GIDX
#undef PG8_KOFFA
#undef PG8_ATILE
#undef PG8_SA
#undef PG8_SB
#undef PG8_STAGE
#undef PG8_LDA
#undef PG8_LDB
#undef PG8_MMA
#undef PG8_WAIT_V
#undef PG8_WAIT_L
#undef PG8_BAR
#undef PG8_SCHED
}

#define EPI_LOOP_ROWS for (int ai = 0; ai < 2; ++ai) _Pragma("unroll") for (int m = 0; m < 4; ++m)
__device__ __forceinline__ u32x4 pack8(const f32x4 v0, const f32x4 v1) { u32x4 w; w.x = pk2(v0[0], v0[1]); w.y = pk2(v0[2], v0[3]); w.z = pk2(v1[0], v1[1]); w.w = pk2(v1[2], v1[3]); return w; }

__device__ __forceinline__ size_t hm_off(int row, int col) { return ((size_t)((row >> 11) * 16 + (col >> 6)) * SEQ + (row & 2047)) * 64 + (col & 63); }
struct EpiBf16 {
    static constexpr bool PERM = true;
    bf16_t* O; int ldc; float scale; int hm;
    __device__ __forceinline__ void operator()(const f32x4 (&acc)[2][2][4][2], const Unit& u, int wr, int wc, int fr, int fq) const {
        const int row0 = u.pm * BM + wr * 64 + fr, col0 = u.pn * BM + wc * 32 + 8 * fq;
#pragma unroll
        EPI_LOOP_ROWS { const int row = row0 + ai * HALF + m * 16;
#pragma unroll
            for (int bj = 0; bj < 2; ++bj) { bf16_t* p = hm ? O + hm_off(row, col0 + bj * HALF) : O + (size_t)row * ldc + col0 + bj * HALF;
                *(u32x4*)p = pack8(acc[ai][bj][m][0] * scale, acc[ai][bj][m][1] * scale); } }
    }
};
struct EpiLora1 {
    static constexpr bool PERM = true;
    bf16_t* O;
    __device__ __forceinline__ void operator()(const f32x4 (&acc)[2][2][4][2], const Unit& u, int wr, int wc, int fr, int fq) const {
        const int row0 = u.pm * BM + wr * 64 + fr, col0 = u.pn * BM + wc * 32 + 8 * fq;
#pragma unroll
        EPI_LOOP_ROWS { bf16_t* rowp = O + (size_t)(row0 + ai * HALF + m * 16) * 512 + col0;
#pragma unroll
            for (int bj = 0; bj < 2; ++bj) { const int c = col0 + bj * HALF; f32x4 v0 = acc[ai][bj][m][0], v1 = acc[ai][bj][m][1];
                if (c < 64) {
#pragma unroll
                    for (int j = 0; j < 4; ++j) { v0[j] = tanhf_(v0[j]); v1[j] = tanhf_(v1[j]); }
                } else if (c < 128) {
                } else if (c < 288) {
#pragma unroll
                    for (int j = 0; j < 4; ++j) { v0[j] = sigmoidf_(v0[j]); v1[j] = sigmoidf_(v1[j]); }
                } else { v0 = (f32x4){0.f, 0.f, 0.f, 0.f}; v1 = v0; }
                *(u32x4*)(rowp + bj * HALF) = pack8(v0, v1); } }
    }
};
struct EpiLora2WA {
    static constexpr bool PERM = true;
    bf16_t* LW; bf16_t* AA; const float* w0; const float* a0;
    __device__ __forceinline__ void operator()(const f32x4 (&acc)[2][2][4][2], const Unit& u, int wr, int wc, int fr, int fq) const {
        const int row0 = u.pm * BM + wr * 64 + fr; const bool isw = u.pn < 4; const int col0 = (u.pn & 3) * BM + wc * 32 + 8 * fq;
        bf16_t* O = isw ? LW : AA; const float* bias = isw ? w0 : a0; const float mul = isw ? -0.60653065971f : 1.0f;
#pragma unroll
        for (int bj = 0; bj < 2; ++bj) { const f32x4 b0 = *(const f32x4*)(bias + col0 + bj * HALF), b1 = *(const f32x4*)(bias + col0 + bj * HALF + 4);
#pragma unroll
            EPI_LOOP_ROWS { bf16_t* rowp = O + hm_off(row0 + ai * HALF + m * 16, col0 + bj * HALF); f32x4 v0 = acc[ai][bj][m][0] + b0, v1 = acc[ai][bj][m][1] + b1;
#pragma unroll
                for (int j = 0; j < 4; ++j) { v0[j] = mul * sigmoidf_(v0[j]); v1[j] = mul * sigmoidf_(v1[j]); }
                *(u32x4*)rowp = pack8(v0, v1); } }
    }
};
struct EpiResX {
    static constexpr bool PERM = true;
    const float* x; bf16_t* h;
    __device__ __forceinline__ void operator()(const f32x4 (&acc)[2][2][4][2], const Unit& u, int wr, int wc, int fr, int fq) const {
        const int row0 = u.pm * BM + wr * 64 + fr, col0 = u.pn * BM + wc * 32 + 8 * fq;
#pragma unroll
        for (int ai = 0; ai < 2; ++ai) {
            f32x4 xb[4][2][2];
#pragma unroll
            for (int m = 0; m < 4; ++m)
#pragma unroll
                for (int bj = 0; bj < 2; ++bj) { const float* p = x + (size_t)(row0 + ai * HALF + m * 16) * 1024 + col0 + bj * HALF; xb[m][bj][0] = *(const f32x4*)p; xb[m][bj][1] = *(const f32x4*)(p + 4); }
#pragma unroll
            for (int m = 0; m < 4; ++m) { const size_t off = (size_t)(row0 + ai * HALF + m * 16) * 1024 + col0;
#pragma unroll
                for (int bj = 0; bj < 2; ++bj) *(u32x4*)(h + off + bj * HALF) = pack8(acc[ai][bj][m][0] + xb[m][bj][0], acc[ai][bj][m][1] + xb[m][bj][1]); } }
    }
};
struct EpiResH {
    static constexpr bool PERM = true;
    bf16_t* h;
    __device__ __forceinline__ void operator()(const f32x4 (&acc)[2][2][4][2], const Unit& u, int wr, int wc, int fr, int fq) const {
        const int row0 = u.pm * BM + wr * 64 + fr, col0 = u.pn * BM + wc * 32 + 8 * fq;
        u32x4 hb[2][4][2];
#pragma unroll
        EPI_LOOP_ROWS { const size_t off = (size_t)(row0 + ai * HALF + m * 16) * 1024 + col0;
#pragma unroll
            for (int bj = 0; bj < 2; ++bj) hb[ai][m][bj] = *(const u32x4*)(h + off + bj * HALF); }
#pragma unroll
        EPI_LOOP_ROWS { const size_t off = (size_t)(row0 + ai * HALF + m * 16) * 1024 + col0;
#pragma unroll
            for (int bj = 0; bj < 2; ++bj) { const u32x4 b = hb[ai][m][bj];
                const f32x4 b0 = {bflo(b.x), bfhi(b.x), bflo(b.y), bfhi(b.y)}, b1 = {bflo(b.z), bfhi(b.z), bflo(b.w), bfhi(b.w)};
                *(u32x4*)(h + off + bj * HALF) = pack8(acc[ai][bj][m][0] + b0, acc[ai][bj][m][1] + b1); } }
    }
};
struct EpiKvqg {
    static constexpr bool PERM = true;
    bf16_t* KV; bf16_t* Q; float* GT; const float* rs;
    __device__ __forceinline__ void operator()(const f32x4 (&acc)[2][2][4][2], const Unit& u, int wr, int wc, int fr, int fq) const {
        const int row0 = u.pm * BM + wr * 64 + fr;
        float rsv[2][4];
#pragma unroll
        EPI_LOOP_ROWS rsv[ai][m] = rs[row0 + ai * HALF + m * 16];
        if (u.pn < 10) {
            const bool iskv = u.pn < 6; bf16_t* O = iskv ? KV : Q; const int ldc = iskv ? 1536 : 1024; const float sc = iskv ? 1.0f : 0.18033688011f;
            const int col0 = (iskv ? u.pn : u.pn - 6) * BM + wc * 32 + 8 * fq;
#pragma unroll
            EPI_LOOP_ROWS { const int row = row0 + ai * HALF + m * 16; const float scr_ = sc * rsv[ai][m]; bf16_t* rowp = O + (size_t)row * ldc + col0;
#pragma unroll
                for (int bj = 0; bj < 2; ++bj) *(u32x4*)(rowp + bj * HALF) = pack8(acc[ai][bj][m][0] * scr_, acc[ai][bj][m][1] * scr_); }
        } else {
            const int c0 = wc * 32 + 8 * fq;
            if (c0 < 48) {
#pragma unroll
                EPI_LOOP_ROWS { const int row = row0 + ai * HALF + m * 16; const float rr_ = rsv[ai][m]; float* rowp = GT + (size_t)row * 48 + c0; f32x4 v0 = acc[ai][0][m][0] * rr_, v1 = acc[ai][0][m][1] * rr_;
#pragma unroll
                    for (int j = 0; j < 4; ++j) { v0[j] = sigmoidf_(v0[j]); v1[j] = sigmoidf_(v1[j]); }
                    *(f32x4*)(rowp) = v0; *(f32x4*)(rowp + 4) = v1; }
            }
        }
    }
};
struct EpiMoe1 {
    static constexpr bool PERM = true;
    bf16_t* H; const float* rs;
    __device__ __forceinline__ void operator()(const f32x4 (&acc)[2][2][4][2], const Unit& u, int wr, int wc, int fr, int fq) const {
        const int row0 = u.pm * BM + wr * 64 + fr, col0 = (u.pn & 3) * 128 + wc * 32 + 8 * fq;
        float rsv[2][4];
#pragma unroll
        EPI_LOOP_ROWS rsv[ai][m] = rs[row0 + ai * HALF + m * 16];
#pragma unroll
        EPI_LOOP_ROWS { const int row = row0 + ai * HALF + m * 16; const float r_ = rsv[ai][m]; bf16_t* rowp = H + (size_t)row * 512 + col0; f32x4 v0, v1;
#pragma unroll
            for (int j = 0; j < 4; ++j) { const float g0 = acc[ai][0][m][0][j] * r_, g1 = acc[ai][0][m][1][j] * r_; v0[j] = g0 * sigmoidf_(g0) * (acc[ai][1][m][0][j] * r_); v1[j] = g1 * sigmoidf_(g1) * (acc[ai][1][m][1][j] * r_); }
            *(u32x4*)(rowp) = pack8(v0, v1); }
    }
};
struct EpiMoe2 {
    static constexpr bool PERM = true;
    bf16_t* Y; const float* roww;
    __device__ __forceinline__ void operator()(const f32x4 (&acc)[2][2][4][2], const Unit& u, int wr, int wc, int fr, int fq) const {
        const bool up = (fr & 8) != 0;
        const int rowb = u.pm * BM + wr * 64 + (fr & 7), colp = (u.pn & 3) * BM + wc * 64 + 8 * fq;
#pragma unroll
        EPI_LOOP_ROWS { const u32x4 a0 = pack8(acc[ai][0][m][0], acc[ai][0][m][1]), a1 = pack8(acc[ai][1][m][0], acc[ai][1][m][1]); u32x4 x1;
            x1.x = (unsigned)__builtin_amdgcn_update_dpp(0, (int)a1.x, 0x128, 0xf, 0xf, true); x1.y = (unsigned)__builtin_amdgcn_update_dpp(0, (int)a1.y, 0x128, 0xf, 0xf, true);
            x1.z = (unsigned)__builtin_amdgcn_update_dpp(0, (int)a1.z, 0x128, 0xf, 0xf, true); x1.w = (unsigned)__builtin_amdgcn_update_dpp(0, (int)a1.w, 0x128, 0xf, 0xf, true);
            bf16_t* r0p = Y + (size_t)(rowb + ai * HALF + m * 16) * 1024 + colp;
            *(u32x4*)(r0p + (up ? 32 : 0)) = up ? x1 : a0;
            *(u32x4*)(r0p + 8 * 1024 + (up ? 0 : 32)) = up ? a0 : x1; }
    }
};
struct EpiCmp {
    static constexpr bool PERM = true;
    bf16_t* O; const float* pb;
    __device__ __forceinline__ void operator()(const f32x4 (&acc)[2][2][4][2], const Unit& u, int wr, int wc, int fr, int fq) const {
        const int row0 = u.pm * BM + wr * 64 + fr, col0 = wc * 32 + 8 * fq;
        f32x4 bias[2][2][2];
#pragma unroll
        for (int ai = 0; ai < 2; ++ai)
#pragma unroll
            for (int bj = 0; bj < 2; ++bj)
#pragma unroll
                for (int hf = 0; hf < 2; ++hf) { const float* p = pb + (size_t)((u.pm >> 6) * 4 + ((2 * u.pm + ai) & 3)) * 256 + col0 + bj * HALF + 4 * hf;
                    bias[ai][bj][hf] = *(const f32x4*)p; }
#pragma unroll
        EPI_LOOP_ROWS { bf16_t* rowp = O + (size_t)(row0 + ai * HALF + m * 16) * 256 + col0;
#pragma unroll
            for (int bj = 0; bj < 2; ++bj) { f32x4 v0 = acc[ai][bj][m][0] + bias[ai][bj][0], v1 = acc[ai][bj][m][1] + bias[ai][bj][1];
#pragma unroll
                for (int j = 0; j < 4; ++j) { v0[j] = gelu_tanh_(v0[j]); v1[j] = gelu_tanh_(v1[j]); }
                *(u32x4*)(rowp + bj * HALF) = pack8(v0, v1); } }
    }
};
}

struct Args { const float* in[41]; float* out; unsigned char* ws; int ph_lo, ph_hi; };
enum { I_X = 0, I_ALN, I_AMU, I_AWR, I_AWK, I_AWV, I_AWO, I_AW0, I_AW1, I_AW2, I_AA0, I_AA1, I_AA2, I_AG1, I_AG2, I_AKK, I_AKA, I_ARK, I_ALNXW, I_ALNXB,
       I_KVLN, I_KVW, I_PEK, I_PEV, I_CKW1, I_CKW2, I_CVW1, I_CVW2, I_RELB, I_BLN, I_BWQG, I_BWO, I_MLN, I_MWG, I_MBG, I_MWE, I_MBE, I_MW1, I_MW3, I_MW2, I_FLN };

struct Fr { LAS unsigned char* lds; int tid, lane, wave, G, gw, ngw; };

__device__ __forceinline__ void tr_item(const float* W, int N, int Klim, int Nlim, int k0, int n0, bf16_t* out, long orow0, int ldo, int kout0,
                                        const float* sc, int scmode, LAS float* scr, int lane) {
    f32x4 ld[8];
#pragma unroll
    for (int i = 0; i < 8; ++i) { const int kk = 8 * i + (lane >> 3), k = k0 + kk, n = n0 + 4 * (lane & 7);
        ld[i] = (k < Klim && n < Nlim) ? *(const f32x4*)(W + (size_t)k * N + n) : (f32x4){0.f, 0.f, 0.f, 0.f}; }
#pragma unroll
    for (int i = 0; i < 8; ++i) { const int kk = 8 * i + (lane >> 3), k = k0 + kk; f32x4 v = ld[i];
        if (scmode && k < Klim) { const float sv = sc[k]; v = v * (scmode == 1 ? sv : 1.f - sv); }
        LAS float* d = scr + kk * 33 + 4 * (lane & 7); d[0] = v.x; d[1] = v.y; d[2] = v.z; d[3] = v.w; }
    LDS_WAIT(); asm volatile("" ::: "memory");
    const int c = lane & 7;
#pragma unroll
    for (int j = 0; j < 4; ++j) { const int n = (lane >> 3) + 8 * j; const LAS float* s = scr + (8 * c) * 33 + n;
        u32x4 o; o.x = pk2(s[0 * 33], s[1 * 33]); o.y = pk2(s[2 * 33], s[3 * 33]); o.z = pk2(s[4 * 33], s[5 * 33]); o.w = pk2(s[6 * 33], s[7 * 33]);
        *(u32x4*)(out + (size_t)(orow0 + n) * ldo + kout0 + 8 * c) = o; }
    LDS_WAIT(); asm volatile("" ::: "memory");
}
__device__ __forceinline__ void conv_mat(const Fr& F, const float* W, int K, int N, bf16_t* out, long orow0, int ldo, int kout0, const float* sc, int scmode, LAS float* scr) {
    const int nkb = (K + 63) / 64, nnb = (N + 31) / 32, nit = nkb * nnb;
    const int off = (int)((((size_t)(out + orow0 * (long)ldo + kout0)) >> 12) % (unsigned)F.ngw);
    for (int it = (F.gw + F.ngw - off) % F.ngw; it < nit; it += F.ngw) { const int kb = it / nnb, nb = it % nnb;
        tr_item(W, N, K, N, kb * 64, nb * 32, out, orow0 + nb * 32, ldo, kout0 + kb * 64, sc, scmode, scr, F.lane); }
}
__device__ __forceinline__ void zero_rect(const Fr& F, bf16_t* out, int rows, int cols8, int ldo) {
    const long tot = (long)rows * cols8;
    for (long i = (long)F.gw * 64 + F.lane; i < tot; i += (long)F.ngw * 64) { const long r = i / cols8, c = i % cols8; *(u32x4*)(out + r * ldo + c * 8) = (u32x4){0u, 0u, 0u, 0u}; }
}
__device__ __forceinline__ bf16x8 pack8c(const float (&v)[8]) { u32x4 w; w.x = cvtpk(v[0], v[1]); w.y = cvtpk(v[2], v[3]); w.z = cvtpk(v[4], v[5]); w.w = cvtpk(v[6], v[7]); return __builtin_bit_cast(bf16x8, w); }
__device__ __forceinline__ void phase_conv(const Fr& F, const Args& a) {
    unsigned char* ws = a.ws;
    LAS float* scr = (LAS float*)(F.lds + F.wave * 8704);
    const float* mu = a.in[I_AMU];
    conv_mat(F, a.in[I_AWR], 1024, 1024, (bf16_t*)(ws + WS_WR), 0, 1024, 0, nullptr, 0, scr);
    conv_mat(F, a.in[I_AWK], 1024, 1024, (bf16_t*)(ws + WS_WK), 0, 1024, 0, nullptr, 0, scr);
    conv_mat(F, a.in[I_AWV], 1024, 1024, (bf16_t*)(ws + WS_WV), 0, 1024, 0, nullptr, 0, scr);
    conv_mat(F, a.in[I_AWO], 1024, 1024, (bf16_t*)(ws + WS_WO), 0, 1024, 0, nullptr, 0, scr);
    {
        bf16_t* o = (bf16_t*)(ws + WS_WL1);
        conv_mat(F, a.in[I_AW1], 1024, 64, o, 0, 2048, 0, mu + 1 * 1024, 2, scr);    conv_mat(F, a.in[I_AW1], 1024, 64, o, 0, 2048, 1024, mu + 1 * 1024, 1, scr);
        conv_mat(F, a.in[I_AA1], 1024, 64, o, 64, 2048, 0, mu + 4 * 1024, 2, scr);   conv_mat(F, a.in[I_AA1], 1024, 64, o, 64, 2048, 1024, mu + 4 * 1024, 1, scr);
        conv_mat(F, a.in[I_AG1], 1024, 160, o, 128, 2048, 0, mu + 5 * 1024, 2, scr); conv_mat(F, a.in[I_AG1], 1024, 160, o, 128, 2048, 1024, mu + 5 * 1024, 1, scr);
        zero_rect(F, o + (size_t)288 * 2048, 224, 256, 2048);
    }
    {
        bf16_t* o = (bf16_t*)(ws + WS_W2WA);
        conv_mat(F, a.in[I_AW2], 64, 1024, o, 0, 128, 0, nullptr, 0, scr);
        zero_rect(F, o + 64, 1024, 8, 128);
        conv_mat(F, a.in[I_AA2], 64, 1024, o, 1024, 128, 64, nullptr, 0, scr);
        zero_rect(F, o + (size_t)1024 * 128, 1024, 8, 128);
    }
    {
        bf16_t* o = (bf16_t*)(ws + WS_W2G);
        conv_mat(F, a.in[I_AG2], 160, 1024, o, 0, 256, 0, nullptr, 0, scr);
        zero_rect(F, o + 192, 1024, 8, 256);
    }
    {
        bf16_t* o = (bf16_t*)(ws + WS_WKVQG);
        conv_mat(F, a.in[I_KVW], 1024, 1536, o, 0, 1024, 0, a.in[I_KVLN], 1, scr);
        conv_mat(F, a.in[I_BWQG], 1024, 1072, o, 1536, 1024, 0, a.in[I_BLN], 1, scr);
        zero_rect(F, o + (size_t)2624 * 1024, 192, 128, 1024);
    }
    conv_mat(F, a.in[I_BWO], 1024, 1024, (bf16_t*)(ws + WS_WOB), 0, 1024, 0, nullptr, 0, scr);
    conv_mat(F, a.in[I_CKW1], 2048, 256, (bf16_t*)(ws + WS_WC1), 0, 2048, 0, nullptr, 0, scr);
    conv_mat(F, a.in[I_CVW1], 2048, 256, (bf16_t*)(ws + WS_WC1) + (size_t)256 * 2048, 0, 2048, 0, nullptr, 0, scr);
    {
        bf16_t* o1 = (bf16_t*)(ws + WS_BT1); bf16_t* o2 = (bf16_t*)(ws + WS_BT2);
        for (int it = F.gw; it < 64 * 256; it += F.ngw) { const int mat = it >> 8, r = it & 255, kb = r >> 4, nb = r & 15, n0 = nb * 32;
            const long orow = (long)mat * 1024 + (n0 >> 7) * 256 + (n0 & 127);
            const float* gm = a.in[I_MLN] + (mat >> 5) * 1024;
            tr_item(a.in[I_MW1] + (size_t)mat * 1024 * 512, 512, 1024, 512, kb * 64, n0, o1, orow, 1024, kb * 64, gm, 1, scr, F.lane);
            tr_item(a.in[I_MW3] + (size_t)mat * 1024 * 512, 512, 1024, 512, kb * 64, n0, o1, orow + 128, 1024, kb * 64, gm, 1, scr, F.lane); }
        for (int it = F.gw; it < 64 * 256; it += F.ngw) { const int mat = it >> 8, r = it & 255, kb = r >> 5, nb = r & 31;
            tr_item(a.in[I_MW2] + (size_t)mat * 512 * 1024, 1024, 512, 1024, kb * 64, nb * 32, o2, (long)mat * 1024 + nb * 32, 512, kb * 64, nullptr, 0, scr, F.lane); }
    }
    {
        int* ci = (int*)(ws + WS_CIDX);
        for (int r = F.gw * 64 + F.lane; r < 2 * 16384; r += F.ngw * 64) { const int grp = r >> 14, rr = r & 16383, bg = rr >> 7, n = rr & 127; ci[r] = ((bg >> 2) * SEQ + 16 * n) * 24 + grp * 4 + (bg & 3); }
        if (F.gw < 512) { const int id = F.gw, grp = id >> 8, nb = (id >> 4) & 15, kq = id & 15, i = F.lane & 15, q = F.lane >> 4;
            const float* pe = a.in[grp ? I_PEV : I_PEK] + (size_t)(i & 3) * 2048 + kq * 128 + 8 * q; const float* w = a.in[grp ? I_CVW1 : I_CKW1] + (size_t)(kq * 128 + 8 * q) * 256 + 16 * nb + i;
            f32x4 acc = (f32x4){0.f, 0.f, 0.f, 0.f};
#pragma unroll
            for (int sk = 0; sk < 4; ++sk) { const f32x4 p0 = *(const f32x4*)(pe + 32 * sk), p1 = *(const f32x4*)(pe + 32 * sk + 4);
                float wv[8];
#pragma unroll
                for (int e = 0; e < 8; ++e) wv[e] = w[(size_t)(32 * sk + e) * 256];
                const float pv[8] = {p0.x, p0.y, p0.z, p0.w, p1.x, p1.y, p1.z, p1.w}; float pl[8];
#pragma unroll
                for (int e = 0; e < 8; ++e) pl[e] = pv[e] - bflo(f2bf(pv[e]));
                const bf16x8 ah = pack8c(pv), al = pack8c(pl), bw = pack8c(wv);
                acc = __builtin_amdgcn_mfma_f32_16x16x32_bf16(ah, bw, acc, 0, 0, 0); acc = __builtin_amdgcn_mfma_f32_16x16x32_bf16(al, bw, acc, 0, 0, 0); }
            if (F.lane < 16) { float* pb = (float*)(ws + WS_PEBP) + ((size_t)(kq * 2 + grp) * 4) * 256 + 16 * nb + i;
#pragma unroll
                for (int rg = 0; rg < 4; ++rg) pb[rg * 256] = acc[rg]; }
        }
    }
    {
        bf16_t* o = (bf16_t*)(ws + WS_W2F);
        for (int i = F.gw * 64 + F.lane; i < 2 * 16384; i += F.ngw * 64) { const int e = i & 7, ln = (i >> 3) & 63, nb = (i >> 9) & 3, sk = (i >> 11) & 7, grp = i >> 14;
            const int k = 32 * sk + 8 * (ln >> 4) + e, n = 16 * nb + (ln & 15); const float v = a.in[grp ? I_CVW2 : I_CKW2][k * 64 + n];
            const unsigned hi = f2bf(v), lo = f2bf(v - bflo(hi));
            bf16_t* ob = o + ((size_t)((grp * 8 + sk) * 2) * 4 + nb) * 512 + ln * 8 + e; ob[0] = (bf16_t)hi; ob[4 * 512] = (bf16_t)lo; }
    }
    {
        bf16_t* o = (bf16_t*)(ws + WS_RFRAG);
        for (int i = F.gw * 64 + F.lane; i < 2 * 49152; i += F.ngw * 64) { const int layer = i / 49152, r = i % 49152, e = r & 7, ln = (r >> 3) & 63, nt = (r >> 9) % 3, s = r / 1536;
            const int k = 32 * s + 8 * (ln >> 4) + e, n = 16 * nt + (ln & 15);
            float v = 0.f; if (n < 4) v = a.in[I_MWG][((size_t)layer * 1024 + k) * 4 + n]; else if (n < 36) v = a.in[I_MWE][((size_t)layer * 1024 + k) * 32 + (n - 4)];
            v *= a.in[I_MLN][layer * 1024 + k];
            const unsigned hi = f2bf(v); const float r1 = v - bflo(hi); const unsigned lo = f2bf(r1); const float r2 = r1 - bflo(lo); const unsigned lo2 = f2bf(r2);
            bf16_t* ob = o + ((size_t)(layer * 32 + s) * 9 + nt) * 512 + ln * 8 + e;
            ob[0] = (bf16_t)hi; ob[3 * 512] = (bf16_t)lo; ob[6 * 512] = (bf16_t)lo2; }
    }
}

__device__ __forceinline__ void phase_r1(const Fr& F, const Args& a) {
    unsigned char* ws = a.ws; const float* x = a.in[I_X];
    bf16_t* XN = (bf16_t*)(ws + WS_S5); bf16_t* XR = (bf16_t*)(ws + WS_S0); bf16_t* XK = (bf16_t*)(ws + WS_S1); bf16_t* XV = (bf16_t*)(ws + WS_S2);
    f32x4 gn[4], mr[4], mk[4], mv[4];
#pragma unroll
    for (int j = 0; j < 4; ++j) { const int c = 256 * j + 4 * F.lane; gn[j] = *(const f32x4*)(a.in[I_ALN] + c); mr[j] = *(const f32x4*)(a.in[I_AMU] + 0 * 1024 + c);
        mk[j] = *(const f32x4*)(a.in[I_AMU] + 2 * 1024 + c); mv[j] = *(const f32x4*)(a.in[I_AMU] + 3 * 1024 + c); }
    for (int run = F.gw; run < NT / 32; run += F.ngw) {
        const int m0 = run * 32, b = m0 >> 11, t0 = m0 & 2047;
        f32x4 pv[4];
        if (t0 == 0) {
#pragma unroll
            for (int j = 0; j < 4; ++j) { pv[j] = (f32x4){0.f, 0.f, 0.f, 0.f}; *(u32x2*)(XN + (size_t)(b * 2049) * 1024 + 256 * j + 4 * F.lane) = (u32x2){0u, 0u}; }
        } else {
            const f32x4* xr = (const f32x4*)(x + (size_t)(m0 - 1) * 1024) + F.lane; float s = 0.f;
#pragma unroll
            for (int j = 0; j < 4; ++j) { pv[j] = xr[64 * j]; s += (pv[j].x * pv[j].x + pv[j].y * pv[j].y) + (pv[j].z * pv[j].z + pv[j].w * pv[j].w); }
            const float rstd = 1.f / sqrtf(wave_sum(s) * (1.f / 1024.f) + 1e-6f);
#pragma unroll
            for (int j = 0; j < 4; ++j) pv[j] = pv[j] * rstd * gn[j];
        }
        f32x4 nx[4];
        { const f32x4* xr = (const f32x4*)(x + (size_t)m0 * 1024) + F.lane;
#pragma unroll
          for (int j = 0; j < 4; ++j) nx[j] = xr[64 * j]; }
        for (int i = 0; i < 32; ++i) {
            const int m = m0 + i;
            f32x4 v[4]; float s = 0.f;
#pragma unroll
            for (int j = 0; j < 4; ++j) v[j] = nx[j];
            if (i < 31) { const f32x4* xr = (const f32x4*)(x + (size_t)(m + 1) * 1024) + F.lane;
#pragma unroll
                for (int j = 0; j < 4; ++j) nx[j] = xr[64 * j]; }
#pragma unroll
            for (int j = 0; j < 4; ++j) s += (v[j].x * v[j].x + v[j].y * v[j].y) + (v[j].z * v[j].z + v[j].w * v[j].w);
            const float rstd = 1.f / sqrtf(wave_sum(s) * (1.f / 1024.f) + 1e-6f);
            const size_t prow = (size_t)(m + b + 1) * 1024, row = (size_t)m * 1024;
#pragma unroll
            for (int j = 0; j < 4; ++j) { const int c = 256 * j + 4 * F.lane;
                const f32x4 cur = v[j] * rstd * gn[j], xx = pv[j] - cur;
                *(u32x2*)(XN + prow + c) = (u32x2){pk2(cur.x, cur.y), pk2(cur.z, cur.w)};
                const f32x4 r_ = cur + xx * mr[j], k_ = cur + xx * mk[j], v_ = cur + xx * mv[j];
                *(u32x2*)(XR + row + c) = (u32x2){pk2(r_.x, r_.y), pk2(r_.z, r_.w)};
                *(u32x2*)(XK + row + c) = (u32x2){pk2(k_.x, k_.y), pk2(k_.z, k_.w)};
                *(u32x2*)(XV + row + c) = (u32x2){pk2(v_.x, v_.y), pk2(v_.z, v_.w)};
                pv[j] = cur; }
        }
    }
}

typedef float f32x16 __attribute__((ext_vector_type(16)));
__device__ __forceinline__ bf16x8 pack8f(float a0, float a1, float a2, float a3, float a4, float a5, float a6, float a7) {
    u32x4 w; w.x = cvtpk(a0, a1); w.y = cvtpk(a2, a3); w.z = cvtpk(a4, a5); w.w = cvtpk(a6, a7); return __builtin_bit_cast(bf16x8, w); }
__device__ __forceinline__ bf16x8 packacc(const f32x16& v, int s2) { return pack8f(v[8 * s2], v[8 * s2 + 1], v[8 * s2 + 2], v[8 * s2 + 3], v[8 * s2 + 4], v[8 * s2 + 5], v[8 * s2 + 6], v[8 * s2 + 7]); }
__device__ __forceinline__ int swap23(int w) { return (w & ~12) | ((w & 4) << 1) | ((w & 8) >> 1); }
constexpr int SC_AT = 0, SC_RT = 4096, SC_BJ = 8192, SC_KJ = 12288, SC_VI = 16384, SC_BT = 20480, SC_KT = 24576, SC_TT = 20480, SC_AAKT = 22528, SC_ABRT = 24576, SC_AKRT = 26624,
              SC_GL = 28672, SC_SS = 28928, SC_SLOT = 29184, SC_YB = 4 * SC_SLOT, SC_BON = SC_YB + 32768;
template <int HALF, int BIT>
__device__ __forceinline__ void reduce32_stage(float (&v)[32], int lane) {
    const bool up = (lane & BIT) != 0; const int addr = (lane ^ BIT) << 2;
#pragma unroll
    for (int i = 0; i < HALF; ++i) { const float keep = up ? v[i + HALF] : v[i], send = up ? v[i] : v[i + HALF];
        v[i] = keep + __int_as_float(__builtin_amdgcn_ds_bpermute(addr, __float_as_int(send))); }
}
__device__ __forceinline__ float reduce32(float (&v)[32], int lane) {
#pragma unroll
    for (int i = 0; i < 16; ++i) { const auto r = __builtin_amdgcn_permlane32_swap(__float_as_uint(v[i]), __float_as_uint(v[i + 16]), false, false); v[i] = __uint_as_float(r[0]) + __uint_as_float(r[1]); }
#pragma unroll
    for (int i = 0; i < 8; ++i) { const auto r = __builtin_amdgcn_permlane16_swap(__float_as_uint(v[i]), __float_as_uint(v[i + 8]), false, false); v[i] = __uint_as_float(r[0]) + __uint_as_float(r[1]); }
    { const bool up = (lane & 8) != 0;
#pragma unroll
      for (int i = 0; i < 4; ++i) { const float keep = up ? v[i + 4] : v[i], send = up ? v[i] : v[i + 4]; v[i] = keep + dppf<DPP_ROR8>(send); } }
    reduce32_stage<2, 4>(v, lane);
    { const bool up = (lane & 2) != 0; const float keep = up ? v[1] : v[0], send = up ? v[0] : v[1]; v[0] = keep + dppf<DPP_XOR2>(send); }
    return v[0] + dppf<DPP_XOR1>(v[0]);
}
#define SC_RAW(area, t) bf2f(*(const LAS bf16_t*)(slot + (area) + (t) * 128 + lane * 2))
#define SC_BARRIER() do { asm volatile("s_waitcnt lgkmcnt(0)" ::: "memory"); __builtin_amdgcn_s_barrier(); asm volatile("" ::: "memory"); } while (0)
struct ScanRaw { u32x4 v[10]; unsigned lwp[16]; };
__device__ __forceinline__ void scan_load(const Args& a, ScanRaw& R, int chain, int t0, int half, int lane) {
    unsigned char* ws = a.ws; const int tb = 16 * half;
    const unsigned char* Rb = ws + WS_S3; const unsigned char* LWb = ws + WS_S0; const unsigned char* Kb = ws + WS_S4; const unsigned char* Vb = (const unsigned char*)a.out; const unsigned char* Ab = ws + WS_S1;
    const size_t rowb = ((size_t)chain * SEQ + t0) * 128;
#pragma unroll
    for (int q = 0; q < 2; ++q) { const size_t o = rowb + (size_t)(tb + 8 * q) * 128 + lane * 16;
        R.v[5 * q + 0] = *(const u32x4*)(Ab + o); R.v[5 * q + 1] = *(const u32x4*)(Rb + o); R.v[5 * q + 2] = *(const u32x4*)(LWb + o); R.v[5 * q + 3] = *(const u32x4*)(Kb + o); R.v[5 * q + 4] = *(const u32x4*)(Vb + o); }
    if (half) {
#pragma unroll
        for (int m = 0; m < 16; ++m) R.lwp[m] = (unsigned)*(const bf16_t*)(LWb + rowb + (size_t)m * 128 + lane * 2); }
}
__device__ __forceinline__ void scan_pre(const Fr& F, const Args& a, LAS unsigned char* slot, LAS float* bon, LAS unsigned char* ysc, int chain, int t0, int half, ScanRaw& R, bool more, float kkc, float kac, float rkc) {
    unsigned char* ws = a.ws;
    int lane = F.lane; asm volatile("" : "+v"(lane));
    { unsigned so = (unsigned)(size_t)slot; asm volatile("" : "+s"(so)); slot = (LAS unsigned char*)(size_t)so; }
    const int b = chain >> 4, hd = chain & 15, ch = hd * 64 + lane, r = lane & 31, h = lane >> 5, tb = 16 * half;
    float cum = 0.f;
    if (half) {
#pragma unroll
        for (int m = 0; m < 16; ++m) cum += bflo(R.lwp[m]); }
    {
#pragma unroll
        for (int q = 0; q < 2; ++q) { const int lo2 = (tb + 8 * q) * 128 + lane * 16;
            *(LAS u32x4*)(slot + SC_AT + lo2) = R.v[5 * q + 0]; *(LAS u32x4*)(slot + SC_RT + lo2) = R.v[5 * q + 1]; *(LAS u32x4*)(slot + SC_BT + lo2) = R.v[5 * q + 2]; *(LAS u32x4*)(slot + SC_KT + lo2) = R.v[5 * q + 3]; *(LAS u32x4*)(slot + SC_BJ + lo2) = R.v[5 * q + 4]; }
        LDS_WAIT();
        if (more) scan_load(a, R, chain, t0 + 64, half, lane);
    }
    float kq[16], aq[16], rq[16];
    {
        float q[32];
#pragma unroll
        for (int tt = 0; tt < 16; ++tt) { const float k = SC_RAW(SC_KT, tb + tt), av = SC_RAW(SC_AT, tb + tt), rv = SC_RAW(SC_RT, tb + tt); kq[tt] = k; aq[tt] = av; rq[tt] = rv;
            const float kkv = k * kkc; q[tt] = kkv * kkv; q[16 + tt] = rv * (k * (1.f + (av - 1.f) * kac)) * rkc; }
        const float s1 = reduce32(q, lane); const int idx = (lane >> 1) & 31;
        if ((lane & 1) == 0) { if (idx < 16) ((LAS float*)(slot + SC_SS))[tb + idx] = s1; else bon[tb + idx - 16] = s1; }
    }
    unsigned vv[8];
#pragma unroll
    for (int m = 0; m < 8; ++m) vv[m] = (unsigned)*(const LAS bf16_t*)(slot + SC_BJ + (tb + 2 * m) * 128 + lane * 2) | ((unsigned)*(const LAS bf16_t*)(slot + SC_BJ + (tb + 2 * m + 1) * 128 + lane * 2) << 16);
    LDS_WAIT(); asm volatile("" ::: "memory");
    const int pj = (lane & 48) | swap23(lane & 15);
    const int pjc = pj >> 3, pjw = (pj & 7) * 2;
    unsigned bj[8], kj[8]; float gprev = half ? fexp_(cum) : 1.f, gl = 1.f;
    f32x4 ssv[4];
#pragma unroll
    for (int q4 = 0; q4 < 4; ++q4) ssv[q4] = *(const LAS f32x4*)(slot + SC_SS + (tb + 4 * q4) * 4);
    const bool odd = (lane & 1) != 0; const int pjwe = pjw & ~2;
#define SC_PAIR_STORE(area, x) do { const float _snd = odd ? x[0] : x[1]; const float _rcv = dppf<DPP_XOR1>(_snd); *(LAS unsigned*)(slot + (area) + ro) = cvtpk(odd ? _rcv : x[0], odd ? x[1] : _rcv); } while (0)
#pragma unroll
    for (int tp = 0; tp < 8; ++tp) { const int t0 = tb + 2 * tp;
        float atv[2], rtv[2], btv[2], ktv[2];
#pragma unroll
        for (int u = 0; u < 2; ++u) { const int tt = 2 * tp + u;
            const float k = kq[tt], av = aq[tt], rv = rq[tt], lw = SC_RAW(SC_BT, tb + tt);
            cum += lw; const float g = fexp_(cum), ginv = __builtin_amdgcn_rcpf(g);
            const float ss = ssv[tt >> 2][tt & 3];
            const float kk = k * kkc * __builtin_amdgcn_rsqf(fmaxf(ss, 1e-24f)); const float kp = k * (1.f + (av - 1.f) * kac);
            atv[u] = -kk * gprev; btv[u] = kk * av * ginv; ktv[u] = kp * ginv; rtv[u] = rv * g;
            gprev = g; gl = g; }
        bj[tp] = cvtpk(btv[0], btv[1]); kj[tp] = cvtpk(ktv[0], ktv[1]);
        const int ro = (t0 + (odd ? 1 : 0)) * 128 + ((pjc ^ ((t0 >> 1) & 7)) << 4) + pjwe;
        SC_PAIR_STORE(SC_AT, atv); SC_PAIR_STORE(SC_RT, rtv); SC_PAIR_STORE(SC_BT, btv); SC_PAIR_STORE(SC_KT, ktv);
    }
#undef SC_PAIR_STORE
    SC_BARRIER();
#pragma unroll
    for (int cc = 0; cc < 2; ++cc) { const int c = 2 * half + cc, m0 = 2 * cc; const int ro = lane * 64 + ((c ^ ((lane >> 2) & 3)) << 4);
        *(LAS u32x4*)(slot + SC_BJ + ro) = (u32x4){bj[m0], bj[m0 + 1], bj[m0 + 4], bj[m0 + 5]};
        *(LAS u32x4*)(slot + SC_KJ + ro) = (u32x4){kj[m0], kj[m0 + 1], kj[m0 + 4], kj[m0 + 5]};
        *(LAS u32x4*)(slot + SC_VI + ro) = (u32x4){vv[m0], vv[m0 + 1], vv[m0 + 4], vv[m0 + 5]}; }
    if (half) ((LAS float*)(slot + SC_GL))[lane] = gl;
    const int swz = (r >> 1) & 7;
    f32x16 D0, D1, D2;
#pragma unroll
    for (int i = 0; i < 16; ++i) { D0[i] = 0.f; D1[i] = 0.f; D2[i] = 0.f; }
    if (half == 0) {
#pragma unroll
        for (int ks = 0; ks < 4; ++ks) { const int ao = r * 128 + (((2 * ks + h) ^ swz) << 4);
            D0 = __builtin_amdgcn_mfma_f32_32x32x16_bf16(*(const LAS bf16x8*)(slot + SC_BT + ao), *(const LAS bf16x8*)(slot + SC_AT + ao), D0, 0, 0, 0); }
    } else {
#pragma unroll
        for (int ks = 0; ks < 4; ++ks) { const int ao = r * 128 + (((2 * ks + h) ^ swz) << 4);
            const bf16x8 bA = *(const LAS bf16x8*)(slot + SC_BT + ao), kA = *(const LAS bf16x8*)(slot + SC_KT + ao), aB = *(const LAS bf16x8*)(slot + SC_AT + ao), rB = *(const LAS bf16x8*)(slot + SC_RT + ao);
            D0 = __builtin_amdgcn_mfma_f32_32x32x16_bf16(kA, aB, D0, 0, 0, 0); D1 = __builtin_amdgcn_mfma_f32_32x32x16_bf16(bA, rB, D1, 0, 0, 0); D2 = __builtin_amdgcn_mfma_f32_32x32x16_bf16(kA, rB, D2, 0, 0, 0); }
    }
    SC_BARRIER();
    if (half == 0) {
        const int sw4 = (r >> 2) & 3; int bo[2];
#pragma unroll
        for (int s2 = 0; s2 < 2; ++s2) bo[s2] = r * 64 + (((2 * s2 + h) ^ sw4) << 4);
        const int pcol = (r & 16) | swap23(r & 15), pcc = pcol >> 3, pcw = (pcol & 7) * 2;
        f32x16 Mx, Tx;
#pragma unroll
        for (int reg = 0; reg < 16; ++reg) { const int sr = (reg & 3) + 8 * (reg >> 2) + 4 * h; const float av = (sr < r) ? D0[reg] : 0.f; Mx[reg] = av; Tx[reg] = av + ((sr == r) ? 1.f : 0.f); }
#pragma unroll
        for (int it = 0; it < 4; ++it) {
#pragma unroll
            for (int reg = 0; reg < 16; ++reg) { const int sr = (reg & 3) + 8 * (reg >> 2) + 4 * h; const int ad = sr * 64 + ((pcc ^ ((sr >> 2) & 3)) << 4) + pcw;
                *(LAS bf16_t*)(ysc + ad) = (bf16_t)f2bf(Mx[reg]); *(LAS bf16_t*)(ysc + 2048 + ad) = (bf16_t)f2bf(Tx[reg]); }
            LDS_WAIT(); asm volatile("" ::: "memory");
            bf16x8 mb[2], m2b[2];
#pragma unroll
            for (int s2 = 0; s2 < 2; ++s2) mb[s2] = packacc(Mx, s2);
            f32x16 M2;
#pragma unroll
            for (int i = 0; i < 16; ++i) M2[i] = 0.f;
#pragma unroll
            for (int s2 = 0; s2 < 2; ++s2) M2 = __builtin_amdgcn_mfma_f32_32x32x16_bf16(*(const LAS bf16x8*)(ysc + bo[s2]), mb[s2], M2, 0, 0, 0);
#pragma unroll
            for (int s2 = 0; s2 < 2; ++s2) m2b[s2] = packacc(M2, s2);
#pragma unroll
            for (int s2 = 0; s2 < 2; ++s2) Tx = __builtin_amdgcn_mfma_f32_32x32x16_bf16(*(const LAS bf16x8*)(ysc + 2048 + bo[s2]), m2b[s2], Tx, 0, 0, 0);
            Mx = M2;
            LDS_WAIT(); asm volatile("" ::: "memory");
        }
#pragma unroll
        for (int g = 0; g < 4; ++g) { const int ro = r * 64 + (((2 * (g >> 1) + h) ^ sw4) << 4) + 8 * (g & 1);
            *(LAS u32x2*)(slot + SC_TT + ro) = (u32x2){cvtpk(Tx[4 * g], Tx[4 * g + 1]), cvtpk(Tx[4 * g + 2], Tx[4 * g + 3])}; }
    } else {
#pragma unroll
        for (int reg = 0; reg < 16; ++reg) { const int sr = (reg & 3) + 8 * (reg >> 2) + 4 * h; D0[reg] = (sr < r) ? D0[reg] : 0.f; D1[reg] = (sr <= r) ? D1[reg] : 0.f; D2[reg] = (sr <= r) ? D2[reg] : 0.f; }
        const int sw4 = (r >> 2) & 3;
#pragma unroll
        for (int g = 0; g < 4; ++g) { const int ro = r * 64 + (((2 * (g >> 1) + h) ^ sw4) << 4) + 8 * (g & 1);
            *(LAS u32x2*)(slot + SC_AAKT + ro) = (u32x2){cvtpk(D0[4 * g], D0[4 * g + 1]), cvtpk(D0[4 * g + 2], D0[4 * g + 3])};
            *(LAS u32x2*)(slot + SC_ABRT + ro) = (u32x2){cvtpk(D1[4 * g], D1[4 * g + 1]), cvtpk(D1[4 * g + 2], D1[4 * g + 3])};
            *(LAS u32x2*)(slot + SC_AKRT + ro) = (u32x2){cvtpk(D2[4 * g], D2[4 * g + 1]), cvtpk(D2[4 * g + 2], D2[4 * g + 3])}; }
    }
}
__device__ __forceinline__ void scan_seq(LAS unsigned char* slot, LAS bf16_t* yb, int ib, int lane, f32x16 (&Z)[2]) {
    asm volatile("" : "+v"(lane));
    { unsigned so = (unsigned)(size_t)slot; asm volatile("" : "+s"(so)); slot = (LAS unsigned char*)(size_t)so; }
    const int r = lane & 31, h = lane >> 5, swz = (r >> 1) & 7, sw4 = (r >> 2) & 3;
    int ao[4], bo[2];
#pragma unroll
    for (int ks = 0; ks < 4; ++ks) ao[ks] = r * 128 + (((2 * ks + h) ^ swz) << 4);
#pragma unroll
    for (int s2 = 0; s2 < 2; ++s2) bo[s2] = r * 64 + (((2 * s2 + h) ^ sw4) << 4);
    bf16x8 zb[4], vB[2], xb[2], pb[2];
#pragma unroll
    for (int jb = 0; jb < 2; ++jb)
#pragma unroll
        for (int s2 = 0; s2 < 2; ++s2) zb[2 * jb + s2] = packacc(Z[jb], s2);
#pragma unroll
    for (int s2 = 0; s2 < 2; ++s2) vB[s2] = *(const LAS bf16x8*)(slot + SC_VI + ib * 2048 + bo[s2]);
    f32x16 X, P, Y;
#pragma unroll
    for (int i = 0; i < 16; ++i) { X[i] = 0.f; P[i] = 0.f; Y[i] = 0.f; }
#pragma unroll
    for (int ks = 0; ks < 4; ++ks) X = __builtin_amdgcn_mfma_f32_32x32x16_bf16(*(const LAS bf16x8*)(slot + SC_AT + ao[ks]), zb[ks], X, 0, 0, 0);
#pragma unroll
    for (int s2 = 0; s2 < 2; ++s2) X = __builtin_amdgcn_mfma_f32_32x32x16_bf16(*(const LAS bf16x8*)(slot + SC_AAKT + bo[s2]), vB[s2], X, 0, 0, 0);
#pragma unroll
    for (int s2 = 0; s2 < 2; ++s2) xb[s2] = packacc(X, s2);
#pragma unroll
    for (int s2 = 0; s2 < 2; ++s2) P = __builtin_amdgcn_mfma_f32_32x32x16_bf16(*(const LAS bf16x8*)(slot + SC_TT + bo[s2]), xb[s2], P, 0, 0, 0);
#pragma unroll
    for (int s2 = 0; s2 < 2; ++s2) pb[s2] = packacc(P, s2);
#pragma unroll
    for (int ks = 0; ks < 4; ++ks) Y = __builtin_amdgcn_mfma_f32_32x32x16_bf16(*(const LAS bf16x8*)(slot + SC_RT + ao[ks]), zb[ks], Y, 0, 0, 0);
#pragma unroll
    for (int s2 = 0; s2 < 2; ++s2) { Y = __builtin_amdgcn_mfma_f32_32x32x16_bf16(*(const LAS bf16x8*)(slot + SC_ABRT + bo[s2]), pb[s2], Y, 0, 0, 0);
        Y = __builtin_amdgcn_mfma_f32_32x32x16_bf16(*(const LAS bf16x8*)(slot + SC_AKRT + bo[s2]), vB[s2], Y, 0, 0, 0); }
#pragma unroll
    for (int jb = 0; jb < 2; ++jb) {
#pragma unroll
        for (int s2 = 0; s2 < 2; ++s2) { Z[jb] = __builtin_amdgcn_mfma_f32_32x32x16_bf16(*(const LAS bf16x8*)(slot + SC_BJ + jb * 2048 + bo[s2]), pb[s2], Z[jb], 0, 0, 0);
            Z[jb] = __builtin_amdgcn_mfma_f32_32x32x16_bf16(*(const LAS bf16x8*)(slot + SC_KJ + jb * 2048 + bo[s2]), vB[s2], Z[jb], 0, 0, 0); }
#pragma unroll
        for (int g = 0; g < 4; ++g) { const f32x4 gl4 = *(const LAS f32x4*)(slot + SC_GL + (32 * jb + 8 * g + 4 * h) * 4);
            Z[jb][4 * g] *= gl4.x; Z[jb][4 * g + 1] *= gl4.y; Z[jb][4 * g + 2] *= gl4.z; Z[jb][4 * g + 3] *= gl4.w; } }
#pragma unroll
    for (int reg = 0; reg < 16; ++reg) yb[((reg & 3) + 8 * (reg >> 2) + 4 * h) * 64 + ib * 32 + r] = (bf16_t)f2bf(Y[reg]);
}
__device__ __forceinline__ void phase_scan(const Fr& F, const Args& a) {
    unsigned char* ws = a.ws; const bf16_t* Vb = (const bf16_t*)a.out; const bf16_t* Gb = (const bf16_t*)(ws + WS_S2); bf16_t* YG = (bf16_t*)(ws + WS_S5);
    LAS bf16_t* YB = (LAS bf16_t*)(F.lds + SC_YB);
    LAS float* BON = (LAS float*)(F.lds + SC_BON);
    const int w = F.wave, lane = F.lane;
    for (int cp = blockIdx.x; cp < 256; cp += F.G) {
        f32x16 Z[2];
#pragma unroll
        for (int i = 0; i < 16; ++i) { Z[0][i] = 0.f; Z[1][i] = 0.f; }
        ScanRaw R; scan_load(a, R, 2 * cp + ((w & 3) >> 1), 32 * (w & 1), w >> 2, lane);
        const int chp = ((2 * cp + ((w & 3) >> 1)) & 15) * 64 + lane; float kkc = a.in[I_AKK][chp], kac = a.in[I_AKA][chp], rkc = a.in[I_ARK][chp];
        asm volatile("" : "+v"(kkc), "+v"(kac), "+v"(rkc));
#pragma unroll 1
        for (int bt = 0; bt <= 32; ++bt) {
            SC_BARRIER();
            if (bt < 32) { const int sl = w & 3;
                scan_pre(F, a, F.lds + sl * SC_SLOT, BON + (bt & 1) * 128 + (sl >> 1) * 64 + (sl & 1) * 32, F.lds + SC_YB + (bt & 1) * 16384 + sl * 4096, 2 * cp + (sl >> 1), 64 * bt + 32 * (sl & 1), w >> 2, R, bt < 31, kkc, kac, rkc); }
            SC_BARRIER();
            if (w >= 4) { if (bt < 32) { const int cl = (w - 4) >> 1, ib = (w - 4) & 1;
                scan_seq(F.lds + (2 * cl) * SC_SLOT, YB + (bt & 1) * 8192 + cl * 4096, ib, lane, Z);
                scan_seq(F.lds + (2 * cl + 1) * SC_SLOT, YB + (bt & 1) * 8192 + cl * 4096 + 2048, ib, lane, Z); } }
            else if (bt >= 1) {
                const int cl = w >> 1, chain = 2 * cp + cl, b = chain >> 4, hd = chain & 15, ch = hd * 64 + lane; const float lw_ = a.in[I_ALNXW][ch], lb_ = a.in[I_ALNXB][ch];
                LAS f32x2* ST = (LAS f32x2*)(F.lds + SC_BON + 1024) + w * 32;
                const int tb = 32 * (w & 1); const LAS bf16_t* yp = YB + ((bt - 1) & 1) * 8192 + cl * 4096 + tb * 64 + lane;
                const size_t go = ((size_t)chain * SEQ + 64 * (bt - 1) + tb) * 64 + lane; const bf16_t* vp = Vb + go; const bf16_t* gp = Gb + go; bf16_t* op = YG + go;
                const LAS float* bp = BON + ((bt - 1) & 1) * 128 + cl * 64 + tb;
#pragma unroll 1
                for (int hh = 0; hh < 2; ++hh) {
                    unsigned vg[16];
#pragma unroll
                    for (int tt = 0; tt < 16; ++tt) vg[tt] = (unsigned)vp[(16 * hh + tt) * 64] | ((unsigned)gp[(16 * hh + tt) * 64] << 16);
                    float yq[16];
                    {
                        float q[32];
#pragma unroll
                        for (int tt = 0; tt < 16; ++tt) { const float y = bf2f(yp[(16 * hh + tt) * 64]); yq[tt] = y; q[tt] = y; q[16 + tt] = y * y; }
                        const float s1 = reduce32(q, lane); const int idx = (lane >> 1) & 31;
                        LAS float* STf = (LAS float*)ST;
                        if ((lane & 1) == 0) STf[idx] = s1;
                    }
                    LDS_WAIT(); asm volatile("" ::: "memory");
                    f32x4 sm[4], sq[4], bv4[4];
#pragma unroll
                    for (int q4 = 0; q4 < 4; ++q4) { sm[q4] = ((const LAS f32x4*)ST)[q4]; sq[q4] = ((const LAS f32x4*)ST)[4 + q4]; bv4[q4] = *(const LAS f32x4*)(bp + 16 * hh + 4 * q4); }
#pragma unroll
                    for (int tt = 0; tt < 16; ++tt) { const int t = 16 * hh + tt; const float mean = sm[tt >> 2][tt & 3] * (1.f / 64.f); const float var = fmaxf(sq[tt >> 2][tt & 3] * (1.f / 64.f) - mean * mean, 0.f);
                        float o = (yq[tt] - mean) * __builtin_amdgcn_rsqf(var + 64e-5f) * lw_ + lb_ + bv4[tt >> 2][tt & 3] * bflo(vg[tt]);
                        o *= bfhi(vg[tt]); op[t * 64] = (bf16_t)f2bf(o); }
                    LDS_WAIT(); asm volatile("" ::: "memory");
                }
            }
        }
    }
}

template <int MODE>
__device__ __forceinline__ float load_row_hb(const Fr& F, const bf16_t* hrow, const bf16_t* Y, const int* asg, int m, float (&v)[16]) {
    int p0 = 0, p1 = 0; if (MODE == 1) { p0 = asg[m * 8 + 6]; p1 = asg[m * 8 + 7]; }
    float s = 0.f;
#pragma unroll
    for (int j = 0; j < 2; ++j) { const u32x4 hv = *(const u32x4*)(hrow + 512 * j + 8 * F.lane);
        float* o = v + 8 * j; o[0] = bflo(hv.x); o[1] = bfhi(hv.x); o[2] = bflo(hv.y); o[3] = bfhi(hv.y); o[4] = bflo(hv.z); o[5] = bfhi(hv.z); o[6] = bflo(hv.w); o[7] = bfhi(hv.w);
        if (MODE == 1) { const u32x4 y0 = *(const u32x4*)(Y + (size_t)p0 * 1024 + 512 * j + 8 * F.lane), y1 = *(const u32x4*)(Y + (size_t)p1 * 1024 + 512 * j + 8 * F.lane);
            o[0] += bflo(y0.x) + bflo(y1.x); o[1] += bfhi(y0.x) + bfhi(y1.x); o[2] += bflo(y0.y) + bflo(y1.y); o[3] += bfhi(y0.y) + bfhi(y1.y);
            o[4] += bflo(y0.z) + bflo(y1.z); o[5] += bfhi(y0.z) + bfhi(y1.z); o[6] += bflo(y0.w) + bflo(y1.w); o[7] += bfhi(y0.w) + bfhi(y1.w); }
#pragma unroll
        for (int e = 0; e < 8; ++e) s += o[e] * o[e]; }
    return 1.f / sqrtf(wave_sum(s) * (1.f / 1024.f) + 1e-6f);
}

struct RowRaw { u32x4 h[2], y0[2], y1[2]; };
__device__ __forceinline__ int y_chunk_col(int c) { const int ci = c & 31; return (c >> 5) * 256 + (((ci >> 2) & 3) * 8 + (ci >> 4) * 4 + (ci & 3)) * 8; }
__device__ __forceinline__ void row_issue(const Fr& F, const bf16_t* hrow, const bf16_t* Y, int p0, int p1, RowRaw& R) {
#pragma unroll
    for (int j = 0; j < 2; ++j) { const int yc = y_chunk_col(64 * j + F.lane);
        R.h[j] = *(const u32x4*)(hrow + 512 * j + 8 * F.lane); R.y0[j] = *(const u32x4*)(Y + (size_t)p0 * 1024 + yc); R.y1[j] = *(const u32x4*)(Y + (size_t)p1 * 1024 + yc); }
}
__device__ __forceinline__ float row_finish(const RowRaw& R, float (&v)[16], float w0, float w1) {
    float s = 0.f;
#pragma unroll
    for (int j = 0; j < 2; ++j) { const u32x4 hv = R.h[j], y0 = R.y0[j], y1 = R.y1[j]; float* o = v + 8 * j;
        o[0] = bflo(hv.x) + (w0 * bflo(y0.x) + w1 * bflo(y1.x)); o[1] = bfhi(hv.x) + (w0 * bfhi(y0.x) + w1 * bfhi(y1.x)); o[2] = bflo(hv.y) + (w0 * bflo(y0.y) + w1 * bflo(y1.y)); o[3] = bfhi(hv.y) + (w0 * bfhi(y0.y) + w1 * bfhi(y1.y));
        o[4] = bflo(hv.z) + (w0 * bflo(y0.z) + w1 * bflo(y1.z)); o[5] = bfhi(hv.z) + (w0 * bfhi(y0.z) + w1 * bfhi(y1.z)); o[6] = bflo(hv.w) + (w0 * bflo(y0.w) + w1 * bflo(y1.w)); o[7] = bfhi(hv.w) + (w0 * bfhi(y0.w) + w1 * bfhi(y1.w));
#pragma unroll
        for (int e = 0; e < 8; ++e) s += o[e] * o[e]; }
    return 1.f / sqrtf(wave_sum(s) * (1.f / 1024.f) + 1e-6f);
}
constexpr int RB = 4;
#define ROWS_ISSUE(Hbase) int p0[RB], p1[RB]; float rw0[RB], rw1[RB]; RowRaw R[RB]; \
        _Pragma("unroll") for (int r = 0; r < RB; ++r) { const int mr = m + r * F.ngw; p0[r] = 0; p1[r] = 0; rw0[r] = 0.f; rw1[r] = 0.f; if (mr < NT) { const u32x4 _as = *(const u32x4*)(asg + mr * 8 + 4); \
            const unsigned _wx = _as.x, _wy = _as.y; rw0[r] = __uint_as_float(_wx); rw1[r] = __uint_as_float(_wy); p0[r] = (int)_as.z; p1[r] = (int)_as.w; } } \
        _Pragma("unroll") for (int r = 0; r < RB; ++r) { const int mr = m + r * F.ngw; if (mr < NT) row_issue(F, (Hbase) + (size_t)mr * 1024, Y, p0[r], p1[r], R[r]); }
__device__ __forceinline__ void phase_m1(const Fr& F, const Args& a, int layer) {
    unsigned char* ws = a.ws; const bf16_t* h = (const bf16_t*)(ws + WS_H); float* RS = (float*)(ws + WS_RSTD);
    int* asg = (int*)(ws + WS_ASG);
    const bf16_t* wfb = (const bf16_t*)(ws + WS_RFRAG) + (size_t)layer * 32 * 9 * 512;
    unsigned* cnt = (unsigned*)(ws + WS_CTL) + CW_CNT + layer * 32 * 64;
    LAS float* Lg = (LAS float*)F.lds + F.wave * 1600;
    LAS float* Lr = Lg + 1536;
    for (int task = F.gw; task < NT / 32; task += F.ngw) {
        const int m0 = task * 32;
        f32x4 acc[2][3];
#pragma unroll
        for (int rb = 0; rb < 2; ++rb)
#pragma unroll
            for (int nt = 0; nt < 3; ++nt) acc[rb][nt] = (f32x4){0.f, 0.f, 0.f, 0.f};
        const int i = F.lane & 15, q = F.lane >> 4; const bf16_t* hr = h + (size_t)(m0 + i) * 1024 + 8 * q;
        float ss0 = 0.f, ss1 = 0.f;
#pragma unroll 4
        for (int s = 0; s < 32; ++s) {
            const bf16x8 a0 = *(const bf16x8*)(hr + 32 * s), a1 = *(const bf16x8*)(hr + 16 * 1024 + 32 * s);
            const bf16_t* wp = wfb + (size_t)s * 9 * 512 + F.lane * 8;
#pragma unroll
            for (int tn = 0; tn < 9; ++tn) { const bf16x8 b = *(const bf16x8*)(wp + tn * 512);
                acc[0][tn % 3] = __builtin_amdgcn_mfma_f32_16x16x32_bf16(a0, b, acc[0][tn % 3], 0, 0, 0); acc[1][tn % 3] = __builtin_amdgcn_mfma_f32_16x16x32_bf16(a1, b, acc[1][tn % 3], 0, 0, 0); }
            const u32x4 u0 = __builtin_bit_cast(u32x4, a0), u1 = __builtin_bit_cast(u32x4, a1);
#pragma unroll
            for (int e = 0; e < 4; ++e) { const float x0 = bflo(u0[e]), y0 = bfhi(u0[e]), x1 = bflo(u1[e]), y1 = bfhi(u1[e]); ss0 += x0 * x0 + y0 * y0; ss1 += x1 * x1 + y1 * y1; }
        }
        {
            auto r16 = __builtin_amdgcn_permlane16_swap(__float_as_uint(ss0), __float_as_uint(ss0), false, false); ss0 = __uint_as_float(r16[0]) + __uint_as_float(r16[1]);
            auto r32 = __builtin_amdgcn_permlane32_swap(__float_as_uint(ss0), __float_as_uint(ss0), false, false); ss0 = __uint_as_float(r32[0]) + __uint_as_float(r32[1]);
            r16 = __builtin_amdgcn_permlane16_swap(__float_as_uint(ss1), __float_as_uint(ss1), false, false); ss1 = __uint_as_float(r16[0]) + __uint_as_float(r16[1]);
            r32 = __builtin_amdgcn_permlane32_swap(__float_as_uint(ss1), __float_as_uint(ss1), false, false); ss1 = __uint_as_float(r32[0]) + __uint_as_float(r32[1]);
            const float rs0 = 1.f / sqrtf(ss0 * (1.f / 1024.f) + 1e-6f), rs1 = 1.f / sqrtf(ss1 * (1.f / 1024.f) + 1e-6f);
            if (F.lane < 16) { RS[m0 + i] = rs0; RS[m0 + 16 + i] = rs1; Lr[i] = rs0; Lr[16 + i] = rs1; }
        }
        LDS_WAIT(); asm volatile("" ::: "memory");
#pragma unroll
        for (int rb = 0; rb < 2; ++rb) { const f32x4 rs = *(const LAS f32x4*)(Lr + 16 * rb + 4 * q);
#pragma unroll
            for (int nt = 0; nt < 3; ++nt)
#pragma unroll
                for (int rg = 0; rg < 4; ++rg) Lg[(16 * rb + 4 * q + rg) * 48 + 16 * nt + i] = acc[rb][nt][rg] * rs[rg]; }
        LDS_WAIT(); asm volatile("" ::: "memory");
        if (F.lane < 32) {
            const int m = m0 + F.lane; const LAS float* lg = Lg + F.lane * 48;
            float gl[4]; float gmax = -3.0e38f; int grp = 0;
#pragma unroll
            for (int j = 0; j < 4; ++j) { gl[j] = lg[j] + a.in[I_MBG][layer * 4 + j]; if (gl[j] > gmax) { gmax = gl[j]; grp = j; } }
            float gs = 0.f;
#pragma unroll
            for (int j = 0; j < 4; ++j) gs += __expf(gl[j] - gmax);
            const float grp_w = 1.f / gs;
            float v1 = -3.0e38f, v2 = -3.0e38f; int i1 = 0, i2 = 0;
            for (int j = 0; j < 8; ++j) { const float e = lg[4 + grp * 8 + j] + a.in[I_MBE][layer * 32 + grp * 8 + j];
                if (e > v1) { v2 = v1; i2 = i1; v1 = e; i1 = j; } else if (e > v2) { v2 = e; i2 = j; } }
            const float r2 = __expf(v2 - v1); const float w1 = grp_w / (1.f + r2), w2 = grp_w * r2 / (1.f + r2);
            const int e1 = grp * 8 + i1, e2 = grp * 8 + i2;
            const unsigned s1 = __hip_atomic_fetch_add(cnt + e1 * 64, 1u, __ATOMIC_RELAXED, __HIP_MEMORY_SCOPE_AGENT);
            const unsigned s2 = __hip_atomic_fetch_add(cnt + e2 * 64, 1u, __ATOMIC_RELAXED, __HIP_MEMORY_SCOPE_AGENT);
            int* r = asg + (size_t)m * 8; r[0] = e1; r[1] = e2; r[2] = (int)s1; r[3] = (int)s2; r[4] = __builtin_bit_cast(int, w1); r[5] = __builtin_bit_cast(int, w2);
        }
        LDS_WAIT(); asm volatile("" ::: "memory");
    }
}

__device__ __forceinline__ void phase_m2(const Fr& F, const Args& a, int layer) {
    unsigned char* ws = a.ws;
    int* asg = (int*)(ws + WS_ASG); float* roww = (float*)(ws + WS_ROWW);
    int* texp = (int*)(ws + WS_TEXP);
    unsigned* cnt = (unsigned*)(ws + WS_CTL) + CW_CNT + layer * 32 * 64;
    LAS int* sb = (LAS int*)F.lds;
    if (F.tid < 32) sb[64 + F.tid] = (int)__hip_atomic_load(cnt + F.tid * 64, __ATOMIC_RELAXED, __HIP_MEMORY_SCOPE_AGENT);
    __syncthreads();
    if (F.tid == 0) { int acc = 0; for (int e = 0; e < 32; ++e) { sb[e] = acc; acc += (sb[64 + e] + 255) & ~255; } sb[32] = acc; }
    __syncthreads();
    if (blockIdx.x == 0) {
        const int ntiles = sb[32] >> 8;
        for (int t = F.tid; t < ntiles; t += 512) { int e = 0; for (int j = 1; j < 32; ++j) if ((t << 8) >= sb[j]) e = j; texp[t] = e; }
        if (F.tid == 0) texp[1023] = ntiles;
        if (F.tid < 8) { int n = 0; for (int q = 0; q < 4; ++q) { const int e = F.tid + 8 * q; for (int t = sb[e] >> 8; t < (sb[e + 1] >> 8); ++t) texp[2048 + F.tid * 640 + n++] = t | (e << 16); } texp[1008 + F.tid] = n; }
    }
    int* ridx = (int*)(ws + WS_RIDX); float* rowrs = (float*)(ws + WS_ROWRS); const float* RS = (const float*)(ws + WS_RSTD);
    for (int as = blockIdx.x * 512 + F.tid; as < NT * 2; as += F.G * 512) {
        const int m = as >> 1, k = as & 1; const int e = asg[m * 8 + k], slot = asg[m * 8 + 2 + k]; const int p = sb[e] + slot;
        ridx[p] = m; rowrs[p] = RS[m]; roww[p] = __builtin_bit_cast(float, asg[m * 8 + 4 + k]); asg[m * 8 + 6 + k] = p; }
    for (int idx = blockIdx.x * 512 + F.tid; idx < 32 * 256; idx += F.G * 512) {
        const int e = idx >> 8, r = idx & 255; const int p = sb[e] + sb[64 + e] + r;
        if (p < sb[e + 1]) { ridx[p] = 0; rowrs[p] = 0.f; roww[p] = 0.f; } }
}

__device__ __forceinline__ void phase_n1(const Fr& F, const Args& a) {
    unsigned char* ws = a.ws; bf16_t* H = (bf16_t*)(ws + WS_H); const bf16_t* Y = (const bf16_t*)(ws + WS_S1); const int* asg = (const int*)(ws + WS_ASG); float* RS = (float*)(ws + WS_RSTD);
    for (int m = F.gw; m < NT; m += RB * F.ngw) {
        ROWS_ISSUE(H)
#pragma unroll
        for (int r = 0; r < RB; ++r) { const int mr = m + r * F.ngw; if (mr < NT) {
            float v[16]; bf16_t* hrow = H + (size_t)mr * 1024; const float rstd = row_finish(R[r], v, rw0[r], rw1[r]);
#pragma unroll
            for (int j = 0; j < 2; ++j) *(u32x4*)(hrow + 512 * j + 8 * F.lane) = (u32x4){pk2(v[8 * j], v[8 * j + 1]), pk2(v[8 * j + 2], v[8 * j + 3]), pk2(v[8 * j + 4], v[8 * j + 5]), pk2(v[8 * j + 6], v[8 * j + 7])};
            if (F.lane == 0) RS[mr] = rstd; } }
    }
}
__device__ __forceinline__ void phase_final(const Fr& F, const Args& a) {
    unsigned char* ws = a.ws; const bf16_t* H = (const bf16_t*)(ws + WS_H); const bf16_t* Y = (const bf16_t*)(ws + WS_S1); const int* asg = (const int*)(ws + WS_ASG); const float* gain = a.in[I_FLN];
    for (int m = F.gw; m < NT; m += RB * F.ngw) {
        ROWS_ISSUE(H)
#pragma unroll
        for (int r = 0; r < RB; ++r) { const int mr = m + r * F.ngw; if (mr < NT) {
            float v[16]; const float rstd = row_finish(R[r], v, rw0[r], rw1[r]); float* orow = a.out + (size_t)mr * 1024;
#pragma unroll
            for (int j = 0; j < 2; ++j) { const int c = 512 * j + 8 * F.lane; const f32x4 g0 = *(const f32x4*)(gain + c), g1 = *(const f32x4*)(gain + c + 4);
                *(f32x4*)(orow + c) = (f32x4){v[8 * j] * rstd * g0.x, v[8 * j + 1] * rstd * g0.y, v[8 * j + 2] * rstd * g0.z, v[8 * j + 3] * rstd * g0.w};
                *(f32x4*)(orow + c + 4) = (f32x4){v[8 * j + 4] * rstd * g1.x, v[8 * j + 5] * rstd * g1.y, v[8 * j + 6] * rstd * g1.z, v[8 * j + 7] * rstd * g1.w}; } } }
    }
}

__device__ __forceinline__ void phase_cmp_gather(const Fr& F, const Args& a) {
    unsigned char* ws = a.ws; const bf16_t* KV = (const bf16_t*)(ws + WS_KV); bf16_t* AC = (bf16_t*)(ws + WS_ACMP);
    for (int r = F.gw; r < 2 * 16384; r += F.ngw) {
        const int grp = r >> 14, rr = r & 16383, bg = rr >> 7, n = rr & 127, b = bg >> 2, g = bg & 3;
        const float* pe = a.in[grp ? I_PEV : I_PEK] + (size_t)g * 32 * 64;
        bf16_t* dst = AC + (size_t)r * 2048;
        for (int l2 = 0; l2 < 16; ++l2) { const int l = 2 * l2 + (F.lane >> 5), d = 2 * (F.lane & 31);
            unsigned o = 0u;
            if (n < 127) { const unsigned kv = *(const unsigned*)(KV + (size_t)(b * SEQ + 16 * n + l) * 1536 + (grp * 4 + g) * 64 + d);
                o = pk2(bflo(kv) + pe[l * 64 + d], bfhi(kv) + pe[l * 64 + d + 1]); }
            *(unsigned*)(dst + l * 64 + d) = o; }
    }
}
__device__ __forceinline__ int perm16pos(int w) { return w < 4 ? w : (w < 8 ? w + 4 : (w < 12 ? w - 4 : w)); }
__device__ __forceinline__ void phase_cmp2(const Fr& F, const Args& a, int task0, int tstep, int tend) {
    unsigned char* ws = a.ws; const bf16_t* HC = (const bf16_t*)(ws + WS_HC); bf16_t* KCB = (bf16_t*)(ws + WS_KCB); bf16_t* VCT = (bf16_t*)(ws + WS_VCT); const bf16_t* WF = (const bf16_t*)(ws + WS_W2F);
    const int i = F.lane & 15, q = F.lane >> 4;
    for (int task = task0; task < tend; task += tstep) {
        const int r0 = task * 16, grp = r0 >> 14, rr = r0 & 16383, bg = rr >> 7, n0 = rr & 127;
        f32x4 acc[4];
#pragma unroll
        for (int nb = 0; nb < 4; ++nb) acc[nb] = (f32x4){0.f, 0.f, 0.f, 0.f};
        const bf16_t* hr = HC + (size_t)(r0 + i) * 256 + 8 * q; const bf16_t* wp = WF + (size_t)grp * 8 * 8 * 512 + F.lane * 8;
#pragma unroll
        for (int sk = 0; sk < 8; ++sk) { const bf16x8 av = *(const bf16x8*)(hr + 32 * sk);
#pragma unroll
            for (int tn = 0; tn < 8; ++tn) acc[tn & 3] = __builtin_amdgcn_mfma_f32_16x16x32_bf16(av, *(const bf16x8*)(wp + (sk * 8 + tn) * 512), acc[tn & 3], 0, 0, 0); }
#pragma unroll
        for (int nb = 0; nb < 4; ++nb) { const int col = 16 * nb + i; f32x4 v = acc[nb];
#pragma unroll
            for (int rg = 0; rg < 4; ++rg) if (n0 + 4 * q + rg == 127) v[rg] = 0.f;
            if (grp == 0) {
#pragma unroll
                for (int rg = 0; rg < 4; ++rg) KCB[((size_t)bg * 128 + n0 + 4 * q + rg) * 64 + col] = (bf16_t)f2bf(v[rg]); }
            else *(u32x2*)(VCT + ((size_t)bg * 64 + col) * 128 + n0 + perm16pos(4 * q)) = (u32x2){cvtpk(v[0], v[1]), cvtpk(v[2], v[3])}; }
    }
}
__device__ __forceinline__ void phase_vt(const Fr& F, const Args& a, int gw, int ngw) {
    unsigned char* ws = a.ws; const bf16_t* KV = (const bf16_t*)(ws + WS_KV); bf16_t* VT = (bf16_t*)a.out;
    LAS unsigned* T2 = (LAS unsigned*)(F.lds) + F.wave * 2080;
    for (int task = gw; task < 8192; task += ngw) {
        const int tile = task & 31, g = (task >> 5) & 3, pg = (task >> 7) & 1, b = task >> 8;
        const u32x4* src = (const u32x4*)(KV + (size_t)(b * SEQ + 64 * tile + F.lane) * 1536 + ((pg ? 5 : 3) * 4 + g) * 64);
#pragma unroll
        for (int i = 0; i < 8; ++i) { const u32x4 v = src[i]; T2[(4 * i + 0) * 65 + F.lane] = v.x; T2[(4 * i + 1) * 65 + F.lane] = v.y; T2[(4 * i + 2) * 65 + F.lane] = v.z; T2[(4 * i + 3) * 65 + F.lane] = v.w; }
        LDS_WAIT(); asm volatile("" ::: "memory");
        const int d = F.lane, dp = d >> 1; const bool hi = d & 1;
        u32x4* dst = (u32x4*)(VT + ((size_t)((b * 2 + pg) * 4 + g) * 64 + d) * 2048 + 64 * tile);
#pragma unroll
        for (int G = 0; G < 4; ++G) {
            unsigned e[16];
#pragma unroll
            for (int p = 0; p < 16; ++p) { const int key = 16 * G + ((p < 4) ? p : (p < 8) ? p + 4 : (p < 12) ? p - 4 : p); const unsigned u = T2[dp * 65 + key]; e[p] = hi ? (u >> 16) : (u & 0xffffu); }
            dst[2 * G] = (u32x4){e[0] | (e[1] << 16), e[2] | (e[3] << 16), e[4] | (e[5] << 16), e[6] | (e[7] << 16)};
            dst[2 * G + 1] = (u32x4){e[8] | (e[9] << 16), e[10] | (e[11] << 16), e[12] | (e[13] << 16), e[14] | (e[15] << 16)};
        }
        LDS_WAIT(); asm volatile("" ::: "memory");
    }
}
__device__ __forceinline__ void dma16(const void* g, LAS void* l) { __builtin_amdgcn_global_load_lds((const unsigned*)g, (LAS unsigned*)l, 16, 0, 0); }
#define ATT_NEG (-__builtin_inff())
__device__ __forceinline__ unsigned xor32u(unsigned x) { const auto r = __builtin_amdgcn_permlane32_swap(x, x, false, false); return (threadIdx.x & 32) ? r[0] : r[1]; }
__device__ __forceinline__ float xor32(float x) { return __uint_as_float(xor32u(__float_as_uint(x))); }
template <int KM>
__device__ __forceinline__ void att_fix(f32x16 (&S)[2], int dbase, unsigned maxd, bool colsel, const LAS float* dBl) {
#pragma unroll
    for (int blk = 0; blk < 2; ++blk) {
        float bv[16];
#pragma unroll
        for (int rr = 0; rr < 16; ++rr) { const int koff = 32 * blk + (rr & 3) + 8 * (rr >> 2); const unsigned di = min((unsigned)(dbase - KM * koff), 128u); bv[rr] = dBl[di]; }
#pragma unroll
        for (int rr = 0; rr < 16; ++rr) asm volatile("" : "+v"(bv[rr]));
#pragma unroll
        for (int rr = 0; rr < 16; ++rr) { const int koff = 32 * blk + (rr & 3) + 8 * (rr >> 2); const int dist = dbase - KM * koff;
            const bool ok = ((unsigned)dist < maxd) && colsel; S[blk][rr] = ok ? S[blk][rr] + bv[rr] : ATT_NEG; } }
}
template <int KM>
__device__ __forceinline__ void att_fixcb(f32x16& S, int dbase, const LAS float* dBl) {
    float bv[16];
#pragma unroll
    for (int rr = 0; rr < 16; ++rr) { const int koff = (rr & 3) + 8 * (rr >> 2); const unsigned di = min((unsigned)(dbase - KM * koff), 128u); bv[rr] = dBl[di]; }
#pragma unroll
    for (int rr = 0; rr < 16; ++rr) asm volatile("" : "+v"(bv[rr]));
#pragma unroll
    for (int rr = 0; rr < 16; ++rr) { const int koff = (rr & 3) + 8 * (rr >> 2); const int dist = dbase - KM * koff; S[rr] = (dist >= 0) ? S[rr] + bv[rr] : ATT_NEG; }
}
__device__ __forceinline__ void att_fix1(f32x16 (&S)[2], int dbase, unsigned maxd, const LAS float* bp) {
#pragma unroll
    for (int blk = 0; blk < 2; ++blk) {
        f32x4 bv[4];
#pragma unroll
        for (int q = 0; q < 4; ++q) bv[q] = *(const LAS f32x4*)(bp + 56 - 32 * blk - 8 * q);
#pragma unroll
        for (int q = 0; q < 4; ++q) asm volatile("" : "+v"(bv[q]));
#pragma unroll
        for (int rr = 0; rr < 16; ++rr) { const int koff = 32 * blk + (rr & 3) + 8 * (rr >> 2); const int dist = dbase - koff;
            S[blk][rr] = ((unsigned)dist < maxd) ? S[blk][rr] + bv[rr >> 2][3 - (rr & 3)] : ATT_NEG; } }
}
__device__ __forceinline__ void att_scores(LAS unsigned char* ktile, const int (&aoff)[4], const bf16x8 (&qf)[4], f32x16 (&S)[2]) {
#pragma unroll
    for (int blk = 0; blk < 2; ++blk)
#pragma unroll
        for (int i = 0; i < 16; ++i) S[blk][i] = 0.f;
    bf16x8 kf[2][4];
#pragma unroll
    for (int s = 0; s < 4; ++s)
#pragma unroll
        for (int blk = 0; blk < 2; ++blk) kf[blk][s] = *(const LAS bf16x8*)(ktile + blk * 4096 + aoff[s]);
#pragma unroll
    for (int s = 0; s < 4; ++s) {
        S[0] = __builtin_amdgcn_mfma_f32_32x32x16_bf16(kf[0][s], qf[s], S[0], 0, 0, 0); S[1] = __builtin_amdgcn_mfma_f32_32x32x16_bf16(kf[1][s], qf[s], S[1], 0, 0, 0);
        __builtin_amdgcn_sched_barrier(0); }
}
__device__ __forceinline__ void att_scores_init(LAS unsigned char* ktile, const int (&aoff)[4], const bf16x8 (&qf)[4], f32x16 (&S)[2], const LAS float* ip) {
#pragma unroll
    for (int blk = 0; blk < 2; ++blk)
#pragma unroll
        for (int q = 0; q < 4; ++q) { const f32x4 v = *(const LAS f32x4*)(ip + 32 * blk + 8 * q); S[blk][4 * q] = v.x; S[blk][4 * q + 1] = v.y; S[blk][4 * q + 2] = v.z; S[blk][4 * q + 3] = v.w; }
    bf16x8 kf[2][4];
#pragma unroll
    for (int s = 0; s < 4; ++s)
#pragma unroll
        for (int blk = 0; blk < 2; ++blk) kf[blk][s] = *(const LAS bf16x8*)(ktile + blk * 4096 + aoff[s]);
#pragma unroll
    for (int s = 0; s < 4; ++s) {
        S[0] = __builtin_amdgcn_mfma_f32_32x32x16_bf16(kf[0][s], qf[s], S[0], 0, 0, 0); S[1] = __builtin_amdgcn_mfma_f32_32x32x16_bf16(kf[1][s], qf[s], S[1], 0, 0, 0);
        __builtin_amdgcn_sched_barrier(0); }
}
__device__ __forceinline__ void att_pv(LAS unsigned char* vtile, const int (&aoff)[4], const f32x16 (&P)[2], f32x16 (&O)[2]) {
    bf16x8 pb[2][2];
#pragma unroll
    for (int blk = 0; blk < 2; ++blk)
#pragma unroll
        for (int s2 = 0; s2 < 2; ++s2) pb[blk][s2] = pack8f(P[blk][8 * s2], P[blk][8 * s2 + 1], P[blk][8 * s2 + 2], P[blk][8 * s2 + 3], P[blk][8 * s2 + 4], P[blk][8 * s2 + 5], P[blk][8 * s2 + 6], P[blk][8 * s2 + 7]);
#pragma unroll
    for (int dt = 0; dt < 2; ++dt)
#pragma unroll
        for (int blk = 0; blk < 2; ++blk)
#pragma unroll
            for (int s2 = 0; s2 < 2; ++s2) { const bf16x8 A = *(const LAS bf16x8*)(vtile + dt * 4096 + aoff[2 * blk + s2]); O[dt] = __builtin_amdgcn_mfma_f32_32x32x16_bf16(A, pb[blk][s2], O[dt], 0, 0, 0); }
}
#define ATT_LHI 1.8446744e19f
#define ATT_TBL_NEG (4 * 2832)
#define ATT_TBL_ZERO (4 * 2832 + 64)
__device__ __forceinline__ float att_colmax(const f32x16 (&S)[2]) {
    float mx = S[0][0];
#pragma unroll
    for (int blk = 0; blk < 2; ++blk)
#pragma unroll
        for (int rr = 0; rr < 16; ++rr) mx = fmaxf(mx, S[blk][rr]);
    return fmaxf(mx, xor32(mx));
}
__device__ __forceinline__ void att_tile(LAS unsigned char* tile, const int (&aoff)[4], const bf16x8 (&qf)[4], f32x16 (&O)[2], float& m, float& l, bool& pending, bool& shifted,
                                         int fixmode, int dbase, bool colsel, const LAS float* dBl, const LAS float* tblbase) {
    f32x16 S[2];
    const LAS float* ip = colsel ? (fixmode == 2 ? dBl - dbase : tblbase + ATT_TBL_ZERO) : tblbase + ATT_TBL_NEG;
    if (fixmode == 0) att_scores(tile, aoff, qf, S); else att_scores_init(tile, aoff, qf, S, ip);
    if (shifted) { S[0] = S[0] - m; S[1] = S[1] - m; }
    if (pending) {
        const float mxc = att_colmax(S); const float dl = (mxc > -1e29f && fabsf(mxc) > 32.f) ? mxc : 0.f;
        if (__any(dl != 0.f)) { m += dl; S[0] = S[0] - dl; S[1] = S[1] - dl; shifted = true; }
        pending = false;
    }
    float ln = l;
#pragma unroll
    for (int blk = 0; blk < 2; ++blk)
#pragma unroll
        for (int rr = 0; rr < 16; ++rr) { const float p = __builtin_amdgcn_exp2f(S[blk][rr]); S[blk][rr] = p; ln += p; }
    if (__any(ln > ATT_LHI)) {
        if (fixmode == 0) att_scores(tile, aoff, qf, S); else att_scores_init(tile, aoff, qf, S, ip);
        if (shifted) { S[0] = S[0] - m; S[1] = S[1] - m; }
        const float mxc = att_colmax(S), lnc = fmaxf(ln, xor32(ln));
        const float dl = (lnc > ATT_LHI) ? fmaxf(mxc, 32.f) : 0.f, corr = __builtin_amdgcn_exp2f(-dl);
        m += dl; l *= corr; O[0] = O[0] * corr; O[1] = O[1] * corr; S[0] = S[0] - dl; S[1] = S[1] - dl; shifted = true;
        ln = l;
#pragma unroll
        for (int blk = 0; blk < 2; ++blk)
#pragma unroll
            for (int rr = 0; rr < 16; ++rr) { const float p = __builtin_amdgcn_exp2f(S[blk][rr]); S[blk][rr] = p; ln += p; }
    }
    l = ln;
    att_pv(tile + 8192, aoff, S, O);
}
__device__ const unsigned char ATT_QOFF[16] = {29, 2, 18, 29, 2, 8, 26, 6, 26, 13, 18, 19, 8, 13, 6, 19};
__device__ __forceinline__ void phase_attn(const Fr& F, const Args& a) {
    unsigned char* ws = a.ws;
    const bf16_t* QB = (const bf16_t*)(ws + WS_Q); const unsigned char* KV = ws + WS_KV; const unsigned char* VT = (const unsigned char*)a.out; const float* GT = (const float*)(ws + WS_GATES);
    const unsigned char* KCB = ws + WS_KCB; const unsigned char* VCT = ws + WS_VCT; bf16_t* OB = (bf16_t*)(ws + WS_OATT);
    LAS unsigned char* RING = F.lds; LAS unsigned char* CMPA = F.lds + 65536; LAS float* dB = (LAS float*)(F.lds + 98304);
    const int w = F.wave, lane = F.lane, r = lane & 31, h = lane >> 5, hh = lane & 3, tl = r >> 2, swz = (r >> 1) & 7;
    int aoff[4];
#pragma unroll
    for (int s = 0; s < 4; ++s) aoff[s] = r * 128 + (((2 * s + h) ^ swz) * 16);
    const int drow = 8 * w + (lane >> 3), dchunk = ((lane & 7) ^ ((drow >> 1) & 7)) * 16;
    const LAS float* dBl = dB + hh * 132;
    LAS float* DB4 = (LAS float*)(F.lds + 102400);
    const LAS float* dB4l = DB4 + hh * 2832 + (tl & 3) * 708 + (tl & 3) + 576;
    int gprev = -1;
    const bool xcdord = F.G == 256;
    for (int unit = blockIdx.x, uk = 0; xcdord ? uk < 16 : unit < 4096; unit += F.G, ++uk) {
        const int qrot = (int)((blockIdx.x >> 3) + ATT_QOFF[uk & 15]) & 31;
        const int bg = xcdord ? (int)(blockIdx.x & 7) + 8 * uk : unit & 127, qt = xcdord ? (((42232u >> (uk & 15)) & 1u) ? 31 - qrot : qrot) : (unit >> 7) ^ ((unit >> 8) & 1);
        const int b = bg >> 2, g = bg & 3, t0 = 64 * qt;
        __syncthreads();
        if (g != gprev) for (int i = F.tid; i < 4 * 129; i += 512) { const int hq = i / 129, d = i % 129;
            dB[hq * 132 + d] = (d < 128) ? (a.in[I_RELB][BKT[d] * 16 + 4 * g + hq] - a.in[I_RELB][31 * 16 + 4 * g + hq]) * 1.44269504089f : 0.f; }
        if (g != gprev) for (int i = F.tid; i < 4 * 2832 + 128; i += 512) { const int hq = i / 2832, rem = i % 2832, cc = rem / 708, d = 576 - (rem % 708 - cc);
            float v;
            if (i >= 4 * 2832) v = (i < 4 * 2832 + 64) ? ATT_NEG : 0.f;
            else v = (d < 0 || d >= 512) ? ATT_NEG : (d < 128 ? (a.in[I_RELB][BKT[d] * 16 + 4 * g + hq] - a.in[I_RELB][31 * 16 + 4 * g + hq]) * 1.44269504089f : 0.f);
            DB4[i] = v; }
        gprev = g;
        const unsigned char* kwin = KV + ((size_t)(b * SEQ) * 1536 + (16 + g) * 64) * 2; const unsigned char* ksel = KV + ((size_t)(b * SEQ) * 1536 + (8 + g) * 64) * 2;
        const unsigned char* vsel = VT + ((size_t)((b * 2 + 0) * 4 + g) * 64) * 4096; const unsigned char* vwin = VT + ((size_t)((b * 2 + 1) * 4 + g) * 64) * 4096;
        const int nwin = min(qt, 8) + 1, ktlo = qt - nwin + 1, nst = nwin + qt + 1, ncmp = (qt >= 16) ? 2 : 1;
#define ATT_STAGE(i_, buf_) do { const int _i = (i_); const bool _isw = _i < nwin; const int _kt = _isw ? qt - _i : _i - nwin; \
            const unsigned char* _kp = (_isw ? kwin : ksel) + ((size_t)(64 * _kt + drow) * 1536) * 2 + dchunk; \
            const unsigned char* _vp = (_isw ? vwin : vsel) + (size_t)drow * 4096 + (size_t)_kt * 128 + dchunk; \
            dma16(_kp, (buf_) + w * 1024); dma16(_vp, (buf_) + 8192 + w * 1024); } while (0)
        for (int i = 0; i < ncmp; ++i) { dma16(KCB + ((size_t)(bg * 128 + 64 * i + drow) * 64) * 2 + dchunk, CMPA + i * 8192 + w * 1024);
            dma16(VCT + ((size_t)(bg * 64 + drow) * 128) * 2 + i * 128 + dchunk, CMPA + 16384 + i * 8192 + w * 1024); }
        const int tcol = t0 + 8 * w + tl; const size_t mtok = (size_t)b * SEQ + tcol; const int head = 4 * g + hh;
        bf16x8 qf[4];
#pragma unroll
        for (int s = 0; s < 4; ++s) qf[s] = *(const bf16x8*)(QB + mtok * 1024 + head * 64 + 16 * s + 8 * h);
        const float g0 = GT[mtok * 48 + head * 3 + 0], g1 = GT[mtok * 48 + head * 3 + 1], g2 = GT[mtok * 48 + head * 3 + 2];
        asm volatile("s_waitcnt vmcnt(0)" ::: "memory"); __syncthreads();
        ATT_STAGE(0, RING); ATT_STAGE(1, RING + 16384); if (nst > 2) ATT_STAGE(2, RING + 32768);
        f32x16 OUT[2], O[2];
        unsigned selmask;
        {
            f32x16 C[4];
            att_scores(CMPA, aoff, qf, *(f32x16 (*)[2])&C[0]);
            if (ncmp == 2) att_scores(CMPA + 8192, aoff, qf, *(f32x16 (*)[2])&C[2]);
            else {
#pragma unroll
                for (int i = 0; i < 16; ++i) { C[2][i] = ATT_NEG; C[3][i] = ATT_NEG; } }
#pragma unroll
            for (int cb = 0; cb < 4; ++cb) { const int tw = t0 + 8 * w, lo = tw - 31 - 16 * (32 * cb + 31), hi = tw + 7 - 31 - 512 * cb;
                if (cb < 2 * ncmp && lo < 128) {
                    if (hi < 0) {
#pragma unroll
                        for (int i = 0; i < 16; ++i) C[cb][i] = ATT_NEG; }
                    else att_fixcb<16>(C[cb], tcol - 31 - 64 * h - 512 * cb, dBl); } }
            float mx = C[0][0];
#pragma unroll
            for (int cb = 0; cb < 4; ++cb)
#pragma unroll
                for (int rr = 0; rr < 16; ++rr) mx = fmaxf(mx, C[cb][rr]);
            mx = fmaxf(mx, xor32(mx)); mx = fmaxf(mx, -1e30f);
            float ls = 0.f;
#pragma unroll
            for (int cb = 0; cb < 4; ++cb)
#pragma unroll
                for (int rr = 0; rr < 16; ++rr) { const float p = __builtin_amdgcn_exp2f(C[cb][rr] - mx); C[cb][rr] = p; ls += p; }
            ls += xor32(ls);
            const float inv = ls > 0.f ? 1.f / ls : 0.f;
#pragma unroll
            for (int cb = 0; cb < 4; ++cb) C[cb] = C[cb] * inv;
#pragma unroll
            for (int i = 0; i < 16; ++i) { OUT[0][i] = 0.f; OUT[1][i] = 0.f; }
            att_pv(CMPA + 16384, aoff, *(const f32x16 (*)[2])&C[0], OUT);
            if (ncmp == 2) att_pv(CMPA + 16384 + 8192, aoff, *(const f32x16 (*)[2])&C[2], OUT);
            OUT[0] = OUT[0] * g0; OUT[1] = OUT[1] * g0;
            if (qt <= 7) selmask = (2u << qt) - 1u;
            else {
                float imp[16], lastv[16];
#pragma unroll
                for (int cb = 0; cb < 4; ++cb)
#pragma unroll
                    for (int rq = 0; rq < 4; ++rq) { imp[4 * cb + rq] = (C[cb][4 * rq] + C[cb][4 * rq + 1]) + (C[cb][4 * rq + 2] + C[cb][4 * rq + 3]); lastv[4 * cb + rq] = C[cb][4 * rq + 3]; }
                unsigned key[16];
#pragma unroll
                for (int q = 0; q < 16; ++q) lastv[q] = xor32(lastv[q]);
#pragma unroll
                for (int q = 0; q < 16; ++q) { const float prev = (q >= 1) ? lastv[q - 1] : 0.f; float v = imp[q] + (h ? lastv[q] : prev);
                    v += dppf<DPP_XOR1>(v); v += dppf<DPP_XOR2>(v);
                    const int j = 2 * q + h; const bool cand = (j >= 1) && (j <= qt - 2);
                    key[q] = cand ? ((__builtin_bit_cast(unsigned, v) & ~31u) | (unsigned)(31 - j)) : 0u; }
                selmask = 1u | (1u << qt) | (1u << (qt - 1));
#pragma unroll 1
                for (int rnd = 0; rnd < 5; ++rnd) {
                    unsigned best = 0u;
#pragma unroll
                    for (int q = 0; q < 16; ++q) best = max(best, key[q]);
                    best = max(best, xor32u(best));
                    if (best != 0u) selmask |= 1u << (31 - (best & 31u));
#pragma unroll
                    for (int q = 0; q < 16; ++q) key[q] = (key[q] == best) ? 0u : key[q];
                }
            }
        }
        unsigned wor = selmask; wor |= (unsigned)__shfl_xor((int)wor, 4); wor |= (unsigned)__shfl_xor((int)wor, 8); wor |= (unsigned)__shfl_xor((int)wor, 16);
        wor = (unsigned)__builtin_amdgcn_readfirstlane((int)wor);
        unsigned wand = selmask; wand &= (unsigned)__shfl_xor((int)wand, 4); wand &= (unsigned)__shfl_xor((int)wand, 8); wand &= (unsigned)__shfl_xor((int)wand, 16);
        wand = (unsigned)__builtin_amdgcn_readfirstlane((int)wand);
        float m = 0.f, l = 0.f; bool pending = true, shifted = false;
        unsigned wall = 0xffffffffu; asm volatile("" : "+s"(wall));
#pragma unroll
        for (int i = 0; i < 16; ++i) { O[0][i] = 0.f; O[1][i] = 0.f; }
#define ATT_FINALIZE(gate_) do { const float _lt = l + xor32(l); const float _sc = _lt > 0.f ? (gate_) / _lt : 0.f; \
            OUT[0] = OUT[0] + O[0] * _sc; OUT[1] = OUT[1] + O[1] * _sc; m = 0.f; l = 0.f; pending = true; shifted = false; \
            _Pragma("unroll") for (int _i = 0; _i < 16; ++_i) { O[0][_i] = 0.f; O[1][_i] = 0.f; } } while (0)
#define ATT_TILE_SYNC(i_) do { const int _ahead = nst - 1 - (i_); \
            if (_ahead >= 2) asm volatile("s_waitcnt vmcnt(4) lgkmcnt(0)" ::: "memory"); else if (_ahead == 1) asm volatile("s_waitcnt vmcnt(2) lgkmcnt(0)" ::: "memory"); else asm volatile("s_waitcnt vmcnt(0) lgkmcnt(0)" ::: "memory"); \
            __builtin_amdgcn_s_barrier(); asm volatile("" ::: "memory"); \
            if ((i_) + 3 < nst) ATT_STAGE((i_) + 3, RING + (((i_) + 3) & 3) * 16384); } while (0)
#pragma unroll 1
        for (int i = 0; i < nwin; ++i) {
            ATT_TILE_SYNC(i);
            const int kt = qt - i; const int fm = (kt >= qt - 2 || kt == qt - 8) ? 2 : 0;
            if ((wall >> i) & 1u)
            att_tile(RING + (i & 3) * 16384, aoff, qf, O, m, l, pending, shifted, fm, tcol - 64 * kt - 4 * h, true, dB4l, DB4);
        }
        ATT_FINALIZE(g2);
#pragma unroll 1
        for (int i = nwin; i < nst; ++i) {
            ATT_TILE_SYNC(i);
            const int j = i - nwin;
            if ((wor >> j) & 1u) { const bool cs = (selmask >> j) & 1u; const int fm = (j >= qt - 2) ? 2 : (((wand >> j) & 1u) ? 0 : 1);
                att_tile(RING + (i & 3) * 16384, aoff, qf, O, m, l, pending, shifted, fm, tcol - 64 * j - 4 * h, cs, dB4l, DB4); }
        }
#undef ATT_TILE_SYNC
        ATT_FINALIZE(g1);
        bf16_t* orow = OB + mtok * 1024 + head * 64 + 4 * h;
#pragma unroll
        for (int dt = 0; dt < 2; ++dt)
#pragma unroll
            for (int rq = 0; rq < 4; ++rq) { u32x2 v; v.x = cvtpk(OUT[dt][4 * rq], OUT[dt][4 * rq + 1]); v.y = cvtpk(OUT[dt][4 * rq + 2], OUT[dt][4 * rq + 3]); *(u32x2*)(orow + 32 * dt + 8 * rq) = v; }
#undef ATT_STAGE
#undef ATT_FINALIZE
    }
}
constexpr int LDS_BYTES = 155648;
constexpr int LDS_MISC = LDS_BYTES - 256;
constexpr int NPH = 21;

__global__ void __launch_bounds__(512, 2) fwd(Args a) {
    extern __shared__ __attribute__((aligned(16))) unsigned char lds_raw[];
    Fr F; F.lds = (LAS unsigned char*)lds_raw; F.tid = threadIdx.x; F.lane = F.tid & 63; F.wave = __builtin_amdgcn_readfirstlane(F.tid >> 6); F.G = gridDim.x;
    F.gw = blockIdx.x * 8 + F.wave; F.ngw = F.G * 8;
    unsigned char* ws = a.ws;
    volatile LAS unsigned* MISC = (volatile LAS unsigned*)(F.lds + LDS_MISC);
    if (F.tid < 64) MISC[F.tid] = 0u;
    __syncthreads();
    const int lo = a.ph_lo, hi = a.ph_hi;
    XcdBarrier bar; bar.bar = (unsigned*)(ws + WS_CTL) + CW_BAR; bar.x = 0; bar.st = nullptr;
    if (hi - lo > 1) bar = xcd_barrier_post((unsigned*)(ws + WS_CTL) + CW_BAR, MISC + 8);


#ifndef REPEAT_MASK
#define REPEAT_MASK 0u
#endif
#ifdef ONLY_PH
#define IN(k) ((k) == ONLY_PH && lo <= (k) && (k) < hi)
#else
#define IN(k) (lo <= (k) && (k) < hi)
#endif
#define REP(k) for (int _rep = 0; _rep < (((REPEAT_MASK >> (k)) & 1u) ? 2 : 1); ++_rep)
#define SEAM(k) do { if (IN(k) && IN((k) + 1)) xcd_barrier(bar); } while (0)
    using namespace pg8;
    const int c = (int)blockIdx.x;

    if (IN(0)) { phase_conv(F, a); if ((REPEAT_MASK >> 30) & 1u) { __syncthreads(); phase_conv(F, a); } phase_r1(F, a); if ((REPEAT_MASK >> 31) & 1u) { __syncthreads(); phase_r1(F, a); } }
    SEAM(0);
    if (IN(1)) REP(1) {
        { Gemm g{(const bf16_t*)(ws + WS_S0), (const bf16_t*)(ws + WS_WR), 1024, 1024, 0, 1 << 20, nullptr, 0}; StaticOrder S; S.init(NT, 1024, F.G, c); EpiBf16 E{(bf16_t*)(ws + WS_S3), 1024, 1.f, 1}; gemm_phase(F.lds, g, S, E);
#ifdef DUP_P1
        gemm_phase(F.lds, g, S, E);
#endif
        }
        { Gemm g{(const bf16_t*)(ws + WS_S1), (const bf16_t*)(ws + WS_WK), 1024, 1024, 0, 1 << 20, nullptr, 0}; StaticOrder S; S.init(NT, 1024, F.G, c); EpiBf16 E{(bf16_t*)(ws + WS_S4), 1024, 1.f, 1}; gemm_phase(F.lds, g, S, E); }
        { Gemm g{(const bf16_t*)(ws + WS_S2), (const bf16_t*)(ws + WS_WV), 1024, 1024, 0, 1 << 20, nullptr, 0}; StaticOrder S; S.init(NT, 1024, F.G, c); EpiBf16 E{(bf16_t*)a.out, 1024, 1.f, 1}; gemm_phase(F.lds, g, S, E); }
        { Gemm g{(const bf16_t*)(ws + WS_S5), (const bf16_t*)(ws + WS_WL1), 2048, 1024, 1, 16, nullptr, 0}; StaticOrder S; S.init(NT, 512, F.G, c); EpiLora1 E{(bf16_t*)((unsigned char*)a.out + 128 * MiB)}; gemm_phase(F.lds, g, S, E); }
    }
    SEAM(1);
    if (IN(2)) REP(2) {
        const bf16_t* T1 = (const bf16_t*)((unsigned char*)a.out + 128 * MiB);
        { int kwa = 128; asm volatile("" : "+s"(kwa));
          Gemm g{T1, (const bf16_t*)(ws + WS_W2WA), kwa, 512, 0, 1 << 20, nullptr, 0}; StaticOrder S; S.init(NT, 2048, F.G, c); EpiLora2WA E{(bf16_t*)(ws + WS_S0), (bf16_t*)(ws + WS_S1), a.in[I_AW0], a.in[I_AA0]}; gemm_phase(F.lds, g, S, E); }
        { Gemm g{T1 + 128, (const bf16_t*)(ws + WS_W2G), 256, 512, 0, 1 << 20, nullptr, 0}; StaticOrder S; S.init(NT, 1024, F.G, c); EpiBf16 E{(bf16_t*)(ws + WS_S2), 1024, 1.f, 1}; gemm_phase(F.lds, g, S, E); }
    }
    SEAM(2);
    if (IN(3)) REP(3) phase_scan(F, a);
    SEAM(3);
    if (IN(4)) REP(4) { Gemm g{(const bf16_t*)(ws + WS_S5), (const bf16_t*)(ws + WS_WO), 1024, 64, 0, 1 << 20, nullptr, 1}; StaticOrder S; S.init(NT, 1024, F.G, c); EpiResX E{a.in[I_X], (bf16_t*)(ws + WS_H)}; gemm_phase(F.lds, g, S, E);
#ifdef DUP_PH4
        gemm_phase(F.lds, g, S, E);
#endif
    }
    SEAM(4);
#define MOE_PHASES(layer, pb) \
    if (IN(pb)) phase_m1(F, a, layer); \
    SEAM(pb); \
    if (IN((pb) + 1)) phase_m2(F, a, layer); \
    SEAM((pb) + 1); \
    if (IN((pb) + 2)) REP((pb) + 2) { const int* texp = (const int*)(ws + WS_TEXP); Gemm g{(const bf16_t*)(ws + WS_H), (const bf16_t*)(ws + WS_BT1) + (size_t)(layer) * 32 * 1024 * 1024, 1024, 1024, 0, 1 << 20, (const int*)(ws + WS_RIDX), 0}; \
        MoeOrder S; S.init(texp, F.G, c); EpiMoe1 E{(bf16_t*)(ws + WS_S4), (const float*)(ws + WS_ROWRS)}; gemm_phase<EpiMoe1, MoeOrder, true>(F.lds, g, S, E); } \
    SEAM((pb) + 2); \
    if (IN((pb) + 3)) REP((pb) + 3) { const int* texp = (const int*)(ws + WS_TEXP); Gemm g{(const bf16_t*)(ws + WS_S4), (const bf16_t*)(ws + WS_BT2) + (size_t)(layer) * 32 * 1024 * 512, 512, 512, 0, 1 << 20, nullptr, 0}; \
        MoeOrder S; S.init(texp, F.G, c); EpiMoe2 E{(bf16_t*)(ws + WS_S1), (const float*)(ws + WS_ROWW)}; gemm_phase(F.lds, g, S, E); } \
    SEAM((pb) + 3);

    MOE_PHASES(0, 5)
    if (IN(9)) phase_n1(F, a);
    SEAM(9);
    if (IN(10)) { if (F.gw < 32) { const float* pp = (const float*)(ws + WS_PEBP) + F.gw * 64 + F.lane; float bs = pp[0];
#pragma unroll
            for (int kq = 1; kq < 16; ++kq) bs += pp[kq * 2048];
            ((float*)(ws + WS_PEB))[F.gw * 64 + F.lane] = bs; } }
    if (IN(10)) REP(10) { Gemm g{(const bf16_t*)(ws + WS_H), (const bf16_t*)(ws + WS_WKVQG), 1024, 1024, 0, 1 << 20, nullptr, 0}; StaticOrder S; S.init(NT, 2816, F.G, c);
        EpiKvqg E{(bf16_t*)(ws + WS_KV), (bf16_t*)(ws + WS_Q), (float*)(ws + WS_GATES), (const float*)(ws + WS_RSTD)}; gemm_phase(F.lds, g, S, E); }
    SEAM(10);
    if (IN(11)) { if (F.G <= 128) phase_vt(F, a, F.gw, F.ngw); }
    if (F.G <= 128) SEAM(11);
    if (IN(12)) { Gemm g{(const bf16_t*)(ws + WS_KV), (const bf16_t*)(ws + WS_WC1), 2048, 64, 0, 1 << 20, (const int*)(ws + WS_CIDX), 2}; CmpOrder S{F.G, c}; EpiCmp E{(bf16_t*)(ws + WS_HC), (const float*)(ws + WS_PEB)}; gemm_phase<EpiCmp, CmpOrder, true>(F.lds, g, S, E);
        if (F.G > 128 && c >= 128) phase_vt(F, a, (c - 128) * 8 + F.wave, (F.G - 128) * 8);
        if (F.G > 128 && c < 128) { __builtin_amdgcn_fence(__ATOMIC_ACQUIRE, "agent"); phase_cmp2(F, a, c * 16 + F.wave, 8, c * 16 + 16); } }
    if (F.G <= 128) SEAM(12);
    if (IN(13) && F.G <= 128) phase_cmp2(F, a, F.gw, F.ngw, 2048);
    SEAM(13);
    if (IN(14)) REP(14) phase_attn(F, a);
    SEAM(14);
    if (IN(15)) { Gemm g{(const bf16_t*)(ws + WS_OATT), (const bf16_t*)(ws + WS_WOB), 1024, 1024, 0, 1 << 20, nullptr, 0}; StaticOrder S; S.init(NT, 1024, F.G, c); EpiResH E{(bf16_t*)(ws + WS_H)}; gemm_phase(F.lds, g, S, E); }
    SEAM(15);
    MOE_PHASES(1, 16)
    if (IN(20)) phase_final(F, a);
#undef IN
#undef SEAM
}

extern "C" void kernel_launch(void* const* d_in, const int* in_sizes, int n_in, void* d_out, int out_size, void* d_ws, size_t ws_size, hipStream_t stream) {
    static int grid = 0;
    if (grid == 0) {
        if (n_in != 41 || out_size != NT * DM || ws_size < WS_NEED) { fprintf(stderr, "kernel_launch: unexpected problem (n_in %d, out %d, ws %zu); nothing launched\n", n_in, out_size, ws_size); grid = -1; return; }
        int dev = 0, cus = 0, per_cu = 0;
        if (hipGetDevice(&dev) != hipSuccess || hipDeviceGetAttribute(&cus, hipDeviceAttributeMultiprocessorCount, dev) != hipSuccess) { grid = -1; return; }
        if (hipFuncSetAttribute((const void*)fwd, hipFuncAttributeMaxDynamicSharedMemorySize, LDS_BYTES) != hipSuccess) { fprintf(stderr, "kernel_launch: hipFuncSetAttribute failed\n"); grid = -1; return; }
        if (hipOccupancyMaxActiveBlocksPerMultiprocessor(&per_cu, (const void*)fwd, 512, LDS_BYTES) != hipSuccess || per_cu < 1)
            fprintf(stderr, "kernel_launch: occupancy query reports %d workgroups per CU\n", per_cu);
        (void)hipGetLastError();
        grid = cus;
    }
    if (grid < 0) return;
    (void)hipMemsetAsync((char*)d_ws + WS_CTL, 0, CTL_BYTES, stream);
    Args a{};
    for (int i = 0; i < 41; ++i) a.in[i] = (const float*)d_in[i];
    a.out = (float*)d_out; a.ws = (unsigned char*)d_ws;
#if N_LAUNCH_MODE == 1
    a.ph_lo = 0; a.ph_hi = NPH;
    hipLaunchKernelGGL(fwd, dim3(grid), dim3(512), LDS_BYTES, stream, a);
#else
    for (int p = 0; p < NPH; ++p) { a.ph_lo = p; a.ph_hi = p + 1; hipLaunchKernelGGL(fwd, dim3(grid), dim3(512), LDS_BYTES, stream, a); }
#endif
}
```
